# Optimizing an MI355X kernel written in HIP

```python
import math
import jax, jax.numpy as jnp
from jax import lax
import numpy as np

D_MODEL = 1024
BATCH = 16
SEQ = 2048
DEPTH = 2

MEM_LEN = 256
GRID_W = 64
Q_BLOCK = 128
ROPE_THETA = 10000.0
NORM_EPS = 1e-6

DIFF_HEADS = 4
DIFF_HEAD_DIM = 64
MLA_HEADS = 8
MLA_Q_RANK = 256
MLA_KV_RANK = 128
MLA_NOPE_DIM = 64
MLA_ROPE_DIM = 32
MLA_V_DIM = 64
GQA_HEADS = 8
GQA_KV_HEADS = 2
GQA_HEAD_DIM = 64
MEM_HEADS = 4
MEM_HEAD_DIM = 128

N_BRANCHES = 4
BRANCH_WIDTH = 512

DIFF_Q_COLS = 2 * DIFF_HEADS * DIFF_HEAD_DIM
DIFF_K_COLS = 2 * DIFF_HEADS * DIFF_HEAD_DIM
DIFF_V_COLS = DIFF_HEADS * 2 * DIFF_HEAD_DIM
GQA_Q_COLS = GQA_HEADS * GQA_HEAD_DIM
GQA_KV_COLS = GQA_KV_HEADS * GQA_HEAD_DIM
MEM_Q_COLS = MEM_HEADS * MEM_HEAD_DIM
IN_COL_SIZES = (DIFF_Q_COLS, DIFF_K_COLS, DIFF_V_COLS,
                MLA_Q_RANK, MLA_KV_RANK, MLA_ROPE_DIM,
                GQA_Q_COLS, GQA_KV_COLS, GQA_KV_COLS,
                MEM_Q_COLS)
IN_COLS = 3232

FFN_DIM = 3584
N_EXPERTS = 8
TOP_K = 2
MOE_ROWS = 512
N_DENSE = (DEPTH + 1) // 2
N_MOE = DEPTH // 2

kernel_name = 'hybrid_gated_encoder'


def rms_norm(x, g):
    xf = x.astype(jnp.float32)
    y = xf * lax.rsqrt(jnp.mean(xf * xf, axis=-1, keepdims=True) + NORM_EPS)
    return (y * g.astype(jnp.float32)).astype(x.dtype)


def rope_angles(pos, dim):
    inv_freq = 1.0 / (ROPE_THETA ** (jnp.arange(0, dim, 2, dtype=jnp.float32) / dim))
    return pos.astype(jnp.float32)[:, None] * inv_freq[None, :]


def apply_rope(x, ang):
    half = x.shape[-1] // 2
    shape = (ang.shape[0],) + (1,) * (x.ndim - 3) + (half,)
    cos = jnp.cos(ang).reshape(shape)
    sin = jnp.sin(ang).reshape(shape)
    xf = x.astype(jnp.float32)
    x1, x2 = xf[..., :half], xf[..., half:]
    return jnp.concatenate([x1 * cos - x2 * sin, x2 * cos + x1 * sin], axis=-1).astype(x.dtype)


def apply_axial_rope(x, ang_row, ang_col):
    half = x.shape[-1] // 2
    return jnp.concatenate([apply_rope(x[..., :half], ang_row),
                            apply_rope(x[..., half:], ang_col)], axis=-1)


def sweep_query_blocks(q, block_fn):
    B, S = q.shape[:2]
    nb = S // Q_BLOCK
    qb = jnp.moveaxis(q.reshape((B, nb, Q_BLOCK) + q.shape[2:]), 1, 0)
    out = lax.map(block_fn, qb)
    out = jnp.moveaxis(out, 0, 1)
    return out.reshape((B, S) + out.shape[3:])


def mha_blocks(q, k, v):
    scale = q.shape[-1] ** -0.5

    def block(qb):
        s = jnp.einsum('bqhd,bkhd->bhqk', qb, k, preferred_element_type=jnp.float32) * scale
        p = jax.nn.softmax(s, axis=-1)
        return jnp.einsum('bhqk,bkhe->bqhe', p.astype(v.dtype), v)

    return sweep_query_blocks(q, block)


def diff_attention(q, k, v, q_g, k_g, lam_params, subln_g, lambda_init, ang):
    B, S = q.shape[:2]
    q = apply_rope(rms_norm(q.reshape(B, S, 2 * DIFF_HEADS, DIFF_HEAD_DIM), q_g), ang)
    k = apply_rope(rms_norm(k.reshape(B, S, 2 * DIFF_HEADS, DIFF_HEAD_DIM), k_g), ang)
    v = v.reshape(B, S, DIFF_HEADS, 2 * DIFF_HEAD_DIM)
    lp = lam_params.astype(jnp.float32)
    lam = jnp.exp(jnp.sum(lp[0] * lp[1])) - jnp.exp(jnp.sum(lp[2] * lp[3])) + lambda_init
    scale = DIFF_HEAD_DIM ** -0.5

    def block(qb):
        s = jnp.einsum('bqhd,bkhd->bhqk', qb, k, preferred_element_type=jnp.float32) * scale
        p = jax.nn.softmax(s, axis=-1).reshape(B, DIFF_HEADS, 2, qb.shape[1], S)
        a = p[:, :, 0] - lam * p[:, :, 1]
        return jnp.einsum('bhqk,bkhe->bqhe', a.astype(v.dtype), v)

    o = sweep_query_blocks(q, block)
    o = rms_norm(o, subln_g) * (1.0 - lambda_init)
    return o.reshape(B, S, BRANCH_WIDTH)


def latent_attention(q_lat, kv_lat, k_rope, q_lat_g, kv_lat_g, w_q_up, w_kv_up, q_g, k_g, ang):
    B, S = q_lat.shape[:2]
    q = (rms_norm(q_lat, q_lat_g) @ w_q_up).reshape(B, S, MLA_HEADS, MLA_NOPE_DIM + MLA_ROPE_DIM)
    kv = (rms_norm(kv_lat, kv_lat_g) @ w_kv_up).reshape(B, S, MLA_HEADS, MLA_NOPE_DIM + MLA_V_DIM)
    k_nope, v = kv[..., :MLA_NOPE_DIM], kv[..., MLA_NOPE_DIM:]
    k_r = jnp.broadcast_to(k_rope[:, :, None, :], (B, S, MLA_HEADS, MLA_ROPE_DIM))
    k = jnp.concatenate([k_nope, k_r], axis=-1)
    q = rms_norm(q, q_g)
    k = rms_norm(k, k_g)
    q = jnp.concatenate([q[..., :MLA_NOPE_DIM], apply_rope(q[..., MLA_NOPE_DIM:], ang)], axis=-1)
    k = jnp.concatenate([k[..., :MLA_NOPE_DIM], apply_rope(k[..., MLA_NOPE_DIM:], ang)], axis=-1)
    o = mha_blocks(q, k, v)
    return o.reshape(B, S, BRANCH_WIDTH)


def axial_gqa(q, k, v, q_g, k_g, ang_row, ang_col):
    B, S = q.shape[:2]
    G = GQA_HEADS // GQA_KV_HEADS
    q = apply_axial_rope(rms_norm(q.reshape(B, S, GQA_KV_HEADS, G, GQA_HEAD_DIM), q_g), ang_row, ang_col)
    k = apply_axial_rope(rms_norm(k.reshape(B, S, GQA_KV_HEADS, GQA_HEAD_DIM), k_g), ang_row, ang_col)
    v = v.reshape(B, S, GQA_KV_HEADS, GQA_HEAD_DIM)
    scale = GQA_HEAD_DIM ** -0.5

    def block(qb):
        s = jnp.einsum('bqngd,bsnd->bngqs', qb, k, preferred_element_type=jnp.float32) * scale
        p = jax.nn.softmax(s, axis=-1)
        return jnp.einsum('bngqs,bsnd->bqngd', p.astype(v.dtype), v)

    o = sweep_query_blocks(q, block)
    return o.reshape(B, S, BRANCH_WIDTH)


def memory_cross_attention(q, mem_n, w_mem_kv, q_g, k_g, ang_q, ang_m):
    B, S = q.shape[:2]
    M = mem_n.shape[1]
    q = apply_rope(rms_norm(q.reshape(B, S, MEM_HEADS, MEM_HEAD_DIM), q_g), ang_q)
    kv = (mem_n @ w_mem_kv).reshape(B, M, MEM_HEADS, 2 * MEM_HEAD_DIM)
    k = apply_rope(rms_norm(kv[..., :MEM_HEAD_DIM], k_g), ang_m)
    v = kv[..., MEM_HEAD_DIM:]
    s = jnp.einsum('bqhd,bkhd->bhqk', q, k, preferred_element_type=jnp.float32) * (MEM_HEAD_DIM ** -0.5)
    p = jax.nn.softmax(s, axis=-1)
    o = jnp.einsum('bhqk,bkhe->bqhe', p.astype(v.dtype), v)
    return o.reshape(B, S, BRANCH_WIDTH)


def swiglu(h, w1, w3, w2):
    return (jax.nn.silu(h @ w1) * (h @ w3)) @ w2


def moe_swiglu(h, w_router, w1, w3, w2):
    B, S, D = h.shape
    N = B * S
    hf = h.reshape(N, D)
    logits = jnp.matmul(hf, w_router, preferred_element_type=jnp.float32)
    top_logit, top_idx = lax.top_k(logits, TOP_K)
    gates = jax.nn.softmax(top_logit, axis=-1)
    n_assign = N * TOP_K
    flat_e = top_idx.reshape(-1).astype(jnp.int32)
    flat_tok = jnp.arange(n_assign, dtype=jnp.int32) // TOP_K
    flat_gate = gates.reshape(-1)
    order = jnp.argsort(flat_e)
    se, stok, sgate = flat_e[order], flat_tok[order], flat_gate[order]
    counts = jnp.bincount(flat_e, length=N_EXPERTS).astype(jnp.int32)
    padded = (counts + MOE_ROWS - 1) // MOE_ROWS * MOE_ROWS
    pad_end = jnp.cumsum(padded)
    pad_start = pad_end - padded
    grp_start = jnp.cumsum(counts) - counts
    slot = pad_start[se] + jnp.arange(n_assign, dtype=jnp.int32) - grp_start[se]
    n_blocks = (n_assign + N_EXPERTS * (MOE_ROWS - 1)) // MOE_ROWS
    n_slots = n_blocks * MOE_ROWS
    slot_tok = jnp.full((n_slots,), N, jnp.int32).at[slot].set(stok)
    slot_gate = jnp.zeros((n_slots,), jnp.float32).at[slot].set(sgate)
    block_start = jnp.arange(n_blocks, dtype=jnp.int32) * MOE_ROWS
    block_expert = jnp.minimum(jnp.searchsorted(pad_end, block_start, side='right'), N_EXPERTS - 1)
    h_pad = jnp.concatenate([hf, jnp.zeros((1, D), hf.dtype)], axis=0)
    xs = h_pad[slot_tok].reshape(n_blocks, MOE_ROWS, D)

    def expert_block(args):
        xb, e = args
        return swiglu(xb, w1[e], w3[e], w2[e])

    ys = lax.map(expert_block, (xs, block_expert)).reshape(n_slots, D)
    ys = ys * slot_gate[:, None].astype(ys.dtype)
    out = jax.ops.segment_sum(ys, slot_tok, num_segments=N + 1)[:N]
    return out.reshape(B, S, D)


def setup_inputs(seed: int = 0) -> dict:
    key = jax.random.key(seed)
    ks = iter(jax.random.split(key, 48))
    f32 = jnp.float32

    def nrm(shape, fan_in):
        return jax.random.normal(next(ks), shape, f32) * (fan_in ** -0.5)

    def gain(shape):
        return 1.0 + 0.02 * jax.random.normal(next(ks), shape, f32)

    D = D_MODEL
    return {
        'x': jax.random.normal(next(ks), (BATCH, SEQ, D), f32),
        'mem': jax.random.normal(next(ks), (BATCH, MEM_LEN, D), f32),
        'norm_attn_g': gain((DEPTH, D)),
        'norm_mem_g': gain((DEPTH, D)),
        'w_in': nrm((DEPTH, D, IN_COLS), D),
        'diff_q_norm_g': gain((DEPTH, DIFF_HEAD_DIM)),
        'diff_k_norm_g': gain((DEPTH, DIFF_HEAD_DIM)),
        'diff_lambda': 0.1 * jax.random.normal(next(ks), (DEPTH, 4, DIFF_HEAD_DIM), f32),
        'diff_subln_g': gain((DEPTH, 2 * DIFF_HEAD_DIM)),
        'mla_q_lat_g': gain((DEPTH, MLA_Q_RANK)),
        'mla_kv_lat_g': gain((DEPTH, MLA_KV_RANK)),
        'w_mla_q_up': nrm((DEPTH, MLA_Q_RANK, MLA_HEADS * (MLA_NOPE_DIM + MLA_ROPE_DIM)), MLA_Q_RANK),
        'w_mla_kv_up': nrm((DEPTH, MLA_KV_RANK, MLA_HEADS * (MLA_NOPE_DIM + MLA_V_DIM)), MLA_KV_RANK),
        'mla_q_norm_g': gain((DEPTH, MLA_NOPE_DIM + MLA_ROPE_DIM)),
        'mla_k_norm_g': gain((DEPTH, MLA_NOPE_DIM + MLA_ROPE_DIM)),
        'gqa_q_norm_g': gain((DEPTH, GQA_HEAD_DIM)),
        'gqa_k_norm_g': gain((DEPTH, GQA_HEAD_DIM)),
        'w_mem_kv': nrm((DEPTH, D, 2 * MEM_HEADS * MEM_HEAD_DIM), D),
        'mem_q_norm_g': gain((DEPTH, MEM_HEAD_DIM)),
        'mem_k_norm_g': gain((DEPTH, MEM_HEAD_DIM)),
        'w_branch': nrm((DEPTH, N_BRANCHES, BRANCH_WIDTH, D), BRANCH_WIDTH),
        'w_gate': nrm((DEPTH, N_BRANCHES, D, D), D),
        'b_gate': 0.02 * jax.random.normal(next(ks), (DEPTH, N_BRANCHES, D), f32),
        'w_out': nrm((DEPTH, D, D), D),
        'norm_ffn_g': gain((DEPTH, D)),
        'dense_w1': nrm((N_DENSE, D, FFN_DIM), D),
        'dense_w3': nrm((N_DENSE, D, FFN_DIM), D),
        'dense_w2': nrm((N_DENSE, FFN_DIM, D), FFN_DIM),
        'moe_router': nrm((N_MOE, D, N_EXPERTS), D),
        'moe_w1': nrm((N_MOE, N_EXPERTS, D, FFN_DIM), D),
        'moe_w3': nrm((N_MOE, N_EXPERTS, D, FFN_DIM), D),
        'moe_w2': nrm((N_MOE, N_EXPERTS, FFN_DIM, D), FFN_DIM),
    }


def reference(x, mem, norm_attn_g, norm_mem_g, w_in, diff_q_norm_g, diff_k_norm_g, diff_lambda,
              diff_subln_g, mla_q_lat_g, mla_kv_lat_g, w_mla_q_up, w_mla_kv_up, mla_q_norm_g,
              mla_k_norm_g, gqa_q_norm_g, gqa_k_norm_g, w_mem_kv, mem_q_norm_g, mem_k_norm_g,
              w_branch, w_gate, b_gate, w_out, norm_ffn_g, dense_w1, dense_w3, dense_w2,
              moe_router, moe_w1, moe_w3, moe_w2):
    B, S, _ = x.shape
    ROWS = S // GRID_W
    pos = jnp.arange(S, dtype=jnp.int32)
    rows = jnp.repeat(jnp.arange(ROWS, dtype=jnp.int32), GRID_W)
    cols = jnp.tile(jnp.arange(GRID_W, dtype=jnp.int32), ROWS)
    ang_diff = rope_angles(pos, DIFF_HEAD_DIM)
    ang_mla = rope_angles(pos, MLA_ROPE_DIM)
    ang_row = rope_angles(rows, GQA_HEAD_DIM // 2)
    ang_col = rope_angles(cols, GQA_HEAD_DIM // 2)
    ang_mem_q = rope_angles(pos, MEM_HEAD_DIM)
    ang_mem_k = rope_angles(jnp.arange(mem.shape[1], dtype=jnp.int32), MEM_HEAD_DIM)
    split_at = [int(c) for c in np.cumsum(IN_COL_SIZES)[:-1]]

    for layer in range(DEPTH):
        lambda_init = 0.8 - 0.6 * math.exp(-0.3 * layer)
        h = rms_norm(x, norm_attn_g[layer])
        proj = h @ w_in[layer]
        dq, dk, dv, mq_lat, mkv_lat, mk_rope, gq, gk, gv, memq = jnp.split(proj, split_at, axis=-1)

        o_a = diff_attention(dq, dk, dv, diff_q_norm_g[layer], diff_k_norm_g[layer],
                             diff_lambda[layer], diff_subln_g[layer], lambda_init, ang_diff)
        o_b = latent_attention(mq_lat, mkv_lat, mk_rope, mla_q_lat_g[layer], mla_kv_lat_g[layer],
                               w_mla_q_up[layer], w_mla_kv_up[layer], mla_q_norm_g[layer],
                               mla_k_norm_g[layer], ang_mla)
        o_c = axial_gqa(gq, gk, gv, gqa_q_norm_g[layer], gqa_k_norm_g[layer], ang_row, ang_col)
        mem_n = rms_norm(mem, norm_mem_g[layer])
        o_d = memory_cross_attention(memq, mem_n, w_mem_kv[layer], mem_q_norm_g[layer],
                                     mem_k_norm_g[layer], ang_mem_q, ang_mem_k)

        merged = None
        for b, o in enumerate((o_a, o_b, o_c, o_d)):
            gate = jax.nn.sigmoid(h @ w_gate[layer, b] + b_gate[layer, b])
            term = gate * (o @ w_branch[layer, b])
            merged = term if merged is None else merged + term
        x = x + merged @ w_out[layer]

        h2 = rms_norm(x, norm_ffn_g[layer])
        i = layer // 2
        if layer % 2 == 0:
            ffn = swiglu(h2, dense_w1[i], dense_w3[i], dense_w2[i])
        else:
            ffn = moe_swiglu(h2, moe_router[i], moe_w1[i], moe_w3[i], moe_w2[i])
        x = x + ffn
    return x
```

```cpp
#include <hip/hip_runtime.h>
#include <cstdio>
#include <cstdint>
namespace pg8 {
#define PG8_LAS __attribute__((address_space(3)))
typedef unsigned short bf16_t;
typedef short bf16x8 __attribute__((ext_vector_type(8)));
typedef float f32x4 __attribute__((ext_vector_type(4)));
typedef float f32x2 __attribute__((ext_vector_type(2)));
typedef unsigned u32x4 __attribute__((ext_vector_type(4)));
typedef unsigned u32x2 __attribute__((ext_vector_type(2)));
constexpr int BM = 256, BK = 64, HALF = 128, HTB = HALF * BK * 2  , STAGE_BYTES = 8 * HTB, NXCD = 8, WGM = 8;

__host__ __device__ __forceinline__ int lds_byte(int r, int c) { const int st = (r >> 4) * 2 + (c >> 5), rr = r & 15, cc = c & 31, ob = rr * 64 + cc * 2; return st * 1024 + (ob ^ (((ob >> 9) & 1) << 5)); }
__host__ __device__ __forceinline__ void stage_rc(int b, int& R, int& C) { const int st = b / 1024, sb = b % 1024, swz = sb ^ (((sb >> 9) & 1) << 5); R = (st >> 1) * 16 + swz / 64; C = (st & 1) * 32 + (swz % 64) / 2; }
__host__ __device__ __forceinline__ int perm32(int rho) { const int n = rho >> 4, i = rho & 15; return 8 * (i >> 2) + 4 * n + (i & 3); }

struct Unit { int pm, pn, z; };
struct Gemm { const bf16_t* A; const bf16_t* Bt; int lda, ldb, K; };

struct StaticOrder {
    int nM, nN, nwg, G, c;
    __device__ __forceinline__ void init(int nM_, int nN_, int G_, int c_) { nM = nM_; nN = nN_; nwg = nM * nN; G = G_; c = c_; }
    __device__ __forceinline__ bool tile(long L, Unit& u) const {
        if (L >= nwg) return false;
        int wgid = (int)L; { const int q = nwg / NXCD, r = nwg % NXCD, xcd = wgid % NXCD, off = wgid / NXCD; wgid = (xcd < r ? xcd * (q + 1) : r * (q + 1) + (xcd - r) * q) + off; }
        const int nig = WGM * nN, gid = wgid / nig, fm = gid * WGM, gsz = (nM - fm) < WGM ? (nM - fm) : WGM;
        u.pm = __builtin_amdgcn_readfirstlane(fm + ((wgid % nig) % gsz)); u.pn = __builtin_amdgcn_readfirstlane((wgid % nig) / gsz); u.z = 0; return true;
    }
    __device__ __forceinline__ bool next(int i, Unit& u) const { return tile((long)i * G + c, u); }
    __device__ __forceinline__ const char* a_ptr(const Gemm& g, const Unit& u) const { return (const char*)g.A + (size_t)u.pm * (BM * 2) * g.lda; }
    __device__ __forceinline__ const char* b_ptr(const Gemm& g, const Unit& u) const { return (const char*)g.Bt + (size_t)u.pn * (BM * 2) * g.ldb; }
    __device__ __forceinline__ unsigned row_off(const Gemm&, const Unit&, int) const { return 0u; }
};

typedef __bf16 bf16x2_t __attribute__((ext_vector_type(2)));
__device__ __forceinline__ unsigned cvt_pk_bf16(float lo, float hi) { f32x2 v = {lo, hi}; bf16x2_t b = __builtin_convertvector(v, bf16x2_t); return __builtin_bit_cast(unsigned, b); }
__device__ __forceinline__ float bf_lo(unsigned w) { return __uint_as_float(w << 16); }
__device__ __forceinline__ float bf_hi(unsigned w) { return __uint_as_float(w & 0xffff0000u); }
__device__ __forceinline__ float sigmoidf_(float v) { return __builtin_amdgcn_rcpf(1.0f + __builtin_amdgcn_exp2f(-1.4426950408889634f * v)); }

struct EpiBf16 {
    static constexpr bool PERM = true;
    bf16_t* O; int ldc; float scale = 1.0f;
    __device__ __forceinline__ bool keep(const Unit&) const { return false; }
    __device__ __forceinline__ void operator()(const f32x4 (&acc)[2][2][4][2], const Unit& u, int wr, int wc, int fr, int fq) const {
        const int row0 = u.pm * BM + wr * 64 + fr, col0 = u.pn * BM + wc * 32 + 8 * fq;
#pragma unroll
        for (int ai = 0; ai < 2; ++ai)
#pragma unroll
            for (int m = 0; m < 4; ++m) { bf16_t* rowp = O + (size_t)(row0 + ai * HALF + m * 16) * ldc + col0;
#pragma unroll
                for (int bj = 0; bj < 2; ++bj) { const f32x4 v0 = acc[ai][bj][m][0] * scale, v1 = acc[ai][bj][m][1] * scale;
                    u32x4 w; w.x = cvt_pk_bf16(v0[0], v0[1]); w.y = cvt_pk_bf16(v0[2], v0[3]); w.z = cvt_pk_bf16(v1[0], v1[1]); w.w = cvt_pk_bf16(v1[2], v1[3]);
                    __builtin_nontemporal_store(w, (u32x4*)(rowp + bj * HALF)); } }
    }
};
struct EpiSigmoid {
    static constexpr bool PERM = true;
    bf16_t* O; int ldc; const float* bias; float scale = 1.0f;
    __device__ __forceinline__ bool keep(const Unit&) const { return false; }
    __device__ __forceinline__ void operator()(const f32x4 (&acc)[2][2][4][2], const Unit& u, int wr, int wc, int fr, int fq) const {
        const int row0 = u.pm * BM + wr * 64 + fr, col0 = u.pn * BM + wc * 32 + 8 * fq;
        f32x4 bv[2][2];
#pragma unroll
        for (int bj = 0; bj < 2; ++bj)
#pragma unroll
            for (int n = 0; n < 2; ++n) bv[bj][n] = *(const f32x4*)(bias + col0 + bj * HALF + 4 * n);
#pragma unroll
        for (int ai = 0; ai < 2; ++ai)
#pragma unroll
            for (int m = 0; m < 4; ++m) { bf16_t* rowp = O + (size_t)(row0 + ai * HALF + m * 16) * ldc + col0;
#pragma unroll
                for (int bj = 0; bj < 2; ++bj) { const f32x4 v0 = acc[ai][bj][m][0] * scale + bv[bj][0], v1 = acc[ai][bj][m][1] * scale + bv[bj][1];
                    u32x4 w; w.x = cvt_pk_bf16(sigmoidf_(v0[0]), sigmoidf_(v0[1])); w.y = cvt_pk_bf16(sigmoidf_(v0[2]), sigmoidf_(v0[3]));
                    w.z = cvt_pk_bf16(sigmoidf_(v1[0]), sigmoidf_(v1[1])); w.w = cvt_pk_bf16(sigmoidf_(v1[2]), sigmoidf_(v1[3]));
                    __builtin_nontemporal_store(w, (u32x4*)(rowp + bj * HALF)); } }
    }
};
struct EpiSigmoidU8 {
    static constexpr bool PERM = true;
    unsigned char* O; int ldc; const float* bias; float scale;
    __device__ __forceinline__ bool keep(const Unit&) const { return false; }
    static __device__ __forceinline__ float q255(float t) { return __builtin_amdgcn_rcpf(__builtin_fmaf(fminf(__builtin_amdgcn_exp2f(t), 254.0f), 1.0f / 255.0f, 1.0f / 255.0f)); }
    __device__ __forceinline__ void operator()(const f32x4 (&acc)[2][2][4][2], const Unit& u, int wr, int wc, int fr, int fq) const {
        const int col0 = u.pn * BM + wc * 32 + 8 * fq;
        f32x4 bv[2][2];
#pragma unroll
        for (int bj = 0; bj < 2; ++bj)
#pragma unroll
            for (int n = 0; n < 2; ++n) bv[bj][n] = *(const f32x4*)(bias + col0 + bj * HALF + 4 * n) * -1.4426950408889634f;
        const float sc2 = scale * -1.4426950408889634f;
        unsigned char* tp = O + ((size_t)(u.pm * 16 + u.pn) << 16) + ((wr * 4 + wc) << 13) + (fq * 16 + fr) * 8;
#pragma unroll
        for (int ai = 0; ai < 2; ++ai)
#pragma unroll
            for (int m = 0; m < 4; ++m) {
#pragma unroll
                for (int bj = 0; bj < 2; ++bj) { const f32x4 v0 = acc[ai][bj][m][0] * sc2 + bv[bj][0], v1 = acc[ai][bj][m][1] * sc2 + bv[bj][1];
                    u32x2 w; w.x = 0u; w.y = 0u;
#pragma unroll
                    for (int e = 0; e < 4; ++e) { w.x = __builtin_amdgcn_cvt_pk_u8_f32(q255(v0[e]), e, w.x); w.y = __builtin_amdgcn_cvt_pk_u8_f32(q255(v1[e]), e, w.y); }
                    __builtin_nontemporal_store(w, (u32x2*)(tp + (((ai * 4 + m) * 2 + bj) << 9))); } }
    }
};
struct EpiSwiGLU {
    static constexpr bool PERM = true;
    bf16_t* O; int ldc; int row_base;
    __device__ __forceinline__ bool keep(const Unit&) const { return false; }
    __device__ __forceinline__ void operator()(const f32x4 (&acc)[2][2][4][2], const Unit& u, int wr, int wc, int fr, int fq) const {
        const int row0 = row_base + u.pm * BM + wr * 64 + fr, col0 = u.pn * HALF + wc * 32 + 8 * fq;
#pragma unroll
        for (int ai = 0; ai < 2; ++ai)
#pragma unroll
            for (int m = 0; m < 4; ++m) { bf16_t* rowp = O + (size_t)(row0 + ai * HALF + m * 16) * ldc + col0;
                float r[8];
#pragma unroll
                for (int n = 0; n < 2; ++n)
#pragma unroll
                    for (int j = 0; j < 4; ++j) { const float gt = acc[ai][0][m][n][j], up = acc[ai][1][m][n][j]; r[n * 4 + j] = gt * sigmoidf_(gt) * up; }
                u32x4 w; w.x = cvt_pk_bf16(r[0], r[1]); w.y = cvt_pk_bf16(r[2], r[3]); w.z = cvt_pk_bf16(r[4], r[5]); w.w = cvt_pk_bf16(r[6], r[7]);
                __builtin_nontemporal_store(w, (u32x4*)rowp); }
    }
};
__device__ __forceinline__ unsigned cvt4_fp8(float a, float b, float c, float d) { int w = __builtin_amdgcn_cvt_pk_fp8_f32(a, b, 0, false); w = __builtin_amdgcn_cvt_pk_fp8_f32(c, d, w, true); return (unsigned)w; }
struct EpiSwiGLU8 {
    static constexpr bool PERM = true;
    unsigned char* O; int ldc; float in_scale, out_scale;
    __device__ __forceinline__ bool keep(const Unit&) const { return false; }
    __device__ __forceinline__ void operator()(const f32x4 (&acc)[2][2][4][2], const Unit& u, int wr, int wc, int fr, int fq) const {
        const int row0 = u.pm * BM + wr * 64 + fr, col0 = u.pn * HALF + wc * 32 + 8 * fq;
        const float k1 = in_scale * -1.4426950408889634f, k2 = in_scale * in_scale * out_scale;
#pragma unroll
        for (int ai = 0; ai < 2; ++ai)
#pragma unroll
            for (int m = 0; m < 4; ++m) { unsigned char* rowp = O + (size_t)(row0 + ai * HALF + m * 16) * ldc + col0;
                float r[8];
#pragma unroll
                for (int n = 0; n < 2; ++n)
#pragma unroll
                    for (int j = 0; j < 4; ++j) { const float a = acc[ai][0][m][n][j], b = acc[ai][1][m][n][j];
                        r[n * 4 + j] = (a * b) * (k2 * __builtin_amdgcn_rcpf(1.0f + __builtin_amdgcn_exp2f(a * k1))); }
                u32x2 w; w.x = cvt4_fp8(r[0], r[1], r[2], r[3]); w.y = cvt4_fp8(r[4], r[5], r[6], r[7]);
                __builtin_nontemporal_store(w, (u32x2*)rowp); }
    }
};
template <bool BASE_BF, bool OUT_BF>
struct EpiResidX {
    static constexpr bool PERM = false;
    const void* base; void* out; int ldc; float scale = 1.0f;
    __device__ __forceinline__ bool keep(const Unit&) const { return false; }
    __device__ __forceinline__ void operator()(const f32x4 (&acc)[2][2][4][2], const Unit& u, int wr, int wc, int fr, int fq) const {
        const int row0 = u.pm * BM + wr * 64 + fr, col0 = u.pn * BM + wc * 32 + 4 * fq;
#pragma unroll
        for (int ai = 0; ai < 2; ++ai)
#pragma unroll
            for (int mp = 0; mp < 2; ++mp) {
                f32x4 b[2][2][2];
#pragma unroll
                for (int mm = 0; mm < 2; ++mm) { const size_t off = (size_t)(row0 + ai * HALF + (2 * mp + mm) * 16) * ldc + col0;
#pragma unroll
                    for (int bj = 0; bj < 2; ++bj)
#pragma unroll
                        for (int n = 0; n < 2; ++n) {
                            if constexpr (BASE_BF) { const u32x2 w = *(const u32x2*)((const bf16_t*)base + off + bj * HALF + n * 16);
                                b[mm][bj][n] = (f32x4){bf_lo(w.x), bf_hi(w.x), bf_lo(w.y), bf_hi(w.y)}; }
                            else b[mm][bj][n] = *(const f32x4*)((const float*)base + off + bj * HALF + n * 16); } }
#pragma unroll
                for (int mm = 0; mm < 2; ++mm) { const size_t off = (size_t)(row0 + ai * HALF + (2 * mp + mm) * 16) * ldc + col0;
#pragma unroll
                    for (int bj = 0; bj < 2; ++bj)
#pragma unroll
                        for (int n = 0; n < 2; ++n) { const f32x4 v = b[mm][bj][n] + acc[ai][bj][2 * mp + mm][n] * scale;
                            if constexpr (OUT_BF) { u32x2 w; w.x = cvt_pk_bf16(v[0], v[1]); w.y = cvt_pk_bf16(v[2], v[3]); __builtin_nontemporal_store(w, (u32x2*)((bf16_t*)out + off + bj * HALF + n * 16)); }
                            else *(f32x4*)((float*)out + off + bj * HALF + n * 16) = v; } }
                asm volatile("" ::: "memory"); }
    }
};

typedef int i32x8 __attribute__((ext_vector_type(8)));
typedef short s16x16 __attribute__((ext_vector_type(16)));
typedef float f32x8 __attribute__((ext_vector_type(8)));
template <class Epi, class Sched, bool ALIGN_EPI, bool GATHER, bool FP8 = false>
__device__ __forceinline__ void gemm_phase(PG8_LAS unsigned char* lds, const Gemm g, const Sched& S, const Epi& E, int wave0) {
    int tid; asm volatile("v_mbcnt_lo_u32_b32 %0, -1, 0\n\tv_mbcnt_hi_u32_b32 %0, -1, %0" : "=v"(tid)); tid = (tid + wave0 * 64) & 511;
    const int wid = __builtin_amdgcn_readfirstlane(tid >> 6), lane = tid & 63, wr = wid >> 2, wc = wid & 3, fr = lane & 15, fq = lane >> 4;
    int K = g.K; asm volatile("" : "+s"(K));
    const int nt = K / BK;
    unsigned voffB[2], offC[2][2], offN[2][2]; int Rr[2], Cc[2];
#pragma unroll
    for (int i = 0; i < 2; ++i) { int R, C; stage_rc(tid * 16 + i * 8192, R, C); const int Rb = Epi::PERM ? ((R & ~31) + perm32(R & 31)) : R;
        voffB[i] = (unsigned)(Rb * g.ldb + C) * 2u; Rr[i] = R; Cc[i] = C;
        offC[0][i] = (unsigned)(R * g.lda + C) * 2u; offC[1][i] = (unsigned)((R + HALF) * g.lda + C) * 2u; offN[0][i] = offC[0][i]; offN[1][i] = offC[1][i]; }
    const size_t dB64 = (size_t)64 * g.ldb * 2, dA64 = (size_t)64 * g.lda * 2, dAh = (size_t)HALF * g.lda * 2;
    const size_t kstep = (size_t)(BK * 2);
    const size_t hstepB = (size_t)HALF * g.ldb * 2;
    const unsigned ldsw = (unsigned)wid * 1024u;
    const int aoff = lds_byte(wr * 64 + fr, fq * 8), boff = lds_byte(wc * 32 + fr, fq * 8);
#define PG8_SA(b, h) (((b) * 2 + (h)) * HTB)
#define PG8_SB(b, h) ((4 + (b) * 2 + (h)) * HTB)
#define PG8_STAGE_B(bufoff, gbase) do { _Pragma("unroll") for (int _i = 0; _i < 2; ++_i) \
        __builtin_amdgcn_global_load_lds((const unsigned*)((const char*)(gbase) + (size_t)_i * dB64 + voffB[0]), (PG8_LAS unsigned*)(lds + (bufoff) + ldsw + _i * 8192), 16, 0, 0); } while (0)
#define PG8_STAGE_A(bufoff, gbase, O, h) do { _Pragma("unroll") for (int _i = 0; _i < 2; ++_i) { \
        if constexpr (GATHER) __builtin_amdgcn_global_load_lds((const unsigned*)((const char*)(gbase) + O[h][_i]), (PG8_LAS unsigned*)(lds + (bufoff) + ldsw + _i * 8192), 16, 0, 0); \
        else __builtin_amdgcn_global_load_lds((const unsigned*)((const char*)(gbase) + (size_t)(h) * dAh + (size_t)_i * dA64 + O[0][0]), (PG8_LAS unsigned*)(lds + (bufoff) + ldsw + _i * 8192), 16, 0, 0); } } while (0)
#define PG8_LD8(addr) __builtin_bit_cast(i32x8, __builtin_shufflevector(*(const PG8_LAS bf16x8*)(lds + (addr)), *(const PG8_LAS bf16x8*)(lds + (addr) + 1024), 0, 1, 2, 3, 4, 5, 6, 7, 8, 9, 10, 11, 12, 13, 14, 15))
#define PG8_LDA8(dst, b, h) do { _Pragma("unroll") for (int m = 0; m < 4; ++m) dst[m] = PG8_LD8(PG8_SA(b, h) + aoff + m * 2048); } while (0)
#define PG8_LDB8(dst, b, h) do { _Pragma("unroll") for (int n = 0; n < 2; ++n) dst[n] = PG8_LD8(PG8_SB(b, h) + boff + n * 2048); } while (0)
#define PG8_MMA8(ai, bj, At, Bt) do { __builtin_amdgcn_s_setprio(1); _Pragma("unroll") for (int m = 0; m < 4; ++m) _Pragma("unroll") for (int n = 0; n < 2; ++n) \
        asm volatile("v_mfma_f32_16x16x128_f8f6f4 %0, %1, %2, %0" : "+v"(acc[ai][bj][m][n]) : "v"(Bt[n]), "v"(At[m])); __builtin_amdgcn_s_setprio(0); } while (0)
#define PG8_LDA(dst, b, h) do { _Pragma("unroll") for (int m = 0; m < 4; ++m) _Pragma("unroll") for (int k = 0; k < 2; ++k) dst[m][k] = *(const PG8_LAS bf16x8*)(lds + PG8_SA(b, h) + aoff + m * 2048 + k * 1024); } while (0)
#define PG8_LDB(dst, b, h) do { _Pragma("unroll") for (int n = 0; n < 2; ++n) _Pragma("unroll") for (int k = 0; k < 2; ++k) dst[n][k] = *(const PG8_LAS bf16x8*)(lds + PG8_SB(b, h) + boff + n * 2048 + k * 1024); } while (0)
#define PG8_MMA(ai, bj, At, Bt) do { __builtin_amdgcn_s_setprio(1); _Pragma("unroll") for (int m = 0; m < 4; ++m) _Pragma("unroll") for (int n = 0; n < 2; ++n) _Pragma("unroll") for (int k = 0; k < 2; ++k) \
        acc[ai][bj][m][n] = __builtin_amdgcn_mfma_f32_16x16x32_bf16(Bt[n][k], At[m][k], acc[ai][bj][m][n], 0, 0, 0); __builtin_amdgcn_s_setprio(0); } while (0)
#define XLDA(b, h) do { if constexpr (FP8) PG8_LDA8(At8, b, h); else PG8_LDA(At, b, h); } while (0)
#define XLDB0(b, h) do { if constexpr (FP8) PG8_LDB8(B08, b, h); else PG8_LDB(B0, b, h); } while (0)
#define XLDB1(b, h) do { if constexpr (FP8) PG8_LDB8(B18, b, h); else PG8_LDB(B1, b, h); } while (0)
#define XMMA(ai, bj, w) do { if constexpr (FP8) { if (w) PG8_MMA8(ai, bj, At8, B18); else PG8_MMA8(ai, bj, At8, B08); } else { if (w) PG8_MMA(ai, bj, At, B1); else PG8_MMA(ai, bj, At, B0); } } while (0)
#define PG8_WAIT_V(n) asm volatile("s_waitcnt vmcnt(" #n ")" ::: "memory")
#define PG8_WAIT_L(n) asm volatile("s_waitcnt lgkmcnt(" #n ")" ::: "memory")
#define PG8_BAR __builtin_amdgcn_s_barrier()
#define PG8_SCHED __builtin_amdgcn_sched_barrier(0)
    Unit cur, nxt; int ui = 0;
    if (!S.next(0, cur)) return;
    f32x4 acc[2][2][4][2];
#pragma unroll
    for (int a = 0; a < 2; ++a)
#pragma unroll
        for (int b = 0; b < 2; ++b)
#pragma unroll
            for (int m = 0; m < 4; ++m)
#pragma unroll
                for (int n = 0; n < 2; ++n) acc[a][b][m][n] = (f32x4){0.f, 0.f, 0.f, 0.f};
    bf16x8 At[4][2], B0[2][2], B1[2][2]; i32x8 At8[4], B08[2], B18[2];
    const char* cA = S.a_ptr(g, cur); const char* cB = S.b_ptr(g, cur);
    if constexpr (GATHER) {
#pragma unroll
        for (int h = 0; h < 2; ++h)
#pragma unroll
            for (int i = 0; i < 2; ++i) offC[h][i] = S.row_off(g, cur, h * HALF + Rr[i]) + (unsigned)Cc[i] * 2u;
    }
    PG8_STAGE_B(PG8_SB(0, 0), cB); PG8_STAGE_B(PG8_SB(0, 1), cB + hstepB); PG8_STAGE_A(PG8_SA(0, 0), cA, offC, 0); PG8_STAGE_A(PG8_SA(0, 1), cA, offC, 1);
    if (wr == 1) PG8_BAR;
    PG8_WAIT_V(2); PG8_BAR;
    PG8_STAGE_B(PG8_SB(1, 0), cB + kstep); PG8_STAGE_A(PG8_SA(1, 0), cA + kstep, offC, 0); PG8_STAGE_B(PG8_SB(1, 1), cB + hstepB + kstep);
    PG8_WAIT_V(6); PG8_BAR;
    for (;;) {
        const bool has_next = S.next(ui + 1, nxt);
        const char* nA = has_next ? S.a_ptr(g, nxt) : cA; const char* nB = has_next ? S.b_ptr(g, nxt) : cB;
        if constexpr (GATHER) {
            if (has_next) {
#pragma unroll
                for (int h = 0; h < 2; ++h)
#pragma unroll
                    for (int i = 0; i < 2; ++i) offN[h][i] = S.row_off(g, nxt, h * HALF + Rr[i]) + (unsigned)Cc[i] * 2u;
            }
        }
#pragma unroll 1
        for (int t = 0; t < nt; t += 2) {
            const bool last = (t == nt - 2);
            const char* a1 = cA + (size_t)(t + 1) * kstep;
            const char* a2 = last ? nA : cA + (size_t)(t + 2) * kstep; const char* b2 = last ? nB : cB + (size_t)(t + 2) * kstep;
            const char* a3 = a2 + kstep; const char* b3 = b2 + kstep;
            unsigned o2[2][2];
#pragma unroll
            for (int h = 0; h < 2; ++h)
#pragma unroll
                for (int i = 0; i < 2; ++i) o2[h][i] = GATHER ? (last ? offN[h][i] : offC[h][i]) : offC[h][i];
            XLDB0(0, 0); XLDB1(0, 1); PG8_SCHED; XLDA(0, 0); PG8_STAGE_A(PG8_SA(1, 1), a1, offC, 1);
            PG8_WAIT_V(8); PG8_WAIT_L(0); PG8_BAR; XMMA(0, 0, 0); XMMA(0, 1, 1); PG8_BAR; PG8_SCHED;
            XLDA(0, 1); PG8_STAGE_B(PG8_SB(0, 0), b2); PG8_STAGE_B(PG8_SB(0, 1), b2 + hstepB); PG8_STAGE_A(PG8_SA(0, 0), a2, o2, 0);
            PG8_WAIT_V(8); PG8_WAIT_L(0); PG8_BAR; XMMA(1, 0, 0); XMMA(1, 1, 1); PG8_BAR; PG8_SCHED;
            XLDB0(1, 0); XLDB1(1, 1); PG8_SCHED; XLDA(1, 0); PG8_STAGE_A(PG8_SA(0, 1), a2, o2, 1);
            PG8_WAIT_V(8); PG8_WAIT_L(0); PG8_BAR; XMMA(0, 0, 0); XMMA(0, 1, 1); PG8_BAR; PG8_SCHED;
            XLDA(1, 1); PG8_STAGE_B(PG8_SB(1, 0), b3); PG8_STAGE_B(PG8_SB(1, 1), b3 + hstepB); PG8_STAGE_A(PG8_SA(1, 0), a3, o2, 0);
            PG8_WAIT_V(8); PG8_WAIT_L(0); PG8_BAR; XMMA(1, 0, 0); XMMA(1, 1, 1); PG8_BAR; PG8_SCHED;
        }
        if constexpr (ALIGN_EPI) { if (wr == 0) PG8_BAR; }
        if constexpr (FP8) {
            asm volatile("s_nop 15" : "+v"(acc[1][0][0][0]), "+v"(acc[1][0][0][1]), "+v"(acc[1][0][1][0]), "+v"(acc[1][0][1][1]), "+v"(acc[1][0][2][0]), "+v"(acc[1][0][2][1]), "+v"(acc[1][0][3][0]), "+v"(acc[1][0][3][1]));
            asm volatile("" : "+v"(acc[1][1][0][0]), "+v"(acc[1][1][0][1]), "+v"(acc[1][1][1][0]), "+v"(acc[1][1][1][1]), "+v"(acc[1][1][2][0]), "+v"(acc[1][1][2][1]), "+v"(acc[1][1][3][0]), "+v"(acc[1][1][3][1])); }
        E(acc, cur, wr, wc, fr, fq);
        if (!has_next) break;
        if (!E.keep(cur)) {
#pragma unroll
        for (int a = 0; a < 2; ++a)
#pragma unroll
            for (int b = 0; b < 2; ++b)
#pragma unroll
                for (int m = 0; m < 4; ++m)
#pragma unroll
                    for (int n = 0; n < 2; ++n) acc[a][b][m][n] = (f32x4){0.f, 0.f, 0.f, 0.f};
        }
        cur = nxt; cA = nA; cB = nB; ++ui;
        if constexpr (GATHER) {
#pragma unroll
            for (int h = 0; h < 2; ++h)
#pragma unroll
                for (int i = 0; i < 2; ++i) offC[h][i] = offN[h][i];
        }
        if constexpr (ALIGN_EPI) { if (wr == 1) PG8_BAR; }
    }
    PG8_WAIT_V(0);
    if constexpr (!ALIGN_EPI) { if (wr == 0) PG8_BAR; }
    PG8_BAR;
#undef PG8_SA
#undef PG8_SB
#undef PG8_STAGE_A
#undef PG8_STAGE_B
#undef PG8_LDA
#undef PG8_LD8
#undef PG8_LDA8
#undef PG8_LDB8
#undef PG8_MMA8
#undef XLDA
#undef XLDB0
#undef XLDB1
#undef XMMA
#undef PG8_LDB
#undef PG8_MMA
#undef PG8_WAIT_V
#undef PG8_WAIT_L
#undef PG8_BAR
#undef PG8_SCHED
}
}
namespace att {
using bf16x8 = __attribute__((ext_vector_type(8))) short;
using s16x4  = __attribute__((ext_vector_type(4))) short;
using f32x16 = __attribute__((ext_vector_type(16))) float;
using u32x4  = __attribute__((ext_vector_type(4))) unsigned;
typedef unsigned short bf16_t;
typedef float f32x4_t __attribute__((ext_vector_type(4)));
#define ALAS __attribute__((address_space(3)))
constexpr int NW = 8, QBLK = 32, KVBLK = 64;
constexpr int LDS_V = 0, LDS_K = 32768, LDS_WS = 65536;
constexpr int LDS_V3 = 0, LDS_K3 = 49152, LDS_WS3 = 98304, LDS_BYTES = LDS_WS3 + NW * 64 * 4;
constexpr float THR = 8.f;
#define KF(row) ((((row) & 7) | ((((row) >> 4) & 1) << 3)))
#define KSWZ(row, colB) ((row) * 256 + ((colB) ^ (KF(row) << 4)))
#define SBAR() __builtin_amdgcn_sched_barrier(0)
constexpr int QK2_BT = 2;
__device__ __forceinline__ int crow(int r, int hi) { return (r & 3) + 8 * (r >> 2) + 4 * hi; }
typedef float f32x2_t __attribute__((ext_vector_type(2))); typedef __bf16 bf16x2_t __attribute__((ext_vector_type(2)));
__device__ __forceinline__ unsigned cvtpk(float lo, float hi) { f32x2_t v = {lo, hi}; bf16x2_t b = __builtin_convertvector(v, bf16x2_t); return __builtin_bit_cast(unsigned, b); }

__device__ __forceinline__ void expHalf(f32x16& p0, float shift, bool use_shift) {
  if (use_shift) {
#pragma unroll
    for (int r = 0; r < 16; ++r) p0[r] = __builtin_amdgcn_exp2f(p0[r] + shift);
  } else {
#pragma unroll
    for (int r = 0; r < 16; ++r) p0[r] = __builtin_amdgcn_exp2f(p0[r]);
  }
}
__device__ __forceinline__ void finishSM(f32x16& p0, f32x16& p1, float& l_reg, bf16x8& pa0, bf16x8& pa1, bf16x8& pa2, bf16x8& pa3, float shift, bool use_shift) {
  expHalf(p1, shift, use_shift);
  float ps = 0;
#pragma unroll
  for (int r = 0; r < 16; ++r) ps += p0[r] + p1[r];
  l_reg += ps;
#define PK4(P, BASE, OUT) do { unsigned a0 = cvtpk(P[BASE + 0], P[BASE + 1]), a1 = cvtpk(P[BASE + 2], P[BASE + 3]);   \
    unsigned b0 = cvtpk(P[BASE + 4], P[BASE + 5]), b1 = cvtpk(P[BASE + 6], P[BASE + 7]);                              \
    auto r0 = __builtin_amdgcn_permlane32_swap(a0, b0, false, false); auto r1 = __builtin_amdgcn_permlane32_swap(a1, b1, false, false); \
    u32x4 w = {r0[0], r1[0], r0[1], r1[1]}; OUT = __builtin_bit_cast(bf16x8, w); } while (0)
  PK4(p0, 0, pa0); PK4(p0, 8, pa1); PK4(p1, 0, pa2); PK4(p1, 8, pa3);
#undef PK4
}
template <int DK, int COLB = 0> __device__ __forceinline__ void qkt(f32x16& p0, f32x16& p1, const ALAS char* Ks, const bf16x8* qr, int r32, int hi) {
  constexpr int ND = DK / 16, BT = ND > 4 ? ND / 2 : ND;
  p0 = f32x16{}; p1 = f32x16{};
#pragma unroll
  for (int b0 = 0; b0 < ND; b0 += BT) {
    bf16x8 k0[BT], k1[BT];
#pragma unroll
    for (int i = 0; i < BT; ++i) { const int cb = COLB + ((b0 + i) * 16 + hi * 8) * 2;
      k0[i] = *(const ALAS bf16x8*)(Ks + KSWZ(r32, cb)); k1[i] = *(const ALAS bf16x8*)(Ks + KSWZ(32 + r32, cb)); }
    SBAR();
#pragma unroll
    for (int i = 0; i < BT; ++i) {
      p0 = __builtin_amdgcn_mfma_f32_32x32x16_bf16(k0[i], qr[b0 + i], p0, 0, 0, 0);
      p1 = __builtin_amdgcn_mfma_f32_32x32x16_bf16(k1[i], qr[b0 + i], p1, 0, 0, 0); }
    SBAR();
  }
}
template <int NB> __device__ __forceinline__ int v_st(int k, int c) { const int kk = (k & ~0xC) | ((k & 4) << 1) | ((k & 8) >> 1); return ((kk >> 3) * NB + (c >> 5)) * 512 + ((kk & 7) * 32 + (c & 31)) * 2; }
__device__ __forceinline__ int v_rd_base(int lane) { return ((lane & 3) << 3) | (((lane >> 2) & 3) << 6) | (((lane >> 4) & 1) << 5) | (((lane >> 5) & 1) << 8); }
template <int OFF> __device__ __forceinline__ s16x4 tr_read(int vb) {
  s16x4 r; asm volatile("ds_read_b64_tr_b16 %0, %1 offset:%2" : "=&v"(r) : "v"(vb), "i"(OFF) : "memory"); return r;
}
template <int NB, int D0> __device__ __forceinline__ void pv_one(f32x16& od, int vb, bf16x8 pa0, bf16x8 pa1, bf16x8 pa2, bf16x8 pa3) {
#define VOFF(ks, half) (D0 * 512 + (ks) * (1024 * NB) + (half) * (512 * NB))
  const s16x4 l0 = tr_read<VOFF(0, 0)>(vb), h0 = tr_read<VOFF(0, 1)>(vb), l1 = tr_read<VOFF(1, 0)>(vb), h1 = tr_read<VOFF(1, 1)>(vb);
  const s16x4 l2 = tr_read<VOFF(2, 0)>(vb), h2 = tr_read<VOFF(2, 1)>(vb), l3 = tr_read<VOFF(3, 0)>(vb), h3 = tr_read<VOFF(3, 1)>(vb);
#undef VOFF
  asm volatile("s_waitcnt lgkmcnt(0)" ::: "memory"); SBAR();
#define PK(L, H) (bf16x8){L[0], L[1], L[2], L[3], H[0], H[1], H[2], H[3]}
  od = __builtin_amdgcn_mfma_f32_32x32x16_bf16(pa0, PK(l0, h0), od, 0, 0, 0);
  od = __builtin_amdgcn_mfma_f32_32x32x16_bf16(pa1, PK(l1, h1), od, 0, 0, 0);
  od = __builtin_amdgcn_mfma_f32_32x32x16_bf16(pa2, PK(l2, h2), od, 0, 0, 0);
  od = __builtin_amdgcn_mfma_f32_32x32x16_bf16(pa3, PK(l3, h3), od, 0, 0, 0);
#undef PK
}
template <int NB> __device__ __forceinline__ void pv_all(f32x16* o, int vb, bf16x8 pa0, bf16x8 pa1, bf16x8 pa2, bf16x8 pa3) {
  pv_one<NB, 0>(o[0], vb, pa0, pa1, pa2, pa3); pv_one<NB, 1>(o[1], vb, pa0, pa1, pa2, pa3);
  if constexpr (NB == 4) { pv_one<NB, 2>(o[2], vb, pa0, pa1, pa2, pa3); pv_one<NB, 3>(o[3], vb, pa0, pa1, pa2, pa3); }
}

struct QPrep { const float* g; const float* c1; const float* s1; const float* c2; const float* s2; int pos0; };
template <int DK, int QMODE>
__device__ __forceinline__ void load_q(bf16x8 (&qr)[DK / 16], const bf16_t* Qw, const QPrep& qp, float qscale, int wid, int r32, int hi) {
  constexpr int ND = DK / 16;
  float x[ND * 8];
#pragma unroll
  for (int d0 = 0; d0 < ND; ++d0) { const u32x4 w = *reinterpret_cast<const u32x4*>(Qw + d0 * 16);
#pragma unroll
    for (int e = 0; e < 4; ++e) { x[d0 * 8 + 2 * e] = __uint_as_float(w[e] << 16); x[d0 * 8 + 2 * e + 1] = __uint_as_float(w[e] & 0xffff0000u); } }
  if constexpr (QMODE != 0) {
    float ss = 0.f;
#pragma unroll
    for (int i = 0; i < ND * 8; ++i) ss += x[i] * x[i];
    { auto rr = __builtin_amdgcn_permlane32_swap(__float_as_uint(ss), __float_as_uint(ss), false, false); ss = __uint_as_float(rr[0]) + __uint_as_float(rr[1]); }
    const float rstd = __builtin_amdgcn_rsqf(ss * (1.f / DK) + 1e-6f);
#pragma unroll
    for (int d0 = 0; d0 < ND; ++d0) { const f32x4_t g0 = *reinterpret_cast<const f32x4_t*>(qp.g + d0 * 16 + hi * 8), g1 = *reinterpret_cast<const f32x4_t*>(qp.g + d0 * 16 + hi * 8 + 4);
#pragma unroll
      for (int e = 0; e < 4; ++e) { x[d0 * 8 + e] *= rstd * g0[e]; x[d0 * 8 + 4 + e] *= rstd * g1[e]; } }
    const int pos = qp.pos0 + wid * QBLK + r32;
#define ROPE_PAIR(dA, dB, CT, ST) do { const f32x4_t c0 = *reinterpret_cast<const f32x4_t*>((CT) + hi * 8), c1_ = *reinterpret_cast<const f32x4_t*>((CT) + hi * 8 + 4), s0 = *reinterpret_cast<const f32x4_t*>((ST) + hi * 8), s1_ = *reinterpret_cast<const f32x4_t*>((ST) + hi * 8 + 4); \
      _Pragma("unroll") for (int e = 0; e < 8; ++e) { const float c = e < 4 ? c0[e & 3] : c1_[e & 3], s = e < 4 ? s0[e & 3] : s1_[e & 3]; const float xa = x[(dA) * 8 + e], xb = x[(dB) * 8 + e]; \
        x[(dA) * 8 + e] = xa * c - xb * s; x[(dB) * 8 + e] = xb * c + xa * s; } } while (0)
    if constexpr (QMODE == 1) {
#pragma unroll
      for (int d0 = 0; d0 < ND / 2; ++d0) ROPE_PAIR(d0, d0 + ND / 2, qp.c1 + (size_t)pos * (DK / 2) + d0 * 16, qp.s1 + (size_t)pos * (DK / 2) + d0 * 16);
    } else if constexpr (QMODE == 2) {
      const int grow = pos >> 6, gcol = pos & 63;
      ROPE_PAIR(0, 1, qp.c1 + grow * 16, qp.s1 + grow * 16); ROPE_PAIR(2, 3, qp.c2 + gcol * 16, qp.s2 + gcol * 16);
    } else if constexpr (QMODE == 3) {
      ROPE_PAIR(4, 5, qp.c1 + pos * 16, qp.s1 + pos * 16);
    }
#undef ROPE_PAIR
  }
#pragma unroll
  for (int d0 = 0; d0 < ND; ++d0) { u32x4 w;
#pragma unroll
    for (int e = 0; e < 4; ++e) w[e] = cvtpk(x[d0 * 8 + 2 * e] * qscale, x[d0 * 8 + 2 * e + 1] * qscale);
    qr[d0] = __builtin_bit_cast(bf16x8, w); }
}

struct DiffEpi { const bf16_t* O1; int ldo1; float lam; const float* g; int layer; };
template <int DK, int DV, int SDEPTH, int QMODE, int PIPE = 2, bool DIFF2 = false>
__device__ __forceinline__ void attn_unit(const bf16_t* Qb, int ldq, const bf16_t* __restrict__ Kh, int ldk, const bf16_t* __restrict__ Vh, int ldv,
                                          bf16_t* Ob, int ldo, int nkeys, float qscale, float negb_, const QPrep& qp, ALAS char* lds, int wave0, float omul = 1.0f, const DiffEpi* de = nullptr) {
  constexpr int NB = DV / 32, KC = DK / 8, VC = DV / 8;
  constexpr int NKC = 64 * KC, NVC = 64 * VC, KPT = (NKC + 511) / 512, VPT = (NVC + 511) / 512;
  constexpr int SHM_V = KVBLK * DV * 2, SHM_K = 16384;
  int tid; asm volatile("v_mbcnt_lo_u32_b32 %0, -1, 0\n\tv_mbcnt_hi_u32_b32 %0, -1, %0" : "=v"(tid)); tid = (tid + wave0 * 64) & 511;
  const int wid = tid >> 6, lane = tid & 63, r32 = lane & 31, hi = lane >> 5;
  ALAS char* V_lds = lds + (PIPE == 3 ? LDS_V3 : LDS_V); ALAS char* K_lds = lds + (PIPE == 3 ? LDS_K3 : LDS_K);
  ALAS float* ws = (ALAS float*)(lds + (PIPE == 3 ? LDS_WS3 : LDS_WS)) + wid * 64; ALAS float* li_l = ws;
  float l_reg = 0; f32x16 o[NB]; bf16x8 qr[DK / 16];
  const bool use_shift = negb_ < -60.f;
  load_q<DK, QMODE>(qr, Qb + (long)(wid * QBLK + r32) * ldq + hi * 8, qp, qscale, wid, r32, hi);
  SBAR();
#pragma unroll
  for (int d = 0; d < NB; ++d) o[d] = f32x16{};
  int kgo[KPT], klo[KPT], vgo[VPT], vlo[VPT]; bool kok[KPT], vok[VPT];
#pragma unroll
  for (int i = 0; i < KPT; ++i) { const int c = tid + 512 * i; kok[i] = (512 * (i + 1) <= NKC) || (c < NKC); const int row = c / KC, col = (c % KC) * 8; kgo[i] = row * ldk + col; klo[i] = KSWZ(row, col * 2); }
#pragma unroll
  for (int i = 0; i < VPT; ++i) { const int c = tid + 512 * i; vok[i] = (512 * (i + 1) <= NVC) || (c < NVC); const int row = c / VC, col = (c % VC) * 8; vgo[i] = row * ldv + col; vlo[i] = v_st<NB>(row, col); }
  const int vb0 = (int)(unsigned)(unsigned long)V_lds + v_rd_base(lane);
  struct { bf16x8 ks[KPT], vs[VPT]; } sr_[SDEPTH];
#define SLOAD(s, k0) do { _Pragma("unroll") for (int i_ = 0; i_ < KPT; ++i_) if (kok[i_]) sr_[s].ks[i_] = *reinterpret_cast<const bf16x8*>(Kh + (long)(k0) * ldk + kgo[i_]); \
    _Pragma("unroll") for (int i_ = 0; i_ < VPT; ++i_) if (vok[i_]) sr_[s].vs[i_] = *reinterpret_cast<const bf16x8*>(Vh + (long)(k0) * ldv + vgo[i_]); } while (0)
#define SWRITE(b, s) do { _Pragma("unroll") for (int i_ = 0; i_ < KPT; ++i_) if (kok[i_]) *(ALAS bf16x8*)(K_lds + (b) * SHM_K + klo[i_]) = sr_[s].ks[i_]; \
    _Pragma("unroll") for (int i_ = 0; i_ < VPT; ++i_) if (vok[i_]) *(ALAS bf16x8*)(V_lds + (b) * SHM_V + vlo[i_]) = sr_[s].vs[i_]; } while (0)
#define SWAIT() do { if constexpr (SDEPTH == 2) asm volatile("s_waitcnt vmcnt(%0)" :: "n"(KPT + VPT) : "memory"); else asm volatile("s_waitcnt vmcnt(0)" ::: "memory"); } while (0)
  bf16x8 pa0, pa1, pa2, pa3; const int NT = nkeys / KVBLK;
  if constexpr (PIPE == 1) {
    f32x16 pA0, pA1;
    SLOAD(0, 0); asm volatile("s_waitcnt vmcnt(0)" ::: "memory"); SWRITE(0, 0); __syncthreads();
    for (int j = 0; j < NT; ++j) {
      const int bsel = j & 1;
      if (j + 1 < NT) SLOAD(0, (j + 1) * KVBLK);
      SBAR(); qkt<DK>(pA0, pA1, K_lds + bsel * SHM_K, qr, r32, hi); expHalf(pA0, negb_, use_shift);
      finishSM(pA0, pA1, l_reg, pa0, pa1, pa2, pa3, negb_, use_shift); SBAR();
      pv_all<NB>(o, vb0 + bsel * SHM_V, pa0, pa1, pa2, pa3);
      if (j + 1 < NT) { asm volatile("s_waitcnt vmcnt(0)" ::: "memory"); SWRITE(bsel ^ 1, 0); }
      __syncthreads();
    }
  } else if constexpr (PIPE == 4) {
    f32x16 pA0, pA1;
    SLOAD(0, 0); asm volatile("s_waitcnt vmcnt(0)" ::: "memory"); SWRITE(0, 0); __syncthreads();
    if (wave0 < 4) {
      for (int j = 0; j < NT; ++j) {
        const int bsel = j & 1;
        if (j + 1 < NT) SLOAD(0, (j + 1) * KVBLK);
        SBAR(); qkt<DK>(pA0, pA1, K_lds + bsel * SHM_K, qr, r32, hi); expHalf(pA0, negb_, use_shift);
        finishSM(pA0, pA1, l_reg, pa0, pa1, pa2, pa3, negb_, use_shift); SBAR();
        __builtin_amdgcn_s_barrier(); SBAR();
        pv_all<NB>(o, vb0 + bsel * SHM_V, pa0, pa1, pa2, pa3);
        if (j + 1 < NT) { asm volatile("s_waitcnt vmcnt(0)" ::: "memory"); SWRITE(bsel ^ 1, 0); }
        __syncthreads();
      }
    } else {
      for (int j = 0; j < NT; ++j) {
        const int bsel = j & 1;
        if (j + 1 < NT) SLOAD(0, (j + 1) * KVBLK);
        SBAR(); if (j > 0) pv_all<NB>(o, vb0 + (bsel ^ 1) * SHM_V, pa0, pa1, pa2, pa3);
        SBAR(); qkt<DK>(pA0, pA1, K_lds + bsel * SHM_K, qr, r32, hi); SBAR();
        __builtin_amdgcn_s_barrier(); SBAR();
        expHalf(pA0, negb_, use_shift); finishSM(pA0, pA1, l_reg, pa0, pa1, pa2, pa3, negb_, use_shift); SBAR();
        if (j + 1 < NT) { asm volatile("s_waitcnt vmcnt(0)" ::: "memory"); SWRITE(bsel ^ 1, 0); }
        __syncthreads();
      }
      pv_all<NB>(o, vb0 + ((NT - 1) & 1) * SHM_V, pa0, pa1, pa2, pa3);
    }
  } else if constexpr (PIPE == 3) {
    f32x16 pA0, pA1, pB0, pB1;
    struct { bf16x8 ks[KPT], vs[VPT]; } st_;
#define GLK(k0) do { _Pragma("unroll") for (int i_ = 0; i_ < KPT; ++i_) if (kok[i_]) st_.ks[i_] = *reinterpret_cast<const bf16x8*>(Kh + (long)(k0) * ldk + kgo[i_]); } while (0)
#define GLV(k0) do { _Pragma("unroll") for (int i_ = 0; i_ < VPT; ++i_) if (vok[i_]) st_.vs[i_] = *reinterpret_cast<const bf16x8*>(Vh + (long)(k0) * ldv + vgo[i_]); } while (0)
#define WRK(off) do { _Pragma("unroll") for (int i_ = 0; i_ < KPT; ++i_) if (kok[i_]) *(ALAS bf16x8*)(K_lds + (off) + klo[i_]) = st_.ks[i_]; } while (0)
#define WRV(off) do { _Pragma("unroll") for (int i_ = 0; i_ < VPT; ++i_) if (vok[i_]) *(ALAS bf16x8*)(V_lds + (off) + vlo[i_]) = st_.vs[i_]; } while (0)
#define ROT3(x, S) ((x) == 2 * (S) ? 0 : (x) + (S))
    GLK(0); GLV(0); asm volatile("s_waitcnt vmcnt(0)" ::: "memory"); WRK(0); WRV(0);
    GLK(KVBLK); asm volatile("s_waitcnt vmcnt(0)" ::: "memory"); WRK(SHM_K);
    if (2 < NT) GLK(2 * KVBLK);
    GLV(KVBLK);
    __syncthreads();
    int kr = 0, vr = 0, kw = 2 * SHM_K, vw = SHM_V;
#define STEP3(PC0, PC1, PP0, PP1, t, HASPREV) do { \
      SBAR(); qkt<DK>(PC0, PC1, K_lds + kr, qr, r32, hi); \
      if (HASPREV) { finishSM(PP0, PP1, l_reg, pa0, pa1, pa2, pa3, negb_, use_shift); SBAR(); pv_all<NB>(o, vb0 + vr, pa0, pa1, pa2, pa3); vr = ROT3(vr, SHM_V); } \
      expHalf(PC0, negb_, use_shift); \
      asm volatile("s_waitcnt vmcnt(0)" ::: "memory"); \
      if ((t) + 2 < NT) WRK(kw); if ((t) + 1 < NT) WRV(vw); \
      if ((t) + 3 < NT) GLK(((t) + 3) * KVBLK); if ((t) + 2 < NT) GLV(((t) + 2) * KVBLK); \
      kr = ROT3(kr, SHM_K); kw = ROT3(kw, SHM_K); vw = ROT3(vw, SHM_V); \
      __syncthreads(); } while (0)
    STEP3(pA0, pA1, pB0, pB1, 0, false);
    for (int t = 1; t + 1 < NT; t += 2) {
      STEP3(pB0, pB1, pA0, pA1, t, true);
      STEP3(pA0, pA1, pB0, pB1, t + 1, true);
    }
    STEP3(pB0, pB1, pA0, pA1, NT - 1, true);
    finishSM(pB0, pB1, l_reg, pa0, pa1, pa2, pa3, negb_, use_shift); SBAR();
    pv_all<NB>(o, vb0 + vr, pa0, pa1, pa2, pa3);
#undef GLK
#undef GLV
#undef WRK
#undef WRV
#undef ROT3
#undef STEP3
  } else {
  f32x16 pA0, pA1, pB0, pB1;
  constexpr int SE = 0, SO = SDEPTH - 1;
  SLOAD(SE, 0); asm volatile("s_waitcnt vmcnt(0)" ::: "memory"); SWRITE(0, SE); __syncthreads();
  qkt<DK>(pA0, pA1, K_lds, qr, r32, hi); expHalf(pA0, negb_, use_shift);
  SLOAD(SO, KVBLK); if constexpr (SDEPTH == 2) { if (2 < NT) SLOAD(SE, 2 * KVBLK); }
  SWAIT(); SWRITE(1, SO); __syncthreads();
  for (int j = 1; j + 1 < NT; j += 2) {
    SBAR(); qkt<DK>(pB0, pB1, K_lds + SHM_K, qr, r32, hi);
    finishSM(pA0, pA1, l_reg, pa0, pa1, pa2, pa3, negb_, use_shift); SBAR();
    SLOAD(SO, (j + SDEPTH) * KVBLK); SBAR();
    pv_all<NB>(o, vb0, pa0, pa1, pa2, pa3); expHalf(pB0, negb_, use_shift);
    __syncthreads(); SWAIT(); SWRITE(0, SE);
    __syncthreads();
    SBAR(); qkt<DK>(pA0, pA1, K_lds, qr, r32, hi);
    finishSM(pB0, pB1, l_reg, pa0, pa1, pa2, pa3, negb_, use_shift); SBAR();
    if (SDEPTH == 1 || j + 3 < NT) SLOAD(SE, (j + 1 + SDEPTH) * KVBLK); SBAR();
    pv_all<NB>(o, vb0 + SHM_V, pa0, pa1, pa2, pa3); expHalf(pA0, negb_, use_shift);
    __syncthreads(); SWAIT(); SWRITE(1, SO);
    __syncthreads();
  }
  SBAR(); qkt<DK>(pB0, pB1, K_lds + SHM_K, qr, r32, hi);
  finishSM(pA0, pA1, l_reg, pa0, pa1, pa2, pa3, negb_, use_shift); SBAR();
  pv_all<NB>(o, vb0, pa0, pa1, pa2, pa3); expHalf(pB0, negb_, use_shift);
  finishSM(pB0, pB1, l_reg, pa0, pa1, pa2, pa3, negb_, use_shift); SBAR();
  pv_all<NB>(o, vb0 + SHM_V, pa0, pa1, pa2, pa3);
  }
  { auto rr = __builtin_amdgcn_permlane32_swap(__float_as_uint(l_reg), __float_as_uint(l_reg), false, false); l_reg = __uint_as_float(rr[0]) + __uint_as_float(rr[1]); }
  if (hi == 0) li_l[r32] = l_reg; asm volatile("s_waitcnt lgkmcnt(0)" ::: "memory");
  float rli[16];
#pragma unroll
  for (int r = 0; r < 16; ++r) rli[r] = __builtin_amdgcn_rcpf(li_l[crow(r, hi)]) * omul;
  bf16_t* Ow = Ob + (long)(wid * QBLK) * ldo;
  if constexpr (DIFF2) {
    const bf16_t* O1w = de->O1 + (long)(wid * QBLK) * de->ldo1;
    float gcol[NB];
    int ly_ = de->layer; asm volatile("" : "+s"(ly_));
    const float post_ = (ly_ == 0) ? 0.8f : (1.0f - (0.8f - 0.6f * 0.74081822068171788f));
#pragma unroll
    for (int d0 = 0; d0 < NB; ++d0) gcol[d0] = de->g[d0 * 32 + r32] * post_;
#pragma unroll
    for (int r = 0; r < 16; ++r) { const int orow = crow(r, hi); float d[NB]; float ss = 0.f;
#pragma unroll
      for (int d0 = 0; d0 < NB; ++d0) { const float o1 = __uint_as_float((unsigned)O1w[(long)orow * de->ldo1 + d0 * 32 + r32] << 16); d[d0] = o1 - de->lam * (o[d0][r] * rli[r]); ss += d[d0] * d[d0]; }
      ss += __int_as_float(__builtin_amdgcn_ds_swizzle(__float_as_int(ss), (1 << 10) | 0x1f)); ss += __int_as_float(__builtin_amdgcn_ds_swizzle(__float_as_int(ss), (2 << 10) | 0x1f));
      ss += __int_as_float(__builtin_amdgcn_ds_swizzle(__float_as_int(ss), (4 << 10) | 0x1f)); ss += __int_as_float(__builtin_amdgcn_ds_swizzle(__float_as_int(ss), (8 << 10) | 0x1f));
      ss += __int_as_float(__builtin_amdgcn_ds_swizzle(__float_as_int(ss), (16 << 10) | 0x1f));
      const float rstd = __builtin_amdgcn_rsqf(ss * (1.f / 128.f) + 1e-6f);
#pragma unroll
      for (int d0 = 0; d0 < NB; ++d0) { const float v = d[d0] * rstd * gcol[d0]; Ow[(long)orow * ldo + d0 * 32 + r32] = (bf16_t)(cvtpk(v, v) & 0xffffu); } }
  } else {
#pragma unroll
  for (int r = 0; r < 16; ++r) { const int orow = crow(r, hi);
#pragma unroll
    for (int d0 = 0; d0 < NB; ++d0) { const float v = o[d0][r] * rli[r]; Ow[(long)orow * ldo + d0 * 32 + r32] = (bf16_t)(cvtpk(v, v) & 0xffffu); } }
  }
  __syncthreads();
#undef SLOAD
#undef SWRITE
#undef SWAIT
}
template <int DK> __device__ __forceinline__ void qkt2(f32x16 (&p)[2][2], const ALAS char* Ks, const bf16x8 (&qr)[2][DK / 16], int r32, int hi) {
  constexpr int ND = DK / 16, BT = QK2_BT < ND ? QK2_BT : ND;
  p[0][0] = f32x16{}; p[0][1] = f32x16{}; p[1][0] = f32x16{}; p[1][1] = f32x16{};
#pragma unroll
  for (int b0 = 0; b0 < ND; b0 += BT) {
    bf16x8 k0[BT], k1[BT];
#pragma unroll
    for (int i = 0; i < BT; ++i) { const int cb = ((b0 + i) * 16 + hi * 8) * 2;
      k0[i] = *(const ALAS bf16x8*)(Ks + KSWZ(r32, cb)); k1[i] = *(const ALAS bf16x8*)(Ks + KSWZ(32 + r32, cb)); }
    SBAR();
#pragma unroll
    for (int i = 0; i < BT; ++i) {
      p[0][0] = __builtin_amdgcn_mfma_f32_32x32x16_bf16(k0[i], qr[0][b0 + i], p[0][0], 0, 0, 0);
      p[1][0] = __builtin_amdgcn_mfma_f32_32x32x16_bf16(k0[i], qr[1][b0 + i], p[1][0], 0, 0, 0);
      p[0][1] = __builtin_amdgcn_mfma_f32_32x32x16_bf16(k1[i], qr[0][b0 + i], p[0][1], 0, 0, 0);
      p[1][1] = __builtin_amdgcn_mfma_f32_32x32x16_bf16(k1[i], qr[1][b0 + i], p[1][1], 0, 0, 0); }
    SBAR();
  }
}
template <int NB, int D0> __device__ __forceinline__ void pv_one2(f32x16& oa, f32x16& ob, int vb, const bf16x8 (&pa)[2][4]) {
#define VOFF(ks, half) (D0 * 512 + (ks) * (1024 * NB) + (half) * (512 * NB))
  const s16x4 l0 = tr_read<VOFF(0, 0)>(vb), h0 = tr_read<VOFF(0, 1)>(vb), l1 = tr_read<VOFF(1, 0)>(vb), h1 = tr_read<VOFF(1, 1)>(vb);
  const s16x4 l2 = tr_read<VOFF(2, 0)>(vb), h2 = tr_read<VOFF(2, 1)>(vb), l3 = tr_read<VOFF(3, 0)>(vb), h3 = tr_read<VOFF(3, 1)>(vb);
#undef VOFF
  asm volatile("s_waitcnt lgkmcnt(0)" ::: "memory"); SBAR();
#define PK(L, H) (bf16x8){L[0], L[1], L[2], L[3], H[0], H[1], H[2], H[3]}
  oa = __builtin_amdgcn_mfma_f32_32x32x16_bf16(pa[0][0], PK(l0, h0), oa, 0, 0, 0);
  ob = __builtin_amdgcn_mfma_f32_32x32x16_bf16(pa[1][0], PK(l0, h0), ob, 0, 0, 0);
  oa = __builtin_amdgcn_mfma_f32_32x32x16_bf16(pa[0][1], PK(l1, h1), oa, 0, 0, 0);
  ob = __builtin_amdgcn_mfma_f32_32x32x16_bf16(pa[1][1], PK(l1, h1), ob, 0, 0, 0);
  oa = __builtin_amdgcn_mfma_f32_32x32x16_bf16(pa[0][2], PK(l2, h2), oa, 0, 0, 0);
  ob = __builtin_amdgcn_mfma_f32_32x32x16_bf16(pa[1][2], PK(l2, h2), ob, 0, 0, 0);
  oa = __builtin_amdgcn_mfma_f32_32x32x16_bf16(pa[0][3], PK(l3, h3), oa, 0, 0, 0);
  ob = __builtin_amdgcn_mfma_f32_32x32x16_bf16(pa[1][3], PK(l3, h3), ob, 0, 0, 0);
#undef PK
}
template <int DK, int QMODE, bool SHAREK = true>
__device__ __forceinline__ void attn_unit2(const bf16_t* Qb, int ldq, const bf16_t* __restrict__ Kh, int ldk, const bf16_t* __restrict__ Vh, int ldv,
                                           bf16_t* Ob, int ldo, int nkeys, float qscale, float negb_, const QPrep& qp, ALAS char* lds, int wave0) {
  constexpr int DV = 64, NB = 2, KC = DK / 8, VC = DV / 8;
  constexpr int NKC = 64 * KC, NVC = 64 * VC, KPT = (NKC + 511) / 512, VPT = (NVC + 511) / 512;
  constexpr int SHM_V = KVBLK * DV * 2, SHM_K = 16384;
  int tid; asm volatile("v_mbcnt_lo_u32_b32 %0, -1, 0\n\tv_mbcnt_hi_u32_b32 %0, -1, %0" : "=v"(tid)); tid = (tid + wave0 * 64) & 511;
  const int wid = tid >> 6, lane = tid & 63, r32 = lane & 31, hi = lane >> 5;
  ALAS char* V_lds = lds + LDS_V; ALAS char* K_lds = lds + LDS_K;
  ALAS float* ws = (ALAS float*)(lds + LDS_WS) + wid * 64;
  const bool use_shift = negb_ < -60.f;
  float l_reg[2] = {0.f, 0.f}; f32x16 o[2][NB]; bf16x8 qr[2][DK / 16];
  { QPrep q2 = qp;
    load_q<DK, QMODE>(qr[0], Qb + (long)(wid * QBLK + r32) * ldq + hi * 8, q2, qscale, wid, r32, hi);
    SBAR();
    q2.pos0 = qp.pos0 + 256;
    load_q<DK, QMODE>(qr[1], Qb + (long)(256 + wid * QBLK + r32) * ldq + hi * 8, q2, qscale, wid, r32, hi); }
  SBAR();
#pragma unroll
  for (int q = 0; q < 2; ++q)
#pragma unroll
    for (int d = 0; d < NB; ++d) o[q][d] = f32x16{};
  int kgo[KPT], klo[KPT], vgo[VPT], vlo[VPT]; bool kok[KPT], vok[VPT];
#pragma unroll
  for (int i = 0; i < KPT; ++i) { const int c = tid + 512 * i; kok[i] = (512 * (i + 1) <= NKC) || (c < NKC); const int row = c / KC, col = (c % KC) * 8; kgo[i] = row * ldk + col; klo[i] = KSWZ(row, col * 2); }
#pragma unroll
  for (int i = 0; i < VPT; ++i) { const int c = tid + 512 * i; vok[i] = (512 * (i + 1) <= NVC) || (c < NVC); const int row = c / VC, col = (c % VC) * 8; vgo[i] = row * ldv + col; vlo[i] = v_st<NB>(row, col); }
  const int vb0 = (int)(unsigned)(unsigned long)V_lds + v_rd_base(lane);
  struct { bf16x8 ks[KPT], vs[VPT]; } sr_;
#define SLOAD2(k0) do { _Pragma("unroll") for (int i_ = 0; i_ < KPT; ++i_) if (kok[i_]) sr_.ks[i_] = *reinterpret_cast<const bf16x8*>(Kh + (long)(k0) * ldk + kgo[i_]); \
    _Pragma("unroll") for (int i_ = 0; i_ < VPT; ++i_) if (vok[i_]) sr_.vs[i_] = *reinterpret_cast<const bf16x8*>(Vh + (long)(k0) * ldv + vgo[i_]); } while (0)
#define SWRITE2(b) do { _Pragma("unroll") for (int i_ = 0; i_ < KPT; ++i_) if (kok[i_]) *(ALAS bf16x8*)(K_lds + (b) * SHM_K + klo[i_]) = sr_.ks[i_]; \
    _Pragma("unroll") for (int i_ = 0; i_ < VPT; ++i_) if (vok[i_]) *(ALAS bf16x8*)(V_lds + (b) * SHM_V + vlo[i_]) = sr_.vs[i_]; } while (0)
  const int NT = nkeys / KVBLK;
  f32x16 p[2][2]; bf16x8 pa[2][4];
  SLOAD2(0); asm volatile("s_waitcnt vmcnt(0)" ::: "memory"); SWRITE2(0); __syncthreads();
  for (int j = 0; j < NT; ++j) {
    const int bsel = j & 1;
    if (j + 1 < NT) SLOAD2((j + 1) * KVBLK);
    if constexpr (SHAREK) {
      SBAR(); qkt2<DK>(p, K_lds + bsel * SHM_K, qr, r32, hi);
      expHalf(p[0][0], negb_, use_shift); finishSM(p[0][0], p[0][1], l_reg[0], pa[0][0], pa[0][1], pa[0][2], pa[0][3], negb_, use_shift);
      expHalf(p[1][0], negb_, use_shift); finishSM(p[1][0], p[1][1], l_reg[1], pa[1][0], pa[1][1], pa[1][2], pa[1][3], negb_, use_shift); SBAR();
    } else {
      SBAR(); qkt<DK>(p[0][0], p[0][1], K_lds + bsel * SHM_K, qr[0], r32, hi);
      expHalf(p[0][0], negb_, use_shift); finishSM(p[0][0], p[0][1], l_reg[0], pa[0][0], pa[0][1], pa[0][2], pa[0][3], negb_, use_shift); SBAR();
      qkt<DK>(p[0][0], p[0][1], K_lds + bsel * SHM_K, qr[1], r32, hi);
      expHalf(p[0][0], negb_, use_shift); finishSM(p[0][0], p[0][1], l_reg[1], pa[1][0], pa[1][1], pa[1][2], pa[1][3], negb_, use_shift); SBAR();
    }
    pv_one2<NB, 0>(o[0][0], o[1][0], vb0 + bsel * SHM_V, pa); pv_one2<NB, 1>(o[0][1], o[1][1], vb0 + bsel * SHM_V, pa);
    if (j + 1 < NT) { asm volatile("s_waitcnt vmcnt(0)" ::: "memory"); SWRITE2(bsel ^ 1); }
    __syncthreads();
  }
#pragma unroll
  for (int q = 0; q < 2; ++q) {
    float lq = l_reg[q];
    { auto rr = __builtin_amdgcn_permlane32_swap(__float_as_uint(lq), __float_as_uint(lq), false, false); lq = __uint_as_float(rr[0]) + __uint_as_float(rr[1]); }
    if (hi == 0) ws[q * 32 + r32] = lq;
  }
  asm volatile("s_waitcnt lgkmcnt(0)" ::: "memory");
#pragma unroll
  for (int q = 0; q < 2; ++q) {
    float rli[16];
#pragma unroll
    for (int r = 0; r < 16; ++r) rli[r] = __builtin_amdgcn_rcpf(ws[q * 32 + crow(r, hi)]);
    bf16_t* Ow = Ob + (long)(q * 256 + wid * QBLK) * ldo;
#pragma unroll
    for (int r = 0; r < 16; ++r) { const int orow = crow(r, hi);
#pragma unroll
      for (int d0 = 0; d0 < NB; ++d0) { const float v = o[q][d0][r] * rli[r]; Ow[(long)orow * ldo + d0 * 32 + r32] = (bf16_t)(cvtpk(v, v) & 0xffffu); } }
  }
  __syncthreads();
#undef SLOAD2
#undef SWRITE2
}
template <int DK, int QMODE, bool SHAREK = true>
__device__ __forceinline__ void attn_unit2d(const bf16_t* Qb, int ldq, const bf16_t* __restrict__ Kh, int ldk, const bf16_t* __restrict__ Vh, int ldv,
                                           bf16_t* Ob, int ldo, int nkeys, float qscale, float negb_, const QPrep& qp, ALAS char* lds, int wave0) {
  constexpr int DV = 64, NB = 2, KC = DK / 8, VC = DV / 8;
  constexpr int NKC = 64 * KC, NVC = 64 * VC, KPT = (NKC + 511) / 512, VPT = (NVC + 511) / 512;
  constexpr int SHM_V = KVBLK * DV * 2, SHM_K = 16384;
  int tid; asm volatile("v_mbcnt_lo_u32_b32 %0, -1, 0\n\tv_mbcnt_hi_u32_b32 %0, -1, %0" : "=v"(tid)); tid = (tid + wave0 * 64) & 511;
  const int wid = tid >> 6, lane = tid & 63, r32 = lane & 31, hi = lane >> 5;
  ALAS char* V_lds = lds + LDS_V; ALAS char* K_lds = lds + LDS_K;
  ALAS float* ws = (ALAS float*)(lds + LDS_WS) + wid * 64;
  const bool use_shift = negb_ < -60.f;
  float l_reg[2] = {0.f, 0.f}; f32x16 o[2][NB]; bf16x8 qr[2][DK / 16];
  { QPrep q2 = qp;
    load_q<DK, QMODE>(qr[0], Qb + (long)(wid * QBLK + r32) * ldq + hi * 8, q2, qscale, wid, r32, hi);
    SBAR();
    q2.pos0 = qp.pos0 + 256;
    load_q<DK, QMODE>(qr[1], Qb + (long)(256 + wid * QBLK + r32) * ldq + hi * 8, q2, qscale, wid, r32, hi); }
  SBAR();
#pragma unroll
  for (int q = 0; q < 2; ++q)
#pragma unroll
    for (int d = 0; d < NB; ++d) o[q][d] = f32x16{};
  const int widu = __builtin_amdgcn_readfirstlane(wid);
  constexpr int KINST = 2, VINST = (64 * DV * 2) / (512 * 16);
  int kg[KINST], vg[VINST]; bool kv_[KINST];
#pragma unroll
  for (int i = 0; i < KINST; ++i) { const int q = (i * 8 + wid) * 64 + lane, row = q >> 4, pos = q & 15, c = pos ^ KF(row); kv_[i] = c < KC; kg[i] = row * ldk + c * 8; }
#pragma unroll
  for (int i = 0; i < VINST; ++i) { const int q = (i * 8 + wid) * 64 + lane, o_ = q * 16, sub = o_ >> 9, e = (o_ & 511) >> 1, kk = (sub / NB) * 8 + (e >> 5), k = (kk & ~0xC) | ((kk & 4) << 1) | ((kk & 8) >> 1), c = (sub % NB) * 32 + (e & 31); vg[i] = k * ldv + c; }
  const int vb0 = (int)(unsigned)(unsigned long)V_lds + v_rd_base(lane);
#define DMA_KV(b, k0) do { \
    _Pragma("unroll") for (int i_ = 0; i_ < KINST; ++i_) if (kv_[i_]) __builtin_amdgcn_global_load_lds((const unsigned*)(Kh + (long)(k0) * ldk + kg[i_]), (ALAS unsigned*)(K_lds + (b) * SHM_K + (i_ * 8 + widu) * 1024), 16, 0, 0); \
    _Pragma("unroll") for (int i_ = 0; i_ < VINST; ++i_) __builtin_amdgcn_global_load_lds((const unsigned*)(Vh + (long)(k0) * ldv + vg[i_]), (ALAS unsigned*)(V_lds + (b) * SHM_V + (i_ * 8 + widu) * 1024), 16, 0, 0); } while (0)
  const int NT = nkeys / KVBLK;
  f32x16 p[2][2]; bf16x8 pa[2][4];
  DMA_KV(0, 0); asm volatile("s_waitcnt vmcnt(0)" ::: "memory"); __syncthreads();
  for (int j = 0; j < NT; ++j) {
    const int bsel = j & 1;
    if (j + 1 < NT) DMA_KV(bsel ^ 1, (j + 1) * KVBLK);
    if constexpr (SHAREK) {
      SBAR(); qkt2<DK>(p, K_lds + bsel * SHM_K, qr, r32, hi);
      expHalf(p[0][0], negb_, use_shift); finishSM(p[0][0], p[0][1], l_reg[0], pa[0][0], pa[0][1], pa[0][2], pa[0][3], negb_, use_shift);
      expHalf(p[1][0], negb_, use_shift); finishSM(p[1][0], p[1][1], l_reg[1], pa[1][0], pa[1][1], pa[1][2], pa[1][3], negb_, use_shift); SBAR();
    } else {
      SBAR(); qkt<DK>(p[0][0], p[0][1], K_lds + bsel * SHM_K, qr[0], r32, hi);
      expHalf(p[0][0], negb_, use_shift); finishSM(p[0][0], p[0][1], l_reg[0], pa[0][0], pa[0][1], pa[0][2], pa[0][3], negb_, use_shift); SBAR();
      qkt<DK>(p[0][0], p[0][1], K_lds + bsel * SHM_K, qr[1], r32, hi);
      expHalf(p[0][0], negb_, use_shift); finishSM(p[0][0], p[0][1], l_reg[1], pa[1][0], pa[1][1], pa[1][2], pa[1][3], negb_, use_shift); SBAR();
    }
    pv_one2<NB, 0>(o[0][0], o[1][0], vb0 + bsel * SHM_V, pa); pv_one2<NB, 1>(o[0][1], o[1][1], vb0 + bsel * SHM_V, pa);
    asm volatile("s_waitcnt vmcnt(0)" ::: "memory");
    __syncthreads();
  }
#pragma unroll
  for (int q = 0; q < 2; ++q) {
    float lq = l_reg[q];
    { auto rr = __builtin_amdgcn_permlane32_swap(__float_as_uint(lq), __float_as_uint(lq), false, false); lq = __uint_as_float(rr[0]) + __uint_as_float(rr[1]); }
    if (hi == 0) ws[q * 32 + r32] = lq;
  }
  asm volatile("s_waitcnt lgkmcnt(0)" ::: "memory");
#pragma unroll
  for (int q = 0; q < 2; ++q) {
    float rli[16];
#pragma unroll
    for (int r = 0; r < 16; ++r) rli[r] = __builtin_amdgcn_rcpf(ws[q * 32 + crow(r, hi)]);
    bf16_t* Ow = Ob + (long)(q * 256 + wid * QBLK) * ldo;
#pragma unroll
    for (int r = 0; r < 16; ++r) { const int orow = crow(r, hi);
#pragma unroll
      for (int d0 = 0; d0 < NB; ++d0) { const float v = o[q][d0][r] * rli[r]; Ow[(long)orow * ldo + d0 * 32 + r32] = (bf16_t)(cvtpk(v, v) & 0xffffu); } }
  }
  __syncthreads();
#undef DMA_KV
}
__device__ __forceinline__ void attn_unit_diff(const bf16_t* Qb, int ldq, const bf16_t* __restrict__ Kh, int ldk, const bf16_t* __restrict__ Vh, int ldv,
                                               bf16_t* Ob, int ldo, int nkeys, float qscale, float negb_, const QPrep& qp, ALAS char* lds, int wave0, float lam, const float* g, float post) {
  constexpr int DK = 64, DV = 128, NB = 4, KC = 16, VC = 16, KPT = 2, VPT = 2, SHM_V = KVBLK * DV * 2, SHM_K = 16384;
  int tid; asm volatile("v_mbcnt_lo_u32_b32 %0, -1, 0\n\tv_mbcnt_hi_u32_b32 %0, -1, %0" : "=v"(tid)); tid = (tid + wave0 * 64) & 511;
  const int wid = tid >> 6, lane = tid & 63, r32 = lane & 31, hi = lane >> 5;
  ALAS char* V_lds = lds + LDS_V; ALAS char* K_lds = lds + LDS_K;
  ALAS float* ws = (ALAS float*)(lds + LDS_WS) + wid * 64;
  const bool use_shift = negb_ < -60.f;
  float l_reg[2] = {0.f, 0.f}; f32x16 o[2][NB]; bf16x8 qr[2][DK / 16];
  load_q<DK, 1>(qr[0], Qb + (long)(wid * QBLK + r32) * ldq + hi * 8, qp, qscale, wid, r32, hi);
  SBAR();
  load_q<DK, 1>(qr[1], Qb + 64 + (long)(wid * QBLK + r32) * ldq + hi * 8, qp, qscale, wid, r32, hi);
  SBAR();
#pragma unroll
  for (int q = 0; q < 2; ++q)
#pragma unroll
    for (int d = 0; d < NB; ++d) o[q][d] = f32x16{};
  int kgo[KPT], klo[KPT], vgo[VPT], vlo[VPT];
#pragma unroll
  for (int i = 0; i < KPT; ++i) { const int c = tid + 512 * i; const int row = c / KC, col = (c % KC) * 8; kgo[i] = row * ldk + col; klo[i] = KSWZ(row, col * 2); }
#pragma unroll
  for (int i = 0; i < VPT; ++i) { const int c = tid + 512 * i; const int row = c / VC, col = (c % VC) * 8; vgo[i] = row * ldv + col; vlo[i] = v_st<NB>(row, col); }
  const int vb0 = (int)(unsigned)(unsigned long)V_lds + v_rd_base(lane);
  struct { bf16x8 ks[KPT], vs[VPT]; } sr_;
#define SLOADD(k0) do { _Pragma("unroll") for (int i_ = 0; i_ < KPT; ++i_) sr_.ks[i_] = *reinterpret_cast<const bf16x8*>(Kh + (long)(k0) * ldk + kgo[i_]); \
    _Pragma("unroll") for (int i_ = 0; i_ < VPT; ++i_) sr_.vs[i_] = *reinterpret_cast<const bf16x8*>(Vh + (long)(k0) * ldv + vgo[i_]); } while (0)
#define SWRITED(b) do { _Pragma("unroll") for (int i_ = 0; i_ < KPT; ++i_) *(ALAS bf16x8*)(K_lds + (b) * SHM_K + klo[i_]) = sr_.ks[i_]; \
    _Pragma("unroll") for (int i_ = 0; i_ < VPT; ++i_) *(ALAS bf16x8*)(V_lds + (b) * SHM_V + vlo[i_]) = sr_.vs[i_]; } while (0)
  const int NT = nkeys / KVBLK;
  f32x16 p0, p1; bf16x8 pa0, pa1, pa2, pa3;
  SLOADD(0); asm volatile("s_waitcnt vmcnt(0)" ::: "memory"); SWRITED(0); __syncthreads();
  for (int j = 0; j < NT; ++j) {
    const int bsel = j & 1;
    if (j + 1 < NT) SLOADD((j + 1) * KVBLK);
    SBAR(); qkt<DK, 0>(p0, p1, K_lds + bsel * SHM_K, qr[0], r32, hi); expHalf(p0, negb_, use_shift);
    finishSM(p0, p1, l_reg[0], pa0, pa1, pa2, pa3, negb_, use_shift); SBAR();
    pv_all<NB>(o[0], vb0 + bsel * SHM_V, pa0, pa1, pa2, pa3);
    SBAR(); qkt<DK, 128>(p0, p1, K_lds + bsel * SHM_K, qr[1], r32, hi); expHalf(p0, negb_, use_shift);
    finishSM(p0, p1, l_reg[1], pa0, pa1, pa2, pa3, negb_, use_shift); SBAR();
    pv_all<NB>(o[1], vb0 + bsel * SHM_V, pa0, pa1, pa2, pa3);
    if (j + 1 < NT) { asm volatile("s_waitcnt vmcnt(0)" ::: "memory"); SWRITED(bsel ^ 1); }
    __syncthreads();
  }
#pragma unroll
  for (int q = 0; q < 2; ++q) { float lq = l_reg[q];
    { auto rr = __builtin_amdgcn_permlane32_swap(__float_as_uint(lq), __float_as_uint(lq), false, false); lq = __uint_as_float(rr[0]) + __uint_as_float(rr[1]); }
    if (hi == 0) ws[q * 32 + r32] = lq; }
  asm volatile("s_waitcnt lgkmcnt(0)" ::: "memory");
  float gcol[NB];
#pragma unroll
  for (int d0 = 0; d0 < NB; ++d0) gcol[d0] = g[d0 * 32 + r32] * post;
  bf16_t* Ow = Ob + (long)(wid * QBLK) * ldo;
#pragma unroll
  for (int r = 0; r < 16; ++r) { const int orow = crow(r, hi); const float r1 = __builtin_amdgcn_rcpf(ws[crow(r, hi)]), r2 = __builtin_amdgcn_rcpf(ws[32 + crow(r, hi)]) * lam; float d[NB]; float ss = 0.f;
#pragma unroll
    for (int d0 = 0; d0 < NB; ++d0) { d[d0] = o[0][d0][r] * r1 - o[1][d0][r] * r2; ss += d[d0] * d[d0]; }
    ss += __int_as_float(__builtin_amdgcn_ds_swizzle(__float_as_int(ss), (1 << 10) | 0x1f)); ss += __int_as_float(__builtin_amdgcn_ds_swizzle(__float_as_int(ss), (2 << 10) | 0x1f));
    ss += __int_as_float(__builtin_amdgcn_ds_swizzle(__float_as_int(ss), (4 << 10) | 0x1f)); ss += __int_as_float(__builtin_amdgcn_ds_swizzle(__float_as_int(ss), (8 << 10) | 0x1f));
    ss += __int_as_float(__builtin_amdgcn_ds_swizzle(__float_as_int(ss), (16 << 10) | 0x1f));
    const float rstd = __builtin_amdgcn_rsqf(ss * (1.f / 128.f) + 1e-6f);
#pragma unroll
    for (int d0 = 0; d0 < NB; ++d0) { const float v = d[d0] * rstd * gcol[d0]; Ow[(long)orow * ldo + d0 * 32 + r32] = (bf16_t)(cvtpk(v, v) & 0xffffu); } }
  __syncthreads();
#undef SLOADD
#undef SWRITED
}
#undef KSWZ
#undef KF
#undef SBAR
}
#define GAS __attribute__((address_space(1)))
#define LAS __attribute__((address_space(3)))
typedef unsigned short bf16;
typedef unsigned v4u __attribute__((ext_vector_type(4)));
typedef unsigned v2u __attribute__((ext_vector_type(2)));
typedef float f32x4 __attribute__((ext_vector_type(4)));
typedef float f32x2 __attribute__((ext_vector_type(2)));
typedef GAS unsigned gu32;
#define RLX_AGENT __ATOMIC_RELAXED, __HIP_MEMORY_SCOPE_AGENT
#define LDS_WAIT() asm volatile("s_waitcnt lgkmcnt(0)" ::: "memory")
#define VM_WAIT() asm volatile("s_waitcnt vmcnt(0)" ::: "memory")
__device__ __forceinline__ unsigned f2bf(float f) { unsigned u = __builtin_bit_cast(unsigned, f); return (u + 0x7fffu + ((u >> 16) & 1u)) >> 16; }
__device__ __forceinline__ unsigned pk2(float lo, float hi) { return pg8::cvt_pk_bf16(lo, hi); }
__device__ __forceinline__ float bflo(unsigned w) { return __uint_as_float(w << 16); }
__device__ __forceinline__ float bfhi(unsigned w) { return __uint_as_float(w & 0xffff0000u); }

__device__ __forceinline__ int lane_id() { int l; asm volatile("v_mbcnt_lo_u32_b32 %0, -1, 0\n\tv_mbcnt_hi_u32_b32 %0, -1, %0" : "=v"(l)); return l; }

#define XB_TMO      128
#define XB_XCNT(j)  (256  + 64 * (j))
#define XB_XSUB(j)  (1280 + 64 * (j))
#define XB_XGEN(j)  (2304 + 64 * (j))
#define XB_TOP      3328
#define XB_TOPGEN   3392
#define XCD_BAR_WORDS 3456
#define XB_SPIN_CAP (1u << 18)

__device__ __forceinline__ unsigned xb_ld(unsigned* p)              { return __hip_atomic_load(p, __ATOMIC_RELAXED, __HIP_MEMORY_SCOPE_AGENT); }
__device__ __forceinline__ unsigned xb_add(unsigned* p, unsigned v) { return __hip_atomic_fetch_add(p, v, __ATOMIC_RELAXED, __HIP_MEMORY_SCOPE_AGENT); }
__device__ __forceinline__ unsigned xb_xcc_id() { return (unsigned)__builtin_amdgcn_s_getreg((3 << 11) | 20) & 0xFu; }
#define XB_SPIN(cond, bar) do { unsigned _sp = 0; while (cond) { __builtin_amdgcn_s_sleep(1); \
    if ((++_sp & 255u) == 0u) { if (xb_ld(&(bar)[XB_TMO])) break; if (_sp > XB_SPIN_CAP) { atomicAdd(&(bar)[XB_TMO], 1u); break; } } } } while (0)

struct XcdBarrier {
    unsigned* bar; unsigned x;
    volatile LAS unsigned* st;
};
__device__ __forceinline__ XcdBarrier xcd_barrier_post(unsigned* bar, volatile LAS unsigned* st, int wave0) {
    XcdBarrier b; b.bar = bar; b.x = xb_xcc_id(); b.st = st;
    if (wave0 == 0 && lane_id() == 0) (void)xb_add(&bar[XB_XCNT(b.x)], 1u);
    return b;
}
__device__ __forceinline__ void xcd_barrier_complete(unsigned* bar, unsigned x, unsigned& nloc, unsigned& nx) {
    const unsigned G = gridDim.x * gridDim.y * gridDim.z;
    unsigned sum, cnt, mine, sp = 0u;
    for (;;) {
        sum = 0u; cnt = 0u; mine = 0u;
#pragma unroll
        for (unsigned j = 0; j < 16; ++j) { const unsigned c = xb_ld(&bar[XB_XCNT(j)]); sum += c; cnt += (c > 0u) ? 1u : 0u; mine = (j == x) ? c : mine; }
        if (sum == G) break;
        __builtin_amdgcn_s_sleep(1);
        if ((++sp & 255u) == 0u) { if (xb_ld(&bar[XB_TMO])) break; if (sp > XB_SPIN_CAP) { atomicAdd(&bar[XB_TMO], 1u); break; } }
    }
    nloc = mine > 0u ? mine : 1u; nx = cnt > 0u ? cnt : 1u;
}
__device__ __forceinline__ void xcd_barrier(const XcdBarrier& b, int wave0) {
    asm volatile("s_waitcnt vmcnt(0)" ::: "memory");
    __syncthreads();
    if (wave0 == 0 && lane_id() == 0) {
        unsigned* bar = b.bar;
        __builtin_amdgcn_s_waitcnt(0);
        unsigned nloc = b.st[0], nx = b.st[1];
        if (nloc == 0u) { xcd_barrier_complete(bar, b.x, nloc, nx); b.st[0] = nloc; b.st[1] = nx; }
        const unsigned old = xb_add(&bar[XB_XSUB(b.x)], 1u);
        const unsigned gen = old / nloc;
        if (old + 1u == (gen + 1u) * nloc) {
            __builtin_amdgcn_fence(__ATOMIC_RELEASE, "agent");
            asm volatile("s_waitcnt vmcnt(0)" ::: "memory");
            const unsigned og = xb_add(&bar[XB_TOP], 1u);
            const unsigned tg = og / nx;
            if (og + 1u == (tg + 1u) * nx) xb_add(&bar[XB_TOPGEN], 1u);
            else XB_SPIN(xb_ld(&bar[XB_TOPGEN]) == tg, bar);
            __builtin_amdgcn_fence(__ATOMIC_ACQUIRE, "agent");
            xb_add(&bar[XB_XGEN(b.x)], 1u);
            asm volatile("s_waitcnt vmcnt(0)" ::: "memory");
        } else {
            XB_SPIN(xb_ld(&bar[XB_XGEN(b.x)]) == gen, bar);
            __builtin_amdgcn_fence(__ATOMIC_ACQUIRE, "agent");
            asm volatile("s_waitcnt vmcnt(0)" ::: "memory");
        }
    }
    __syncthreads();
}

template <int CTRL> __device__ __forceinline__ float dpp_f(float v) { return __int_as_float(__builtin_amdgcn_update_dpp(0, __float_as_int(v), CTRL, 0xf, 0xf, true)); }
template <int CTRL> __device__ __forceinline__ int dpp_i(int v) { return __builtin_amdgcn_update_dpp(0, v, CTRL, 0xf, 0xf, true); }
template <int K> __device__ __forceinline__ float xshfl(float v) {
    static_assert(K == 1 || K == 2 || K == 4 || K == 8, "xshfl: K");
    if constexpr (K == 1) return dpp_f<0xB1>(v);
    else if constexpr (K == 2) return dpp_f<0x4E>(v);
    else if constexpr (K == 4) return dpp_f<0x1B>(dpp_f<0x141>(v));
    else return dpp_f<0x128>(v);
}
__device__ __forceinline__ float xshfl16(float v, int lane) { const auto rr = __builtin_amdgcn_permlane16_swap(__float_as_uint(v), __float_as_uint(v), false, false); return __uint_as_float((lane & 16) ? rr[0] : rr[1]); }
__device__ __forceinline__ float sum8(float v) { v += dpp_f<0xB1>(v); v += dpp_f<0x4E>(v); v += dpp_f<0x141>(v); return v; }
__device__ __forceinline__ float sum16(float v) { v = sum8(v); v += dpp_f<0x140>(v); return v; }
__device__ __forceinline__ float half_sum(float v) { v = sum16(v); const auto rr = __builtin_amdgcn_permlane16_swap(__float_as_uint(v), __float_as_uint(v), false, false); return __uint_as_float(rr[0]) + __uint_as_float(rr[1]); }
__device__ __forceinline__ float wave_sum(float v) {
    v = half_sum(v);
    const auto rr = __builtin_amdgcn_permlane32_swap(__float_as_uint(v), __float_as_uint(v), false, false);
    return __uint_as_float(rr[0]) + __uint_as_float(rr[1]);
}
__device__ __forceinline__ float wave_max(float v) {
    v = fmaxf(v, dpp_f<0xB1>(v)); v = fmaxf(v, dpp_f<0x4E>(v)); v = fmaxf(v, dpp_f<0x141>(v)); v = fmaxf(v, dpp_f<0x140>(v));
    { const auto rr = __builtin_amdgcn_permlane16_swap(__float_as_uint(v), __float_as_uint(v), false, false); v = fmaxf(__uint_as_float(rr[0]), __uint_as_float(rr[1])); }
    const auto rr = __builtin_amdgcn_permlane32_swap(__float_as_uint(v), __float_as_uint(v), false, false);
    return fmaxf(__uint_as_float(rr[0]), __uint_as_float(rr[1]));
}
__device__ __forceinline__ int wave_sum_i(int v) {
    v += dpp_i<0xB1>(v); v += dpp_i<0x4E>(v); v += dpp_i<0x141>(v); v += dpp_i<0x140>(v);
    { const auto rr = __builtin_amdgcn_permlane16_swap((unsigned)v, (unsigned)v, false, false); v = (int)(rr[0] + rr[1]); }
    const auto rr = __builtin_amdgcn_permlane32_swap((unsigned)v, (unsigned)v, false, false);
    return (int)(rr[0] + rr[1]);
}
__device__ __forceinline__ float xshfl32(float v, int hi) { const auto rr = __builtin_amdgcn_permlane32_swap(__float_as_uint(v), __float_as_uint(v), false, false); return __uint_as_float(hi ? rr[0] : rr[1]); }
constexpr float NEPS = 1e-6f;
template <int HW, int ROPE>
__device__ __forceinline__ unsigned head_norm_rope(unsigned w, const float* g, const float* cs0, const float* sn0, const float* cs1, const float* sn1, int lane) {
    const int j = (HW == 64) ? (lane & 31) : lane;
    float a = bflo(w), b = bfhi(w);
    float ss = a * a + b * b;
    ss = (HW == 64) ? half_sum(ss) : wave_sum(ss);
    const float rstd = __builtin_amdgcn_rsqf(ss * (1.f / HW) + NEPS);
    const f32x2 gg = *(const f32x2*)(g + 2 * j);
    a = a * rstd * gg.x; b = b * rstd * gg.y;
    if (ROPE == 1) {
        constexpr int HALF_ = HW / 2;
        const float pa = (HALF_ / 2 == 32) ? xshfl32(a, lane >> 5) : xshfl16(a, lane), pb = (HALF_ / 2 == 32) ? xshfl32(b, lane >> 5) : xshfl16(b, lane);
        const int e = 2 * j, f = e % HALF_; const bool first = e < HALF_;
        const f32x2 c = *(const f32x2*)(cs0 + f), s = *(const f32x2*)(sn0 + f);
        a = first ? (a * c.x - pa * s.x) : (a * c.x + pa * s.x);
        b = first ? (b * c.y - pb * s.y) : (b * c.y + pb * s.y);
    } else if (ROPE == 2) {
        const float pa = xshfl<8>(a), pb = xshfl<8>(b);
        const int e = (2 * j) & 31, f = e & 15; const bool first = e < 16; const bool blk1 = (2 * j) >= 32;
        const float* ct = blk1 ? cs1 : cs0; const float* st = blk1 ? sn1 : sn0;
        const f32x2 c = *(const f32x2*)(ct + f), s = *(const f32x2*)(st + f);
        a = first ? (a * c.x - pa * s.x) : (a * c.x + pa * s.x);
        b = first ? (b * c.y - pb * s.y) : (b * c.y + pb * s.y);
    }
    return pk2(a, b);
}
__device__ __forceinline__ unsigned mla_head(float a, float b, const float* g, const float* cs, const float* sn, int lane) {
    const float ss = wave_sum(a * a + b * b);
    const float rstd = __builtin_amdgcn_rsqf(ss * (1.f / 96.f) + NEPS);
    const int jj = lane < 48 ? lane : 0;
    const f32x2 gg = *(const f32x2*)(g + 2 * jj);
    a = a * rstd * gg.x; b = b * rstd * gg.y;
    const float pa = xshfl<8>(a), pb = xshfl<8>(b);
    if (lane >= 32 && lane < 48) {
        const int e = 2 * lane - 64, f = e & 15; const bool first = e < 16;
        const f32x2 c = *(const f32x2*)(cs + f), s = *(const f32x2*)(sn + f);
        a = first ? (a * c.x - pa * s.x) : (a * c.x + pa * s.x);
        b = first ? (b * c.y - pb * s.y) : (b * c.y + pb * s.y);
    }
    return pk2(a, b);
}

template <int HW, int ROPE>
__device__ __forceinline__ unsigned head_apply(unsigned w, f32x2 g2, f32x2 c2, f32x2 s2, int lane) {
    const int j = (HW == 64) ? (lane & 31) : lane;
    float a = bflo(w), b = bfhi(w);
    float ss = a * a + b * b;
    ss = (HW == 64) ? half_sum(ss) : wave_sum(ss);
    const float rstd = __builtin_amdgcn_rsqf(ss * (1.f / HW) + NEPS);
    a = a * rstd * g2.x; b = b * rstd * g2.y;
    if (ROPE == 1) {
        constexpr int HALF_ = HW / 2;
        const float pa = (HALF_ / 2 == 32) ? xshfl32(a, lane >> 5) : xshfl16(a, lane), pb = (HALF_ / 2 == 32) ? xshfl32(b, lane >> 5) : xshfl16(b, lane);
        const bool first = 2 * j < HALF_;
        a = first ? (a * c2.x - pa * s2.x) : (a * c2.x + pa * s2.x);
        b = first ? (b * c2.y - pb * s2.y) : (b * c2.y + pb * s2.y);
    } else if (ROPE == 2) {
        const float pa = xshfl<8>(a), pb = xshfl<8>(b);
        const bool first = ((2 * j) & 31) < 16;
        a = first ? (a * c2.x - pa * s2.x) : (a * c2.x + pa * s2.x);
        b = first ? (b * c2.y - pb * s2.y) : (b * c2.y + pb * s2.y);
    }
    return pk2(a, b);
}
__device__ __forceinline__ unsigned mla_apply(float a, float b, f32x2 g2, f32x2 c2, f32x2 s2, int lane) {
    const float ss = wave_sum(a * a + b * b);
    const float rstd = __builtin_amdgcn_rsqf(ss * (1.f / 96.f) + NEPS);
    a = a * rstd * g2.x; b = b * rstd * g2.y;
    const float pa = xshfl<8>(a), pb = xshfl<8>(b);
    if (lane >= 32 && lane < 48) {
        const bool first = (2 * lane - 64) < 16;
        a = first ? (a * c2.x - pa * s2.x) : (a * c2.x + pa * s2.x);
        b = first ? (b * c2.y - pb * s2.y) : (b * c2.y + pb * s2.y);
    }
    return pk2(a, b);
}
constexpr int NWAVES = 8;
constexpr int BATCH = 16, SEQ = 2048, DM = 1024, M = BATCH * SEQ, MEML = 256, MMEM = BATCH * MEML;
constexpr int FF = 3584, NEXP = 8, DEPTH = 2;
constexpr int RAWW = 3328;
constexpr int C_DQ = 0, C_DK = 512, C_DV = 1024, C_QLAT = 1536, C_KVLAT = 1792, C_KROPE = 1920, C_GQ = 2048, C_GK = 2560, C_GV = 2688, C_MEMQ = 2816;
constexpr int C_OA = 0, C_OB = 1536, C_OC = 2048, C_OD = 2816;
constexpr int MLAW = 1792;
enum { I_X = 0, I_MEM, I_NORM_ATTN_G, I_NORM_MEM_G, I_W_IN, I_DQ_G, I_DK_G, I_DLAMBDA, I_DSUBLN_G, I_MLA_QLAT_G, I_MLA_KVLAT_G, I_W_QUP, I_W_KVUP, I_MLA_Q_G, I_MLA_K_G,
       I_GQA_Q_G, I_GQA_K_G, I_W_MEMKV, I_MEM_Q_G, I_MEM_K_G, I_W_BRANCH, I_W_GATE, I_B_GATE, I_W_OUT, I_NORM_FFN_G, I_DW1, I_DW3, I_DW2, I_ROUTER, I_MW1, I_MW3, I_MW2, N_IN };
constexpr size_t MiB = 1u << 20;
constexpr size_t WS_CTL = 0, CTL_ZERO_BYTES = 64 * 1024;
constexpr size_t WS_TAB = 1 * MiB;
constexpr size_t T_DC = 0, T_DS = T_DC + 2048 * 32 * 4, T_MC = T_DS + 2048 * 32 * 4, T_MS = T_MC + 2048 * 16 * 4, T_QC = T_MS + 2048 * 16 * 4, T_QS = T_QC + 2048 * 64 * 4,
                 T_RC = T_QS + 2048 * 64 * 4, T_RS = T_RC + 32 * 16 * 4, T_CC = T_RS + 32 * 16 * 4, T_CS = T_CC + 64 * 16 * 4, T_END = T_CS + 64 * 16 * 4;
static_assert(T_END <= 2 * MiB, "tables");
constexpr size_t WS_MOE = 3 * MiB;
constexpr size_t WS_AW = 4 * MiB;
constexpr size_t AW_IN = 0, AW_GATE = AW_IN + (size_t)RAWW * DM * 2, AW_BR = AW_GATE + (size_t)4096 * DM * 2, AW_OUT = AW_BR + (size_t)4096 * 512 * 2,
                 AW_QUP = AW_OUT + (size_t)DM * DM * 2, AW_KVUP = AW_QUP + (size_t)768 * 256 * 2, AW_MEMKV = AW_KVUP + (size_t)1024 * 256 * 2, AW_END = AW_MEMKV + (size_t)DM * DM * 2;
static_assert(AW_END <= 32 * MiB, "attention weights");
constexpr size_t WS_HB = 36 * MiB;
constexpr size_t WS_RAW = 100 * MiB;
constexpr size_t WS_G = 308 * MiB;
constexpr size_t WS_MLARAW = 308 * MiB, WS_KMLA = 420 * MiB, WS_ODIFF = 468 * MiB, WS_LATN = 468 * MiB, WS_MEMKV = 532 * MiB, WS_MEMN = 540 * MiB;
constexpr size_t WS_FW = 100 * MiB;
constexpr size_t WS_U = 268 * MiB;
constexpr size_t WS_Y = 380 * MiB;
constexpr size_t WS_XS8 = 184 * MiB;
constexpr size_t WS_XB = 36 * MiB;
constexpr size_t WS_HBM8 = 512 * MiB, WS_TAILP = 544 * MiB;
constexpr size_t WS_HBA = 436 * MiB;
constexpr size_t WS_HBF = 121 * MiB;
constexpr size_t WS_MERGED = 436 * MiB;
constexpr size_t WS_HB8 = 564 * MiB;
constexpr size_t WS_END = 600 * MiB;
constexpr int CW_BAR = 4096;
constexpr int MOE_SLOTS = 2 * M + NEXP * 256;
constexpr size_t MO_SLOT_TOK = 0, MO_TOK_SLOT = 278528, MO_TOK_GATE = MO_TOK_SLOT + (size_t)M * 8, MO_WGCNT = MO_TOK_GATE + (size_t)M * 8, MO_END = MO_WGCNT + 256 * 8 * 4;
static_assert((size_t)MOE_SLOTS * 4 <= MO_TOK_SLOT && MO_END <= 1 * MiB, "MoE lists");
constexpr size_t EXPERT_BYTES = (size_t)3 * FF * DM, W2_OFF = (size_t)2 * FF * DM;
constexpr int MOE_CHUNK_TILES = 128;
constexpr float S_H8 = 16.f, S_W13 = 32.f, S_U8 = 4.f, S_W2 = 64.f, S_WG = 32.f;
constexpr int RING_OFF = 0, RING_BYTES = 131072;
constexpr int LDSCTL_OFF = RING_BYTES, MISC_OFF = LDSCTL_OFF + 320, PTAB_OFF = LDSCTL_OFF + 1024, MOE_LDS = LDSCTL_OFF + 2048;
constexpr int ML_SEL = 0, ML_RNK = 256, ML_CNT = 512, ML_TOT = 520, ML_PRE = 528, ML_SEGB = 536, ML_TE = 576;
constexpr int LDS_BYTES = 147456;
static_assert(att::LDS_BYTES <= RING_BYTES, "attention LDS");

struct Args { const float* in[N_IN]; float* out; unsigned char* ws; };
__device__ __forceinline__ unsigned char* launder(unsigned char* p) { GAS unsigned char* q = (GAS unsigned char*)p; asm volatile("" : "+s"(q)); return (unsigned char*)q; }
__device__ __forceinline__ const float* inp(LAS unsigned char* lds, int i) {
    const volatile LAS unsigned* p = (const volatile LAS unsigned*)(lds + PTAB_OFF) + 2 * i;
    const unsigned lo = __builtin_amdgcn_readfirstlane(p[0]), hi = __builtin_amdgcn_readfirstlane(p[1]);
    const GAS float* q = (const GAS float*)(((unsigned long long)hi << 32) | lo); asm volatile("" : "+s"(q)); return (const float*)q;
}
#define IN(i) inp(lds, (i))

__device__ __forceinline__ void transpose_item(const float* W, int ldw, int k0, int n0, bf16* WT, int ldk, int drow0, LAS float* scr, int lane) {
    f32x4 v[8];
#pragma unroll
    for (int i = 0; i < 8; ++i) v[i] = *(const GAS f32x4*)(W + (size_t)(k0 + 8 * i + (lane >> 3)) * ldw + n0 + 4 * (lane & 7));
#pragma unroll
    for (int i = 0; i < 8; ++i) { LAS float* d = scr + (8 * i + (lane >> 3)) * 33 + 4 * (lane & 7); d[0] = v[i].x; d[1] = v[i].y; d[2] = v[i].z; d[3] = v[i].w; }
    LDS_WAIT(); asm volatile("" ::: "memory");
    const int c = lane & 7;
#pragma unroll
    for (int j = 0; j < 4; ++j) { const int n = (lane >> 3) + 8 * j; const LAS float* s = scr + (8 * c) * 33 + n;
        v4u o; o.x = pk2(s[0 * 33], s[1 * 33]); o.y = pk2(s[2 * 33], s[3 * 33]); o.z = pk2(s[4 * 33], s[5 * 33]); o.w = pk2(s[6 * 33], s[7 * 33]);
        __builtin_nontemporal_store(o, (GAS v4u*)(WT + (size_t)(drow0 + n) * ldk + k0 + 8 * c)); }
    LDS_WAIT(); asm volatile("" ::: "memory");
}
__device__ __forceinline__ void plain_item(int r, const float* W, int K, int N, bf16* WT, int ldk, int drow_shift, LAS float* scr, int lane) {
    const int nbn = N / 32, kb = r / nbn, nb = r % nbn; transpose_item(W, N, 64 * kb, 32 * nb, WT, ldk, 32 * nb + drow_shift, scr, lane);
}
constexpr int FFN_ITEMS_13 = (DM / 64) * (FF / 32), FFN_ITEMS_2 = (FF / 64) * (DM / 32), FFN_ITEMS = 2 * FFN_ITEMS_13 + FFN_ITEMS_2;
__device__ __forceinline__ void ffn_weight_item(int it, const float* w1, const float* w3, const float* w2, bf16* W13t, bf16* W2t, LAS float* scr, int lane) {
    if (it < 2 * FFN_ITEMS_13) { const int which = it / FFN_ITEMS_13, r = it % FFN_ITEMS_13, kb = r / (FF / 32), nb = r % (FF / 32);
        transpose_item(which ? w3 : w1, FF, 64 * kb, 32 * nb, W13t, DM, (nb >> 2) * 256 + (nb & 3) * 32 + which * 128, scr, lane); }
    else { const int r = it - 2 * FFN_ITEMS_13, kb = r / (DM / 32), nb = r % (DM / 32); transpose_item(w2, DM, 64 * kb, 32 * nb, W2t, FF, 32 * nb, scr, lane); }
}
__device__ __forceinline__ void transpose_item8(const float* W, int ldw, int k0, int n0, unsigned char* WT, int ldk, int drow0, float scale, LAS float* scr, int lane) {
    f32x4 v[8];
#pragma unroll
    for (int i = 0; i < 8; ++i) v[i] = *(const GAS f32x4*)(W + (size_t)(k0 + 8 * i + (lane >> 3)) * ldw + n0 + 4 * (lane & 7));
#pragma unroll
    for (int i = 0; i < 8; ++i) { LAS float* d = scr + (8 * i + (lane >> 3)) * 33 + 4 * (lane & 7); d[0] = v[i].x * scale; d[1] = v[i].y * scale; d[2] = v[i].z * scale; d[3] = v[i].w * scale; }
    LDS_WAIT(); asm volatile("" ::: "memory");
    const int c = lane & 7;
#pragma unroll
    for (int j = 0; j < 4; ++j) { const int n = (lane >> 3) + 8 * j; const LAS float* s = scr + (8 * c) * 33 + n;
        v2u o; o.x = pg8::cvt4_fp8(s[0 * 33], s[1 * 33], s[2 * 33], s[3 * 33]); o.y = pg8::cvt4_fp8(s[4 * 33], s[5 * 33], s[6 * 33], s[7 * 33]);
        __builtin_nontemporal_store(o, (GAS v2u*)(WT + (size_t)(drow0 + n) * ldk + k0 + 8 * c)); }
    LDS_WAIT(); asm volatile("" ::: "memory");
}
__device__ __forceinline__ void ffn_weight_item8(int it, const float* w1, const float* w3, const float* w2, unsigned char* W13t, unsigned char* W2t, LAS float* scr, int lane) {
    if (it < 2 * FFN_ITEMS_13) { const int which = it / FFN_ITEMS_13, r = it % FFN_ITEMS_13, kb = r / (FF / 32), nb = r % (FF / 32);
        transpose_item8(which ? w3 : w1, FF, 64 * kb, 32 * nb, W13t, DM, (nb >> 2) * 256 + (nb & 3) * 32 + which * 128, S_W13, scr, lane); }
    else { const int r = it - 2 * FFN_ITEMS_13, kb = r / (DM / 32), nb = r % (DM / 32); transpose_item8(w2, DM, 64 * kb, 32 * nb, W2t, FF, 32 * nb, S_W2, scr, lane); }
}
constexpr int AI_IN = 16 * 101, AI_GATE = 4 * 16 * 32, AI_BR = 4 * 8 * 32, AI_OUT = 16 * 32, AI_QUP = 4 * 24, AI_KVUP = 2 * 32, AI_MEMKV = 16 * 32;
constexpr int AI_TOTAL = AI_IN + AI_GATE + AI_BR + AI_OUT + AI_QUP + AI_KVUP + AI_MEMKV;
__device__ __forceinline__ void attn_weight_item(int it, int l, LAS unsigned char* lds, unsigned char* aw, LAS float* scr, int lane) {
    int r = it;
    if (r < AI_IN) { const int kb = r / 101, nb = r % 101;
        transpose_item(IN(I_W_IN) + (size_t)l * DM * 3232, 3232, 64 * kb, 32 * nb, (bf16*)(aw + AW_IN), DM, 32 * nb + (nb >= 61 ? 96 : 0), scr, lane); return; } r -= AI_IN;
    if (r < AI_GATE) { const int b = r / 512, rr = r % 512, kb = rr / 32, nb = rr % 32;
        transpose_item8(IN(I_W_GATE) + ((size_t)l * 4 + b) * DM * DM, DM, 64 * kb, 32 * nb, aw + AW_GATE, DM, 32 * nb + b * 1024, S_WG, scr, lane); return; } r -= AI_GATE;
    if (r < AI_BR) { const int b = r / 256; plain_item(r % 256, IN(I_W_BRANCH) + ((size_t)l * 4 + b) * 512 * DM, 512, DM, (bf16*)(aw + AW_BR), 512, b * 1024, scr, lane); return; } r -= AI_BR;
    if (r < AI_OUT) { plain_item(r, IN(I_W_OUT) + (size_t)l * DM * DM, DM, DM, (bf16*)(aw + AW_OUT), DM, 0, scr, lane); return; } r -= AI_OUT;
    if (r < AI_QUP) { plain_item(r, IN(I_W_QUP) + (size_t)l * 256 * 768, 256, 768, (bf16*)(aw + AW_QUP), 256, 0, scr, lane); return; } r -= AI_QUP;
    if (r < AI_KVUP) { plain_item(r, IN(I_W_KVUP) + (size_t)l * 128 * 1024, 128, 1024, (bf16*)(aw + AW_KVUP), 256, 0, scr, lane); return; } r -= AI_KVUP;
    plain_item(r, IN(I_W_MEMKV) + (size_t)l * DM * DM, DM, DM, (bf16*)(aw + AW_MEMKV), DM, 0, scr, lane);
}
template <bool IN_BF> __device__ __forceinline__ f32x4 rr_load(const float* X, int m, int lane, int j) {
    if constexpr (IN_BF) { const v2u w = ((const GAS v2u*)((const bf16*)X + (size_t)m * DM) + lane)[64 * j]; return (f32x4){bflo(w.x), bfhi(w.x), bflo(w.y), bfhi(w.y)}; }
    else return ((const GAS f32x4*)(X + (size_t)m * DM) + lane)[64 * j];
}
template <bool F8COPY = false, bool BF = true, bool IN_BF = false>
__device__ __forceinline__ void rms_rows_to_bf16(const float* X, const float* g, bf16* O, int nrows, int gw, int NGW, int lane, unsigned char* O8 = nullptr, float s8 = 1.0f) {
    f32x4 gg[4];
#pragma unroll
    for (int j = 0; j < 4; ++j) gg[j] = ((const GAS f32x4*)g + lane)[64 * j];
    if (gw >= nrows) return;
    f32x4 cur[4], nxt[4];
#pragma unroll
    for (int j = 0; j < 4; ++j) { cur[j] = rr_load<IN_BF>(X, gw, lane, j); nxt[j] = cur[j]; }
    for (int m = gw; m < nrows; m += NGW) {
        const int mn = m + NGW;
        if (mn < nrows) {
#pragma unroll
            for (int j = 0; j < 4; ++j) nxt[j] = rr_load<IN_BF>(X, mn, lane, j);
        }
        float s = 0.f;
#pragma unroll
        for (int j = 0; j < 4; ++j) s += (cur[j].x * cur[j].x + cur[j].y * cur[j].y) + (cur[j].z * cur[j].z + cur[j].w * cur[j].w);
        const float rstd = __builtin_amdgcn_rsqf(wave_sum(s) * (1.f / DM) + NEPS);
        GAS unsigned long long* o8 = (GAS unsigned long long*)(O + (size_t)m * DM) + lane;
#pragma unroll
        for (int j = 0; j < 4; ++j) __builtin_nontemporal_store((unsigned long long)pk2(cur[j].x * rstd * gg[j].x, cur[j].y * rstd * gg[j].y) | ((unsigned long long)pk2(cur[j].z * rstd * gg[j].z, cur[j].w * rstd * gg[j].w) << 32), o8 + 64 * j);
        if constexpr (F8COPY) { GAS unsigned* o4 = (GAS unsigned*)(O8 + (size_t)m * DM) + lane; const float r8 = rstd * s8;
#pragma unroll
            for (int j = 0; j < 4; ++j) __builtin_nontemporal_store(pg8::cvt4_fp8(cur[j].x * r8 * gg[j].x, cur[j].y * r8 * gg[j].y, cur[j].z * r8 * gg[j].z, cur[j].w * r8 * gg[j].w), o4 + 64 * j); }
#pragma unroll
        for (int j = 0; j < 4; ++j) cur[j] = nxt[j];
    }
}
__device__ __forceinline__ void rope_entry(int pos, int i, int dim, float* c, float* s) {
    const float e = (float)(2 * i) / (float)dim;
    const float inv = 1.0f / powf(10000.0f, e);
    const float ang = (float)pos * inv;
    const double ad = (double)ang, k = rint(ad * 0.15915494309189535), r = ad - k * 6.283185307179586;
    const float rf = (float)r;
    *c = cosf(rf); *s = sinf(rf);
}

struct UpOrder : pg8::StaticOrder {
    const bf16* wq; const bf16* wkv;
    __device__ __forceinline__ const char* a_ptr(const pg8::Gemm& g, const pg8::Unit& u) const { return (const char*)g.A + (size_t)u.pm * (256 * 2) * g.lda + (u.pn >= 3 ? 512 : 0); }
    __device__ __forceinline__ const char* b_ptr(const pg8::Gemm& g, const pg8::Unit& u) const { return u.pn >= 3 ? (const char*)wkv + (size_t)(u.pn - 3) * 256 * 256 * 2 : (const char*)wq + (size_t)u.pn * 256 * 256 * 2; }
};
struct MergeOrder : pg8::StaticOrder {
    __device__ __forceinline__ bool next(int i, pg8::Unit& u) const { if (!tile((long)(i >> 2) * G + c, u)) return false; u.z = i & 3; return true; }
    __device__ __forceinline__ const char* a_ptr(const pg8::Gemm& g, const pg8::Unit& u) const {
        const int co = u.z == 0 ? C_OA : u.z == 1 ? C_OB : u.z == 2 ? C_OC : C_OD; return (const char*)g.A + (size_t)u.pm * (256 * 2) * g.lda + co * 2; }
    __device__ __forceinline__ const char* b_ptr(const pg8::Gemm& g, const pg8::Unit& u) const { return (const char*)g.Bt + (size_t)(u.z * 1024 + u.pn * 256) * g.ldb * 2; }
};
struct MoeUpOrder : pg8::StaticOrder {
    const int* slot_tok; int tile0; const volatile LAS int* te; const char* wbase;
    __device__ __forceinline__ const char* a_ptr(const pg8::Gemm& g, const pg8::Unit&) const { return (const char*)g.A; }
    __device__ __forceinline__ const char* b_ptr(const pg8::Gemm& g, const pg8::Unit& u) const { const int e = __builtin_amdgcn_readfirstlane(te[tile0 + u.pm]); return wbase + (size_t)e * EXPERT_BYTES + (size_t)u.pn * (256 * 2) * g.ldb; }
    __device__ __forceinline__ unsigned row_off(const pg8::Gemm& g, const pg8::Unit& u, int row) const { return (unsigned)slot_tok[(tile0 + u.pm) * 256 + row] * (unsigned)(g.lda * 2); }
};
struct MoeDownOrder : pg8::StaticOrder {
    int tile0; const volatile LAS int* te; const char* wbase;
    __device__ __forceinline__ const char* b_ptr(const pg8::Gemm& g, const pg8::Unit& u) const { const int e = __builtin_amdgcn_readfirstlane(te[tile0 + u.pm]); return wbase + (size_t)e * EXPERT_BYTES + (size_t)u.pn * (256 * 2) * g.ldb; }
};
__device__ __forceinline__ float wave_max_abs(const float* g, int n, int lane) {
    float v = lane < n ? fabsf(g[lane]) : 0.f; if (lane + 64 < n) v = fmaxf(v, fabsf(g[lane + 64]));
    return wave_max(v);
}
__device__ __forceinline__ v2u tail_row(const float* P, int rows, int r, int q, float sc) {
    f32x4 s = *((const GAS f32x4*)(P + (size_t)r * DM) + q);
#pragma unroll
    for (int z = 1; z < 7; ++z) s += *((const GAS f32x4*)(P + ((size_t)z * rows + r) * DM) + q);
    v2u o; o.x = pk2(s.x * sc, s.y * sc); o.y = pk2(s.z * sc, s.w * sc); return o;
}
struct TailDownOrder : pg8::StaticOrder {
    const volatile LAS int* te; const char* wbase;
    __device__ __forceinline__ bool next(int i, pg8::Unit& u) const { const int L = i * G + c; if (L >= nwg * 7) return false; u.z = L % 7; const int t = L / 7; u.pn = __builtin_amdgcn_readfirstlane(t % nN); u.pm = __builtin_amdgcn_readfirstlane(t / nN); return true; }
    __device__ __forceinline__ const char* a_ptr(const pg8::Gemm& g, const pg8::Unit& u) const { return (const char*)g.A + (size_t)u.pm * (256 * 2) * g.lda + (size_t)u.z * 512; }
    __device__ __forceinline__ const char* b_ptr(const pg8::Gemm& g, const pg8::Unit& u) const { const int e = __builtin_amdgcn_readfirstlane(te[256 + u.pm]); return wbase + (size_t)e * EXPERT_BYTES + (size_t)u.pn * (256 * 2) * g.ldb + (size_t)u.z * 512; }
};
struct EpiPartF32 {
    static constexpr bool PERM = false;
    float* P; int rows;
    __device__ __forceinline__ bool keep(const pg8::Unit&) const { return false; }
    __device__ __forceinline__ void operator()(const pg8::f32x4 (&acc)[2][2][4][2], const pg8::Unit& u, int wr, int wc, int fr, int fq) const {
        const int row0 = u.pm * 256 + wr * 64 + fr, col0 = u.pn * 256 + wc * 32 + 4 * fq;
        GAS float* pb = (GAS float*)(P + ((size_t)u.z * rows + row0) * DM + col0);
#pragma unroll
        for (int ai = 0; ai < 2; ++ai)
#pragma unroll
            for (int m = 0; m < 4; ++m)
#pragma unroll
                for (int bj = 0; bj < 2; ++bj)
#pragma unroll
                    for (int n = 0; n < 2; ++n) __builtin_nontemporal_store(acc[ai][bj][m][n], (GAS pg8::f32x4*)(pb + (size_t)(ai * 128 + m * 16) * DM + bj * 128 + n * 16));
    }
};
struct EpiMerge {
    static constexpr bool PERM = true;
    const unsigned char* Gq;
    bf16* Mg;
    __device__ __forceinline__ bool keep(const pg8::Unit& u) const { return u.z < 3; }
    __device__ __forceinline__ void operator()(pg8::f32x4 (&acc)[2][2][4][2], const pg8::Unit& u, int wr, int wc, int fr, int fq) const {
        const int row0 = u.pm * 256 + wr * 64 + fr, col0 = u.pn * 256 + wc * 32 + 8 * fq, z = u.z;
#pragma unroll
        for (int ai = 0; ai < 2; ++ai)
#pragma unroll
            for (int mp = 0; mp < 2; ++mp) {
                const GAS unsigned char* gb = (const GAS unsigned char*)(Gq + ((size_t)(u.pm * 16 + u.pn) << 16) + ((wr * 4 + wc) << 13) + (fq * 16 + fr) * 8);
                asm volatile("" : "+v"(gb));
                v2u gn[2][2], gd[2][2];
#pragma unroll
                for (int mm = 0; mm < 2; ++mm)
#pragma unroll
                    for (int bj = 0; bj < 2; ++bj) { const int m = 2 * mp + mm; const GAS unsigned char* gp = gb + (((ai * 4 + m) * 2 + bj) << 9);
                        gn[mm][bj] = *(const GAS v2u*)(gp + ((size_t)(z * 4) << 16)); if (z < 3) gd[mm][bj] = *(const GAS v2u*)(gp + ((size_t)(z * 4 + 4) << 16)); }
#pragma unroll
                for (int mm = 0; mm < 2; ++mm)
#pragma unroll
                    for (int bj = 0; bj < 2; ++bj) { const int m = 2 * mp + mm; const v2u g = gn[mm][bj];
                        float f[8];
#pragma unroll
                        for (int e = 0; e < 8; ++e) f[e] = (float)(((e < 4 ? g.x : g.y) >> (8 * (e & 3))) & 0xffu);
                        if (z < 3) { const v2u d = gd[mm][bj];
#pragma unroll
                            for (int e = 0; e < 8; ++e) f[e] *= __builtin_amdgcn_rcpf((float)(((e < 4 ? d.x : d.y) >> (8 * (e & 3))) & 0xffu)); }
                        else {
#pragma unroll
                            for (int e = 0; e < 8; ++e) f[e] *= (1.0f / 255.0f); }
                        pg8::f32x4& v0 = acc[ai][bj][m][0]; pg8::f32x4& v1 = acc[ai][bj][m][1];
                        v0[0] *= f[0]; v0[1] *= f[1]; v0[2] *= f[2]; v0[3] *= f[3]; v1[0] *= f[4]; v1[1] *= f[5]; v1[2] *= f[6]; v1[3] *= f[7];
                        if (z == 3) { v4u w; w.x = pg8::cvt_pk_bf16(v0[0], v0[1]); w.y = pg8::cvt_pk_bf16(v0[2], v0[3]); w.z = pg8::cvt_pk_bf16(v1[0], v1[1]); w.w = pg8::cvt_pk_bf16(v1[2], v1[3]);
                            __builtin_nontemporal_store(w, (GAS v4u*)(Mg + (size_t)(row0 + ai * 128 + m * 16) * 1024 + col0 + bj * 128)); } }
                asm volatile("" ::: "memory");
            }
    }
};

__global__ void __launch_bounds__(NWAVES * 64, 2) fwd(Args args) {
    extern __shared__ __attribute__((aligned(16))) unsigned char lds_raw[];
    LAS unsigned char* lds = (LAS unsigned char*)lds_raw;
    volatile LAS unsigned* MISC = (volatile LAS unsigned*)(lds + MISC_OFF);
    const int tid = threadIdx.x; const int wave0 = __builtin_amdgcn_readfirstlane(tid >> 6);
    constexpr int G = 256; const int bx = blockIdx.x; const int vcu = (bx % 8) * (G / 8) + bx / 8;
    unsigned char* ws = args.ws;
    gu32* ctl = (gu32*)(ws + WS_CTL);
    for (int u = tid; u < (LDS_BYTES - LDSCTL_OFF) / 4; u += NWAVES * 64) ((LAS unsigned*)(lds + LDSCTL_OFF))[u] = 0u;
    __syncthreads();
    XcdBarrier bar = xcd_barrier_post((unsigned*)(ctl + CW_BAR), MISC + 8, wave0);
    float* out = args.out;
    if (tid < N_IN) ((LAS unsigned long long*)(lds + PTAB_OFF))[tid] = (unsigned long long)args.in[tid];
    __syncthreads();
#define PHASE_PTRS unsigned char* wsp = launder(ws); int lane = lane_id(); asm volatile("" : "+v"(lane)); int wave = wave0; asm volatile("" : "+s"(wave)); \
    const int gw = vcu * NWAVES + wave, NGW = G * NWAVES; const int gt = gw * 64 + lane, NGT = NGW * 64; LAS float* scr = (LAS float*)(lds + RING_OFF + wave * 16384); \
    (void)gw; (void)NGW; (void)gt; (void)NGT; (void)scr; \
    bf16* HB = (bf16*)(wsp + WS_HB); bf16* RAW = (bf16*)(wsp + WS_RAW); bf16* GT = (bf16*)(wsp + WS_G); \
    bf16* MLARAW = (bf16*)(wsp + WS_MLARAW); bf16* KMLA = (bf16*)(wsp + WS_KMLA); bf16* ODIFF = (bf16*)(wsp + WS_ODIFF); bf16* LATN = (bf16*)(wsp + WS_LATN); \
    bf16* MEMKV = (bf16*)(wsp + WS_MEMKV); bf16* MEMN = (bf16*)(wsp + WS_MEMN); \
    bf16* W13t = (bf16*)(wsp + WS_FW); bf16* W2t = W13t + (size_t)2 * FF * DM; bf16* U = (bf16*)(wsp + WS_U); \
    unsigned char* aw = wsp + WS_AW; const float* tab = (const float*)(wsp + WS_TAB); \
    (void)HB; (void)RAW; (void)GT; (void)MLARAW; (void)KMLA; (void)ODIFF; (void)LATN; (void)MEMKV; (void)MEMN; (void)W13t; (void)W2t; (void)U; (void)aw; (void)tab

#pragma unroll 1
    for (int l = 0; l < DEPTH; ++l) {
        const float lambda_init = (l == 0) ? 0.2f : (0.8f - 0.6f * 0.74081822068171788f);
        {
            PHASE_PTRS;
            for (int it = gw; it < AI_TOTAL; it += NGW) attn_weight_item(it, l, lds, aw, scr, lane);
            unsigned zz_ = 0u; asm volatile("" : "+v"(zz_)); const v4u zero4 = {zz_, zz_, zz_, zz_};
            for (int c = gt; c < 96 * 128; c += NGT) *(GAS v4u*)(aw + AW_IN + (size_t)1952 * DM * 2 + (size_t)c * 16) = zero4;
            for (int c = gt; c < 1024 * 16; c += NGT) *(GAS v4u*)(aw + AW_KVUP + (size_t)(c >> 4) * 512 + 256 + (c & 15) * 16) = zero4;
            if (l == 0) rms_rows_to_bf16<true>(IN(I_X), IN(I_NORM_ATTN_G), (bf16*)(wsp + WS_HBA), M, gw, NGW, lane, wsp + WS_HB8, S_H8);
            else rms_rows_to_bf16<true, true, true>((const float*)(wsp + WS_XB), IN(I_NORM_ATTN_G) + DM, (bf16*)(wsp + WS_HBA), M, gw, NGW, lane, wsp + WS_HB8, S_H8);
            rms_rows_to_bf16(IN(I_MEM), IN(I_NORM_MEM_G) + l * DM, MEMN, MMEM, gw, NGW, lane);
            if (l == 0) {
                float* tw = (float*)(wsp + WS_TAB);
                for (int e = gt; e < 2048 * 32; e += NGT) rope_entry(e >> 5, e & 31, 64, tw + T_DC / 4 + e, tw + T_DS / 4 + e);
                for (int e = gt; e < 2048 * 16; e += NGT) rope_entry(e >> 4, e & 15, 32, tw + T_MC / 4 + e, tw + T_MS / 4 + e);
                for (int e = gt; e < 2048 * 64; e += NGT) rope_entry(e >> 6, e & 63, 128, tw + T_QC / 4 + e, tw + T_QS / 4 + e);
                for (int e = gt; e < 32 * 16; e += NGT) rope_entry(e >> 4, e & 15, 32, tw + T_RC / 4 + e, tw + T_RS / 4 + e);
                for (int e = gt; e < 64 * 16; e += NGT) rope_entry(e >> 4, e & 15, 32, tw + T_CC / 4 + e, tw + T_CS / 4 + e);
            }
        }
        xcd_barrier(bar, wave0);
        {
            PHASE_PTRS;
            pg8::Gemm g{(const bf16*)(wsp + WS_HBA), (const bf16*)(aw + AW_IN), DM, DM, DM}; pg8::StaticOrder S; S.init(M / 256, RAWW / 256, G, bx);
            pg8::EpiBf16 E{RAW, RAWW};
            pg8::gemm_phase<pg8::EpiBf16, pg8::StaticOrder, true, false>(lds + RING_OFF, g, S, E, wave0);
            pg8::Gemm g2{MEMN, (const bf16*)(aw + AW_MEMKV), DM, DM, DM}; pg8::StaticOrder S2; S2.init(MMEM / 256, DM / 256, G, (bx + G / 2) % G);
            pg8::EpiBf16 E2{MEMKV, DM};
            pg8::gemm_phase<pg8::EpiBf16, pg8::StaticOrder, true, false>(lds + RING_OFF, g2, S2, E2, wave0);
        }
        xcd_barrier(bar, wave0);
        {
            PHASE_PTRS;
            const int j32 = lane & 31, hh = lane >> 3, j8 = lane & 7;
            const f32x4 gdk0 = *(const GAS f32x4*)(IN(I_DK_G) + l * 64 + 4 * j8), gdk1 = *(const GAS f32x4*)(IN(I_DK_G) + l * 64 + 32 + 4 * j8);
            const f32x2 ggk = *((const f32x2*)(IN(I_GQA_K_G) + l * 64) + j32);
            const f32x2 gmk = *((const f32x2*)(IN(I_MEM_K_G) + l * 128) + lane);
            const f32x2 gql0 = *((const f32x2*)(IN(I_MLA_QLAT_G) + l * 256) + lane), gql1 = *((const f32x2*)(IN(I_MLA_QLAT_G) + l * 256 + 128) + lane), gkl = *((const f32x2*)(IN(I_MLA_KVLAT_G) + l * 128) + lane);
            const int fa = (2 * j32) & 15, fm = (2 * lane) & 63; const bool ablk1 = (2 * j32) >= 32;
#define T1_LOAD(K0_, K1_, W_, DC_, DS_, AC_, AS_, mm) do { const int pos_ = (mm) & (SEQ - 1), grow_ = pos_ >> 6, gcol_ = pos_ & 63; const GAS unsigned* rp_ = (const GAS unsigned*)(RAW + (size_t)(mm) * RAWW) + lane; \
                K0_ = *(const GAS v2u*)(RAW + (size_t)(mm) * RAWW + C_DK + 64 * hh + 4 * j8); K1_ = *(const GAS v2u*)(RAW + (size_t)(mm) * RAWW + C_DK + 64 * hh + 32 + 4 * j8); \
                W_[0] = rp_[64 * 12]; W_[1] = rp_[64 * 13]; W_[2] = rp_[64 * 14]; W_[3] = rp_[64 * 20]; \
                DC_ = *(const GAS f32x4*)(tab + T_DC / 4 + pos_ * 32 + 4 * j8); DS_ = *(const GAS f32x4*)(tab + T_DS / 4 + pos_ * 32 + 4 * j8); \
                AC_ = *(const GAS f32x2*)(tab + (ablk1 ? T_CC / 4 + gcol_ * 16 : T_RC / 4 + grow_ * 16) + fa); AS_ = *(const GAS f32x2*)(tab + (ablk1 ? T_CS / 4 + gcol_ * 16 : T_RS / 4 + grow_ * 16) + fa); } while (0)
            v2u k0, k1, k0n, k1n; unsigned w[4], wn[4]; f32x4 dc, ds, dcn, dsn; f32x2 ac, as, acn, asn;
            T1_LOAD(k0, k1, w, dc, ds, ac, as, gw);
            k0n = k0; k1n = k1; dcn = dc; dsn = ds; acn = ac; asn = as;
#pragma unroll
            for (int c = 0; c < 4; ++c) wn[c] = w[c];
            for (int m = gw; m < M; m += NGW) {
                if (m + NGW < M) { T1_LOAD(k0n, k1n, wn, dcn, dsn, acn, asn, m + NGW); }
                v2u o0, o1;
                { float a[4] = {bflo(k0.x), bfhi(k0.x), bflo(k0.y), bfhi(k0.y)}, b[4] = {bflo(k1.x), bfhi(k1.x), bflo(k1.y), bfhi(k1.y)};
                  float ss = 0.f;
#pragma unroll
                  for (int i = 0; i < 4; ++i) ss += a[i] * a[i] + b[i] * b[i];
                  const float rstd = __builtin_amdgcn_rsqf(sum8(ss) * (1.f / 64.f) + NEPS);
                  float y0[4], y1[4];
#pragma unroll
                  for (int i = 0; i < 4; ++i) { const float p = a[i] * rstd * gdk0[i], q = b[i] * rstd * gdk1[i]; y0[i] = p * dc[i] - q * ds[i]; y1[i] = q * dc[i] + p * ds[i]; }
                  o0.x = pk2(y0[0], y0[1]); o0.y = pk2(y0[2], y0[3]); o1.x = pk2(y1[0], y1[1]); o1.y = pk2(y1[2], y1[3]); }
                const unsigned wg = head_apply<64, 2>(w[3], ggk, ac, as, lane);
                unsigned l0, l1, l2;
                { const float a0 = bflo(w[0]), a1 = bfhi(w[0]), a2 = bflo(w[1]), a3 = bfhi(w[1]);
                  const float rstd = __builtin_amdgcn_rsqf(wave_sum(a0 * a0 + a1 * a1 + a2 * a2 + a3 * a3) * (1.f / 256.f) + NEPS);
                  l0 = pk2(a0 * rstd * gql0.x, a1 * rstd * gql0.y); l1 = pk2(a2 * rstd * gql1.x, a3 * rstd * gql1.y); }
                { const float a0 = bflo(w[2]), a1 = bfhi(w[2]);
                  const float rstd = __builtin_amdgcn_rsqf(wave_sum(a0 * a0 + a1 * a1) * (1.f / 128.f) + NEPS); l2 = pk2(a0 * rstd * gkl.x, a1 * rstd * gkl.y); }
                GAS bf16* kp = (GAS bf16*)(RAW + (size_t)m * RAWW + C_DK + 64 * hh + 4 * j8);
                __builtin_nontemporal_store(o0, (GAS v2u*)kp); __builtin_nontemporal_store(o1, (GAS v2u*)(kp + 32));
                __builtin_nontemporal_store(wg, (GAS unsigned*)(RAW + (size_t)m * RAWW) + lane + 64 * 20);
                GAS unsigned* lp = (GAS unsigned*)(LATN + (size_t)m * 512) + lane;
                __builtin_nontemporal_store(l0, lp); __builtin_nontemporal_store(l1, lp + 64); __builtin_nontemporal_store(l2, lp + 128); __builtin_nontemporal_store(0u, lp + 192);
                k0 = k0n; k1 = k1n; dc = dcn; ds = dsn; ac = acn; as = asn;
#pragma unroll
                for (int c = 0; c < 4; ++c) w[c] = wn[c];
            }
#undef T1_LOAD
            for (int m = gw; m < MMEM; m += NGW) {
                const int pos = m & (MEML - 1);
                GAS unsigned* kp = (GAS unsigned*)(MEMKV + (size_t)m * DM) + lane;
                unsigned w[4];
#pragma unroll
                for (int h = 0; h < 4; ++h) w[h] = kp[128 * h];
                const f32x2 qc = *(const GAS f32x2*)(tab + T_QC / 4 + pos * 64 + fm), qs = *(const GAS f32x2*)(tab + T_QS / 4 + pos * 64 + fm);
#pragma unroll
                for (int h = 0; h < 4; ++h) w[h] = head_apply<128, 1>(w[h], gmk, qc, qs, lane);
#pragma unroll
                for (int h = 0; h < 4; ++h) kp[128 * h] = w[h];
            }
        }
        xcd_barrier(bar, wave0);
        {
            PHASE_PTRS;
            pg8::Gemm g{LATN, nullptr, 512, 256, 256}; UpOrder S; S.init(M / 256, 7, G, bx); S.wq = (const bf16*)(aw + AW_QUP); S.wkv = (const bf16*)(aw + AW_KVUP);
            pg8::EpiBf16 E{MLARAW, MLAW};
            pg8::gemm_phase<pg8::EpiBf16, UpOrder, true, false>(lds + RING_OFF, g, S, E, wave0);
        }
        xcd_barrier(bar, wave0);
        {
            PHASE_PTRS;
            const int hh = lane >> 3, j = lane & 7;
            const float* gkp = IN(I_MLA_K_G) + l * 96;
            const f32x4 gn0 = *(const GAS f32x4*)(gkp + 8 * j), gn1 = *(const GAS f32x4*)(gkp + 8 * j + 4), gr = *(const GAS f32x4*)(gkp + 64 + 4 * j);
            const bool first = j < 4;
#define T2_LOAD(KN_, KR_, MC_, MS_, mm) do { const int pos_ = (mm) & (SEQ - 1); \
                KN_ = *(const GAS v4u*)(MLARAW + (size_t)(mm) * MLAW + 768 + 128 * hh + 8 * j); KR_ = *(const GAS v2u*)(RAW + (size_t)(mm) * RAWW + C_KROPE + 4 * j); \
                MC_ = *(const GAS f32x4*)(tab + T_MC / 4 + pos_ * 16 + 4 * (j & 3)); MS_ = *(const GAS f32x4*)(tab + T_MS / 4 + pos_ * 16 + 4 * (j & 3)); } while (0)
            v4u kn, knn; v2u kr, krn; f32x4 mc, ms, mcn, msn;
            T2_LOAD(kn, kr, mc, ms, gw);
            knn = kn; krn = kr; mcn = mc; msn = ms;
            for (int m = gw; m < M; m += NGW) {
                if (m + NGW < M) { T2_LOAD(knn, krn, mcn, msn, m + NGW); }
                float a[8] = {bflo(kn.x), bfhi(kn.x), bflo(kn.y), bfhi(kn.y), bflo(kn.z), bfhi(kn.z), bflo(kn.w), bfhi(kn.w)};
                float r[4] = {bflo(kr.x), bfhi(kr.x), bflo(kr.y), bfhi(kr.y)};
                float ss = 0.f;
#pragma unroll
                for (int i = 0; i < 8; ++i) ss += a[i] * a[i];
#pragma unroll
                for (int i = 0; i < 4; ++i) ss += r[i] * r[i];
                ss = sum8(ss);
                const float rstd = __builtin_amdgcn_rsqf(ss * (1.f / 96.f) + NEPS);
                v4u on; on.x = pk2(a[0] * rstd * gn0.x, a[1] * rstd * gn0.y); on.y = pk2(a[2] * rstd * gn0.z, a[3] * rstd * gn0.w);
                on.z = pk2(a[4] * rstd * gn1.x, a[5] * rstd * gn1.y); on.w = pk2(a[6] * rstd * gn1.z, a[7] * rstd * gn1.w);
#pragma unroll
                for (int i = 0; i < 4; ++i) { r[i] = r[i] * rstd * gr[i]; }
                float y[4];
#pragma unroll
                for (int i = 0; i < 4; ++i) { const float pr = xshfl<4>(r[i]); y[i] = first ? (r[i] * mc[i] - pr * ms[i]) : (r[i] * mc[i] + pr * ms[i]); }
                v2u orp; orp.x = pk2(y[0], y[1]); orp.y = pk2(y[2], y[3]);
                GAS bf16* kp = (GAS bf16*)(KMLA + (size_t)m * 768 + 96 * hh);
                __builtin_nontemporal_store(on, (GAS v4u*)(kp + 8 * j)); __builtin_nontemporal_store(orp, (GAS v2u*)(kp + 64 + 4 * j));
                kn = knn; kr = krn; mc = mcn; ms = msn;
            }
#undef T2_LOAD
        }
        xcd_barrier(bar, wave0);
        {
            PHASE_PTRS;
            LAS char* al = (LAS char*)(lds + RING_OFF);
            constexpr float L2E = 1.4426950408889634f;
#define NBOUND(c, gq, gk, n) __uint_as_float(__builtin_amdgcn_readfirstlane(__float_as_uint(-(c) * L2E * wave_max_abs((gq), (n), lane) * wave_max_abs((gk), (n), lane))))
            const float nb_diff = NBOUND(8.0f, IN(I_DQ_G) + l * 64, IN(I_DK_G) + l * 64, 64);
            const float nb_mla = NBOUND(9.797958971f, IN(I_MLA_Q_G) + l * 96, IN(I_MLA_K_G) + l * 96, 96);
            const float nb_gqa = NBOUND(8.0f, IN(I_GQA_Q_G) + l * 64, IN(I_GQA_K_G) + l * 64, 64);
            const float nb_mem = NBOUND(11.3137085f, IN(I_MEM_Q_G) + l * 128, IN(I_MEM_K_G) + l * 128, 128);
            const float* lp_ = IN(I_DLAMBDA) + l * 256;
            const float lam = __uint_as_float(__builtin_amdgcn_readfirstlane(__float_as_uint(expf(wave_sum(lp_[lane] * lp_[64 + lane])) - expf(wave_sum(lp_[128 + lane] * lp_[192 + lane])) + lambda_init)));
            for (int u = vcu; u < 512; u += G) {
                const int qb = u & 7, h = (u >> 3) & 3, b = u >> 5; const size_t r0 = (size_t)b * SEQ;
                const att::QPrep qp{IN(I_DQ_G) + l * 64, tab + T_DC / 4, tab + T_DS / 4, nullptr, nullptr, qb * 256};
                att::attn_unit<64, 128, 1, 1, 4>(RAW + (r0 + qb * 256) * RAWW + C_DQ + (2 * h) * 64, RAWW, RAW + r0 * RAWW + C_DK + (2 * h) * 64, RAWW, RAW + r0 * RAWW + C_DV + h * 128, RAWW,
                                                 ODIFF + (r0 + qb * 256) * 1024 + h * 128, 1024, SEQ, 0.125f * L2E, nb_diff, qp, al, wave0);
                const att::DiffEpi de{ODIFF + (r0 + qb * 256) * 1024 + h * 128, 1024, lam, IN(I_DSUBLN_G) + l * 128, l};
                att::attn_unit<64, 128, 1, 1, 4, true>(RAW + (r0 + qb * 256) * RAWW + C_DQ + (2 * h + 1) * 64, RAWW, RAW + r0 * RAWW + C_DK + (2 * h + 1) * 64, RAWW, RAW + r0 * RAWW + C_DV + h * 128, RAWW,
                                                       RAW + (r0 + qb * 256) * RAWW + C_OA + h * 128, RAWW, SEQ, 0.125f * L2E, nb_diff, qp, al, wave0, 1.0f, &de);
            }
            for (int u = vcu; u < 512; u += G) {
                const int qb = u & 3, h = (u >> 2) & 7, b = u >> 5; const size_t r0 = (size_t)b * SEQ;
                const att::QPrep qp{IN(I_MLA_Q_G) + l * 96, tab + T_MC / 4, tab + T_MS / 4, nullptr, nullptr, qb * 512};
                att::attn_unit2d<96, 3, true>(MLARAW + (r0 + qb * 512) * MLAW + h * 96, MLAW, KMLA + r0 * 768 + h * 96, 768, MLARAW + r0 * MLAW + 768 + h * 128 + 64, MLAW,
                                                  RAW + (r0 + qb * 512) * RAWW + C_OB + h * 64, RAWW, SEQ, 0.10206207261596575f * L2E, nb_mla, qp, al, wave0);
            }
            for (int u = vcu; u < 512; u += G) {
                const int qb = u & 3, qh = (u >> 2) & 7, b = u >> 5; const size_t r0 = (size_t)b * SEQ;
                const att::QPrep qp{IN(I_GQA_Q_G) + l * 64, tab + T_RC / 4, tab + T_RS / 4, tab + T_CC / 4, tab + T_CS / 4, qb * 512};
                att::attn_unit2d<64, 2>(RAW + (r0 + qb * 512) * RAWW + C_GQ + qh * 64, RAWW, RAW + r0 * RAWW + C_GK + (qh >> 2) * 64, RAWW, RAW + r0 * RAWW + C_GV + (qh >> 2) * 64, RAWW,
                                       RAW + (r0 + qb * 512) * RAWW + C_OC + qh * 64, RAWW, SEQ, 0.125f * L2E, nb_gqa, qp, al, wave0);
            }
            for (int u = vcu; u < 512; u += G) {
                const int qb = u & 7, h = (u >> 3) & 3, b = u >> 5; const size_t r0 = (size_t)b * SEQ;
                const att::QPrep qp{IN(I_MEM_Q_G) + l * 128, tab + T_QC / 4, tab + T_QS / 4, nullptr, nullptr, qb * 256};
                att::attn_unit<128, 128, 1, 1, 4>(RAW + (r0 + qb * 256) * RAWW + C_MEMQ + h * 128, RAWW, MEMKV + (size_t)b * MEML * DM + h * 256, DM, MEMKV + (size_t)b * MEML * DM + h * 256 + 128, DM,
                                               RAW + (r0 + qb * 256) * RAWW + C_OD + h * 128, RAWW, MEML, 0.08838834764831845f * L2E, nb_mem, qp, al, wave0);
            }
        }
        xcd_barrier(bar, wave0);
        {
            PHASE_PTRS;
            pg8::Gemm g{(const bf16*)(wsp + WS_HB8), (const bf16*)(aw + AW_GATE), DM / 2, DM / 2, DM / 2}; pg8::StaticOrder S; S.init(M / 256, 16, G, bx);
            pg8::EpiSigmoidU8 E{(unsigned char*)GT, 4096, IN(I_B_GATE) + l * 4096, 1.0f / (S_H8 * S_WG)};
            pg8::gemm_phase<pg8::EpiSigmoidU8, pg8::StaticOrder, true, false, true>(lds + RING_OFF, g, S, E, wave0);
        }
        xcd_barrier(bar, wave0);
        {
            PHASE_PTRS;
            pg8::Gemm g{RAW, (const bf16*)(aw + AW_BR), RAWW, 512, 512}; MergeOrder S; S.init(M / 256, 4, G, bx);
            EpiMerge E{(const unsigned char*)GT, (bf16*)(wsp + WS_MERGED)};
            pg8::gemm_phase<EpiMerge, MergeOrder, true, false>(lds + RING_OFF, g, S, E, wave0);
        }
        xcd_barrier(bar, wave0);
        {
            PHASE_PTRS;
            pg8::Gemm g{(const bf16*)(wsp + WS_MERGED), (const bf16*)(aw + AW_OUT), DM, DM, DM}; pg8::StaticOrder S; S.init(M / 256, 4, G, bx);
            if (l == 0) { pg8::EpiResidX<false, true> E{IN(I_X), wsp + WS_XB, DM};
                pg8::gemm_phase<pg8::EpiResidX<false, true>, pg8::StaticOrder, true, false>(lds + RING_OFF, g, S, E, wave0); }
            else { pg8::EpiResidX<true, true> E{wsp + WS_XB, wsp + WS_XB, DM};
                pg8::gemm_phase<pg8::EpiResidX<true, true>, pg8::StaticOrder, true, false>(lds + RING_OFF, g, S, E, wave0); }
        }
        xcd_barrier(bar, wave0);
        if (l == 0) {
            {
                PHASE_PTRS;
                for (int it = gw; it < FFN_ITEMS; it += NGW) ffn_weight_item(it, IN(I_DW1), IN(I_DW3), IN(I_DW2), W13t, W2t, scr, lane);
                rms_rows_to_bf16<false, true, true>((const float*)(wsp + WS_XB), IN(I_NORM_FFN_G), (bf16*)(wsp + WS_HBF), M, gw, NGW, lane);
            }
            xcd_barrier(bar, wave0);
            {
                PHASE_PTRS;
                pg8::Gemm g{(const bf16*)(wsp + WS_HBF), W13t, DM, DM, DM}; pg8::StaticOrder S; S.init(M / 256, 2 * FF / 256, G, bx);
                pg8::EpiSwiGLU E{U, FF, 0};
                pg8::gemm_phase<pg8::EpiSwiGLU, pg8::StaticOrder, true, false>(lds + RING_OFF, g, S, E, wave0);
            }
            xcd_barrier(bar, wave0);
            {
                PHASE_PTRS;
                pg8::Gemm g{U, W2t, FF, FF, FF}; pg8::StaticOrder S; S.init(M / 256, DM / 256, G, bx);
                pg8::EpiResidX<true, true> E{wsp + WS_XB, wsp + WS_XB, DM};
                pg8::gemm_phase<pg8::EpiResidX<true, true>, pg8::StaticOrder, true, false>(lds + RING_OFF, g, S, E, wave0);
            }
            xcd_barrier(bar, wave0);
        }

        if (l == 1) {
            {
                PHASE_PTRS;
                volatile LAS int* ml = (volatile LAS int*)(lds + MOE_LDS);
                int* slot_tok = (int*)(wsp + WS_MOE + MO_SLOT_TOK); float* tok_gate = (float*)(wsp + WS_MOE + MO_TOK_GATE); int* wgcnt = (int*)(wsp + WS_MOE + MO_WGCNT);
                for (int it = gw; it < NEXP * FFN_ITEMS; it += NGW) { const int e = it / FFN_ITEMS; unsigned char* w13 = (unsigned char*)W13t + (size_t)e * EXPERT_BYTES;
                    ffn_weight_item8(it % FFN_ITEMS, IN(I_MW1) + (size_t)e * DM * FF, IN(I_MW3) + (size_t)e * DM * FF, IN(I_MW2) + (size_t)e * FF * DM, w13, w13 + W2_OFF, scr, lane); }
                for (int c = gt; c < MOE_SLOTS; c += NGT) slot_tok[c] = 0;
                const float* wr_ = IN(I_ROUTER); const float* gf = IN(I_NORM_FFN_G) + DM;
                f32x4 rw[4][4][2];
#pragma unroll
                for (int j = 0; j < 4; ++j)
#pragma unroll
                    for (int q = 0; q < 4; ++q) { const GAS f32x4* rp = (const GAS f32x4*)(wr_ + (size_t)(4 * (lane + 64 * j) + q) * 8); rw[j][q][0] = rp[0]; rw[j][q][1] = rp[1]; }
                f32x4 v[4], vn[4], ggv[4];
#pragma unroll
                for (int j = 0; j < 4; ++j) ggv[j] = ((const GAS f32x4*)gf + lane)[64 * j];
                { const float* xb_ = (const float*)(wsp + WS_XB);
#pragma unroll
                  for (int j = 0; j < 4; ++j) { v[j] = rr_load<true>(xb_, vcu * 128 + wave * 16, lane, j); vn[j] = v[j]; } }
                for (int i = 0; i < 16; ++i) {
                    const int tl = wave * 16 + i, t = vcu * 128 + tl;
                    if (i + 1 < 16) { const float* xb_ = (const float*)(wsp + WS_XB);
#pragma unroll
                        for (int j = 0; j < 4; ++j) vn[j] = rr_load<true>(xb_, t + 1, lane, j); }
                    float s = 0.f;
#pragma unroll
                    for (int j = 0; j < 4; ++j) { s += (v[j].x * v[j].x + v[j].y * v[j].y) + (v[j].z * v[j].z + v[j].w * v[j].w); }
                    const float rstd = __builtin_amdgcn_rsqf(wave_sum(s) * (1.f / DM) + NEPS);
                    GAS unsigned* o4 = (GAS unsigned*)(wsp + WS_HBM8 + (size_t)t * DM) + lane;
                    float lg[8] = {0.f, 0.f, 0.f, 0.f, 0.f, 0.f, 0.f, 0.f};
#pragma unroll
                    for (int j = 0; j < 4; ++j) { const f32x4 gg = ggv[j]; const float h0 = v[j].x * rstd * gg.x, h1 = v[j].y * rstd * gg.y, h2 = v[j].z * rstd * gg.z, h3 = v[j].w * rstd * gg.w;
                        __builtin_nontemporal_store(pg8::cvt4_fp8(h0 * S_H8, h1 * S_H8, h2 * S_H8, h3 * S_H8), o4 + 64 * j);
#pragma unroll
                        for (int e = 0; e < 8; ++e) lg[e] += h0 * rw[j][0][e >> 2][e & 3] + h1 * rw[j][1][e >> 2][e & 3] + h2 * rw[j][2][e >> 2][e & 3] + h3 * rw[j][3][e >> 2][e & 3]; }
#pragma unroll
                    for (int e = 0; e < 8; ++e) lg[e] = wave_sum(lg[e]);
                    int e1 = 0; float l1 = lg[0];
#pragma unroll
                    for (int e = 1; e < 8; ++e) if (lg[e] > l1) { l1 = lg[e]; e1 = e; }
                    int e2 = -1; float l2 = -3.0e38f;
#pragma unroll
                    for (int e = 0; e < 8; ++e) if (e != e1 && lg[e] > l2) { l2 = lg[e]; e2 = e; }
                    const float ex = expf(l2 - l1), g1 = 1.0f / (1.0f + ex), g2 = ex / (1.0f + ex);
                    if (lane == 0) { ml[ML_SEL + 2 * tl] = e1; ml[ML_SEL + 2 * tl + 1] = e2; tok_gate[2 * t] = g1; tok_gate[2 * t + 1] = g2; }
#pragma unroll
                    for (int j = 0; j < 4; ++j) v[j] = vn[j];
                }
                LDS_WAIT(); __syncthreads();
                if (wave == 0) {
                    int base[8] = {0, 0, 0, 0, 0, 0, 0, 0}; const unsigned long long lt = (1ull << lane) - 1ull;
#pragma unroll
                    for (int j = 0; j < 4; ++j) { const int a = 64 * j + lane, e = ml[ML_SEL + a]; int r = 0;
#pragma unroll
                        for (int ee = 0; ee < 8; ++ee) { const unsigned long long mk = __ballot(e == ee); if (e == ee) r = base[ee] + __popcll(mk & lt); base[ee] += __popcll(mk); }
                        ml[ML_RNK + a] = r; }
                    int cv = 0;
#pragma unroll
                    for (int ee = 0; ee < 8; ++ee) if (lane == ee) cv = base[ee];
                    if (lane < 8) wgcnt[vcu * 8 + lane] = cv;
                }
            }
            xcd_barrier(bar, wave0);
            {
                PHASE_PTRS;
                volatile LAS int* ml = (volatile LAS int*)(lds + MOE_LDS);
                int* slot_tok = (int*)(wsp + WS_MOE + MO_SLOT_TOK); int* tok_slot = (int*)(wsp + WS_MOE + MO_TOK_SLOT); const int* wgcnt = (const int*)(wsp + WS_MOE + MO_WGCNT);
                { int s = 0, p = 0;
#pragma unroll
                  for (int q = 0; q < 4; ++q) { const int w = 4 * lane + q; const int c = wgcnt[w * 8 + wave]; s += c; if (w < vcu) p += c; }
                  s = wave_sum_i(s); p = wave_sum_i(p);
                  if (lane == 0) { ml[ML_TOT + wave] = s; ml[ML_PRE + wave] = p; } }
                LDS_WAIT(); __syncthreads();
                if (wave == 0 && lane == 0) { int b = 0; for (int e = 0; e < 8; ++e) { ml[ML_SEGB + e] = b; b += (ml[ML_TOT + e] + 255) & ~255; } ml[ML_SEGB + 8] = b; }
                LDS_WAIT(); __syncthreads();
                { const int a = wave * 64 + lane;
                  if (a < 272) { int e = 0;
#pragma unroll
                      for (int q = 1; q < 8; ++q) if (ml[ML_SEGB + q] <= 256 * a) e = q;
                      ml[ML_TE + a] = e; }
                  if (a < 256) { const int e = ml[ML_SEL + a], slot = ml[ML_SEGB + e] + ml[ML_PRE + e] + ml[ML_RNK + a], t = vcu * 128 + (a >> 1);
                      slot_tok[slot] = t; tok_slot[2 * t + (a & 1)] = slot; } }
                LDS_WAIT(); __syncthreads();
                for (int i = 0; i < 32; i += 4) {
                    v4u r[4]; int sl[4];
#pragma unroll
                    for (int q = 0; q < 4; ++q) { const int a = wave * 32 + i + q, e = ml[ML_SEL + a]; sl[q] = ml[ML_SEGB + e] + ml[ML_PRE + e] + ml[ML_RNK + a];
                        r[q] = *((const GAS v4u*)(wsp + WS_HBM8 + (size_t)(vcu * 128 + (a >> 1)) * DM) + lane); }
#pragma unroll
                    for (int q = 0; q < 4; ++q) __builtin_nontemporal_store(r[q], (GAS v4u*)(wsp + WS_XS8 + (size_t)sl[q] * DM) + lane);
                }
            }
            xcd_barrier(bar, wave0);
            const int n_tiles = __builtin_amdgcn_readfirstlane(((volatile LAS int*)(lds + MOE_LDS))[ML_SEGB + 8]) >> 8;
            const int n_full = n_tiles < 256 ? n_tiles : 256, n_tail = n_tiles - n_full;
#pragma unroll 1
            for (int ch = 0; ch * MOE_CHUNK_TILES < n_full; ++ch) {
                const int tile0 = ch * MOE_CHUNK_TILES, nt_c = (n_full - tile0) < MOE_CHUNK_TILES ? (n_full - tile0) : MOE_CHUNK_TILES;
                {
                    PHASE_PTRS;
                    pg8::Gemm g{(const bf16*)(wsp + WS_XS8 + (size_t)tile0 * 256 * DM), nullptr, DM / 2, DM / 2, DM / 2}; MoeDownOrder S; S.init(nt_c, 2 * FF / 256, G, bx);
                    S.tile0 = tile0; S.te = (const volatile LAS int*)(lds + MOE_LDS) + ML_TE; S.wbase = (const char*)W13t;
                    pg8::EpiSwiGLU8 E{(unsigned char*)U, FF, 1.0f / (S_H8 * S_W13), S_U8};
                    pg8::gemm_phase<pg8::EpiSwiGLU8, MoeDownOrder, true, false, true>(lds + RING_OFF, g, S, E, wave0);
                }
                xcd_barrier(bar, wave0);
                {
                    PHASE_PTRS;
                    pg8::Gemm g{U, nullptr, FF / 2, FF / 2, FF / 2}; MoeDownOrder S; S.init(nt_c, DM / 256, G, bx);
                    S.tile0 = tile0; S.te = (const volatile LAS int*)(lds + MOE_LDS) + ML_TE; S.wbase = (const char*)W13t + W2_OFF;
                    pg8::EpiBf16 E{(bf16*)(wsp + WS_Y) + (size_t)tile0 * 256 * DM, DM, 1.0f / (S_U8 * S_W2)};
                    pg8::gemm_phase<pg8::EpiBf16, MoeDownOrder, true, false, true>(lds + RING_OFF, g, S, E, wave0);
                }
                xcd_barrier(bar, wave0);
            }
            if (n_tail > 0) {
                {
                    PHASE_PTRS;
                    pg8::Gemm g{(const bf16*)(wsp + WS_XS8 + (size_t)256 * 256 * DM), nullptr, DM / 2, DM / 2, DM / 2}; MoeDownOrder S; S.init(n_tail, 2 * FF / 256, G, bx);
                    S.tile0 = 256; S.te = (const volatile LAS int*)(lds + MOE_LDS) + ML_TE; S.wbase = (const char*)W13t;
                    pg8::EpiSwiGLU8 E{(unsigned char*)U, FF, 1.0f / (S_H8 * S_W13), S_U8};
                    pg8::gemm_phase<pg8::EpiSwiGLU8, MoeDownOrder, true, false, true>(lds + RING_OFF, g, S, E, wave0);
                }
                xcd_barrier(bar, wave0);
                {
                    PHASE_PTRS;
                    pg8::Gemm g{U, nullptr, FF / 2, FF / 2, 256}; TailDownOrder S; S.init(n_tail, DM / 256, G, bx);
                    S.te = (const volatile LAS int*)(lds + MOE_LDS) + ML_TE; S.wbase = (const char*)W13t + W2_OFF;
                    EpiPartF32 E{(float*)(wsp + WS_TAILP), n_tail * 256};
                    pg8::gemm_phase<EpiPartF32, TailDownOrder, true, false, true>(lds + RING_OFF, g, S, E, wave0);
                }
                xcd_barrier(bar, wave0);
            }
            {
                PHASE_PTRS;
                const int* tok_slot = (const int*)(wsp + WS_MOE + MO_TOK_SLOT); const float* tok_gate = (const float*)(wsp + WS_MOE + MO_TOK_GATE); const bf16* Y = (const bf16*)(wsp + WS_Y);
#define MC_IDX(S1_, S2_, G1_, G2_, tt) do { const int t_ = (tt) < M ? (tt) : gw; S1_ = tok_slot[2 * t_]; S2_ = tok_slot[2 * t_ + 1]; G1_ = tok_gate[2 * t_]; G2_ = tok_gate[2 * t_ + 1]; } while (0)
#define MC_ROWS(X_, A_, B_, S1_, S2_, tt) do { const int t_ = (tt) < M ? (tt) : gw; \
                    const GAS v2u* y1_ = (const GAS v2u*)(Y + (size_t)(S1_) * DM) + lane; const GAS v2u* y2_ = (const GAS v2u*)(Y + (size_t)(S2_) * DM) + lane; \
                    _Pragma("unroll") for (int j = 0; j < 4; ++j) { X_[j] = rr_load<true>(XBp, t_, lane, j); A_[j] = (S1_) >= 65536 ? tail_row(PT, n_tail * 256, (S1_) - 65536, lane + 64 * j, TSC) : y1_[64 * j]; B_[j] = (S2_) >= 65536 ? tail_row(PT, n_tail * 256, (S2_) - 65536, lane + 64 * j, TSC) : y2_[64 * j]; } } while (0)
                const float* PT = (const float*)(wsp + WS_TAILP); const float* XBp = (const float*)(wsp + WS_XB); constexpr float TSC = 1.0f / (S_U8 * S_W2);
                int s1a, s2a, s1b, s2b, s1c, s2c; float g1a, g2a, g1b, g2b, g1c, g2c; f32x4 xc[4], xn[4]; v2u ac[4], bc[4], an[4], bn[4];
                MC_IDX(s1a, s2a, g1a, g2a, gw); MC_IDX(s1b, s2b, g1b, g2b, gw + NGW);
                MC_ROWS(xc, ac, bc, s1a, s2a, gw);
                for (int t = gw; t < M; t += NGW) {
                    MC_IDX(s1c, s2c, g1c, g2c, t + 2 * NGW);
                    MC_ROWS(xn, an, bn, s1b, s2b, t + NGW);
                    GAS f32x4* xr = (GAS f32x4*)(out + (size_t)t * DM) + lane;
#pragma unroll
                    for (int j = 0; j < 4; ++j) { f32x4 x = xc[j]; const v2u a = ac[j], b = bc[j];
                        x.x += g1a * bflo(a.x) + g2a * bflo(b.x); x.y += g1a * bfhi(a.x) + g2a * bfhi(b.x); x.z += g1a * bflo(a.y) + g2a * bflo(b.y); x.w += g1a * bfhi(a.y) + g2a * bfhi(b.y);
                        __builtin_nontemporal_store(x, xr + 64 * j); }
#pragma unroll
                    for (int j = 0; j < 4; ++j) { xc[j] = xn[j]; ac[j] = an[j]; bc[j] = bn[j]; }
                    s1a = s1b; s2a = s2b; g1a = g1b; g2a = g2b; s1b = s1c; s2b = s2c; g1b = g1c; g2b = g2c;
                }
#undef MC_IDX
#undef MC_ROWS
            }
        }
    }
}

extern "C" void kernel_launch(void* const* d_in, const int* in_sizes, int n_in, void* d_out, int out_size, void* d_ws, size_t ws_size, hipStream_t stream) {
    static int grid = 0;
    if (grid == 0) {
        if (n_in != N_IN || in_sizes[0] != M * DM || out_size != M * DM || ws_size < WS_END) { fprintf(stderr, "kernel_launch: shape/workspace mismatch (n_in %d, ws %zu)\n", n_in, ws_size); grid = -1; return; }
        int dev = 0, cus = 0;
        if (hipGetDevice(&dev) != hipSuccess || hipDeviceGetAttribute(&cus, hipDeviceAttributeMultiprocessorCount, dev) != hipSuccess) { grid = -1; return; }
        if (hipFuncSetAttribute((const void*)fwd, hipFuncAttributeMaxDynamicSharedMemorySize, LDS_BYTES) != hipSuccess) { grid = -1; return; }
        int per_cu = 0;
        if (hipOccupancyMaxActiveBlocksPerMultiprocessor(&per_cu, (const void*)fwd, NWAVES * 64, LDS_BYTES) != hipSuccess || per_cu < 1) { fprintf(stderr, "kernel_launch: occupancy query says %d\n", per_cu); }
        (void)hipGetLastError();
        if (cus != 256) { fprintf(stderr, "kernel_launch: built for 256 CUs, got %d\n", cus); grid = -1; return; }
        grid = cus;
    }
    if (grid < 0) return;
    if (hipMemsetAsync((char*)d_ws + WS_CTL, 0, CTL_ZERO_BYTES, stream) != hipSuccess) return;
    Args a{};
    for (int i = 0; i < N_IN; ++i) a.in[i] = (const float*)d_in[i];
    a.out = (float*)d_out; a.ws = (unsigned char*)d_ws;
    hipLaunchKernelGGL(fwd, dim3(grid), dim3(NWAVES * 64), LDS_BYTES, stream, a);
}
```

```cpp
#include <hip/hip_runtime.h>
#include <cstdio>
#include <cstdint>
namespace pg8 {
#define PG8_LAS __attribute__((address_space(3)))
typedef unsigned short bf16_t;
typedef short bf16x8 __attribute__((ext_vector_type(8)));
typedef float f32x4 __attribute__((ext_vector_type(4)));
typedef float f32x2 __attribute__((ext_vector_type(2)));
typedef unsigned u32x4 __attribute__((ext_vector_type(4)));
typedef unsigned u32x2 __attribute__((ext_vector_type(2)));
constexpr int BM = 256, BK = 64, HALF = 128, HTB = HALF * BK * 2  , STAGE_BYTES = 8 * HTB, NXCD = 8, WGM = 8;

__host__ __device__ __forceinline__ int lds_byte(int r, int c) { const int st = (r >> 4) * 2 + (c >> 5), rr = r & 15, cc = c & 31, ob = rr * 64 + cc * 2; return st * 1024 + (ob ^ (((ob >> 9) & 1) << 5)); }
__host__ __device__ __forceinline__ void stage_rc(int b, int& R, int& C) { const int st = b / 1024, sb = b % 1024, swz = sb ^ (((sb >> 9) & 1) << 5); R = (st >> 1) * 16 + swz / 64; C = (st & 1) * 32 + (swz % 64) / 2; }
__host__ __device__ __forceinline__ int perm32(int rho) { const int n = rho >> 4, i = rho & 15; return 8 * (i >> 2) + 4 * n + (i & 3); }

struct Unit { int pm, pn, z; };
struct Gemm { const bf16_t* A; const bf16_t* Bt; int lda, ldb, K; };

struct StaticOrder {
    int nM, nN, nwg, G, c;
    __device__ __forceinline__ void init(int nM_, int nN_, int G_, int c_) { nM = nM_; nN = nN_; nwg = nM * nN; G = G_; c = c_; }
    __device__ __forceinline__ bool tile(long L, Unit& u) const {
        if (L >= nwg) return false;
        int wgid = (int)L; { const int q = nwg / NXCD, r = nwg % NXCD, xcd = wgid % NXCD, off = wgid / NXCD; wgid = (xcd < r ? xcd * (q + 1) : r * (q + 1) + (xcd - r) * q) + off; }
        const int nig = WGM * nN, gid = wgid / nig, fm = gid * WGM, gsz = (nM - fm) < WGM ? (nM - fm) : WGM;
        u.pm = __builtin_amdgcn_readfirstlane(fm + ((wgid % nig) % gsz)); u.pn = __builtin_amdgcn_readfirstlane((wgid % nig) / gsz); u.z = 0; return true;
    }
    __device__ __forceinline__ bool next(int i, Unit& u) const { return tile((long)i * G + c, u); }
    __device__ __forceinline__ const char* a_ptr(const Gemm& g, const Unit& u) const { return (const char*)g.A + (size_t)u.pm * (BM * 2) * g.lda; }
    __device__ __forceinline__ const char* b_ptr(const Gemm& g, const Unit& u) const { return (const char*)g.Bt + (size_t)u.pn * (BM * 2) * g.ldb; }
    __device__ __forceinline__ unsigned row_off(const Gemm&, const Unit&, int) const { return 0u; }
};

typedef __bf16 bf16x2_t __attribute__((ext_vector_type(2)));
__device__ __forceinline__ unsigned cvt_pk_bf16(float lo, float hi) { f32x2 v = {lo, hi}; bf16x2_t b = __builtin_convertvector(v, bf16x2_t); return __builtin_bit_cast(unsigned, b); }
__device__ __forceinline__ float bf_lo(unsigned w) { return __uint_as_float(w << 16); }
__device__ __forceinline__ float bf_hi(unsigned w) { return __uint_as_float(w & 0xffff0000u); }
__device__ __forceinline__ float sigmoidf_(float v) { return __builtin_amdgcn_rcpf(1.0f + __builtin_amdgcn_exp2f(-1.4426950408889634f * v)); }

struct EpiBf16 {
    static constexpr bool PERM = true;
    bf16_t* O; int ldc; float scale = 1.0f;
    __device__ __forceinline__ bool keep(const Unit&) const { return false; }
    __device__ __forceinline__ void operator()(const f32x4 (&acc)[2][2][4][2], const Unit& u, int wr, int wc, int fr, int fq) const {
        const int row0 = u.pm * BM + wr * 64 + fr, col0 = u.pn * BM + wc * 32 + 8 * fq;
#pragma unroll
        for (int ai = 0; ai < 2; ++ai)
#pragma unroll
            for (int m = 0; m < 4; ++m) { bf16_t* rowp = O + (size_t)(row0 + ai * HALF + m * 16) * ldc + col0;
#pragma unroll
                for (int bj = 0; bj < 2; ++bj) { const f32x4 v0 = acc[ai][bj][m][0] * scale, v1 = acc[ai][bj][m][1] * scale;
                    u32x4 w; w.x = cvt_pk_bf16(v0[0], v0[1]); w.y = cvt_pk_bf16(v0[2], v0[3]); w.z = cvt_pk_bf16(v1[0], v1[1]); w.w = cvt_pk_bf16(v1[2], v1[3]);
                    __builtin_nontemporal_store(w, (u32x4*)(rowp + bj * HALF)); } }
    }
};
struct EpiSigmoid {
    static constexpr bool PERM = true;
    bf16_t* O; int ldc; const float* bias; float scale = 1.0f;
    __device__ __forceinline__ bool keep(const Unit&) const { return false; }
    __device__ __forceinline__ void operator()(const f32x4 (&acc)[2][2][4][2], const Unit& u, int wr, int wc, int fr, int fq) const {
        const int row0 = u.pm * BM + wr * 64 + fr, col0 = u.pn * BM + wc * 32 + 8 * fq;
        f32x4 bv[2][2];
#pragma unroll
        for (int bj = 0; bj < 2; ++bj)
#pragma unroll
            for (int n = 0; n < 2; ++n) bv[bj][n] = *(const f32x4*)(bias + col0 + bj * HALF + 4 * n);
#pragma unroll
        for (int ai = 0; ai < 2; ++ai)
#pragma unroll
            for (int m = 0; m < 4; ++m) { bf16_t* rowp = O + (size_t)(row0 + ai * HALF + m * 16) * ldc + col0;
#pragma unroll
                for (int bj = 0; bj < 2; ++bj) { const f32x4 v0 = acc[ai][bj][m][0] * scale + bv[bj][0], v1 = acc[ai][bj][m][1] * scale + bv[bj][1];
                    u32x4 w; w.x = cvt_pk_bf16(sigmoidf_(v0[0]), sigmoidf_(v0[1])); w.y = cvt_pk_bf16(sigmoidf_(v0[2]), sigmoidf_(v0[3]));
                    w.z = cvt_pk_bf16(sigmoidf_(v1[0]), sigmoidf_(v1[1])); w.w = cvt_pk_bf16(sigmoidf_(v1[2]), sigmoidf_(v1[3]));
                    __builtin_nontemporal_store(w, (u32x4*)(rowp + bj * HALF)); } }
    }
};
struct EpiSigmoidU8 {
    static constexpr bool PERM = true;
    unsigned char* O; int ldc; const float* bias; float scale;
    __device__ __forceinline__ bool keep(const Unit&) const { return false; }
    static __device__ __forceinline__ float q255(float t) { return __builtin_amdgcn_rcpf(__builtin_fmaf(fminf(__builtin_amdgcn_exp2f(t), 254.0f), 1.0f / 255.0f, 1.0f / 255.0f)); }
    __device__ __forceinline__ void operator()(const f32x4 (&acc)[2][2][4][2], const Unit& u, int wr, int wc, int fr, int fq) const {
        const int col0 = u.pn * BM + wc * 32 + 8 * fq;
        f32x4 bv[2][2];
#pragma unroll
        for (int bj = 0; bj < 2; ++bj)
#pragma unroll
            for (int n = 0; n < 2; ++n) bv[bj][n] = *(const f32x4*)(bias + col0 + bj * HALF + 4 * n) * -1.4426950408889634f;
        const float sc2 = scale * -1.4426950408889634f;
        unsigned char* tp = O + ((size_t)(u.pm * 16 + u.pn) << 16) + ((wr * 4 + wc) << 13) + (fq * 16 + fr) * 8;
#pragma unroll
        for (int ai = 0; ai < 2; ++ai)
#pragma unroll
            for (int m = 0; m < 4; ++m) {
#pragma unroll
                for (int bj = 0; bj < 2; ++bj) { const f32x4 v0 = acc[ai][bj][m][0] * sc2 + bv[bj][0], v1 = acc[ai][bj][m][1] * sc2 + bv[bj][1];
                    u32x2 w; w.x = 0u; w.y = 0u;
#pragma unroll
                    for (int e = 0; e < 4; ++e) { w.x = __builtin_amdgcn_cvt_pk_u8_f32(q255(v0[e]), e, w.x); w.y = __builtin_amdgcn_cvt_pk_u8_f32(q255(v1[e]), e, w.y); }
                    __builtin_nontemporal_store(w, (u32x2*)(tp + (((ai * 4 + m) * 2 + bj) << 9))); } }
    }
};
struct EpiSwiGLU {
    static constexpr bool PERM = true;
    bf16_t* O; int ldc; int row_base;
    __device__ __forceinline__ bool keep(const Unit&) const { return false; }
    __device__ __forceinline__ void operator()(const f32x4 (&acc)[2][2][4][2], const Unit& u, int wr, int wc, int fr, int fq) const {
        const int row0 = row_base + u.pm * BM + wr * 64 + fr, col0 = u.pn * HALF + wc * 32 + 8 * fq;
#pragma unroll
        for (int ai = 0; ai < 2; ++ai)
#pragma unroll
            for (int m = 0; m < 4; ++m) { bf16_t* rowp = O + (size_t)(row0 + ai * HALF + m * 16) * ldc + col0;
                float r[8];
#pragma unroll
                for (int n = 0; n < 2; ++n)
#pragma unroll
                    for (int j = 0; j < 4; ++j) { const float gt = acc[ai][0][m][n][j], up = acc[ai][1][m][n][j]; r[n * 4 + j] = gt * sigmoidf_(gt) * up; }
                u32x4 w; w.x = cvt_pk_bf16(r[0], r[1]); w.y = cvt_pk_bf16(r[2], r[3]); w.z = cvt_pk_bf16(r[4], r[5]); w.w = cvt_pk_bf16(r[6], r[7]);
                __builtin_nontemporal_store(w, (u32x4*)rowp); }
    }
};
__device__ __forceinline__ unsigned cvt4_fp8(float a, float b, float c, float d) { int w = __builtin_amdgcn_cvt_pk_fp8_f32(a, b, 0, false); w = __builtin_amdgcn_cvt_pk_fp8_f32(c, d, w, true); return (unsigned)w; }
struct EpiSwiGLU8 {
    static constexpr bool PERM = true;
    unsigned char* O; int ldc; float in_scale, out_scale;
    __device__ __forceinline__ bool keep(const Unit&) const { return false; }
    __device__ __forceinline__ void operator()(const f32x4 (&acc)[2][2][4][2], const Unit& u, int wr, int wc, int fr, int fq) const {
        const int row0 = u.pm * BM + wr * 64 + fr, col0 = u.pn * HALF + wc * 32 + 8 * fq;
        const float k1 = in_scale * -1.4426950408889634f, k2 = in_scale * in_scale * out_scale;
#pragma unroll
        for (int ai = 0; ai < 2; ++ai)
#pragma unroll
            for (int m = 0; m < 4; ++m) { unsigned char* rowp = O + (size_t)(row0 + ai * HALF + m * 16) * ldc + col0;
                float r[8];
#pragma unroll
                for (int n = 0; n < 2; ++n)
#pragma unroll
                    for (int j = 0; j < 4; ++j) { const float a = acc[ai][0][m][n][j], b = acc[ai][1][m][n][j];
                        r[n * 4 + j] = (a * b) * (k2 * __builtin_amdgcn_rcpf(1.0f + __builtin_amdgcn_exp2f(a * k1))); }
                u32x2 w; w.x = cvt4_fp8(r[0], r[1], r[2], r[3]); w.y = cvt4_fp8(r[4], r[5], r[6], r[7]);
                __builtin_nontemporal_store(w, (u32x2*)rowp); }
    }
};
template <bool BASE_BF, bool OUT_BF>
struct EpiResidX {
    static constexpr bool PERM = false;
    const void* base; void* out; int ldc; float scale = 1.0f;
    __device__ __forceinline__ bool keep(const Unit&) const { return false; }
    __device__ __forceinline__ void operator()(const f32x4 (&acc)[2][2][4][2], const Unit& u, int wr, int wc, int fr, int fq) const {
        const int row0 = u.pm * BM + wr * 64 + fr, col0 = u.pn * BM + wc * 32 + 4 * fq;
#pragma unroll
        for (int ai = 0; ai < 2; ++ai)
#pragma unroll
            for (int mp = 0; mp < 2; ++mp) {
                f32x4 b[2][2][2];
#pragma unroll
                for (int mm = 0; mm < 2; ++mm) { const size_t off = (size_t)(row0 + ai * HALF + (2 * mp + mm) * 16) * ldc + col0;
#pragma unroll
                    for (int bj = 0; bj < 2; ++bj)
#pragma unroll
                        for (int n = 0; n < 2; ++n) {
                            if constexpr (BASE_BF) { const u32x2 w = __builtin_nontemporal_load((const u32x2*)((const bf16_t*)base + off + bj * HALF + n * 16));
                                b[mm][bj][n] = (f32x4){bf_lo(w.x), bf_hi(w.x), bf_lo(w.y), bf_hi(w.y)}; }
                            else b[mm][bj][n] = __builtin_nontemporal_load((const f32x4*)((const float*)base + off + bj * HALF + n * 16)); } }
#pragma unroll
                for (int mm = 0; mm < 2; ++mm) { const size_t off = (size_t)(row0 + ai * HALF + (2 * mp + mm) * 16) * ldc + col0;
#pragma unroll
                    for (int bj = 0; bj < 2; ++bj)
#pragma unroll
                        for (int n = 0; n < 2; ++n) { const f32x4 v = b[mm][bj][n] + acc[ai][bj][2 * mp + mm][n] * scale;
                            if constexpr (OUT_BF) { u32x2 w; w.x = cvt_pk_bf16(v[0], v[1]); w.y = cvt_pk_bf16(v[2], v[3]); __builtin_nontemporal_store(w, (u32x2*)((bf16_t*)out + off + bj * HALF + n * 16)); }
                            else *(f32x4*)((float*)out + off + bj * HALF + n * 16) = v; } }
                asm volatile("" ::: "memory"); }
    }
};

typedef int i32x8 __attribute__((ext_vector_type(8)));
typedef short s16x16 __attribute__((ext_vector_type(16)));
typedef float f32x8 __attribute__((ext_vector_type(8)));
template <class Epi, class Sched, bool ALIGN_EPI, bool GATHER, bool FP8 = false>
__device__ __forceinline__ void gemm_phase(PG8_LAS unsigned char* lds, const Gemm g, const Sched& S, const Epi& E, int wave0) {
    int tid; asm volatile("v_mbcnt_lo_u32_b32 %0, -1, 0\n\tv_mbcnt_hi_u32_b32 %0, -1, %0" : "=v"(tid)); tid = (tid + wave0 * 64) & 511;
    const int wid = __builtin_amdgcn_readfirstlane(tid >> 6), lane = tid & 63, wr = wid >> 2, wc = wid & 3, fr = lane & 15, fq = lane >> 4;
    int K = g.K; asm volatile("" : "+s"(K));
    const int nt = K / BK;
    unsigned voffB[2], offC[2][2], offN[2][2]; int Rr[2], Cc[2];
#pragma unroll
    for (int i = 0; i < 2; ++i) { int R, C; stage_rc(tid * 16 + i * 8192, R, C); const int Rb = Epi::PERM ? ((R & ~31) + perm32(R & 31)) : R;
        voffB[i] = (unsigned)(Rb * g.ldb + C) * 2u; Rr[i] = R; Cc[i] = C;
        offC[0][i] = (unsigned)(R * g.lda + C) * 2u; offC[1][i] = (unsigned)((R + HALF) * g.lda + C) * 2u; offN[0][i] = offC[0][i]; offN[1][i] = offC[1][i]; }
    const size_t dB64 = (size_t)64 * g.ldb * 2, dA64 = (size_t)64 * g.lda * 2, dAh = (size_t)HALF * g.lda * 2;
    const size_t kstep = (size_t)(BK * 2);
    const size_t hstepB = (size_t)HALF * g.ldb * 2;
    const unsigned ldsw = (unsigned)wid * 1024u;
    const int aoff = lds_byte(wr * 64 + fr, fq * 8), boff = lds_byte(wc * 32 + fr, fq * 8);
#define PG8_SA(b, h) (((b) * 2 + (h)) * HTB)
#define PG8_SB(b, h) ((4 + (b) * 2 + (h)) * HTB)
#define PG8_STAGE_B(bufoff, gbase) do { _Pragma("unroll") for (int _i = 0; _i < 2; ++_i) \
        __builtin_amdgcn_global_load_lds((const unsigned*)((const char*)(gbase) + (size_t)_i * dB64 + voffB[0]), (PG8_LAS unsigned*)(lds + (bufoff) + ldsw + _i * 8192), 16, 0, 0); } while (0)
#define PG8_STAGE_A(bufoff, gbase, O, h) do { _Pragma("unroll") for (int _i = 0; _i < 2; ++_i) { \
        if constexpr (GATHER) __builtin_amdgcn_global_load_lds((const unsigned*)((const char*)(gbase) + O[h][_i]), (PG8_LAS unsigned*)(lds + (bufoff) + ldsw + _i * 8192), 16, 0, 0); \
        else __builtin_amdgcn_global_load_lds((const unsigned*)((const char*)(gbase) + (size_t)(h) * dAh + (size_t)_i * dA64 + O[0][0]), (PG8_LAS unsigned*)(lds + (bufoff) + ldsw + _i * 8192), 16, 0, 0); } } while (0)
#define PG8_LD8(addr) __builtin_bit_cast(i32x8, __builtin_shufflevector(*(const PG8_LAS bf16x8*)(lds + (addr)), *(const PG8_LAS bf16x8*)(lds + (addr) + 1024), 0, 1, 2, 3, 4, 5, 6, 7, 8, 9, 10, 11, 12, 13, 14, 15))
#define PG8_LDA8(dst, b, h) do { _Pragma("unroll") for (int m = 0; m < 4; ++m) dst[m] = PG8_LD8(PG8_SA(b, h) + aoff + m * 2048); } while (0)
#define PG8_LDB8(dst, b, h) do { _Pragma("unroll") for (int n = 0; n < 2; ++n) dst[n] = PG8_LD8(PG8_SB(b, h) + boff + n * 2048); } while (0)
#define PG8_MMA8(ai, bj, At, Bt) do { __builtin_amdgcn_s_setprio(1); _Pragma("unroll") for (int m = 0; m < 4; ++m) _Pragma("unroll") for (int n = 0; n < 2; ++n) \
        asm volatile("v_mfma_f32_16x16x128_f8f6f4 %0, %1, %2, %0" : "+v"(acc[ai][bj][m][n]) : "v"(Bt[n]), "v"(At[m])); __builtin_amdgcn_s_setprio(0); } while (0)
#define PG8_LDA(dst, b, h) do { _Pragma("unroll") for (int m = 0; m < 4; ++m) _Pragma("unroll") for (int k = 0; k < 2; ++k) dst[m][k] = *(const PG8_LAS bf16x8*)(lds + PG8_SA(b, h) + aoff + m * 2048 + k * 1024); } while (0)
#define PG8_LDB(dst, b, h) do { _Pragma("unroll") for (int n = 0; n < 2; ++n) _Pragma("unroll") for (int k = 0; k < 2; ++k) dst[n][k] = *(const PG8_LAS bf16x8*)(lds + PG8_SB(b, h) + boff + n * 2048 + k * 1024); } while (0)
#define PG8_MMA(ai, bj, At, Bt) do { __builtin_amdgcn_s_setprio(1); _Pragma("unroll") for (int m = 0; m < 4; ++m) _Pragma("unroll") for (int n = 0; n < 2; ++n) _Pragma("unroll") for (int k = 0; k < 2; ++k) \
        acc[ai][bj][m][n] = __builtin_amdgcn_mfma_f32_16x16x32_bf16(Bt[n][k], At[m][k], acc[ai][bj][m][n], 0, 0, 0); __builtin_amdgcn_s_setprio(0); } while (0)
#define XLDA(b, h) do { if constexpr (FP8) PG8_LDA8(At8, b, h); else PG8_LDA(At, b, h); } while (0)
#define XLDB0(b, h) do { if constexpr (FP8) PG8_LDB8(B08, b, h); else PG8_LDB(B0, b, h); } while (0)
#define XLDB1(b, h) do { if constexpr (FP8) PG8_LDB8(B18, b, h); else PG8_LDB(B1, b, h); } while (0)
#define XMMA(ai, bj, w) do { if constexpr (FP8) { if (w) PG8_MMA8(ai, bj, At8, B18); else PG8_MMA8(ai, bj, At8, B08); } else { if (w) PG8_MMA(ai, bj, At, B1); else PG8_MMA(ai, bj, At, B0); } } while (0)
#define PG8_WAIT_V(n) asm volatile("s_waitcnt vmcnt(" #n ")" ::: "memory")
#define PG8_WAIT_L(n) asm volatile("s_waitcnt lgkmcnt(" #n ")" ::: "memory")
#define PG8_BAR __builtin_amdgcn_s_barrier()
#define PG8_SCHED __builtin_amdgcn_sched_barrier(0)
    Unit cur, nxt; int ui = 0;
    if (!S.next(0, cur)) return;
    f32x4 acc[2][2][4][2];
#pragma unroll
    for (int a = 0; a < 2; ++a)
#pragma unroll
        for (int b = 0; b < 2; ++b)
#pragma unroll
            for (int m = 0; m < 4; ++m)
#pragma unroll
                for (int n = 0; n < 2; ++n) acc[a][b][m][n] = (f32x4){0.f, 0.f, 0.f, 0.f};
    bf16x8 At[4][2], B0[2][2], B1[2][2]; i32x8 At8[4], B08[2], B18[2];
    const char* cA = S.a_ptr(g, cur); const char* cB = S.b_ptr(g, cur);
    if constexpr (GATHER) {
#pragma unroll
        for (int h = 0; h < 2; ++h)
#pragma unroll
            for (int i = 0; i < 2; ++i) offC[h][i] = S.row_off(g, cur, h * HALF + Rr[i]) + (unsigned)Cc[i] * 2u;
    }
    PG8_STAGE_B(PG8_SB(0, 0), cB); PG8_STAGE_B(PG8_SB(0, 1), cB + hstepB); PG8_STAGE_A(PG8_SA(0, 0), cA, offC, 0); PG8_STAGE_A(PG8_SA(0, 1), cA, offC, 1);
    if (wr == 1) PG8_BAR;
    PG8_WAIT_V(2); PG8_BAR;
    PG8_STAGE_B(PG8_SB(1, 0), cB + kstep); PG8_STAGE_A(PG8_SA(1, 0), cA + kstep, offC, 0); PG8_STAGE_B(PG8_SB(1, 1), cB + hstepB + kstep);
    PG8_WAIT_V(6); PG8_BAR;
    for (;;) {
        const bool has_next = S.next(ui + 1, nxt);
        const char* nA = has_next ? S.a_ptr(g, nxt) : cA; const char* nB = has_next ? S.b_ptr(g, nxt) : cB;
        if constexpr (GATHER) {
            if (has_next) {
#pragma unroll
                for (int h = 0; h < 2; ++h)
#pragma unroll
                    for (int i = 0; i < 2; ++i) offN[h][i] = S.row_off(g, nxt, h * HALF + Rr[i]) + (unsigned)Cc[i] * 2u;
            }
        }
#pragma unroll 1
        for (int t = 0; t < nt; t += 2) {
            const bool last = (t == nt - 2);
            const char* a1 = cA + (size_t)(t + 1) * kstep;
            const char* a2 = last ? nA : cA + (size_t)(t + 2) * kstep; const char* b2 = last ? nB : cB + (size_t)(t + 2) * kstep;
            const char* a3 = a2 + kstep; const char* b3 = b2 + kstep;
            unsigned o2[2][2];
#pragma unroll
            for (int h = 0; h < 2; ++h)
#pragma unroll
                for (int i = 0; i < 2; ++i) o2[h][i] = GATHER ? (last ? offN[h][i] : offC[h][i]) : offC[h][i];
            XLDB0(0, 0); XLDB1(0, 1); PG8_SCHED; XLDA(0, 0); PG8_STAGE_A(PG8_SA(1, 1), a1, offC, 1);
            PG8_WAIT_V(8); PG8_WAIT_L(0); PG8_BAR; XMMA(0, 0, 0); XMMA(0, 1, 1); PG8_BAR; PG8_SCHED;
            XLDA(0, 1); PG8_STAGE_B(PG8_SB(0, 0), b2); PG8_STAGE_B(PG8_SB(0, 1), b2 + hstepB); PG8_STAGE_A(PG8_SA(0, 0), a2, o2, 0);
            PG8_WAIT_V(8); PG8_WAIT_L(0); PG8_BAR; XMMA(1, 0, 0); XMMA(1, 1, 1); PG8_BAR; PG8_SCHED;
            XLDB0(1, 0); XLDB1(1, 1); PG8_SCHED; XLDA(1, 0); PG8_STAGE_A(PG8_SA(0, 1), a2, o2, 1);
            PG8_WAIT_V(8); PG8_WAIT_L(0); PG8_BAR; XMMA(0, 0, 0); XMMA(0, 1, 1); PG8_BAR; PG8_SCHED;
            XLDA(1, 1); PG8_STAGE_B(PG8_SB(1, 0), b3); PG8_STAGE_B(PG8_SB(1, 1), b3 + hstepB); PG8_STAGE_A(PG8_SA(1, 0), a3, o2, 0);
            PG8_WAIT_V(8); PG8_WAIT_L(0); PG8_BAR; XMMA(1, 0, 0); XMMA(1, 1, 1); PG8_BAR; PG8_SCHED;
        }
        if constexpr (ALIGN_EPI) { if (wr == 0) PG8_BAR; }
        if constexpr (FP8) {
            asm volatile("s_nop 15" : "+v"(acc[1][0][0][0]), "+v"(acc[1][0][0][1]), "+v"(acc[1][0][1][0]), "+v"(acc[1][0][1][1]), "+v"(acc[1][0][2][0]), "+v"(acc[1][0][2][1]), "+v"(acc[1][0][3][0]), "+v"(acc[1][0][3][1]));
            asm volatile("" : "+v"(acc[1][1][0][0]), "+v"(acc[1][1][0][1]), "+v"(acc[1][1][1][0]), "+v"(acc[1][1][1][1]), "+v"(acc[1][1][2][0]), "+v"(acc[1][1][2][1]), "+v"(acc[1][1][3][0]), "+v"(acc[1][1][3][1])); }
        E(acc, cur, wr, wc, fr, fq);
        if (!has_next) break;
        if (!E.keep(cur)) {
#pragma unroll
        for (int a = 0; a < 2; ++a)
#pragma unroll
            for (int b = 0; b < 2; ++b)
#pragma unroll
                for (int m = 0; m < 4; ++m)
#pragma unroll
                    for (int n = 0; n < 2; ++n) acc[a][b][m][n] = (f32x4){0.f, 0.f, 0.f, 0.f};
        }
        cur = nxt; cA = nA; cB = nB; ++ui;
        if constexpr (GATHER) {
#pragma unroll
            for (int h = 0; h < 2; ++h)
#pragma unroll
                for (int i = 0; i < 2; ++i) offC[h][i] = offN[h][i];
        }
        if constexpr (ALIGN_EPI) { if (wr == 1) PG8_BAR; }
    }
    PG8_WAIT_V(0);
    if constexpr (!ALIGN_EPI) { if (wr == 0) PG8_BAR; }
    PG8_BAR;
#undef PG8_SA
#undef PG8_SB
#undef PG8_STAGE_A
#undef PG8_STAGE_B
#undef PG8_LDA
#undef PG8_LD8
#undef PG8_LDA8
#undef PG8_LDB8
#undef PG8_MMA8
#undef XLDA
#undef XLDB0
#undef XLDB1
#undef XMMA
#undef PG8_LDB
#undef PG8_MMA
#undef PG8_WAIT_V
#undef PG8_WAIT_L
#undef PG8_BAR
#undef PG8_SCHED
}
}
namespace att {
using bf16x8 = __attribute__((ext_vector_type(8))) short;
using s16x4  = __attribute__((ext_vector_type(4))) short;
using f32x16 = __attribute__((ext_vector_type(16))) float;
using u32x4  = __attribute__((ext_vector_type(4))) unsigned;
typedef unsigned short bf16_t;
typedef float f32x4_t __attribute__((ext_vector_type(4)));
#define ALAS __attribute__((address_space(3)))
constexpr int NW = 8, QBLK = 32, KVBLK = 64;
constexpr int LDS_V = 0, LDS_K = 32768, LDS_WS = 65536;
constexpr int LDS_V3 = 0, LDS_K3 = 49152, LDS_WS3 = 98304, LDS_BYTES = LDS_WS3 + NW * 64 * 4;
constexpr float THR = 8.f;
#define KF(row) ((((row) & 7) | ((((row) >> 4) & 1) << 3)))
#define KSWZ(row, colB) ((row) * 256 + ((colB) ^ (KF(row) << 4)))
#define SBAR() __builtin_amdgcn_sched_barrier(0)
constexpr int QK2_BT = 2;
__device__ __forceinline__ int crow(int r, int hi) { return (r & 3) + 8 * (r >> 2) + 4 * hi; }
typedef float f32x2_t __attribute__((ext_vector_type(2))); typedef __bf16 bf16x2_t __attribute__((ext_vector_type(2)));
__device__ __forceinline__ unsigned cvtpk(float lo, float hi) { f32x2_t v = {lo, hi}; bf16x2_t b = __builtin_convertvector(v, bf16x2_t); return __builtin_bit_cast(unsigned, b); }

__device__ __forceinline__ void expHalf(f32x16& p0, float shift, bool use_shift) {
  if (use_shift) {
#pragma unroll
    for (int r = 0; r < 16; ++r) p0[r] = __builtin_amdgcn_exp2f(p0[r] + shift);
  } else {
#pragma unroll
    for (int r = 0; r < 16; ++r) p0[r] = __builtin_amdgcn_exp2f(p0[r]);
  }
}
__device__ __forceinline__ void finishSM(f32x16& p0, f32x16& p1, float& l_reg, bf16x8& pa0, bf16x8& pa1, bf16x8& pa2, bf16x8& pa3, float shift, bool use_shift) {
  expHalf(p1, shift, use_shift);
  float ps = 0;
#pragma unroll
  for (int r = 0; r < 16; ++r) ps += p0[r] + p1[r];
  l_reg += ps;
#define PK4(P, BASE, OUT) do { unsigned a0 = cvtpk(P[BASE + 0], P[BASE + 1]), a1 = cvtpk(P[BASE + 2], P[BASE + 3]);   \
    unsigned b0 = cvtpk(P[BASE + 4], P[BASE + 5]), b1 = cvtpk(P[BASE + 6], P[BASE + 7]);                              \
    auto r0 = __builtin_amdgcn_permlane32_swap(a0, b0, false, false); auto r1 = __builtin_amdgcn_permlane32_swap(a1, b1, false, false); \
    u32x4 w = {r0[0], r1[0], r0[1], r1[1]}; OUT = __builtin_bit_cast(bf16x8, w); } while (0)
  PK4(p0, 0, pa0); PK4(p0, 8, pa1); PK4(p1, 0, pa2); PK4(p1, 8, pa3);
#undef PK4
}
template <int DK, int COLB = 0> __device__ __forceinline__ void qkt(f32x16& p0, f32x16& p1, const ALAS char* Ks, const bf16x8* qr, int r32, int hi) {
  constexpr int ND = DK / 16, BT = ND > 4 ? ND / 2 : ND;
  p0 = f32x16{}; p1 = f32x16{};
#pragma unroll
  for (int b0 = 0; b0 < ND; b0 += BT) {
    bf16x8 k0[BT], k1[BT];
#pragma unroll
    for (int i = 0; i < BT; ++i) { const int cb = COLB + ((b0 + i) * 16 + hi * 8) * 2;
      k0[i] = *(const ALAS bf16x8*)(Ks + KSWZ(r32, cb)); k1[i] = *(const ALAS bf16x8*)(Ks + KSWZ(32 + r32, cb)); }
    SBAR();
#pragma unroll
    for (int i = 0; i < BT; ++i) {
      p0 = __builtin_amdgcn_mfma_f32_32x32x16_bf16(k0[i], qr[b0 + i], p0, 0, 0, 0);
      p1 = __builtin_amdgcn_mfma_f32_32x32x16_bf16(k1[i], qr[b0 + i], p1, 0, 0, 0); }
    SBAR();
  }
}
template <int NB> __device__ __forceinline__ int v_st(int k, int c) { const int kk = (k & ~0xC) | ((k & 4) << 1) | ((k & 8) >> 1); return ((kk >> 3) * NB + (c >> 5)) * 512 + ((kk & 7) * 32 + (c & 31)) * 2; }
__device__ __forceinline__ int v_rd_base(int lane) { return ((lane & 3) << 3) | (((lane >> 2) & 3) << 6) | (((lane >> 4) & 1) << 5) | (((lane >> 5) & 1) << 8); }
template <int OFF> __device__ __forceinline__ s16x4 tr_read(int vb) {
  s16x4 r; asm volatile("ds_read_b64_tr_b16 %0, %1 offset:%2" : "=&v"(r) : "v"(vb), "i"(OFF) : "memory"); return r;
}
template <int NB, int D0> __device__ __forceinline__ void pv_one(f32x16& od, int vb, bf16x8 pa0, bf16x8 pa1, bf16x8 pa2, bf16x8 pa3) {
#define VOFF(ks, half) (D0 * 512 + (ks) * (1024 * NB) + (half) * (512 * NB))
  const s16x4 l0 = tr_read<VOFF(0, 0)>(vb), h0 = tr_read<VOFF(0, 1)>(vb), l1 = tr_read<VOFF(1, 0)>(vb), h1 = tr_read<VOFF(1, 1)>(vb);
  const s16x4 l2 = tr_read<VOFF(2, 0)>(vb), h2 = tr_read<VOFF(2, 1)>(vb), l3 = tr_read<VOFF(3, 0)>(vb), h3 = tr_read<VOFF(3, 1)>(vb);
#undef VOFF
  asm volatile("s_waitcnt lgkmcnt(0)" ::: "memory"); SBAR();
#define PK(L, H) (bf16x8){L[0], L[1], L[2], L[3], H[0], H[1], H[2], H[3]}
  od = __builtin_amdgcn_mfma_f32_32x32x16_bf16(pa0, PK(l0, h0), od, 0, 0, 0);
  od = __builtin_amdgcn_mfma_f32_32x32x16_bf16(pa1, PK(l1, h1), od, 0, 0, 0);
  od = __builtin_amdgcn_mfma_f32_32x32x16_bf16(pa2, PK(l2, h2), od, 0, 0, 0);
  od = __builtin_amdgcn_mfma_f32_32x32x16_bf16(pa3, PK(l3, h3), od, 0, 0, 0);
#undef PK
}
template <int NB> __device__ __forceinline__ void pv_all(f32x16* o, int vb, bf16x8 pa0, bf16x8 pa1, bf16x8 pa2, bf16x8 pa3) {
  pv_one<NB, 0>(o[0], vb, pa0, pa1, pa2, pa3); pv_one<NB, 1>(o[1], vb, pa0, pa1, pa2, pa3);
  if constexpr (NB == 4) { pv_one<NB, 2>(o[2], vb, pa0, pa1, pa2, pa3); pv_one<NB, 3>(o[3], vb, pa0, pa1, pa2, pa3); }
}

struct QPrep { const float* g; const float* c1; const float* s1; const float* c2; const float* s2; int pos0; };
template <int DK, int QMODE>
__device__ __forceinline__ void load_q(bf16x8 (&qr)[DK / 16], const bf16_t* Qw, const QPrep& qp, float qscale, int wid, int r32, int hi) {
  constexpr int ND = DK / 16;
  float x[ND * 8];
#pragma unroll
  for (int d0 = 0; d0 < ND; ++d0) { const u32x4 w = *reinterpret_cast<const u32x4*>(Qw + d0 * 16);
#pragma unroll
    for (int e = 0; e < 4; ++e) { x[d0 * 8 + 2 * e] = __uint_as_float(w[e] << 16); x[d0 * 8 + 2 * e + 1] = __uint_as_float(w[e] & 0xffff0000u); } }
  if constexpr (QMODE != 0) {
    float ss = 0.f;
#pragma unroll
    for (int i = 0; i < ND * 8; ++i) ss += x[i] * x[i];
    { auto rr = __builtin_amdgcn_permlane32_swap(__float_as_uint(ss), __float_as_uint(ss), false, false); ss = __uint_as_float(rr[0]) + __uint_as_float(rr[1]); }
    const float rstd = __builtin_amdgcn_rsqf(ss * (1.f / DK) + 1e-6f);
#pragma unroll
    for (int d0 = 0; d0 < ND; ++d0) { const f32x4_t g0 = *reinterpret_cast<const f32x4_t*>(qp.g + d0 * 16 + hi * 8), g1 = *reinterpret_cast<const f32x4_t*>(qp.g + d0 * 16 + hi * 8 + 4);
#pragma unroll
      for (int e = 0; e < 4; ++e) { x[d0 * 8 + e] *= rstd * g0[e]; x[d0 * 8 + 4 + e] *= rstd * g1[e]; } }
    const int pos = qp.pos0 + wid * QBLK + r32;
#define ROPE_PAIR(dA, dB, CT, ST) do { const f32x4_t c0 = *reinterpret_cast<const f32x4_t*>((CT) + hi * 8), c1_ = *reinterpret_cast<const f32x4_t*>((CT) + hi * 8 + 4), s0 = *reinterpret_cast<const f32x4_t*>((ST) + hi * 8), s1_ = *reinterpret_cast<const f32x4_t*>((ST) + hi * 8 + 4); \
      _Pragma("unroll") for (int e = 0; e < 8; ++e) { const float c = e < 4 ? c0[e & 3] : c1_[e & 3], s = e < 4 ? s0[e & 3] : s1_[e & 3]; const float xa = x[(dA) * 8 + e], xb = x[(dB) * 8 + e]; \
        x[(dA) * 8 + e] = xa * c - xb * s; x[(dB) * 8 + e] = xb * c + xa * s; } } while (0)
    if constexpr (QMODE == 1) {
#pragma unroll
      for (int d0 = 0; d0 < ND / 2; ++d0) ROPE_PAIR(d0, d0 + ND / 2, qp.c1 + (size_t)pos * (DK / 2) + d0 * 16, qp.s1 + (size_t)pos * (DK / 2) + d0 * 16);
    } else if constexpr (QMODE == 2) {
      const int grow = pos >> 6, gcol = pos & 63;
      ROPE_PAIR(0, 1, qp.c1 + grow * 16, qp.s1 + grow * 16); ROPE_PAIR(2, 3, qp.c2 + gcol * 16, qp.s2 + gcol * 16);
    } else if constexpr (QMODE == 3) {
      ROPE_PAIR(4, 5, qp.c1 + pos * 16, qp.s1 + pos * 16);
    }
#undef ROPE_PAIR
  }
#pragma unroll
  for (int d0 = 0; d0 < ND; ++d0) { u32x4 w;
#pragma unroll
    for (int e = 0; e < 4; ++e) w[e] = cvtpk(x[d0 * 8 + 2 * e] * qscale, x[d0 * 8 + 2 * e + 1] * qscale);
    qr[d0] = __builtin_bit_cast(bf16x8, w); }
}

struct DiffEpi { const bf16_t* O1; int ldo1; float lam; const float* g; int layer; };
template <int DK, int DV, int SDEPTH, int QMODE, int PIPE = 2, bool DIFF2 = false>
__device__ __forceinline__ void attn_unit(const bf16_t* Qb, int ldq, const bf16_t* __restrict__ Kh, int ldk, const bf16_t* __restrict__ Vh, int ldv,
                                          bf16_t* Ob, int ldo, int nkeys, float qscale, float negb_, const QPrep& qp, ALAS char* lds, int wave0, float omul = 1.0f, const DiffEpi* de = nullptr) {
  constexpr int NB = DV / 32, KC = DK / 8, VC = DV / 8;
  constexpr int NKC = 64 * KC, NVC = 64 * VC, KPT = (NKC + 511) / 512, VPT = (NVC + 511) / 512;
  constexpr int SHM_V = KVBLK * DV * 2, SHM_K = 16384;
  int tid; asm volatile("v_mbcnt_lo_u32_b32 %0, -1, 0\n\tv_mbcnt_hi_u32_b32 %0, -1, %0" : "=v"(tid)); tid = (tid + wave0 * 64) & 511;
  const int wid = tid >> 6, lane = tid & 63, r32 = lane & 31, hi = lane >> 5;
  ALAS char* V_lds = lds + (PIPE == 3 ? LDS_V3 : LDS_V); ALAS char* K_lds = lds + (PIPE == 3 ? LDS_K3 : LDS_K);
  ALAS float* ws = (ALAS float*)(lds + (PIPE == 3 ? LDS_WS3 : LDS_WS)) + wid * 64; ALAS float* li_l = ws;
  float l_reg = 0; f32x16 o[NB]; bf16x8 qr[DK / 16];
  const bool use_shift = negb_ < -60.f;
  load_q<DK, QMODE>(qr, Qb + (long)(wid * QBLK + r32) * ldq + hi * 8, qp, qscale, wid, r32, hi);
  SBAR();
#pragma unroll
  for (int d = 0; d < NB; ++d) o[d] = f32x16{};
  int kgo[KPT], klo[KPT], vgo[VPT], vlo[VPT]; bool kok[KPT], vok[VPT];
#pragma unroll
  for (int i = 0; i < KPT; ++i) { const int c = tid + 512 * i; kok[i] = (512 * (i + 1) <= NKC) || (c < NKC); const int row = c / KC, col = (c % KC) * 8; kgo[i] = row * ldk + col; klo[i] = KSWZ(row, col * 2); }
#pragma unroll
  for (int i = 0; i < VPT; ++i) { const int c = tid + 512 * i; vok[i] = (512 * (i + 1) <= NVC) || (c < NVC); const int row = c / VC, col = (c % VC) * 8; vgo[i] = row * ldv + col; vlo[i] = v_st<NB>(row, col); }
  const int vb0 = (int)(unsigned)(unsigned long)V_lds + v_rd_base(lane);
  struct { bf16x8 ks[KPT], vs[VPT]; } sr_[SDEPTH];
#define SLOAD(s, k0) do { _Pragma("unroll") for (int i_ = 0; i_ < KPT; ++i_) if (kok[i_]) sr_[s].ks[i_] = *reinterpret_cast<const bf16x8*>(Kh + (long)(k0) * ldk + kgo[i_]); \
    _Pragma("unroll") for (int i_ = 0; i_ < VPT; ++i_) if (vok[i_]) sr_[s].vs[i_] = *reinterpret_cast<const bf16x8*>(Vh + (long)(k0) * ldv + vgo[i_]); } while (0)
#define SWRITE(b, s) do { _Pragma("unroll") for (int i_ = 0; i_ < KPT; ++i_) if (kok[i_]) *(ALAS bf16x8*)(K_lds + (b) * SHM_K + klo[i_]) = sr_[s].ks[i_]; \
    _Pragma("unroll") for (int i_ = 0; i_ < VPT; ++i_) if (vok[i_]) *(ALAS bf16x8*)(V_lds + (b) * SHM_V + vlo[i_]) = sr_[s].vs[i_]; } while (0)
#define SWAIT() do { if constexpr (SDEPTH == 2) asm volatile("s_waitcnt vmcnt(%0)" :: "n"(KPT + VPT) : "memory"); else asm volatile("s_waitcnt vmcnt(0)" ::: "memory"); } while (0)
  bf16x8 pa0, pa1, pa2, pa3; const int NT = nkeys / KVBLK;
  if constexpr (PIPE == 1) {
    f32x16 pA0, pA1;
    SLOAD(0, 0); asm volatile("s_waitcnt vmcnt(0)" ::: "memory"); SWRITE(0, 0); __syncthreads();
    for (int j = 0; j < NT; ++j) {
      const int bsel = j & 1;
      if (j + 1 < NT) SLOAD(0, (j + 1) * KVBLK);
      SBAR(); qkt<DK>(pA0, pA1, K_lds + bsel * SHM_K, qr, r32, hi); expHalf(pA0, negb_, use_shift);
      finishSM(pA0, pA1, l_reg, pa0, pa1, pa2, pa3, negb_, use_shift); SBAR();
      pv_all<NB>(o, vb0 + bsel * SHM_V, pa0, pa1, pa2, pa3);
      if (j + 1 < NT) { asm volatile("s_waitcnt vmcnt(0)" ::: "memory"); SWRITE(bsel ^ 1, 0); }
      __syncthreads();
    }
  } else if constexpr (PIPE == 4) {
    f32x16 pA0, pA1;
    SLOAD(0, 0); asm volatile("s_waitcnt vmcnt(0)" ::: "memory"); SWRITE(0, 0); __syncthreads();
    if (wave0 < 4) {
      for (int j = 0; j < NT; ++j) {
        const int bsel = j & 1;
        if (j + 1 < NT) SLOAD(0, (j + 1) * KVBLK);
        SBAR(); qkt<DK>(pA0, pA1, K_lds + bsel * SHM_K, qr, r32, hi); expHalf(pA0, negb_, use_shift);
        finishSM(pA0, pA1, l_reg, pa0, pa1, pa2, pa3, negb_, use_shift); SBAR();
        __builtin_amdgcn_s_barrier(); SBAR();
        pv_all<NB>(o, vb0 + bsel * SHM_V, pa0, pa1, pa2, pa3);
        if (j + 1 < NT) { asm volatile("s_waitcnt vmcnt(0)" ::: "memory"); SWRITE(bsel ^ 1, 0); }
        __syncthreads();
      }
    } else {
      for (int j = 0; j < NT; ++j) {
        const int bsel = j & 1;
        if (j + 1 < NT) SLOAD(0, (j + 1) * KVBLK);
        SBAR(); if (j > 0) pv_all<NB>(o, vb0 + (bsel ^ 1) * SHM_V, pa0, pa1, pa2, pa3);
        SBAR(); qkt<DK>(pA0, pA1, K_lds + bsel * SHM_K, qr, r32, hi); SBAR();
        __builtin_amdgcn_s_barrier(); SBAR();
        expHalf(pA0, negb_, use_shift); finishSM(pA0, pA1, l_reg, pa0, pa1, pa2, pa3, negb_, use_shift); SBAR();
        if (j + 1 < NT) { asm volatile("s_waitcnt vmcnt(0)" ::: "memory"); SWRITE(bsel ^ 1, 0); }
        __syncthreads();
      }
      pv_all<NB>(o, vb0 + ((NT - 1) & 1) * SHM_V, pa0, pa1, pa2, pa3);
    }
  } else if constexpr (PIPE == 3) {
    f32x16 pA0, pA1, pB0, pB1;
    struct { bf16x8 ks[KPT], vs[VPT]; } st_;
#define GLK(k0) do { _Pragma("unroll") for (int i_ = 0; i_ < KPT; ++i_) if (kok[i_]) st_.ks[i_] = *reinterpret_cast<const bf16x8*>(Kh + (long)(k0) * ldk + kgo[i_]); } while (0)
#define GLV(k0) do { _Pragma("unroll") for (int i_ = 0; i_ < VPT; ++i_) if (vok[i_]) st_.vs[i_] = *reinterpret_cast<const bf16x8*>(Vh + (long)(k0) * ldv + vgo[i_]); } while (0)
#define WRK(off) do { _Pragma("unroll") for (int i_ = 0; i_ < KPT; ++i_) if (kok[i_]) *(ALAS bf16x8*)(K_lds + (off) + klo[i_]) = st_.ks[i_]; } while (0)
#define WRV(off) do { _Pragma("unroll") for (int i_ = 0; i_ < VPT; ++i_) if (vok[i_]) *(ALAS bf16x8*)(V_lds + (off) + vlo[i_]) = st_.vs[i_]; } while (0)
#define ROT3(x, S) ((x) == 2 * (S) ? 0 : (x) + (S))
    GLK(0); GLV(0); asm volatile("s_waitcnt vmcnt(0)" ::: "memory"); WRK(0); WRV(0);
    GLK(KVBLK); asm volatile("s_waitcnt vmcnt(0)" ::: "memory"); WRK(SHM_K);
    if (2 < NT) GLK(2 * KVBLK);
    GLV(KVBLK);
    __syncthreads();
    int kr = 0, vr = 0, kw = 2 * SHM_K, vw = SHM_V;
#define STEP3(PC0, PC1, PP0, PP1, t, HASPREV) do { \
      SBAR(); qkt<DK>(PC0, PC1, K_lds + kr, qr, r32, hi); \
      if (HASPREV) { finishSM(PP0, PP1, l_reg, pa0, pa1, pa2, pa3, negb_, use_shift); SBAR(); pv_all<NB>(o, vb0 + vr, pa0, pa1, pa2, pa3); vr = ROT3(vr, SHM_V); } \
      expHalf(PC0, negb_, use_shift); \
      asm volatile("s_waitcnt vmcnt(0)" ::: "memory"); \
      if ((t) + 2 < NT) WRK(kw); if ((t) + 1 < NT) WRV(vw); \
      if ((t) + 3 < NT) GLK(((t) + 3) * KVBLK); if ((t) + 2 < NT) GLV(((t) + 2) * KVBLK); \
      kr = ROT3(kr, SHM_K); kw = ROT3(kw, SHM_K); vw = ROT3(vw, SHM_V); \
      __syncthreads(); } while (0)
    STEP3(pA0, pA1, pB0, pB1, 0, false);
    for (int t = 1; t + 1 < NT; t += 2) {
      STEP3(pB0, pB1, pA0, pA1, t, true);
      STEP3(pA0, pA1, pB0, pB1, t + 1, true);
    }
    STEP3(pB0, pB1, pA0, pA1, NT - 1, true);
    finishSM(pB0, pB1, l_reg, pa0, pa1, pa2, pa3, negb_, use_shift); SBAR();
    pv_all<NB>(o, vb0 + vr, pa0, pa1, pa2, pa3);
#undef GLK
#undef GLV
#undef WRK
#undef WRV
#undef ROT3
#undef STEP3
  } else {
  f32x16 pA0, pA1, pB0, pB1;
  constexpr int SE = 0, SO = SDEPTH - 1;
  SLOAD(SE, 0); asm volatile("s_waitcnt vmcnt(0)" ::: "memory"); SWRITE(0, SE); __syncthreads();
  qkt<DK>(pA0, pA1, K_lds, qr, r32, hi); expHalf(pA0, negb_, use_shift);
  SLOAD(SO, KVBLK); if constexpr (SDEPTH == 2) { if (2 < NT) SLOAD(SE, 2 * KVBLK); }
  SWAIT(); SWRITE(1, SO); __syncthreads();
  for (int j = 1; j + 1 < NT; j += 2) {
    SBAR(); qkt<DK>(pB0, pB1, K_lds + SHM_K, qr, r32, hi);
    finishSM(pA0, pA1, l_reg, pa0, pa1, pa2, pa3, negb_, use_shift); SBAR();
    SLOAD(SO, (j + SDEPTH) * KVBLK); SBAR();
    pv_all<NB>(o, vb0, pa0, pa1, pa2, pa3); expHalf(pB0, negb_, use_shift);
    __syncthreads(); SWAIT(); SWRITE(0, SE);
    __syncthreads();
    SBAR(); qkt<DK>(pA0, pA1, K_lds, qr, r32, hi);
    finishSM(pB0, pB1, l_reg, pa0, pa1, pa2, pa3, negb_, use_shift); SBAR();
    if (SDEPTH == 1 || j + 3 < NT) SLOAD(SE, (j + 1 + SDEPTH) * KVBLK); SBAR();
    pv_all<NB>(o, vb0 + SHM_V, pa0, pa1, pa2, pa3); expHalf(pA0, negb_, use_shift);
    __syncthreads(); SWAIT(); SWRITE(1, SO);
    __syncthreads();
  }
  SBAR(); qkt<DK>(pB0, pB1, K_lds + SHM_K, qr, r32, hi);
  finishSM(pA0, pA1, l_reg, pa0, pa1, pa2, pa3, negb_, use_shift); SBAR();
  pv_all<NB>(o, vb0, pa0, pa1, pa2, pa3); expHalf(pB0, negb_, use_shift);
  finishSM(pB0, pB1, l_reg, pa0, pa1, pa2, pa3, negb_, use_shift); SBAR();
  pv_all<NB>(o, vb0 + SHM_V, pa0, pa1, pa2, pa3);
  }
  { auto rr = __builtin_amdgcn_permlane32_swap(__float_as_uint(l_reg), __float_as_uint(l_reg), false, false); l_reg = __uint_as_float(rr[0]) + __uint_as_float(rr[1]); }
  if (hi == 0) li_l[r32] = l_reg; asm volatile("s_waitcnt lgkmcnt(0)" ::: "memory");
  float rli[16];
#pragma unroll
  for (int r = 0; r < 16; ++r) rli[r] = __builtin_amdgcn_rcpf(li_l[crow(r, hi)]) * omul;
  bf16_t* Ow = Ob + (long)(wid * QBLK) * ldo;
  if constexpr (DIFF2) {
    const bf16_t* O1w = de->O1 + (long)(wid * QBLK) * de->ldo1;
    float gcol[NB];
    int ly_ = de->layer; asm volatile("" : "+s"(ly_));
    const float post_ = (ly_ == 0) ? 0.8f : (1.0f - (0.8f - 0.6f * 0.74081822068171788f));
#pragma unroll
    for (int d0 = 0; d0 < NB; ++d0) gcol[d0] = de->g[d0 * 32 + r32] * post_;
#pragma unroll
    for (int r = 0; r < 16; ++r) { const int orow = crow(r, hi); float d[NB]; float ss = 0.f;
#pragma unroll
      for (int d0 = 0; d0 < NB; ++d0) { const float o1 = __uint_as_float((unsigned)O1w[(long)orow * de->ldo1 + d0 * 32 + r32] << 16); d[d0] = o1 - de->lam * (o[d0][r] * rli[r]); ss += d[d0] * d[d0]; }
      ss += __int_as_float(__builtin_amdgcn_ds_swizzle(__float_as_int(ss), (1 << 10) | 0x1f)); ss += __int_as_float(__builtin_amdgcn_ds_swizzle(__float_as_int(ss), (2 << 10) | 0x1f));
      ss += __int_as_float(__builtin_amdgcn_ds_swizzle(__float_as_int(ss), (4 << 10) | 0x1f)); ss += __int_as_float(__builtin_amdgcn_ds_swizzle(__float_as_int(ss), (8 << 10) | 0x1f));
      ss += __int_as_float(__builtin_amdgcn_ds_swizzle(__float_as_int(ss), (16 << 10) | 0x1f));
      const float rstd = __builtin_amdgcn_rsqf(ss * (1.f / 128.f) + 1e-6f);
#pragma unroll
      for (int d0 = 0; d0 < NB; ++d0) { const float v = d[d0] * rstd * gcol[d0]; __builtin_nontemporal_store((bf16_t)(cvtpk(v, v) & 0xffffu), Ow + (long)orow * ldo + d0 * 32 + r32); } }
  } else {
#pragma unroll
  for (int r = 0; r < 16; ++r) { const int orow = crow(r, hi);
#pragma unroll
    for (int d0 = 0; d0 < NB; ++d0) { const float v = o[d0][r] * rli[r]; const bf16_t w_ = (bf16_t)(cvtpk(v, v) & 0xffffu);
      if constexpr (DK == 64) Ow[(long)orow * ldo + d0 * 32 + r32] = w_;
      else __builtin_nontemporal_store(w_, Ow + (long)orow * ldo + d0 * 32 + r32); } }
  }
  __syncthreads();
#undef SLOAD
#undef SWRITE
#undef SWAIT
}
template <int DK> __device__ __forceinline__ void qkt2(f32x16 (&p)[2][2], const ALAS char* Ks, const bf16x8 (&qr)[2][DK / 16], int r32, int hi) {
  constexpr int ND = DK / 16, BT = QK2_BT < ND ? QK2_BT : ND;
  p[0][0] = f32x16{}; p[0][1] = f32x16{}; p[1][0] = f32x16{}; p[1][1] = f32x16{};
#pragma unroll
  for (int b0 = 0; b0 < ND; b0 += BT) {
    bf16x8 k0[BT], k1[BT];
#pragma unroll
    for (int i = 0; i < BT; ++i) { const int cb = ((b0 + i) * 16 + hi * 8) * 2;
      k0[i] = *(const ALAS bf16x8*)(Ks + KSWZ(r32, cb)); k1[i] = *(const ALAS bf16x8*)(Ks + KSWZ(32 + r32, cb)); }
    SBAR();
#pragma unroll
    for (int i = 0; i < BT; ++i) {
      p[0][0] = __builtin_amdgcn_mfma_f32_32x32x16_bf16(k0[i], qr[0][b0 + i], p[0][0], 0, 0, 0);
      p[1][0] = __builtin_amdgcn_mfma_f32_32x32x16_bf16(k0[i], qr[1][b0 + i], p[1][0], 0, 0, 0);
      p[0][1] = __builtin_amdgcn_mfma_f32_32x32x16_bf16(k1[i], qr[0][b0 + i], p[0][1], 0, 0, 0);
      p[1][1] = __builtin_amdgcn_mfma_f32_32x32x16_bf16(k1[i], qr[1][b0 + i], p[1][1], 0, 0, 0); }
    SBAR();
  }
}
template <int NB, int D0> __device__ __forceinline__ void pv_one2(f32x16& oa, f32x16& ob, int vb, const bf16x8 (&pa)[2][4]) {
#define VOFF(ks, half) (D0 * 512 + (ks) * (1024 * NB) + (half) * (512 * NB))
  const s16x4 l0 = tr_read<VOFF(0, 0)>(vb), h0 = tr_read<VOFF(0, 1)>(vb), l1 = tr_read<VOFF(1, 0)>(vb), h1 = tr_read<VOFF(1, 1)>(vb);
  const s16x4 l2 = tr_read<VOFF(2, 0)>(vb), h2 = tr_read<VOFF(2, 1)>(vb), l3 = tr_read<VOFF(3, 0)>(vb), h3 = tr_read<VOFF(3, 1)>(vb);
#undef VOFF
  asm volatile("s_waitcnt lgkmcnt(0)" ::: "memory"); SBAR();
#define PK(L, H) (bf16x8){L[0], L[1], L[2], L[3], H[0], H[1], H[2], H[3]}
  oa = __builtin_amdgcn_mfma_f32_32x32x16_bf16(pa[0][0], PK(l0, h0), oa, 0, 0, 0);
  ob = __builtin_amdgcn_mfma_f32_32x32x16_bf16(pa[1][0], PK(l0, h0), ob, 0, 0, 0);
  oa = __builtin_amdgcn_mfma_f32_32x32x16_bf16(pa[0][1], PK(l1, h1), oa, 0, 0, 0);
  ob = __builtin_amdgcn_mfma_f32_32x32x16_bf16(pa[1][1], PK(l1, h1), ob, 0, 0, 0);
  oa = __builtin_amdgcn_mfma_f32_32x32x16_bf16(pa[0][2], PK(l2, h2), oa, 0, 0, 0);
  ob = __builtin_amdgcn_mfma_f32_32x32x16_bf16(pa[1][2], PK(l2, h2), ob, 0, 0, 0);
  oa = __builtin_amdgcn_mfma_f32_32x32x16_bf16(pa[0][3], PK(l3, h3), oa, 0, 0, 0);
  ob = __builtin_amdgcn_mfma_f32_32x32x16_bf16(pa[1][3], PK(l3, h3), ob, 0, 0, 0);
#undef PK
}
template <int DK, int QMODE, bool SHAREK = true>
__device__ __forceinline__ void attn_unit2(const bf16_t* Qb, int ldq, const bf16_t* __restrict__ Kh, int ldk, const bf16_t* __restrict__ Vh, int ldv,
                                           bf16_t* Ob, int ldo, int nkeys, float qscale, float negb_, const QPrep& qp, ALAS char* lds, int wave0) {
  constexpr int DV = 64, NB = 2, KC = DK / 8, VC = DV / 8;
  constexpr int NKC = 64 * KC, NVC = 64 * VC, KPT = (NKC + 511) / 512, VPT = (NVC + 511) / 512;
  constexpr int SHM_V = KVBLK * DV * 2, SHM_K = 16384;
  int tid; asm volatile("v_mbcnt_lo_u32_b32 %0, -1, 0\n\tv_mbcnt_hi_u32_b32 %0, -1, %0" : "=v"(tid)); tid = (tid + wave0 * 64) & 511;
  const int wid = tid >> 6, lane = tid & 63, r32 = lane & 31, hi = lane >> 5;
  ALAS char* V_lds = lds + LDS_V; ALAS char* K_lds = lds + LDS_K;
  ALAS float* ws = (ALAS float*)(lds + LDS_WS) + wid * 64;
  const bool use_shift = negb_ < -60.f;
  float l_reg[2] = {0.f, 0.f}; f32x16 o[2][NB]; bf16x8 qr[2][DK / 16];
  { QPrep q2 = qp;
    load_q<DK, QMODE>(qr[0], Qb + (long)(wid * QBLK + r32) * ldq + hi * 8, q2, qscale, wid, r32, hi);
    SBAR();
    q2.pos0 = qp.pos0 + 256;
    load_q<DK, QMODE>(qr[1], Qb + (long)(256 + wid * QBLK + r32) * ldq + hi * 8, q2, qscale, wid, r32, hi); }
  SBAR();
#pragma unroll
  for (int q = 0; q < 2; ++q)
#pragma unroll
    for (int d = 0; d < NB; ++d) o[q][d] = f32x16{};
  int kgo[KPT], klo[KPT], vgo[VPT], vlo[VPT]; bool kok[KPT], vok[VPT];
#pragma unroll
  for (int i = 0; i < KPT; ++i) { const int c = tid + 512 * i; kok[i] = (512 * (i + 1) <= NKC) || (c < NKC); const int row = c / KC, col = (c % KC) * 8; kgo[i] = row * ldk + col; klo[i] = KSWZ(row, col * 2); }
#pragma unroll
  for (int i = 0; i < VPT; ++i) { const int c = tid + 512 * i; vok[i] = (512 * (i + 1) <= NVC) || (c < NVC); const int row = c / VC, col = (c % VC) * 8; vgo[i] = row * ldv + col; vlo[i] = v_st<NB>(row, col); }
  const int vb0 = (int)(unsigned)(unsigned long)V_lds + v_rd_base(lane);
  struct { bf16x8 ks[KPT], vs[VPT]; } sr_;
#define SLOAD2(k0) do { _Pragma("unroll") for (int i_ = 0; i_ < KPT; ++i_) if (kok[i_]) sr_.ks[i_] = *reinterpret_cast<const bf16x8*>(Kh + (long)(k0) * ldk + kgo[i_]); \
    _Pragma("unroll") for (int i_ = 0; i_ < VPT; ++i_) if (vok[i_]) sr_.vs[i_] = *reinterpret_cast<const bf16x8*>(Vh + (long)(k0) * ldv + vgo[i_]); } while (0)
#define SWRITE2(b) do { _Pragma("unroll") for (int i_ = 0; i_ < KPT; ++i_) if (kok[i_]) *(ALAS bf16x8*)(K_lds + (b) * SHM_K + klo[i_]) = sr_.ks[i_]; \
    _Pragma("unroll") for (int i_ = 0; i_ < VPT; ++i_) if (vok[i_]) *(ALAS bf16x8*)(V_lds + (b) * SHM_V + vlo[i_]) = sr_.vs[i_]; } while (0)
  const int NT = nkeys / KVBLK;
  f32x16 p[2][2]; bf16x8 pa[2][4];
  SLOAD2(0); asm volatile("s_waitcnt vmcnt(0)" ::: "memory"); SWRITE2(0); __syncthreads();
  for (int j = 0; j < NT; ++j) {
    const int bsel = j & 1;
    if (j + 1 < NT) SLOAD2((j + 1) * KVBLK);
    if constexpr (SHAREK) {
      SBAR(); qkt2<DK>(p, K_lds + bsel * SHM_K, qr, r32, hi);
      expHalf(p[0][0], negb_, use_shift); finishSM(p[0][0], p[0][1], l_reg[0], pa[0][0], pa[0][1], pa[0][2], pa[0][3], negb_, use_shift);
      expHalf(p[1][0], negb_, use_shift); finishSM(p[1][0], p[1][1], l_reg[1], pa[1][0], pa[1][1], pa[1][2], pa[1][3], negb_, use_shift); SBAR();
    } else {
      SBAR(); qkt<DK>(p[0][0], p[0][1], K_lds + bsel * SHM_K, qr[0], r32, hi);
      expHalf(p[0][0], negb_, use_shift); finishSM(p[0][0], p[0][1], l_reg[0], pa[0][0], pa[0][1], pa[0][2], pa[0][3], negb_, use_shift); SBAR();
      qkt<DK>(p[0][0], p[0][1], K_lds + bsel * SHM_K, qr[1], r32, hi);
      expHalf(p[0][0], negb_, use_shift); finishSM(p[0][0], p[0][1], l_reg[1], pa[1][0], pa[1][1], pa[1][2], pa[1][3], negb_, use_shift); SBAR();
    }
    pv_one2<NB, 0>(o[0][0], o[1][0], vb0 + bsel * SHM_V, pa); pv_one2<NB, 1>(o[0][1], o[1][1], vb0 + bsel * SHM_V, pa);
    if (j + 1 < NT) { asm volatile("s_waitcnt vmcnt(0)" ::: "memory"); SWRITE2(bsel ^ 1); }
    __syncthreads();
  }
#pragma unroll
  for (int q = 0; q < 2; ++q) {
    float lq = l_reg[q];
    { auto rr = __builtin_amdgcn_permlane32_swap(__float_as_uint(lq), __float_as_uint(lq), false, false); lq = __uint_as_float(rr[0]) + __uint_as_float(rr[1]); }
    if (hi == 0) ws[q * 32 + r32] = lq;
  }
  asm volatile("s_waitcnt lgkmcnt(0)" ::: "memory");
#pragma unroll
  for (int q = 0; q < 2; ++q) {
    float rli[16];
#pragma unroll
    for (int r = 0; r < 16; ++r) rli[r] = __builtin_amdgcn_rcpf(ws[q * 32 + crow(r, hi)]);
    bf16_t* Ow = Ob + (long)(q * 256 + wid * QBLK) * ldo;
#pragma unroll
    for (int r = 0; r < 16; ++r) { const int orow = crow(r, hi);
#pragma unroll
      for (int d0 = 0; d0 < NB; ++d0) { const float v = o[q][d0][r] * rli[r]; __builtin_nontemporal_store((bf16_t)(cvtpk(v, v) & 0xffffu), Ow + (long)orow * ldo + d0 * 32 + r32); } }
  }
  __syncthreads();
#undef SLOAD2
#undef SWRITE2
}
template <int DK, int QMODE, bool SHAREK = true>
__device__ __forceinline__ void attn_unit2d(const bf16_t* Qb, int ldq, const bf16_t* __restrict__ Kh, int ldk, const bf16_t* __restrict__ Vh, int ldv,
                                           bf16_t* Ob, int ldo, int nkeys, float qscale, float negb_, const QPrep& qp, ALAS char* lds, int wave0) {
  constexpr int DV = 64, NB = 2, KC = DK / 8, VC = DV / 8;
  constexpr int NKC = 64 * KC, NVC = 64 * VC, KPT = (NKC + 511) / 512, VPT = (NVC + 511) / 512;
  constexpr int SHM_V = KVBLK * DV * 2, SHM_K = 16384;
  int tid; asm volatile("v_mbcnt_lo_u32_b32 %0, -1, 0\n\tv_mbcnt_hi_u32_b32 %0, -1, %0" : "=v"(tid)); tid = (tid + wave0 * 64) & 511;
  const int wid = tid >> 6, lane = tid & 63, r32 = lane & 31, hi = lane >> 5;
  ALAS char* V_lds = lds + LDS_V; ALAS char* K_lds = lds + LDS_K;
  ALAS float* ws = (ALAS float*)(lds + LDS_WS) + wid * 64;
  const bool use_shift = negb_ < -60.f;
  float l_reg[2] = {0.f, 0.f}; f32x16 o[2][NB]; bf16x8 qr[2][DK / 16];
  { QPrep q2 = qp;
    load_q<DK, QMODE>(qr[0], Qb + (long)(wid * QBLK + r32) * ldq + hi * 8, q2, qscale, wid, r32, hi);
    SBAR();
    q2.pos0 = qp.pos0 + 256;
    load_q<DK, QMODE>(qr[1], Qb + (long)(256 + wid * QBLK + r32) * ldq + hi * 8, q2, qscale, wid, r32, hi); }
  SBAR();
#pragma unroll
  for (int q = 0; q < 2; ++q)
#pragma unroll
    for (int d = 0; d < NB; ++d) o[q][d] = f32x16{};
  const int widu = __builtin_amdgcn_readfirstlane(wid);
  constexpr int KINST = 2, VINST = (64 * DV * 2) / (512 * 16);
  int kg[KINST], vg[VINST]; bool kv_[KINST];
#pragma unroll
  for (int i = 0; i < KINST; ++i) { const int q = (i * 8 + wid) * 64 + lane, row = q >> 4, pos = q & 15, c = pos ^ KF(row); kv_[i] = c < KC; kg[i] = row * ldk + c * 8; }
#pragma unroll
  for (int i = 0; i < VINST; ++i) { const int q = (i * 8 + wid) * 64 + lane, o_ = q * 16, sub = o_ >> 9, e = (o_ & 511) >> 1, kk = (sub / NB) * 8 + (e >> 5), k = (kk & ~0xC) | ((kk & 4) << 1) | ((kk & 8) >> 1), c = (sub % NB) * 32 + (e & 31); vg[i] = k * ldv + c; }
  const int vb0 = (int)(unsigned)(unsigned long)V_lds + v_rd_base(lane);
#define DMA_KV(b, k0) do { \
    _Pragma("unroll") for (int i_ = 0; i_ < KINST; ++i_) if (kv_[i_]) __builtin_amdgcn_global_load_lds((const unsigned*)(Kh + (long)(k0) * ldk + kg[i_]), (ALAS unsigned*)(K_lds + (b) * SHM_K + (i_ * 8 + widu) * 1024), 16, 0, 0); \
    _Pragma("unroll") for (int i_ = 0; i_ < VINST; ++i_) __builtin_amdgcn_global_load_lds((const unsigned*)(Vh + (long)(k0) * ldv + vg[i_]), (ALAS unsigned*)(V_lds + (b) * SHM_V + (i_ * 8 + widu) * 1024), 16, 0, 0); } while (0)
  const int NT = nkeys / KVBLK;
  f32x16 p[2][2]; bf16x8 pa[2][4];
  DMA_KV(0, 0); asm volatile("s_waitcnt vmcnt(0)" ::: "memory"); __syncthreads();
  for (int j = 0; j < NT; ++j) {
    const int bsel = j & 1;
    if (j + 1 < NT) DMA_KV(bsel ^ 1, (j + 1) * KVBLK);
    if constexpr (SHAREK) {
      SBAR(); qkt2<DK>(p, K_lds + bsel * SHM_K, qr, r32, hi);
      expHalf(p[0][0], negb_, use_shift); finishSM(p[0][0], p[0][1], l_reg[0], pa[0][0], pa[0][1], pa[0][2], pa[0][3], negb_, use_shift);
      expHalf(p[1][0], negb_, use_shift); finishSM(p[1][0], p[1][1], l_reg[1], pa[1][0], pa[1][1], pa[1][2], pa[1][3], negb_, use_shift); SBAR();
    } else {
      SBAR(); qkt<DK>(p[0][0], p[0][1], K_lds + bsel * SHM_K, qr[0], r32, hi);
      expHalf(p[0][0], negb_, use_shift); finishSM(p[0][0], p[0][1], l_reg[0], pa[0][0], pa[0][1], pa[0][2], pa[0][3], negb_, use_shift); SBAR();
      qkt<DK>(p[0][0], p[0][1], K_lds + bsel * SHM_K, qr[1], r32, hi);
      expHalf(p[0][0], negb_, use_shift); finishSM(p[0][0], p[0][1], l_reg[1], pa[1][0], pa[1][1], pa[1][2], pa[1][3], negb_, use_shift); SBAR();
    }
    pv_one2<NB, 0>(o[0][0], o[1][0], vb0 + bsel * SHM_V, pa); pv_one2<NB, 1>(o[0][1], o[1][1], vb0 + bsel * SHM_V, pa);
    asm volatile("s_waitcnt vmcnt(0)" ::: "memory");
    __syncthreads();
  }
#pragma unroll
  for (int q = 0; q < 2; ++q) {
    float lq = l_reg[q];
    { auto rr = __builtin_amdgcn_permlane32_swap(__float_as_uint(lq), __float_as_uint(lq), false, false); lq = __uint_as_float(rr[0]) + __uint_as_float(rr[1]); }
    if (hi == 0) ws[q * 32 + r32] = lq;
  }
  asm volatile("s_waitcnt lgkmcnt(0)" ::: "memory");
#pragma unroll
  for (int q = 0; q < 2; ++q) {
    float rli[16];
#pragma unroll
    for (int r = 0; r < 16; ++r) rli[r] = __builtin_amdgcn_rcpf(ws[q * 32 + crow(r, hi)]);
    bf16_t* Ow = Ob + (long)(q * 256 + wid * QBLK) * ldo;
#pragma unroll
    for (int r = 0; r < 16; ++r) { const int orow = crow(r, hi);
#pragma unroll
      for (int d0 = 0; d0 < NB; ++d0) { const float v = o[q][d0][r] * rli[r]; __builtin_nontemporal_store((bf16_t)(cvtpk(v, v) & 0xffffu), Ow + (long)orow * ldo + d0 * 32 + r32); } }
  }
  __syncthreads();
#undef DMA_KV
}
__device__ __forceinline__ void attn_unit_diff(const bf16_t* Qb, int ldq, const bf16_t* __restrict__ Kh, int ldk, const bf16_t* __restrict__ Vh, int ldv,
                                               bf16_t* Ob, int ldo, int nkeys, float qscale, float negb_, const QPrep& qp, ALAS char* lds, int wave0, float lam, const float* g, float post) {
  constexpr int DK = 64, DV = 128, NB = 4, KC = 16, VC = 16, KPT = 2, VPT = 2, SHM_V = KVBLK * DV * 2, SHM_K = 16384;
  int tid; asm volatile("v_mbcnt_lo_u32_b32 %0, -1, 0\n\tv_mbcnt_hi_u32_b32 %0, -1, %0" : "=v"(tid)); tid = (tid + wave0 * 64) & 511;
  const int wid = tid >> 6, lane = tid & 63, r32 = lane & 31, hi = lane >> 5;
  ALAS char* V_lds = lds + LDS_V; ALAS char* K_lds = lds + LDS_K;
  ALAS float* ws = (ALAS float*)(lds + LDS_WS) + wid * 64;
  const bool use_shift = negb_ < -60.f;
  float l_reg[2] = {0.f, 0.f}; f32x16 o[2][NB]; bf16x8 qr[2][DK / 16];
  load_q<DK, 1>(qr[0], Qb + (long)(wid * QBLK + r32) * ldq + hi * 8, qp, qscale, wid, r32, hi);
  SBAR();
  load_q<DK, 1>(qr[1], Qb + 64 + (long)(wid * QBLK + r32) * ldq + hi * 8, qp, qscale, wid, r32, hi);
  SBAR();
#pragma unroll
  for (int q = 0; q < 2; ++q)
#pragma unroll
    for (int d = 0; d < NB; ++d) o[q][d] = f32x16{};
  int kgo[KPT], klo[KPT], vgo[VPT], vlo[VPT];
#pragma unroll
  for (int i = 0; i < KPT; ++i) { const int c = tid + 512 * i; const int row = c / KC, col = (c % KC) * 8; kgo[i] = row * ldk + col; klo[i] = KSWZ(row, col * 2); }
#pragma unroll
  for (int i = 0; i < VPT; ++i) { const int c = tid + 512 * i; const int row = c / VC, col = (c % VC) * 8; vgo[i] = row * ldv + col; vlo[i] = v_st<NB>(row, col); }
  const int vb0 = (int)(unsigned)(unsigned long)V_lds + v_rd_base(lane);
  struct { bf16x8 ks[KPT], vs[VPT]; } sr_;
#define SLOADD(k0) do { _Pragma("unroll") for (int i_ = 0; i_ < KPT; ++i_) sr_.ks[i_] = *reinterpret_cast<const bf16x8*>(Kh + (long)(k0) * ldk + kgo[i_]); \
    _Pragma("unroll") for (int i_ = 0; i_ < VPT; ++i_) sr_.vs[i_] = *reinterpret_cast<const bf16x8*>(Vh + (long)(k0) * ldv + vgo[i_]); } while (0)
#define SWRITED(b) do { _Pragma("unroll") for (int i_ = 0; i_ < KPT; ++i_) *(ALAS bf16x8*)(K_lds + (b) * SHM_K + klo[i_]) = sr_.ks[i_]; \
    _Pragma("unroll") for (int i_ = 0; i_ < VPT; ++i_) *(ALAS bf16x8*)(V_lds + (b) * SHM_V + vlo[i_]) = sr_.vs[i_]; } while (0)
  const int NT = nkeys / KVBLK;
  f32x16 p0, p1; bf16x8 pa0, pa1, pa2, pa3;
  SLOADD(0); asm volatile("s_waitcnt vmcnt(0)" ::: "memory"); SWRITED(0); __syncthreads();
  for (int j = 0; j < NT; ++j) {
    const int bsel = j & 1;
    if (j + 1 < NT) SLOADD((j + 1) * KVBLK);
    SBAR(); qkt<DK, 0>(p0, p1, K_lds + bsel * SHM_K, qr[0], r32, hi); expHalf(p0, negb_, use_shift);
    finishSM(p0, p1, l_reg[0], pa0, pa1, pa2, pa3, negb_, use_shift); SBAR();
    pv_all<NB>(o[0], vb0 + bsel * SHM_V, pa0, pa1, pa2, pa3);
    SBAR(); qkt<DK, 128>(p0, p1, K_lds + bsel * SHM_K, qr[1], r32, hi); expHalf(p0, negb_, use_shift);
    finishSM(p0, p1, l_reg[1], pa0, pa1, pa2, pa3, negb_, use_shift); SBAR();
    pv_all<NB>(o[1], vb0 + bsel * SHM_V, pa0, pa1, pa2, pa3);
    if (j + 1 < NT) { asm volatile("s_waitcnt vmcnt(0)" ::: "memory"); SWRITED(bsel ^ 1); }
    __syncthreads();
  }
#pragma unroll
  for (int q = 0; q < 2; ++q) { float lq = l_reg[q];
    { auto rr = __builtin_amdgcn_permlane32_swap(__float_as_uint(lq), __float_as_uint(lq), false, false); lq = __uint_as_float(rr[0]) + __uint_as_float(rr[1]); }
    if (hi == 0) ws[q * 32 + r32] = lq; }
  asm volatile("s_waitcnt lgkmcnt(0)" ::: "memory");
  float gcol[NB];
#pragma unroll
  for (int d0 = 0; d0 < NB; ++d0) gcol[d0] = g[d0 * 32 + r32] * post;
  bf16_t* Ow = Ob + (long)(wid * QBLK) * ldo;
#pragma unroll
  for (int r = 0; r < 16; ++r) { const int orow = crow(r, hi); const float r1 = __builtin_amdgcn_rcpf(ws[crow(r, hi)]), r2 = __builtin_amdgcn_rcpf(ws[32 + crow(r, hi)]) * lam; float d[NB]; float ss = 0.f;
#pragma unroll
    for (int d0 = 0; d0 < NB; ++d0) { d[d0] = o[0][d0][r] * r1 - o[1][d0][r] * r2; ss += d[d0] * d[d0]; }
    ss += __int_as_float(__builtin_amdgcn_ds_swizzle(__float_as_int(ss), (1 << 10) | 0x1f)); ss += __int_as_float(__builtin_amdgcn_ds_swizzle(__float_as_int(ss), (2 << 10) | 0x1f));
    ss += __int_as_float(__builtin_amdgcn_ds_swizzle(__float_as_int(ss), (4 << 10) | 0x1f)); ss += __int_as_float(__builtin_amdgcn_ds_swizzle(__float_as_int(ss), (8 << 10) | 0x1f));
    ss += __int_as_float(__builtin_amdgcn_ds_swizzle(__float_as_int(ss), (16 << 10) | 0x1f));
    const float rstd = __builtin_amdgcn_rsqf(ss * (1.f / 128.f) + 1e-6f);
#pragma unroll
    for (int d0 = 0; d0 < NB; ++d0) { const float v = d[d0] * rstd * gcol[d0]; Ow[(long)orow * ldo + d0 * 32 + r32] = (bf16_t)(cvtpk(v, v) & 0xffffu); } }
  __syncthreads();
#undef SLOADD
#undef SWRITED
}
#undef KSWZ
#undef KF
#undef SBAR
}
#define GAS __attribute__((address_space(1)))
#define LAS __attribute__((address_space(3)))
typedef unsigned short bf16;
typedef unsigned v4u __attribute__((ext_vector_type(4)));
typedef unsigned v2u __attribute__((ext_vector_type(2)));
typedef float f32x4 __attribute__((ext_vector_type(4)));
typedef float f32x2 __attribute__((ext_vector_type(2)));
typedef GAS unsigned gu32;
#define RLX_AGENT __ATOMIC_RELAXED, __HIP_MEMORY_SCOPE_AGENT
#define LDS_WAIT() asm volatile("s_waitcnt lgkmcnt(0)" ::: "memory")
#define VM_WAIT() asm volatile("s_waitcnt vmcnt(0)" ::: "memory")
__device__ __forceinline__ unsigned f2bf(float f) { unsigned u = __builtin_bit_cast(unsigned, f); return (u + 0x7fffu + ((u >> 16) & 1u)) >> 16; }
__device__ __forceinline__ unsigned pk2(float lo, float hi) { return pg8::cvt_pk_bf16(lo, hi); }
__device__ __forceinline__ float bflo(unsigned w) { return __uint_as_float(w << 16); }
__device__ __forceinline__ float bfhi(unsigned w) { return __uint_as_float(w & 0xffff0000u); }

__device__ __forceinline__ int lane_id() { int l; asm volatile("v_mbcnt_lo_u32_b32 %0, -1, 0\n\tv_mbcnt_hi_u32_b32 %0, -1, %0" : "=v"(l)); return l; }

#define XB_TMO      128
#define XB_XCNT(j)  (256  + 64 * (j))
#define XB_XSUB(j)  (1280 + 64 * (j))
#define XB_XGEN(j)  (2304 + 64 * (j))
#define XB_TOP      3328
#define XB_TOPGEN   3392
#define XCD_BAR_WORDS 3456
#define XB_SPIN_CAP (1u << 18)

__device__ __forceinline__ unsigned xb_ld(unsigned* p)              { return __hip_atomic_load(p, __ATOMIC_RELAXED, __HIP_MEMORY_SCOPE_AGENT); }
__device__ __forceinline__ unsigned xb_add(unsigned* p, unsigned v) { return __hip_atomic_fetch_add(p, v, __ATOMIC_RELAXED, __HIP_MEMORY_SCOPE_AGENT); }
__device__ __forceinline__ unsigned xb_xcc_id() { return (unsigned)__builtin_amdgcn_s_getreg((3 << 11) | 20) & 0xFu; }
#define XB_SPIN(cond, bar) do { unsigned _sp = 0; while (cond) { __builtin_amdgcn_s_sleep(1); \
    if ((++_sp & 255u) == 0u) { if (xb_ld(&(bar)[XB_TMO])) break; if (_sp > XB_SPIN_CAP) { atomicAdd(&(bar)[XB_TMO], 1u); break; } } } } while (0)

struct XcdBarrier {
    unsigned* bar; unsigned x;
    volatile LAS unsigned* st;
};
__device__ __forceinline__ XcdBarrier xcd_barrier_post(unsigned* bar, volatile LAS unsigned* st, int wave0) {
    XcdBarrier b; b.bar = bar; b.x = xb_xcc_id(); b.st = st;
    if (wave0 == 0 && lane_id() == 0) (void)xb_add(&bar[XB_XCNT(b.x)], 1u);
    return b;
}
__device__ __forceinline__ void xcd_barrier_complete(unsigned* bar, unsigned x, unsigned& nloc, unsigned& nx) {
    const unsigned G = gridDim.x * gridDim.y * gridDim.z;
    unsigned sum, cnt, mine, sp = 0u;
    for (;;) {
        sum = 0u; cnt = 0u; mine = 0u;
#pragma unroll
        for (unsigned j = 0; j < 16; ++j) { const unsigned c = xb_ld(&bar[XB_XCNT(j)]); sum += c; cnt += (c > 0u) ? 1u : 0u; mine = (j == x) ? c : mine; }
        if (sum == G) break;
        __builtin_amdgcn_s_sleep(1);
        if ((++sp & 255u) == 0u) { if (xb_ld(&bar[XB_TMO])) break; if (sp > XB_SPIN_CAP) { atomicAdd(&bar[XB_TMO], 1u); break; } }
    }
    nloc = mine > 0u ? mine : 1u; nx = cnt > 0u ? cnt : 1u;
}
__device__ __forceinline__ void xcd_barrier(const XcdBarrier& b, int wave0) {
    asm volatile("s_waitcnt vmcnt(0)" ::: "memory");
    __syncthreads();
    if (wave0 == 0 && lane_id() == 0) {
        unsigned* bar = b.bar;
        __builtin_amdgcn_s_waitcnt(0);
        unsigned nloc = b.st[0], nx = b.st[1];
        if (nloc == 0u) { xcd_barrier_complete(bar, b.x, nloc, nx); b.st[0] = nloc; b.st[1] = nx; }
        const unsigned old = xb_add(&bar[XB_XSUB(b.x)], 1u);
        const unsigned gen = old / nloc;
        if (old + 1u == (gen + 1u) * nloc) {
            __builtin_amdgcn_fence(__ATOMIC_RELEASE, "agent");
            asm volatile("s_waitcnt vmcnt(0)" ::: "memory");
            const unsigned og = xb_add(&bar[XB_TOP], 1u);
            const unsigned tg = og / nx;
            if (og + 1u == (tg + 1u) * nx) xb_add(&bar[XB_TOPGEN], 1u);
            else XB_SPIN(xb_ld(&bar[XB_TOPGEN]) == tg, bar);
            __builtin_amdgcn_fence(__ATOMIC_ACQUIRE, "agent");
            xb_add(&bar[XB_XGEN(b.x)], 1u);
            asm volatile("s_waitcnt vmcnt(0)" ::: "memory");
        } else {
            XB_SPIN(xb_ld(&bar[XB_XGEN(b.x)]) == gen, bar);
            __builtin_amdgcn_fence(__ATOMIC_ACQUIRE, "agent");
            asm volatile("s_waitcnt vmcnt(0)" ::: "memory");
        }
    }
    __syncthreads();
}

template <int CTRL> __device__ __forceinline__ float dpp_f(float v) { return __int_as_float(__builtin_amdgcn_update_dpp(0, __float_as_int(v), CTRL, 0xf, 0xf, true)); }
template <int CTRL> __device__ __forceinline__ int dpp_i(int v) { return __builtin_amdgcn_update_dpp(0, v, CTRL, 0xf, 0xf, true); }
template <int K> __device__ __forceinline__ float xshfl(float v) {
    static_assert(K == 1 || K == 2 || K == 4 || K == 8, "xshfl: K");
    if constexpr (K == 1) return dpp_f<0xB1>(v);
    else if constexpr (K == 2) return dpp_f<0x4E>(v);
    else if constexpr (K == 4) return dpp_f<0x1B>(dpp_f<0x141>(v));
    else return dpp_f<0x128>(v);
}
__device__ __forceinline__ float xshfl16(float v, int lane) { const auto rr = __builtin_amdgcn_permlane16_swap(__float_as_uint(v), __float_as_uint(v), false, false); return __uint_as_float((lane & 16) ? rr[0] : rr[1]); }
__device__ __forceinline__ float sum8(float v) { v += dpp_f<0xB1>(v); v += dpp_f<0x4E>(v); v += dpp_f<0x141>(v); return v; }
__device__ __forceinline__ float sum16(float v) { v = sum8(v); v += dpp_f<0x140>(v); return v; }
__device__ __forceinline__ float half_sum(float v) { v = sum16(v); const auto rr = __builtin_amdgcn_permlane16_swap(__float_as_uint(v), __float_as_uint(v), false, false); return __uint_as_float(rr[0]) + __uint_as_float(rr[1]); }
__device__ __forceinline__ float wave_sum(float v) {
    v = half_sum(v);
    const auto rr = __builtin_amdgcn_permlane32_swap(__float_as_uint(v), __float_as_uint(v), false, false);
    return __uint_as_float(rr[0]) + __uint_as_float(rr[1]);
}
__device__ __forceinline__ float wave_max(float v) {
    v = fmaxf(v, dpp_f<0xB1>(v)); v = fmaxf(v, dpp_f<0x4E>(v)); v = fmaxf(v, dpp_f<0x141>(v)); v = fmaxf(v, dpp_f<0x140>(v));
    { const auto rr = __builtin_amdgcn_permlane16_swap(__float_as_uint(v), __float_as_uint(v), false, false); v = fmaxf(__uint_as_float(rr[0]), __uint_as_float(rr[1])); }
    const auto rr = __builtin_amdgcn_permlane32_swap(__float_as_uint(v), __float_as_uint(v), false, false);
    return fmaxf(__uint_as_float(rr[0]), __uint_as_float(rr[1]));
}
__device__ __forceinline__ int wave_sum_i(int v) {
    v += dpp_i<0xB1>(v); v += dpp_i<0x4E>(v); v += dpp_i<0x141>(v); v += dpp_i<0x140>(v);
    { const auto rr = __builtin_amdgcn_permlane16_swap((unsigned)v, (unsigned)v, false, false); v = (int)(rr[0] + rr[1]); }
    const auto rr = __builtin_amdgcn_permlane32_swap((unsigned)v, (unsigned)v, false, false);
    return (int)(rr[0] + rr[1]);
}
__device__ __forceinline__ float xshfl32(float v, int hi) { const auto rr = __builtin_amdgcn_permlane32_swap(__float_as_uint(v), __float_as_uint(v), false, false); return __uint_as_float(hi ? rr[0] : rr[1]); }
constexpr float NEPS = 1e-6f;
template <int HW, int ROPE>
__device__ __forceinline__ unsigned head_norm_rope(unsigned w, const float* g, const float* cs0, const float* sn0, const float* cs1, const float* sn1, int lane) {
    const int j = (HW == 64) ? (lane & 31) : lane;
    float a = bflo(w), b = bfhi(w);
    float ss = a * a + b * b;
    ss = (HW == 64) ? half_sum(ss) : wave_sum(ss);
    const float rstd = __builtin_amdgcn_rsqf(ss * (1.f / HW) + NEPS);
    const f32x2 gg = *(const f32x2*)(g + 2 * j);
    a = a * rstd * gg.x; b = b * rstd * gg.y;
    if (ROPE == 1) {
        constexpr int HALF_ = HW / 2;
        const float pa = (HALF_ / 2 == 32) ? xshfl32(a, lane >> 5) : xshfl16(a, lane), pb = (HALF_ / 2 == 32) ? xshfl32(b, lane >> 5) : xshfl16(b, lane);
        const int e = 2 * j, f = e % HALF_; const bool first = e < HALF_;
        const f32x2 c = *(const f32x2*)(cs0 + f), s = *(const f32x2*)(sn0 + f);
        a = first ? (a * c.x - pa * s.x) : (a * c.x + pa * s.x);
        b = first ? (b * c.y - pb * s.y) : (b * c.y + pb * s.y);
    } else if (ROPE == 2) {
        const float pa = xshfl<8>(a), pb = xshfl<8>(b);
        const int e = (2 * j) & 31, f = e & 15; const bool first = e < 16; const bool blk1 = (2 * j) >= 32;
        const float* ct = blk1 ? cs1 : cs0; const float* st = blk1 ? sn1 : sn0;
        const f32x2 c = *(const f32x2*)(ct + f), s = *(const f32x2*)(st + f);
        a = first ? (a * c.x - pa * s.x) : (a * c.x + pa * s.x);
        b = first ? (b * c.y - pb * s.y) : (b * c.y + pb * s.y);
    }
    return pk2(a, b);
}
__device__ __forceinline__ unsigned mla_head(float a, float b, const float* g, const float* cs, const float* sn, int lane) {
    const float ss = wave_sum(a * a + b * b);
    const float rstd = __builtin_amdgcn_rsqf(ss * (1.f / 96.f) + NEPS);
    const int jj = lane < 48 ? lane : 0;
    const f32x2 gg = *(const f32x2*)(g + 2 * jj);
    a = a * rstd * gg.x; b = b * rstd * gg.y;
    const float pa = xshfl<8>(a), pb = xshfl<8>(b);
    if (lane >= 32 && lane < 48) {
        const int e = 2 * lane - 64, f = e & 15; const bool first = e < 16;
        const f32x2 c = *(const f32x2*)(cs + f), s = *(const f32x2*)(sn + f);
        a = first ? (a * c.x - pa * s.x) : (a * c.x + pa * s.x);
        b = first ? (b * c.y - pb * s.y) : (b * c.y + pb * s.y);
    }
    return pk2(a, b);
}

template <int HW, int ROPE>
__device__ __forceinline__ unsigned head_apply(unsigned w, f32x2 g2, f32x2 c2, f32x2 s2, int lane) {
    const int j = (HW == 64) ? (lane & 31) : lane;
    float a = bflo(w), b = bfhi(w);
    float ss = a * a + b * b;
    ss = (HW == 64) ? half_sum(ss) : wave_sum(ss);
    const float rstd = __builtin_amdgcn_rsqf(ss * (1.f / HW) + NEPS);
    a = a * rstd * g2.x; b = b * rstd * g2.y;
    if (ROPE == 1) {
        constexpr int HALF_ = HW / 2;
        const float pa = (HALF_ / 2 == 32) ? xshfl32(a, lane >> 5) : xshfl16(a, lane), pb = (HALF_ / 2 == 32) ? xshfl32(b, lane >> 5) : xshfl16(b, lane);
        const bool first = 2 * j < HALF_;
        a = first ? (a * c2.x - pa * s2.x) : (a * c2.x + pa * s2.x);
        b = first ? (b * c2.y - pb * s2.y) : (b * c2.y + pb * s2.y);
    } else if (ROPE == 2) {
        const float pa = xshfl<8>(a), pb = xshfl<8>(b);
        const bool first = ((2 * j) & 31) < 16;
        a = first ? (a * c2.x - pa * s2.x) : (a * c2.x + pa * s2.x);
        b = first ? (b * c2.y - pb * s2.y) : (b * c2.y + pb * s2.y);
    }
    return pk2(a, b);
}
__device__ __forceinline__ unsigned mla_apply(float a, float b, f32x2 g2, f32x2 c2, f32x2 s2, int lane) {
    const float ss = wave_sum(a * a + b * b);
    const float rstd = __builtin_amdgcn_rsqf(ss * (1.f / 96.f) + NEPS);
    a = a * rstd * g2.x; b = b * rstd * g2.y;
    const float pa = xshfl<8>(a), pb = xshfl<8>(b);
    if (lane >= 32 && lane < 48) {
        const bool first = (2 * lane - 64) < 16;
        a = first ? (a * c2.x - pa * s2.x) : (a * c2.x + pa * s2.x);
        b = first ? (b * c2.y - pb * s2.y) : (b * c2.y + pb * s2.y);
    }
    return pk2(a, b);
}
constexpr int NWAVES = 8;
constexpr int BATCH = 16, SEQ = 2048, DM = 1024, M = BATCH * SEQ, MEML = 256, MMEM = BATCH * MEML;
constexpr int FF = 3584, NEXP = 8, DEPTH = 2;
constexpr int RAWW = 3328;
constexpr int C_DQ = 0, C_DK = 512, C_DV = 1024, C_QLAT = 1536, C_KVLAT = 1792, C_KROPE = 1920, C_GQ = 2048, C_GK = 2560, C_GV = 2688, C_MEMQ = 2816;
constexpr int C_OA = 0, C_OB = 1536, C_OC = 2048, C_OD = 2816;
constexpr int MLAW = 1792;
enum { I_X = 0, I_MEM, I_NORM_ATTN_G, I_NORM_MEM_G, I_W_IN, I_DQ_G, I_DK_G, I_DLAMBDA, I_DSUBLN_G, I_MLA_QLAT_G, I_MLA_KVLAT_G, I_W_QUP, I_W_KVUP, I_MLA_Q_G, I_MLA_K_G,
       I_GQA_Q_G, I_GQA_K_G, I_W_MEMKV, I_MEM_Q_G, I_MEM_K_G, I_W_BRANCH, I_W_GATE, I_B_GATE, I_W_OUT, I_NORM_FFN_G, I_DW1, I_DW3, I_DW2, I_ROUTER, I_MW1, I_MW3, I_MW2, N_IN };
constexpr size_t MiB = 1u << 20;
constexpr size_t WS_CTL = 0, CTL_ZERO_BYTES = 64 * 1024;
constexpr size_t WS_TAB = 1 * MiB;
constexpr size_t T_DC = 0, T_DS = T_DC + 2048 * 32 * 4, T_MC = T_DS + 2048 * 32 * 4, T_MS = T_MC + 2048 * 16 * 4, T_QC = T_MS + 2048 * 16 * 4, T_QS = T_QC + 2048 * 64 * 4,
                 T_RC = T_QS + 2048 * 64 * 4, T_RS = T_RC + 32 * 16 * 4, T_CC = T_RS + 32 * 16 * 4, T_CS = T_CC + 64 * 16 * 4, T_END = T_CS + 64 * 16 * 4;
static_assert(T_END <= 2 * MiB, "tables");
constexpr size_t WS_MOE = 3 * MiB;
constexpr size_t WS_AW = 4 * MiB;
constexpr size_t AW_IN = 0, AW_GATE = AW_IN + (size_t)RAWW * DM * 2, AW_BR = AW_GATE + (size_t)4096 * DM * 2, AW_OUT = AW_BR + (size_t)4096 * 512 * 2,
                 AW_QUP = AW_OUT + (size_t)DM * DM * 2, AW_KVUP = AW_QUP + (size_t)768 * 256 * 2, AW_MEMKV = AW_KVUP + (size_t)1024 * 256 * 2, AW_END = AW_MEMKV + (size_t)DM * DM * 2;
static_assert(AW_END <= 32 * MiB, "attention weights");
constexpr size_t WS_HB = 36 * MiB;
constexpr size_t WS_RAW = 100 * MiB;
constexpr size_t WS_G = 308 * MiB;
constexpr size_t WS_MLARAW = 308 * MiB, WS_KMLA = 420 * MiB, WS_ODIFF = 468 * MiB, WS_LATN = 468 * MiB, WS_MEMKV = 532 * MiB, WS_MEMN = 540 * MiB;
constexpr size_t WS_FW = 100 * MiB;
constexpr size_t WS_U = 268 * MiB;
constexpr size_t WS_Y = 380 * MiB;
constexpr size_t WS_XS8 = 184 * MiB;
constexpr size_t WS_XB = 36 * MiB;
constexpr size_t WS_HBM8 = 512 * MiB, WS_TAILP = 544 * MiB;
constexpr size_t WS_HBA = 436 * MiB;
constexpr size_t WS_HBF = 121 * MiB;
constexpr size_t WS_MERGED = 436 * MiB;
constexpr size_t WS_HB8 = 564 * MiB;
constexpr size_t WS_END = 600 * MiB;
constexpr int CW_BAR = 4096;
constexpr int MOE_SLOTS = 2 * M + NEXP * 256;
constexpr size_t MO_SLOT_TOK = 0, MO_TOK_SLOT = 278528, MO_TOK_GATE = MO_TOK_SLOT + (size_t)M * 8, MO_WGCNT = MO_TOK_GATE + (size_t)M * 8, MO_END = MO_WGCNT + 256 * 8 * 4;
static_assert((size_t)MOE_SLOTS * 4 <= MO_TOK_SLOT && MO_END <= 1 * MiB, "MoE lists");
constexpr size_t EXPERT_BYTES = (size_t)3 * FF * DM, W2_OFF = (size_t)2 * FF * DM;
constexpr int MOE_CHUNK_TILES = 128;
constexpr float S_H8 = 16.f, S_W13 = 32.f, S_U8 = 4.f, S_W2 = 64.f, S_WG = 32.f;
constexpr int RING_OFF = 0, RING_BYTES = 131072;
constexpr int LDSCTL_OFF = RING_BYTES, MISC_OFF = LDSCTL_OFF + 320, PTAB_OFF = LDSCTL_OFF + 1024, MOE_LDS = LDSCTL_OFF + 2048;
constexpr int ML_SEL = 0, ML_RNK = 256, ML_CNT = 512, ML_TOT = 520, ML_PRE = 528, ML_SEGB = 536, ML_TE = 576;
constexpr int LDS_BYTES = 147456;
static_assert(att::LDS_BYTES <= RING_BYTES, "attention LDS");

struct Args { const float* in[N_IN]; float* out; unsigned char* ws; };
__device__ __forceinline__ unsigned char* launder(unsigned char* p) { GAS unsigned char* q = (GAS unsigned char*)p; asm volatile("" : "+s"(q)); return (unsigned char*)q; }
__device__ __forceinline__ const float* inp(LAS unsigned char* lds, int i) {
    const volatile LAS unsigned* p = (const volatile LAS unsigned*)(lds + PTAB_OFF) + 2 * i;
    const unsigned lo = __builtin_amdgcn_readfirstlane(p[0]), hi = __builtin_amdgcn_readfirstlane(p[1]);
    const GAS float* q = (const GAS float*)(((unsigned long long)hi << 32) | lo); asm volatile("" : "+s"(q)); return (const float*)q;
}
#define IN(i) inp(lds, (i))

__device__ __forceinline__ void transpose_item(const float* W, int ldw, int k0, int n0, bf16* WT, int ldk, int drow0, LAS float* scr, int lane) {
    f32x4 v[8];
#pragma unroll
    for (int i = 0; i < 8; ++i) v[i] = *(const GAS f32x4*)(W + (size_t)(k0 + 8 * i + (lane >> 3)) * ldw + n0 + 4 * (lane & 7));
#pragma unroll
    for (int i = 0; i < 8; ++i) { LAS float* d = scr + (8 * i + (lane >> 3)) * 33 + 4 * (lane & 7); d[0] = v[i].x; d[1] = v[i].y; d[2] = v[i].z; d[3] = v[i].w; }
    LDS_WAIT(); asm volatile("" ::: "memory");
    const int c = lane & 7;
#pragma unroll
    for (int j = 0; j < 4; ++j) { const int n = (lane >> 3) + 8 * j; const LAS float* s = scr + (8 * c) * 33 + n;
        v4u o; o.x = pk2(s[0 * 33], s[1 * 33]); o.y = pk2(s[2 * 33], s[3 * 33]); o.z = pk2(s[4 * 33], s[5 * 33]); o.w = pk2(s[6 * 33], s[7 * 33]);
        *(GAS v4u*)(WT + (size_t)(drow0 + n) * ldk + k0 + 8 * c) = o; }
    LDS_WAIT(); asm volatile("" ::: "memory");
}
__device__ __forceinline__ void plain_item(int r, const float* W, int K, int N, bf16* WT, int ldk, int drow_shift, LAS float* scr, int lane) {
    const int nbn = N / 32, kb = r / nbn, nb = r % nbn; transpose_item(W, N, 64 * kb, 32 * nb, WT, ldk, 32 * nb + drow_shift, scr, lane);
}
constexpr int FFN_ITEMS_13 = (DM / 64) * (FF / 32), FFN_ITEMS_2 = (FF / 64) * (DM / 32), FFN_ITEMS = 2 * FFN_ITEMS_13 + FFN_ITEMS_2;
__device__ __forceinline__ void ffn_weight_item(int it, const float* w1, const float* w3, const float* w2, bf16* W13t, bf16* W2t, LAS float* scr, int lane) {
    if (it < 2 * FFN_ITEMS_13) { const int which = it / FFN_ITEMS_13, r = it % FFN_ITEMS_13, kb = r / (FF / 32), nb = r % (FF / 32);
        transpose_item(which ? w3 : w1, FF, 64 * kb, 32 * nb, W13t, DM, (nb >> 2) * 256 + (nb & 3) * 32 + which * 128, scr, lane); }
    else { const int r = it - 2 * FFN_ITEMS_13, kb = r / (DM / 32), nb = r % (DM / 32); transpose_item(w2, DM, 64 * kb, 32 * nb, W2t, FF, 32 * nb, scr, lane); }
}
__device__ __forceinline__ void transpose_item8(const float* W, int ldw, int k0, int n0, unsigned char* WT, int ldk, int drow0, float scale, LAS float* scr, int lane) {
    f32x4 v[8];
#pragma unroll
    for (int i = 0; i < 8; ++i) v[i] = *(const GAS f32x4*)(W + (size_t)(k0 + 8 * i + (lane >> 3)) * ldw + n0 + 4 * (lane & 7));
#pragma unroll
    for (int i = 0; i < 8; ++i) { LAS float* d = scr + (8 * i + (lane >> 3)) * 33 + 4 * (lane & 7); d[0] = v[i].x * scale; d[1] = v[i].y * scale; d[2] = v[i].z * scale; d[3] = v[i].w * scale; }
    LDS_WAIT(); asm volatile("" ::: "memory");
    const int c = lane & 7;
#pragma unroll
    for (int j = 0; j < 4; ++j) { const int n = (lane >> 3) + 8 * j; const LAS float* s = scr + (8 * c) * 33 + n;
        v2u o; o.x = pg8::cvt4_fp8(s[0 * 33], s[1 * 33], s[2 * 33], s[3 * 33]); o.y = pg8::cvt4_fp8(s[4 * 33], s[5 * 33], s[6 * 33], s[7 * 33]);
        *(GAS v2u*)(WT + (size_t)(drow0 + n) * ldk + k0 + 8 * c) = o; }
    LDS_WAIT(); asm volatile("" ::: "memory");
}
__device__ __forceinline__ void ffn_weight_item8(int it, const float* w1, const float* w3, const float* w2, unsigned char* W13t, unsigned char* W2t, LAS float* scr, int lane) {
    if (it < 2 * FFN_ITEMS_13) { const int which = it / FFN_ITEMS_13, r = it % FFN_ITEMS_13, kb = r / (FF / 32), nb = r % (FF / 32);
        transpose_item8(which ? w3 : w1, FF, 64 * kb, 32 * nb, W13t, DM, (nb >> 2) * 256 + (nb & 3) * 32 + which * 128, S_W13, scr, lane); }
    else { const int r = it - 2 * FFN_ITEMS_13, kb = r / (DM / 32), nb = r % (DM / 32); transpose_item8(w2, DM, 64 * kb, 32 * nb, W2t, FF, 32 * nb, S_W2, scr, lane); }
}
constexpr int AI_IN = 16 * 101, AI_GATE = 4 * 16 * 32, AI_BR = 4 * 8 * 32, AI_OUT = 16 * 32, AI_QUP = 4 * 24, AI_KVUP = 2 * 32, AI_MEMKV = 16 * 32;
constexpr int AI_TOTAL = AI_IN + AI_GATE + AI_BR + AI_OUT + AI_QUP + AI_KVUP + AI_MEMKV;
__device__ __forceinline__ void attn_weight_item(int it, int l, LAS unsigned char* lds, unsigned char* aw, LAS float* scr, int lane) {
    int r = it;
    if (r < AI_IN) { const int kb = r / 101, nb = r % 101;
        transpose_item(IN(I_W_IN) + (size_t)l * DM * 3232, 3232, 64 * kb, 32 * nb, (bf16*)(aw + AW_IN), DM, 32 * nb + (nb >= 61 ? 96 : 0), scr, lane); return; } r -= AI_IN;
    if (r < AI_GATE) { const int b = r / 512, rr = r % 512, kb = rr / 32, nb = rr % 32;
        transpose_item8(IN(I_W_GATE) + ((size_t)l * 4 + b) * DM * DM, DM, 64 * kb, 32 * nb, aw + AW_GATE, DM, 32 * nb + b * 1024, S_WG, scr, lane); return; } r -= AI_GATE;
    if (r < AI_BR) { const int b = r / 256; plain_item(r % 256, IN(I_W_BRANCH) + ((size_t)l * 4 + b) * 512 * DM, 512, DM, (bf16*)(aw + AW_BR), 512, b * 1024, scr, lane); return; } r -= AI_BR;
    if (r < AI_OUT) { plain_item(r, IN(I_W_OUT) + (size_t)l * DM * DM, DM, DM, (bf16*)(aw + AW_OUT), DM, 0, scr, lane); return; } r -= AI_OUT;
    if (r < AI_QUP) { plain_item(r, IN(I_W_QUP) + (size_t)l * 256 * 768, 256, 768, (bf16*)(aw + AW_QUP), 256, 0, scr, lane); return; } r -= AI_QUP;
    if (r < AI_KVUP) { plain_item(r, IN(I_W_KVUP) + (size_t)l * 128 * 1024, 128, 1024, (bf16*)(aw + AW_KVUP), 256, 0, scr, lane); return; } r -= AI_KVUP;
    plain_item(r, IN(I_W_MEMKV) + (size_t)l * DM * DM, DM, DM, (bf16*)(aw + AW_MEMKV), DM, 0, scr, lane);
}
template <bool IN_BF> __device__ __forceinline__ f32x4 rr_load(const float* X, int m, int lane, int j) {
    if constexpr (IN_BF) { const v2u w = ((const GAS v2u*)((const bf16*)X + (size_t)m * DM) + lane)[64 * j]; return (f32x4){bflo(w.x), bfhi(w.x), bflo(w.y), bfhi(w.y)}; }
    else return ((const GAS f32x4*)(X + (size_t)m * DM) + lane)[64 * j];
}
template <bool F8COPY = false, bool BF = true, bool IN_BF = false>
__device__ __forceinline__ void rms_rows_to_bf16(const float* X, const float* g, bf16* O, int nrows, int gw, int NGW, int lane, unsigned char* O8 = nullptr, float s8 = 1.0f) {
    f32x4 gg[4];
#pragma unroll
    for (int j = 0; j < 4; ++j) gg[j] = ((const GAS f32x4*)g + lane)[64 * j];
    if (gw >= nrows) return;
    f32x4 cur[4], nxt[4];
#pragma unroll
    for (int j = 0; j < 4; ++j) { cur[j] = rr_load<IN_BF>(X, gw, lane, j); nxt[j] = cur[j]; }
    for (int m = gw; m < nrows; m += NGW) {
        const int mn = m + NGW;
        if (mn < nrows) {
#pragma unroll
            for (int j = 0; j < 4; ++j) nxt[j] = rr_load<IN_BF>(X, mn, lane, j);
        }
        float s = 0.f;
#pragma unroll
        for (int j = 0; j < 4; ++j) s += (cur[j].x * cur[j].x + cur[j].y * cur[j].y) + (cur[j].z * cur[j].z + cur[j].w * cur[j].w);
        const float rstd = __builtin_amdgcn_rsqf(wave_sum(s) * (1.f / DM) + NEPS);
        GAS unsigned long long* o8 = (GAS unsigned long long*)(O + (size_t)m * DM) + lane;
#pragma unroll
        for (int j = 0; j < 4; ++j) o8[64 * j] = (unsigned long long)pk2(cur[j].x * rstd * gg[j].x, cur[j].y * rstd * gg[j].y) | ((unsigned long long)pk2(cur[j].z * rstd * gg[j].z, cur[j].w * rstd * gg[j].w) << 32);
        if constexpr (F8COPY) { GAS unsigned* o4 = (GAS unsigned*)(O8 + (size_t)m * DM) + lane; const float r8 = rstd * s8;
#pragma unroll
            for (int j = 0; j < 4; ++j) o4[64 * j] = pg8::cvt4_fp8(cur[j].x * r8 * gg[j].x, cur[j].y * r8 * gg[j].y, cur[j].z * r8 * gg[j].z, cur[j].w * r8 * gg[j].w); }
#pragma unroll
        for (int j = 0; j < 4; ++j) cur[j] = nxt[j];
    }
}
__device__ __forceinline__ void rope_entry(int pos, int i, int dim, float* c, float* s) {
    const float e = (float)(2 * i) / (float)dim;
    const float inv = 1.0f / powf(10000.0f, e);
    const float ang = (float)pos * inv;
    const double ad = (double)ang, k = rint(ad * 0.15915494309189535), r = ad - k * 6.283185307179586;
    const float rf = (float)r;
    *c = cosf(rf); *s = sinf(rf);
}

struct UpOrder : pg8::StaticOrder {
    const bf16* wq; const bf16* wkv;
    __device__ __forceinline__ const char* a_ptr(const pg8::Gemm& g, const pg8::Unit& u) const { return (const char*)g.A + (size_t)u.pm * (256 * 2) * g.lda + (u.pn >= 3 ? 512 : 0); }
    __device__ __forceinline__ const char* b_ptr(const pg8::Gemm& g, const pg8::Unit& u) const { return u.pn >= 3 ? (const char*)wkv + (size_t)(u.pn - 3) * 256 * 256 * 2 : (const char*)wq + (size_t)u.pn * 256 * 256 * 2; }
};
struct MergeOrder : pg8::StaticOrder {
    __device__ __forceinline__ bool next(int i, pg8::Unit& u) const { if (!tile((long)(i >> 2) * G + c, u)) return false; u.z = i & 3; return true; }
    __device__ __forceinline__ const char* a_ptr(const pg8::Gemm& g, const pg8::Unit& u) const {
        const int co = u.z == 0 ? C_OA : u.z == 1 ? C_OB : u.z == 2 ? C_OC : C_OD; return (const char*)g.A + (size_t)u.pm * (256 * 2) * g.lda + co * 2; }
    __device__ __forceinline__ const char* b_ptr(const pg8::Gemm& g, const pg8::Unit& u) const { return (const char*)g.Bt + (size_t)(u.z * 1024 + u.pn * 256) * g.ldb * 2; }
};
struct MoeUpOrder : pg8::StaticOrder {
    const int* slot_tok; int tile0; const volatile LAS int* te; const char* wbase;
    __device__ __forceinline__ const char* a_ptr(const pg8::Gemm& g, const pg8::Unit&) const { return (const char*)g.A; }
    __device__ __forceinline__ const char* b_ptr(const pg8::Gemm& g, const pg8::Unit& u) const { const int e = __builtin_amdgcn_readfirstlane(te[tile0 + u.pm]); return wbase + (size_t)e * EXPERT_BYTES + (size_t)u.pn * (256 * 2) * g.ldb; }
    __device__ __forceinline__ unsigned row_off(const pg8::Gemm& g, const pg8::Unit& u, int row) const { return (unsigned)slot_tok[(tile0 + u.pm) * 256 + row] * (unsigned)(g.lda * 2); }
};
struct MoeDownOrder : pg8::StaticOrder {
    int tile0; const volatile LAS int* te; const char* wbase;
    __device__ __forceinline__ const char* b_ptr(const pg8::Gemm& g, const pg8::Unit& u) const { const int e = __builtin_amdgcn_readfirstlane(te[tile0 + u.pm]); return wbase + (size_t)e * EXPERT_BYTES + (size_t)u.pn * (256 * 2) * g.ldb; }
};
__device__ __forceinline__ float wave_max_abs(const float* g, int n, int lane) {
    float v = lane < n ? fabsf(g[lane]) : 0.f; if (lane + 64 < n) v = fmaxf(v, fabsf(g[lane + 64]));
    return wave_max(v);
}
__device__ __forceinline__ v2u tail_row(const float* P, int rows, int r, int q, float sc) {
    f32x4 s = *((const GAS f32x4*)(P + (size_t)r * DM) + q);
#pragma unroll
    for (int z = 1; z < 7; ++z) s += *((const GAS f32x4*)(P + ((size_t)z * rows + r) * DM) + q);
    v2u o; o.x = pk2(s.x * sc, s.y * sc); o.y = pk2(s.z * sc, s.w * sc); return o;
}
struct TailDownOrder : pg8::StaticOrder {
    const volatile LAS int* te; const char* wbase;
    __device__ __forceinline__ bool next(int i, pg8::Unit& u) const { const int L = i * G + c; if (L >= nwg * 7) return false; u.z = L % 7; const int t = L / 7; u.pn = __builtin_amdgcn_readfirstlane(t % nN); u.pm = __builtin_amdgcn_readfirstlane(t / nN); return true; }
    __device__ __forceinline__ const char* a_ptr(const pg8::Gemm& g, const pg8::Unit& u) const { return (const char*)g.A + (size_t)u.pm * (256 * 2) * g.lda + (size_t)u.z * 512; }
    __device__ __forceinline__ const char* b_ptr(const pg8::Gemm& g, const pg8::Unit& u) const { const int e = __builtin_amdgcn_readfirstlane(te[256 + u.pm]); return wbase + (size_t)e * EXPERT_BYTES + (size_t)u.pn * (256 * 2) * g.ldb + (size_t)u.z * 512; }
};
struct EpiPartF32 {
    static constexpr bool PERM = false;
    float* P; int rows;
    __device__ __forceinline__ bool keep(const pg8::Unit&) const { return false; }
    __device__ __forceinline__ void operator()(const pg8::f32x4 (&acc)[2][2][4][2], const pg8::Unit& u, int wr, int wc, int fr, int fq) const {
        const int row0 = u.pm * 256 + wr * 64 + fr, col0 = u.pn * 256 + wc * 32 + 4 * fq;
        GAS float* pb = (GAS float*)(P + ((size_t)u.z * rows + row0) * DM + col0);
#pragma unroll
        for (int ai = 0; ai < 2; ++ai)
#pragma unroll
            for (int m = 0; m < 4; ++m)
#pragma unroll
                for (int bj = 0; bj < 2; ++bj)
#pragma unroll
                    for (int n = 0; n < 2; ++n) __builtin_nontemporal_store(acc[ai][bj][m][n], (GAS pg8::f32x4*)(pb + (size_t)(ai * 128 + m * 16) * DM + bj * 128 + n * 16));
    }
};
struct EpiMerge {
    static constexpr bool PERM = true;
    const unsigned char* Gq;
    bf16* Mg;
    __device__ __forceinline__ bool keep(const pg8::Unit& u) const { return u.z < 3; }
    __device__ __forceinline__ void operator()(pg8::f32x4 (&acc)[2][2][4][2], const pg8::Unit& u, int wr, int wc, int fr, int fq) const {
        const int row0 = u.pm * 256 + wr * 64 + fr, col0 = u.pn * 256 + wc * 32 + 8 * fq, z = u.z;
#pragma unroll
        for (int ai = 0; ai < 2; ++ai)
#pragma unroll
            for (int mp = 0; mp < 2; ++mp) {
                const GAS unsigned char* gb = (const GAS unsigned char*)(Gq + ((size_t)(u.pm * 16 + u.pn) << 16) + ((wr * 4 + wc) << 13) + (fq * 16 + fr) * 8);
                asm volatile("" : "+v"(gb));
                v2u gn[2][2], gd[2][2];
#pragma unroll
                for (int mm = 0; mm < 2; ++mm)
#pragma unroll
                    for (int bj = 0; bj < 2; ++bj) { const int m = 2 * mp + mm; const GAS unsigned char* gp = gb + (((ai * 4 + m) * 2 + bj) << 9);
                        gn[mm][bj] = *(const GAS v2u*)(gp + ((size_t)(z * 4) << 16)); if (z < 3) gd[mm][bj] = *(const GAS v2u*)(gp + ((size_t)(z * 4 + 4) << 16)); }
#pragma unroll
                for (int mm = 0; mm < 2; ++mm)
#pragma unroll
                    for (int bj = 0; bj < 2; ++bj) { const int m = 2 * mp + mm; const v2u g = gn[mm][bj];
                        float f[8];
#pragma unroll
                        for (int e = 0; e < 8; ++e) f[e] = (float)(((e < 4 ? g.x : g.y) >> (8 * (e & 3))) & 0xffu);
                        if (z < 3) { const v2u d = gd[mm][bj];
#pragma unroll
                            for (int e = 0; e < 8; ++e) f[e] *= __builtin_amdgcn_rcpf((float)(((e < 4 ? d.x : d.y) >> (8 * (e & 3))) & 0xffu)); }
                        else {
#pragma unroll
                            for (int e = 0; e < 8; ++e) f[e] *= (1.0f / 255.0f); }
                        pg8::f32x4& v0 = acc[ai][bj][m][0]; pg8::f32x4& v1 = acc[ai][bj][m][1];
                        v0[0] *= f[0]; v0[1] *= f[1]; v0[2] *= f[2]; v0[3] *= f[3]; v1[0] *= f[4]; v1[1] *= f[5]; v1[2] *= f[6]; v1[3] *= f[7];
                        if (z == 3) { v4u w; w.x = pg8::cvt_pk_bf16(v0[0], v0[1]); w.y = pg8::cvt_pk_bf16(v0[2], v0[3]); w.z = pg8::cvt_pk_bf16(v1[0], v1[1]); w.w = pg8::cvt_pk_bf16(v1[2], v1[3]);
                            __builtin_nontemporal_store(w, (GAS v4u*)(Mg + (size_t)(row0 + ai * 128 + m * 16) * 1024 + col0 + bj * 128)); } }
                asm volatile("" ::: "memory");
            }
    }
};

__global__ void __launch_bounds__(NWAVES * 64, 2) fwd(Args args) {
    extern __shared__ __attribute__((aligned(16))) unsigned char lds_raw[];
    LAS unsigned char* lds = (LAS unsigned char*)lds_raw;
    volatile LAS unsigned* MISC = (volatile LAS unsigned*)(lds + MISC_OFF);
    const int tid = threadIdx.x; const int wave0 = __builtin_amdgcn_readfirstlane(tid >> 6);
    constexpr int G = 256; const int bx = blockIdx.x; const int vcu = (bx % 8) * (G / 8) + bx / 8;
    unsigned char* ws = args.ws;
    gu32* ctl = (gu32*)(ws + WS_CTL);
    for (int u = tid; u < (LDS_BYTES - LDSCTL_OFF) / 4; u += NWAVES * 64) ((LAS unsigned*)(lds + LDSCTL_OFF))[u] = 0u;
    __syncthreads();
    XcdBarrier bar = xcd_barrier_post((unsigned*)(ctl + CW_BAR), MISC + 8, wave0);
    float* out = args.out;
    if (tid < N_IN) ((LAS unsigned long long*)(lds + PTAB_OFF))[tid] = (unsigned long long)args.in[tid];
    __syncthreads();
#define PHASE_PTRS unsigned char* wsp = launder(ws); int lane = lane_id(); asm volatile("" : "+v"(lane)); int wave = wave0; asm volatile("" : "+s"(wave)); \
    const int gw = vcu * NWAVES + wave, NGW = G * NWAVES; const int gt = gw * 64 + lane, NGT = NGW * 64; LAS float* scr = (LAS float*)(lds + RING_OFF + wave * 16384); \
    (void)gw; (void)NGW; (void)gt; (void)NGT; (void)scr; \
    bf16* HB = (bf16*)(wsp + WS_HB); bf16* RAW = (bf16*)(wsp + WS_RAW); bf16* GT = (bf16*)(wsp + WS_G); \
    bf16* MLARAW = (bf16*)(wsp + WS_MLARAW); bf16* KMLA = (bf16*)(wsp + WS_KMLA); bf16* ODIFF = (bf16*)(wsp + WS_ODIFF); bf16* LATN = (bf16*)(wsp + WS_LATN); \
    bf16* MEMKV = (bf16*)(wsp + WS_MEMKV); bf16* MEMN = (bf16*)(wsp + WS_MEMN); \
    bf16* W13t = (bf16*)(wsp + WS_FW); bf16* W2t = W13t + (size_t)2 * FF * DM; bf16* U = (bf16*)(wsp + WS_U); \
    unsigned char* aw = wsp + WS_AW; const float* tab = (const float*)(wsp + WS_TAB); \
    (void)HB; (void)RAW; (void)GT; (void)MLARAW; (void)KMLA; (void)ODIFF; (void)LATN; (void)MEMKV; (void)MEMN; (void)W13t; (void)W2t; (void)U; (void)aw; (void)tab

#pragma unroll 1
    for (int l = 0; l < DEPTH; ++l) {
        const float lambda_init = (l == 0) ? 0.2f : (0.8f - 0.6f * 0.74081822068171788f);
        {
            PHASE_PTRS;
            for (int it = gw; it < AI_TOTAL; it += NGW) attn_weight_item(it, l, lds, aw, scr, lane);
            unsigned zz_ = 0u; asm volatile("" : "+v"(zz_)); const v4u zero4 = {zz_, zz_, zz_, zz_};
            for (int c = gt; c < 96 * 128; c += NGT) *(GAS v4u*)(aw + AW_IN + (size_t)1952 * DM * 2 + (size_t)c * 16) = zero4;
            for (int c = gt; c < 1024 * 16; c += NGT) *(GAS v4u*)(aw + AW_KVUP + (size_t)(c >> 4) * 512 + 256 + (c & 15) * 16) = zero4;
            if (l == 0) rms_rows_to_bf16<true>(IN(I_X), IN(I_NORM_ATTN_G), (bf16*)(wsp + WS_HBA), M, gw, NGW, lane, wsp + WS_HB8, S_H8);
            else rms_rows_to_bf16<true, true, true>((const float*)(wsp + WS_XB), IN(I_NORM_ATTN_G) + DM, (bf16*)(wsp + WS_HBA), M, gw, NGW, lane, wsp + WS_HB8, S_H8);
            rms_rows_to_bf16(IN(I_MEM), IN(I_NORM_MEM_G) + l * DM, MEMN, MMEM, gw, NGW, lane);
            if (l == 0) {
                float* tw = (float*)(wsp + WS_TAB);
                for (int e = gt; e < 2048 * 32; e += NGT) rope_entry(e >> 5, e & 31, 64, tw + T_DC / 4 + e, tw + T_DS / 4 + e);
                for (int e = gt; e < 2048 * 16; e += NGT) rope_entry(e >> 4, e & 15, 32, tw + T_MC / 4 + e, tw + T_MS / 4 + e);
                for (int e = gt; e < 2048 * 64; e += NGT) rope_entry(e >> 6, e & 63, 128, tw + T_QC / 4 + e, tw + T_QS / 4 + e);
                for (int e = gt; e < 32 * 16; e += NGT) rope_entry(e >> 4, e & 15, 32, tw + T_RC / 4 + e, tw + T_RS / 4 + e);
                for (int e = gt; e < 64 * 16; e += NGT) rope_entry(e >> 4, e & 15, 32, tw + T_CC / 4 + e, tw + T_CS / 4 + e);
            }
        }
        xcd_barrier(bar, wave0);
        {
            PHASE_PTRS;
            pg8::Gemm g{(const bf16*)(wsp + WS_HBA), (const bf16*)(aw + AW_IN), DM, DM, DM}; pg8::StaticOrder S; S.init(M / 256, RAWW / 256, G, bx);
            pg8::EpiBf16 E{RAW, RAWW};
            pg8::gemm_phase<pg8::EpiBf16, pg8::StaticOrder, true, false>(lds + RING_OFF, g, S, E, wave0);
            pg8::Gemm g2{MEMN, (const bf16*)(aw + AW_MEMKV), DM, DM, DM}; pg8::StaticOrder S2; S2.init(MMEM / 256, DM / 256, G, (bx + G / 2) % G);
            pg8::EpiBf16 E2{MEMKV, DM};
            pg8::gemm_phase<pg8::EpiBf16, pg8::StaticOrder, true, false>(lds + RING_OFF, g2, S2, E2, wave0);
        }
        xcd_barrier(bar, wave0);
        {
            PHASE_PTRS;
            const int j32 = lane & 31, hh = lane >> 3, j8 = lane & 7;
            const f32x4 gdk0 = *(const GAS f32x4*)(IN(I_DK_G) + l * 64 + 4 * j8), gdk1 = *(const GAS f32x4*)(IN(I_DK_G) + l * 64 + 32 + 4 * j8);
            const f32x2 ggk = *((const f32x2*)(IN(I_GQA_K_G) + l * 64) + j32);
            const f32x2 gmk = *((const f32x2*)(IN(I_MEM_K_G) + l * 128) + lane);
            const f32x2 gql0 = *((const f32x2*)(IN(I_MLA_QLAT_G) + l * 256) + lane), gql1 = *((const f32x2*)(IN(I_MLA_QLAT_G) + l * 256 + 128) + lane), gkl = *((const f32x2*)(IN(I_MLA_KVLAT_G) + l * 128) + lane);
            const int fa = (2 * j32) & 15, fm = (2 * lane) & 63; const bool ablk1 = (2 * j32) >= 32;
#define T1_LOAD(K0_, K1_, W_, DC_, DS_, AC_, AS_, mm) do { const int pos_ = (mm) & (SEQ - 1), grow_ = pos_ >> 6, gcol_ = pos_ & 63; const GAS unsigned* rp_ = (const GAS unsigned*)(RAW + (size_t)(mm) * RAWW) + lane; \
                K0_ = *(const GAS v2u*)(RAW + (size_t)(mm) * RAWW + C_DK + 64 * hh + 4 * j8); K1_ = *(const GAS v2u*)(RAW + (size_t)(mm) * RAWW + C_DK + 64 * hh + 32 + 4 * j8); \
                W_[0] = rp_[64 * 12]; W_[1] = rp_[64 * 13]; W_[2] = rp_[64 * 14]; W_[3] = rp_[64 * 20]; \
                DC_ = *(const GAS f32x4*)(tab + T_DC / 4 + pos_ * 32 + 4 * j8); DS_ = *(const GAS f32x4*)(tab + T_DS / 4 + pos_ * 32 + 4 * j8); \
                AC_ = *(const GAS f32x2*)(tab + (ablk1 ? T_CC / 4 + gcol_ * 16 : T_RC / 4 + grow_ * 16) + fa); AS_ = *(const GAS f32x2*)(tab + (ablk1 ? T_CS / 4 + gcol_ * 16 : T_RS / 4 + grow_ * 16) + fa); } while (0)
            v2u k0, k1, k0n, k1n; unsigned w[4], wn[4]; f32x4 dc, ds, dcn, dsn; f32x2 ac, as, acn, asn;
            T1_LOAD(k0, k1, w, dc, ds, ac, as, gw);
            k0n = k0; k1n = k1; dcn = dc; dsn = ds; acn = ac; asn = as;
#pragma unroll
            for (int c = 0; c < 4; ++c) wn[c] = w[c];
            for (int m = gw; m < M; m += NGW) {
                if (m + NGW < M) { T1_LOAD(k0n, k1n, wn, dcn, dsn, acn, asn, m + NGW); }
                v2u o0, o1;
                { float a[4] = {bflo(k0.x), bfhi(k0.x), bflo(k0.y), bfhi(k0.y)}, b[4] = {bflo(k1.x), bfhi(k1.x), bflo(k1.y), bfhi(k1.y)};
                  float ss = 0.f;
#pragma unroll
                  for (int i = 0; i < 4; ++i) ss += a[i] * a[i] + b[i] * b[i];
                  const float rstd = __builtin_amdgcn_rsqf(sum8(ss) * (1.f / 64.f) + NEPS);
                  float y0[4], y1[4];
#pragma unroll
                  for (int i = 0; i < 4; ++i) { const float p = a[i] * rstd * gdk0[i], q = b[i] * rstd * gdk1[i]; y0[i] = p * dc[i] - q * ds[i]; y1[i] = q * dc[i] + p * ds[i]; }
                  o0.x = pk2(y0[0], y0[1]); o0.y = pk2(y0[2], y0[3]); o1.x = pk2(y1[0], y1[1]); o1.y = pk2(y1[2], y1[3]); }
                const unsigned wg = head_apply<64, 2>(w[3], ggk, ac, as, lane);
                unsigned l0, l1, l2;
                { const float a0 = bflo(w[0]), a1 = bfhi(w[0]), a2 = bflo(w[1]), a3 = bfhi(w[1]);
                  const float rstd = __builtin_amdgcn_rsqf(wave_sum(a0 * a0 + a1 * a1 + a2 * a2 + a3 * a3) * (1.f / 256.f) + NEPS);
                  l0 = pk2(a0 * rstd * gql0.x, a1 * rstd * gql0.y); l1 = pk2(a2 * rstd * gql1.x, a3 * rstd * gql1.y); }
                { const float a0 = bflo(w[2]), a1 = bfhi(w[2]);
                  const float rstd = __builtin_amdgcn_rsqf(wave_sum(a0 * a0 + a1 * a1) * (1.f / 128.f) + NEPS); l2 = pk2(a0 * rstd * gkl.x, a1 * rstd * gkl.y); }
                GAS bf16* kp = (GAS bf16*)(RAW + (size_t)m * RAWW + C_DK + 64 * hh + 4 * j8);
                *(GAS v2u*)kp = o0; *(GAS v2u*)(kp + 32) = o1;
                ((GAS unsigned*)(RAW + (size_t)m * RAWW) + lane)[64 * 20] = wg;
                GAS unsigned* lp = (GAS unsigned*)(LATN + (size_t)m * 512) + lane;
                lp[0] = l0; lp[64] = l1; lp[128] = l2; lp[192] = 0u;
                k0 = k0n; k1 = k1n; dc = dcn; ds = dsn; ac = acn; as = asn;
#pragma unroll
                for (int c = 0; c < 4; ++c) w[c] = wn[c];
            }
#undef T1_LOAD
            for (int m = gw; m < MMEM; m += NGW) {
                const int pos = m & (MEML - 1);
                GAS unsigned* kp = (GAS unsigned*)(MEMKV + (size_t)m * DM) + lane;
                unsigned w[4];
#pragma unroll
                for (int h = 0; h < 4; ++h) w[h] = kp[128 * h];
                const f32x2 qc = *(const GAS f32x2*)(tab + T_QC / 4 + pos * 64 + fm), qs = *(const GAS f32x2*)(tab + T_QS / 4 + pos * 64 + fm);
#pragma unroll
                for (int h = 0; h < 4; ++h) w[h] = head_apply<128, 1>(w[h], gmk, qc, qs, lane);
#pragma unroll
                for (int h = 0; h < 4; ++h) kp[128 * h] = w[h];
            }
        }
        xcd_barrier(bar, wave0);
        {
            PHASE_PTRS;
            pg8::Gemm g{LATN, nullptr, 512, 256, 256}; UpOrder S; S.init(M / 256, 7, G, bx); S.wq = (const bf16*)(aw + AW_QUP); S.wkv = (const bf16*)(aw + AW_KVUP);
            pg8::EpiBf16 E{MLARAW, MLAW};
            pg8::gemm_phase<pg8::EpiBf16, UpOrder, true, false>(lds + RING_OFF, g, S, E, wave0);
        }
        xcd_barrier(bar, wave0);
        {
            PHASE_PTRS;
            const int hh = lane >> 3, j = lane & 7;
            const float* gkp = IN(I_MLA_K_G) + l * 96;
            const f32x4 gn0 = *(const GAS f32x4*)(gkp + 8 * j), gn1 = *(const GAS f32x4*)(gkp + 8 * j + 4), gr = *(const GAS f32x4*)(gkp + 64 + 4 * j);
            const bool first = j < 4;
#define T2_LOAD(KN_, KR_, MC_, MS_, mm) do { const int pos_ = (mm) & (SEQ - 1); \
                KN_ = *(const GAS v4u*)(MLARAW + (size_t)(mm) * MLAW + 768 + 128 * hh + 8 * j); KR_ = *(const GAS v2u*)(RAW + (size_t)(mm) * RAWW + C_KROPE + 4 * j); \
                MC_ = *(const GAS f32x4*)(tab + T_MC / 4 + pos_ * 16 + 4 * (j & 3)); MS_ = *(const GAS f32x4*)(tab + T_MS / 4 + pos_ * 16 + 4 * (j & 3)); } while (0)
            v4u kn, knn; v2u kr, krn; f32x4 mc, ms, mcn, msn;
            T2_LOAD(kn, kr, mc, ms, gw);
            knn = kn; krn = kr; mcn = mc; msn = ms;
            for (int m = gw; m < M; m += NGW) {
                if (m + NGW < M) { T2_LOAD(knn, krn, mcn, msn, m + NGW); }
                float a[8] = {bflo(kn.x), bfhi(kn.x), bflo(kn.y), bfhi(kn.y), bflo(kn.z), bfhi(kn.z), bflo(kn.w), bfhi(kn.w)};
                float r[4] = {bflo(kr.x), bfhi(kr.x), bflo(kr.y), bfhi(kr.y)};
                float ss = 0.f;
#pragma unroll
                for (int i = 0; i < 8; ++i) ss += a[i] * a[i];
#pragma unroll
                for (int i = 0; i < 4; ++i) ss += r[i] * r[i];
                ss = sum8(ss);
                const float rstd = __builtin_amdgcn_rsqf(ss * (1.f / 96.f) + NEPS);
                v4u on; on.x = pk2(a[0] * rstd * gn0.x, a[1] * rstd * gn0.y); on.y = pk2(a[2] * rstd * gn0.z, a[3] * rstd * gn0.w);
                on.z = pk2(a[4] * rstd * gn1.x, a[5] * rstd * gn1.y); on.w = pk2(a[6] * rstd * gn1.z, a[7] * rstd * gn1.w);
#pragma unroll
                for (int i = 0; i < 4; ++i) { r[i] = r[i] * rstd * gr[i]; }
                float y[4];
#pragma unroll
                for (int i = 0; i < 4; ++i) { const float pr = xshfl<4>(r[i]); y[i] = first ? (r[i] * mc[i] - pr * ms[i]) : (r[i] * mc[i] + pr * ms[i]); }
                v2u orp; orp.x = pk2(y[0], y[1]); orp.y = pk2(y[2], y[3]);
                GAS bf16* kp = (GAS bf16*)(KMLA + (size_t)m * 768 + 96 * hh);
                *(GAS v4u*)(kp + 8 * j) = on; *(GAS v2u*)(kp + 64 + 4 * j) = orp;
                kn = knn; kr = krn; mc = mcn; ms = msn;
            }
#undef T2_LOAD
        }
        xcd_barrier(bar, wave0);
        {
            PHASE_PTRS;
            LAS char* al = (LAS char*)(lds + RING_OFF);
            constexpr float L2E = 1.4426950408889634f;
#define NBOUND(c, gq, gk, n) __uint_as_float(__builtin_amdgcn_readfirstlane(__float_as_uint(-(c) * L2E * wave_max_abs((gq), (n), lane) * wave_max_abs((gk), (n), lane))))
            const float nb_diff = NBOUND(8.0f, IN(I_DQ_G) + l * 64, IN(I_DK_G) + l * 64, 64);
            const float nb_mla = NBOUND(9.797958971f, IN(I_MLA_Q_G) + l * 96, IN(I_MLA_K_G) + l * 96, 96);
            const float nb_gqa = NBOUND(8.0f, IN(I_GQA_Q_G) + l * 64, IN(I_GQA_K_G) + l * 64, 64);
            const float nb_mem = NBOUND(11.3137085f, IN(I_MEM_Q_G) + l * 128, IN(I_MEM_K_G) + l * 128, 128);
            const float* lp_ = IN(I_DLAMBDA) + l * 256;
            const float lam = __uint_as_float(__builtin_amdgcn_readfirstlane(__float_as_uint(expf(wave_sum(lp_[lane] * lp_[64 + lane])) - expf(wave_sum(lp_[128 + lane] * lp_[192 + lane])) + lambda_init)));
            for (int u = vcu; u < 512; u += G) {
                const int qb = u & 7, h = (u >> 3) & 3, b = u >> 5; const size_t r0 = (size_t)b * SEQ;
                const att::QPrep qp{IN(I_DQ_G) + l * 64, tab + T_DC / 4, tab + T_DS / 4, nullptr, nullptr, qb * 256};
                att::attn_unit<64, 128, 1, 1, 4>(RAW + (r0 + qb * 256) * RAWW + C_DQ + (2 * h) * 64, RAWW, RAW + r0 * RAWW + C_DK + (2 * h) * 64, RAWW, RAW + r0 * RAWW + C_DV + h * 128, RAWW,
                                                 ODIFF + (r0 + qb * 256) * 1024 + h * 128, 1024, SEQ, 0.125f * L2E, nb_diff, qp, al, wave0);
                const att::DiffEpi de{ODIFF + (r0 + qb * 256) * 1024 + h * 128, 1024, lam, IN(I_DSUBLN_G) + l * 128, l};
                att::attn_unit<64, 128, 1, 1, 4, true>(RAW + (r0 + qb * 256) * RAWW + C_DQ + (2 * h + 1) * 64, RAWW, RAW + r0 * RAWW + C_DK + (2 * h + 1) * 64, RAWW, RAW + r0 * RAWW + C_DV + h * 128, RAWW,
                                                       RAW + (r0 + qb * 256) * RAWW + C_OA + h * 128, RAWW, SEQ, 0.125f * L2E, nb_diff, qp, al, wave0, 1.0f, &de);
            }
            for (int u = vcu; u < 512; u += G) {
                const int qb = u & 3, h = (u >> 2) & 7, b = u >> 5; const size_t r0 = (size_t)b * SEQ;
                const att::QPrep qp{IN(I_MLA_Q_G) + l * 96, tab + T_MC / 4, tab + T_MS / 4, nullptr, nullptr, qb * 512};
                att::attn_unit2d<96, 3, true>(MLARAW + (r0 + qb * 512) * MLAW + h * 96, MLAW, KMLA + r0 * 768 + h * 96, 768, MLARAW + r0 * MLAW + 768 + h * 128 + 64, MLAW,
                                                  RAW + (r0 + qb * 512) * RAWW + C_OB + h * 64, RAWW, SEQ, 0.10206207261596575f * L2E, nb_mla, qp, al, wave0);
            }
            for (int u = vcu; u < 512; u += G) {
                const int qb = u & 3, qh = (u >> 2) & 7, b = u >> 5; const size_t r0 = (size_t)b * SEQ;
                const att::QPrep qp{IN(I_GQA_Q_G) + l * 64, tab + T_RC / 4, tab + T_RS / 4, tab + T_CC / 4, tab + T_CS / 4, qb * 512};
                att::attn_unit2d<64, 2>(RAW + (r0 + qb * 512) * RAWW + C_GQ + qh * 64, RAWW, RAW + r0 * RAWW + C_GK + (qh >> 2) * 64, RAWW, RAW + r0 * RAWW + C_GV + (qh >> 2) * 64, RAWW,
                                       RAW + (r0 + qb * 512) * RAWW + C_OC + qh * 64, RAWW, SEQ, 0.125f * L2E, nb_gqa, qp, al, wave0);
            }
            for (int u = vcu; u < 512; u += G) {
                const int qb = u & 7, h = (u >> 3) & 3, b = u >> 5; const size_t r0 = (size_t)b * SEQ;
                const att::QPrep qp{IN(I_MEM_Q_G) + l * 128, tab + T_QC / 4, tab + T_QS / 4, nullptr, nullptr, qb * 256};
                att::attn_unit<128, 128, 1, 1, 4>(RAW + (r0 + qb * 256) * RAWW + C_MEMQ + h * 128, RAWW, MEMKV + (size_t)b * MEML * DM + h * 256, DM, MEMKV + (size_t)b * MEML * DM + h * 256 + 128, DM,
                                               RAW + (r0 + qb * 256) * RAWW + C_OD + h * 128, RAWW, MEML, 0.08838834764831845f * L2E, nb_mem, qp, al, wave0);
            }
        }
        xcd_barrier(bar, wave0);
        {
            PHASE_PTRS;
            pg8::Gemm g{(const bf16*)(wsp + WS_HB8), (const bf16*)(aw + AW_GATE), DM / 2, DM / 2, DM / 2}; pg8::StaticOrder S; S.init(M / 256, 16, G, bx);
            pg8::EpiSigmoidU8 E{(unsigned char*)GT, 4096, IN(I_B_GATE) + l * 4096, 1.0f / (S_H8 * S_WG)};
            pg8::gemm_phase<pg8::EpiSigmoidU8, pg8::StaticOrder, true, false, true>(lds + RING_OFF, g, S, E, wave0);
        }
        xcd_barrier(bar, wave0);
        {
            PHASE_PTRS;
            pg8::Gemm g{RAW, (const bf16*)(aw + AW_BR), RAWW, 512, 512}; MergeOrder S; S.init(M / 256, 4, G, bx);
            EpiMerge E{(const unsigned char*)GT, (bf16*)(wsp + WS_MERGED)};
            pg8::gemm_phase<EpiMerge, MergeOrder, true, false>(lds + RING_OFF, g, S, E, wave0);
        }
        xcd_barrier(bar, wave0);
        {
            PHASE_PTRS;
            pg8::Gemm g{(const bf16*)(wsp + WS_MERGED), (const bf16*)(aw + AW_OUT), DM, DM, DM}; pg8::StaticOrder S; S.init(M / 256, 4, G, bx);
            if (l == 0) { pg8::EpiResidX<false, true> E{IN(I_X), wsp + WS_XB, DM};
                pg8::gemm_phase<pg8::EpiResidX<false, true>, pg8::StaticOrder, true, false>(lds + RING_OFF, g, S, E, wave0); }
            else { pg8::EpiResidX<true, true> E{wsp + WS_XB, wsp + WS_XB, DM};
                pg8::gemm_phase<pg8::EpiResidX<true, true>, pg8::StaticOrder, true, false>(lds + RING_OFF, g, S, E, wave0); }
        }
        xcd_barrier(bar, wave0);
        if (l == 0) {
            {
                PHASE_PTRS;
                for (int it = gw; it < FFN_ITEMS; it += NGW) ffn_weight_item(it, IN(I_DW1), IN(I_DW3), IN(I_DW2), W13t, W2t, scr, lane);
                rms_rows_to_bf16<false, true, true>((const float*)(wsp + WS_XB), IN(I_NORM_FFN_G), (bf16*)(wsp + WS_HBF), M, gw, NGW, lane);
            }
            xcd_barrier(bar, wave0);
            {
                PHASE_PTRS;
                pg8::Gemm g{(const bf16*)(wsp + WS_HBF), W13t, DM, DM, DM}; pg8::StaticOrder S; S.init(M / 256, 2 * FF / 256, G, bx);
                pg8::EpiSwiGLU E{U, FF, 0};
                pg8::gemm_phase<pg8::EpiSwiGLU, pg8::StaticOrder, true, false>(lds + RING_OFF, g, S, E, wave0);
            }
            xcd_barrier(bar, wave0);
            {
                PHASE_PTRS;
                pg8::Gemm g{U, W2t, FF, FF, FF}; pg8::StaticOrder S; S.init(M / 256, DM / 256, G, bx);
                pg8::EpiResidX<true, true> E{wsp + WS_XB, wsp + WS_XB, DM};
                pg8::gemm_phase<pg8::EpiResidX<true, true>, pg8::StaticOrder, true, false>(lds + RING_OFF, g, S, E, wave0);
            }
            xcd_barrier(bar, wave0);
        }

        if (l == 1) {
            {
                PHASE_PTRS;
                volatile LAS int* ml = (volatile LAS int*)(lds + MOE_LDS);
                int* slot_tok = (int*)(wsp + WS_MOE + MO_SLOT_TOK); float* tok_gate = (float*)(wsp + WS_MOE + MO_TOK_GATE); int* wgcnt = (int*)(wsp + WS_MOE + MO_WGCNT);
                for (int it = gw; it < NEXP * FFN_ITEMS; it += NGW) { const int e = it / FFN_ITEMS; unsigned char* w13 = (unsigned char*)W13t + (size_t)e * EXPERT_BYTES;
                    ffn_weight_item8(it % FFN_ITEMS, IN(I_MW1) + (size_t)e * DM * FF, IN(I_MW3) + (size_t)e * DM * FF, IN(I_MW2) + (size_t)e * FF * DM, w13, w13 + W2_OFF, scr, lane); }
                for (int c = gt; c < MOE_SLOTS; c += NGT) slot_tok[c] = 0;
                const float* wr_ = IN(I_ROUTER); const float* gf = IN(I_NORM_FFN_G) + DM;
                f32x4 rw[4][4][2];
#pragma unroll
                for (int j = 0; j < 4; ++j)
#pragma unroll
                    for (int q = 0; q < 4; ++q) { const GAS f32x4* rp = (const GAS f32x4*)(wr_ + (size_t)(4 * (lane + 64 * j) + q) * 8); rw[j][q][0] = rp[0]; rw[j][q][1] = rp[1]; }
                f32x4 v[4], vn[4], ggv[4];
#pragma unroll
                for (int j = 0; j < 4; ++j) ggv[j] = ((const GAS f32x4*)gf + lane)[64 * j];
                { const float* xb_ = (const float*)(wsp + WS_XB);
#pragma unroll
                  for (int j = 0; j < 4; ++j) { v[j] = rr_load<true>(xb_, vcu * 128 + wave * 16, lane, j); vn[j] = v[j]; } }
                for (int i = 0; i < 16; ++i) {
                    const int tl = wave * 16 + i, t = vcu * 128 + tl;
                    if (i + 1 < 16) { const float* xb_ = (const float*)(wsp + WS_XB);
#pragma unroll
                        for (int j = 0; j < 4; ++j) vn[j] = rr_load<true>(xb_, t + 1, lane, j); }
                    float s = 0.f;
#pragma unroll
                    for (int j = 0; j < 4; ++j) { s += (v[j].x * v[j].x + v[j].y * v[j].y) + (v[j].z * v[j].z + v[j].w * v[j].w); }
                    const float rstd = __builtin_amdgcn_rsqf(wave_sum(s) * (1.f / DM) + NEPS);
                    GAS unsigned* o4 = (GAS unsigned*)(wsp + WS_HBM8 + (size_t)t * DM) + lane;
                    float lg[8] = {0.f, 0.f, 0.f, 0.f, 0.f, 0.f, 0.f, 0.f};
#pragma unroll
                    for (int j = 0; j < 4; ++j) { const f32x4 gg = ggv[j]; const float h0 = v[j].x * rstd * gg.x, h1 = v[j].y * rstd * gg.y, h2 = v[j].z * rstd * gg.z, h3 = v[j].w * rstd * gg.w;
                        o4[64 * j] = pg8::cvt4_fp8(h0 * S_H8, h1 * S_H8, h2 * S_H8, h3 * S_H8);
#pragma unroll
                        for (int e = 0; e < 8; ++e) lg[e] += h0 * rw[j][0][e >> 2][e & 3] + h1 * rw[j][1][e >> 2][e & 3] + h2 * rw[j][2][e >> 2][e & 3] + h3 * rw[j][3][e >> 2][e & 3]; }
#pragma unroll
                    for (int e = 0; e < 8; ++e) lg[e] = wave_sum(lg[e]);
                    int e1 = 0; float l1 = lg[0];
#pragma unroll
                    for (int e = 1; e < 8; ++e) if (lg[e] > l1) { l1 = lg[e]; e1 = e; }
                    int e2 = -1; float l2 = -3.0e38f;
#pragma unroll
                    for (int e = 0; e < 8; ++e) if (e != e1 && lg[e] > l2) { l2 = lg[e]; e2 = e; }
                    const float ex = expf(l2 - l1), g1 = 1.0f / (1.0f + ex), g2 = ex / (1.0f + ex);
                    if (lane == 0) { ml[ML_SEL + 2 * tl] = e1; ml[ML_SEL + 2 * tl + 1] = e2; tok_gate[2 * t] = g1; tok_gate[2 * t + 1] = g2; }
#pragma unroll
                    for (int j = 0; j < 4; ++j) v[j] = vn[j];
                }
                LDS_WAIT(); __syncthreads();
                if (wave == 0) {
                    int base[8] = {0, 0, 0, 0, 0, 0, 0, 0}; const unsigned long long lt = (1ull << lane) - 1ull;
#pragma unroll
                    for (int j = 0; j < 4; ++j) { const int a = 64 * j + lane, e = ml[ML_SEL + a]; int r = 0;
#pragma unroll
                        for (int ee = 0; ee < 8; ++ee) { const unsigned long long mk = __ballot(e == ee); if (e == ee) r = base[ee] + __popcll(mk & lt); base[ee] += __popcll(mk); }
                        ml[ML_RNK + a] = r; }
                    int cv = 0;
#pragma unroll
                    for (int ee = 0; ee < 8; ++ee) if (lane == ee) cv = base[ee];
                    if (lane < 8) wgcnt[vcu * 8 + lane] = cv;
                }
            }
            xcd_barrier(bar, wave0);
            {
                PHASE_PTRS;
                volatile LAS int* ml = (volatile LAS int*)(lds + MOE_LDS);
                int* slot_tok = (int*)(wsp + WS_MOE + MO_SLOT_TOK); int* tok_slot = (int*)(wsp + WS_MOE + MO_TOK_SLOT); const int* wgcnt = (const int*)(wsp + WS_MOE + MO_WGCNT);
                { int s = 0, p = 0;
#pragma unroll
                  for (int q = 0; q < 4; ++q) { const int w = 4 * lane + q; const int c = wgcnt[w * 8 + wave]; s += c; if (w < vcu) p += c; }
                  s = wave_sum_i(s); p = wave_sum_i(p);
                  if (lane == 0) { ml[ML_TOT + wave] = s; ml[ML_PRE + wave] = p; } }
                LDS_WAIT(); __syncthreads();
                if (wave == 0 && lane == 0) { int b = 0; for (int e = 0; e < 8; ++e) { ml[ML_SEGB + e] = b; b += (ml[ML_TOT + e] + 255) & ~255; } ml[ML_SEGB + 8] = b; }
                LDS_WAIT(); __syncthreads();
                { const int a = wave * 64 + lane;
                  if (a < 272) { int e = 0;
#pragma unroll
                      for (int q = 1; q < 8; ++q) if (ml[ML_SEGB + q] <= 256 * a) e = q;
                      ml[ML_TE + a] = e; }
                  if (a < 256) { const int e = ml[ML_SEL + a], slot = ml[ML_SEGB + e] + ml[ML_PRE + e] + ml[ML_RNK + a], t = vcu * 128 + (a >> 1);
                      slot_tok[slot] = t; tok_slot[2 * t + (a & 1)] = slot; } }
                LDS_WAIT(); __syncthreads();
                for (int i = 0; i < 32; i += 4) {
                    v4u r[4]; int sl[4];
#pragma unroll
                    for (int q = 0; q < 4; ++q) { const int a = wave * 32 + i + q, e = ml[ML_SEL + a]; sl[q] = ml[ML_SEGB + e] + ml[ML_PRE + e] + ml[ML_RNK + a];
                        r[q] = *((const GAS v4u*)(wsp + WS_HBM8 + (size_t)(vcu * 128 + (a >> 1)) * DM) + lane); }
#pragma unroll
                    for (int q = 0; q < 4; ++q) *((GAS v4u*)(wsp + WS_XS8 + (size_t)sl[q] * DM) + lane) = r[q];
                }
            }
            xcd_barrier(bar, wave0);
            const int n_tiles = __builtin_amdgcn_readfirstlane(((volatile LAS int*)(lds + MOE_LDS))[ML_SEGB + 8]) >> 8;
            const int n_full = n_tiles < 256 ? n_tiles : 256, n_tail = n_tiles - n_full;
#pragma unroll 1
            for (int ch = 0; ch * MOE_CHUNK_TILES < n_full; ++ch) {
                const int tile0 = ch * MOE_CHUNK_TILES, nt_c = (n_full - tile0) < MOE_CHUNK_TILES ? (n_full - tile0) : MOE_CHUNK_TILES;
                {
                    PHASE_PTRS;
                    pg8::Gemm g{(const bf16*)(wsp + WS_XS8 + (size_t)tile0 * 256 * DM), nullptr, DM / 2, DM / 2, DM / 2}; MoeDownOrder S; S.init(nt_c, 2 * FF / 256, G, bx);
                    S.tile0 = tile0; S.te = (const volatile LAS int*)(lds + MOE_LDS) + ML_TE; S.wbase = (const char*)W13t;
                    pg8::EpiSwiGLU8 E{(unsigned char*)U, FF, 1.0f / (S_H8 * S_W13), S_U8};
                    pg8::gemm_phase<pg8::EpiSwiGLU8, MoeDownOrder, true, false, true>(lds + RING_OFF, g, S, E, wave0);
                }
                xcd_barrier(bar, wave0);
                {
                    PHASE_PTRS;
                    pg8::Gemm g{U, nullptr, FF / 2, FF / 2, FF / 2}; MoeDownOrder S; S.init(nt_c, DM / 256, G, bx);
                    S.tile0 = tile0; S.te = (const volatile LAS int*)(lds + MOE_LDS) + ML_TE; S.wbase = (const char*)W13t + W2_OFF;
                    pg8::EpiBf16 E{(bf16*)(wsp + WS_Y) + (size_t)tile0 * 256 * DM, DM, 1.0f / (S_U8 * S_W2)};
                    pg8::gemm_phase<pg8::EpiBf16, MoeDownOrder, true, false, true>(lds + RING_OFF, g, S, E, wave0);
                }
                xcd_barrier(bar, wave0);
            }
            if (n_tail > 0) {
                {
                    PHASE_PTRS;
                    pg8::Gemm g{(const bf16*)(wsp + WS_XS8 + (size_t)256 * 256 * DM), nullptr, DM / 2, DM / 2, DM / 2}; MoeDownOrder S; S.init(n_tail, 2 * FF / 256, G, bx);
                    S.tile0 = 256; S.te = (const volatile LAS int*)(lds + MOE_LDS) + ML_TE; S.wbase = (const char*)W13t;
                    pg8::EpiSwiGLU8 E{(unsigned char*)U, FF, 1.0f / (S_H8 * S_W13), S_U8};
                    pg8::gemm_phase<pg8::EpiSwiGLU8, MoeDownOrder, true, false, true>(lds + RING_OFF, g, S, E, wave0);
                }
                xcd_barrier(bar, wave0);
                {
                    PHASE_PTRS;
                    pg8::Gemm g{U, nullptr, FF / 2, FF / 2, 256}; TailDownOrder S; S.init(n_tail, DM / 256, G, bx);
                    S.te = (const volatile LAS int*)(lds + MOE_LDS) + ML_TE; S.wbase = (const char*)W13t + W2_OFF;
                    EpiPartF32 E{(float*)(wsp + WS_TAILP), n_tail * 256};
                    pg8::gemm_phase<EpiPartF32, TailDownOrder, true, false, true>(lds + RING_OFF, g, S, E, wave0);
                }
                xcd_barrier(bar, wave0);
            }
            {
                PHASE_PTRS;
                const int* tok_slot = (const int*)(wsp + WS_MOE + MO_TOK_SLOT); const float* tok_gate = (const float*)(wsp + WS_MOE + MO_TOK_GATE); const bf16* Y = (const bf16*)(wsp + WS_Y);
#define MC_IDX(S1_, S2_, G1_, G2_, tt) do { const int t_ = (tt) < M ? (tt) : gw; S1_ = tok_slot[2 * t_]; S2_ = tok_slot[2 * t_ + 1]; G1_ = tok_gate[2 * t_]; G2_ = tok_gate[2 * t_ + 1]; } while (0)
#define MC_ROWS(X_, A_, B_, S1_, S2_, tt) do { const int t_ = (tt) < M ? (tt) : gw; \
                    const GAS v2u* y1_ = (const GAS v2u*)(Y + (size_t)(S1_) * DM) + lane; const GAS v2u* y2_ = (const GAS v2u*)(Y + (size_t)(S2_) * DM) + lane; \
                    _Pragma("unroll") for (int j = 0; j < 4; ++j) { X_[j] = rr_load<true>(XBp, t_, lane, j); A_[j] = (S1_) >= 65536 ? tail_row(PT, n_tail * 256, (S1_) - 65536, lane + 64 * j, TSC) : y1_[64 * j]; B_[j] = (S2_) >= 65536 ? tail_row(PT, n_tail * 256, (S2_) - 65536, lane + 64 * j, TSC) : y2_[64 * j]; } } while (0)
                const float* PT = (const float*)(wsp + WS_TAILP); const float* XBp = (const float*)(wsp + WS_XB); constexpr float TSC = 1.0f / (S_U8 * S_W2);
                int s1a, s2a, s1b, s2b, s1c, s2c; float g1a, g2a, g1b, g2b, g1c, g2c; f32x4 xc[4], xn[4]; v2u ac[4], bc[4], an[4], bn[4];
                MC_IDX(s1a, s2a, g1a, g2a, gw); MC_IDX(s1b, s2b, g1b, g2b, gw + NGW);
                MC_ROWS(xc, ac, bc, s1a, s2a, gw);
                for (int t = gw; t < M; t += NGW) {
                    MC_IDX(s1c, s2c, g1c, g2c, t + 2 * NGW);
                    MC_ROWS(xn, an, bn, s1b, s2b, t + NGW);
                    GAS f32x4* xr = (GAS f32x4*)(out + (size_t)t * DM) + lane;
#pragma unroll
                    for (int j = 0; j < 4; ++j) { f32x4 x = xc[j]; const v2u a = ac[j], b = bc[j];
                        x.x += g1a * bflo(a.x) + g2a * bflo(b.x); x.y += g1a * bfhi(a.x) + g2a * bfhi(b.x); x.z += g1a * bflo(a.y) + g2a * bflo(b.y); x.w += g1a * bfhi(a.y) + g2a * bfhi(b.y);
                        xr[64 * j] = x; }
#pragma unroll
                    for (int j = 0; j < 4; ++j) { xc[j] = xn[j]; ac[j] = an[j]; bc[j] = bn[j]; }
                    s1a = s1b; s2a = s2b; g1a = g1b; g2a = g2b; s1b = s1c; s2b = s2c; g1b = g1c; g2b = g2c;
                }
#undef MC_IDX
#undef MC_ROWS
            }
        }
    }
}

extern "C" void kernel_launch(void* const* d_in, const int* in_sizes, int n_in, void* d_out, int out_size, void* d_ws, size_t ws_size, hipStream_t stream) {
    static int grid = 0;
    if (grid == 0) {
        if (n_in != N_IN || in_sizes[0] != M * DM || out_size != M * DM || ws_size < WS_END) { fprintf(stderr, "kernel_launch: shape/workspace mismatch (n_in %d, ws %zu)\n", n_in, ws_size); grid = -1; return; }
        int dev = 0, cus = 0;
        if (hipGetDevice(&dev) != hipSuccess || hipDeviceGetAttribute(&cus, hipDeviceAttributeMultiprocessorCount, dev) != hipSuccess) { grid = -1; return; }
        if (hipFuncSetAttribute((const void*)fwd, hipFuncAttributeMaxDynamicSharedMemorySize, LDS_BYTES) != hipSuccess) { grid = -1; return; }
        int per_cu = 0;
        if (hipOccupancyMaxActiveBlocksPerMultiprocessor(&per_cu, (const void*)fwd, NWAVES * 64, LDS_BYTES) != hipSuccess || per_cu < 1) { fprintf(stderr, "kernel_launch: occupancy query says %d\n", per_cu); }
        (void)hipGetLastError();
        if (cus != 256) { fprintf(stderr, "kernel_launch: built for 256 CUs, got %d\n", cus); grid = -1; return; }
        grid = cus;
    }
    if (grid < 0) return;
    if (hipMemsetAsync((char*)d_ws + WS_CTL, 0, CTL_ZERO_BYTES, stream) != hipSuccess) return;
    Args a{};
    for (int i = 0; i < N_IN; ++i) a.in[i] = (const float*)d_in[i];
    a.out = (float*)d_out; a.ws = (unsigned char*)d_ws;
    hipLaunchKernelGGL(fwd, dim3(grid), dim3(NWAVES * 64), LDS_BYTES, stream, a);
}
```

```cpp
#include <hip/hip_runtime.h>
#include <cstdio>
#include <cstdint>
namespace pg8 {
#define PG8_LAS __attribute__((address_space(3)))
typedef unsigned short bf16_t;
typedef short bf16x8 __attribute__((ext_vector_type(8)));
typedef float f32x4 __attribute__((ext_vector_type(4)));
typedef float f32x2 __attribute__((ext_vector_type(2)));
typedef unsigned u32x4 __attribute__((ext_vector_type(4)));
typedef unsigned u32x2 __attribute__((ext_vector_type(2)));
constexpr int BM = 256, BK = 64, HALF = 128, HTB = HALF * BK * 2  , STAGE_BYTES = 8 * HTB, NXCD = 8, WGM = 8;

__host__ __device__ __forceinline__ int lds_byte(int r, int c) { const int st = (r >> 4) * 2 + (c >> 5), rr = r & 15, cc = c & 31, ob = rr * 64 + cc * 2; return st * 1024 + (ob ^ (((ob >> 9) & 1) << 5)); }
__host__ __device__ __forceinline__ void stage_rc(int b, int& R, int& C) { const int st = b / 1024, sb = b % 1024, swz = sb ^ (((sb >> 9) & 1) << 5); R = (st >> 1) * 16 + swz / 64; C = (st & 1) * 32 + (swz % 64) / 2; }
__host__ __device__ __forceinline__ int perm32(int rho) { const int n = rho >> 4, i = rho & 15; return 8 * (i >> 2) + 4 * n + (i & 3); }

struct Unit { int pm, pn, z; };
struct Gemm { const bf16_t* A; const bf16_t* Bt; int lda, ldb, K; };

struct StaticOrder {
    int nM, nN, nwg, G, c;
    __device__ __forceinline__ void init(int nM_, int nN_, int G_, int c_) { nM = nM_; nN = nN_; nwg = nM * nN; G = G_; c = c_; }
    __device__ __forceinline__ bool tile(long L, Unit& u) const {
        if (L >= nwg) return false;
        int wgid = (int)L; { const int q = nwg / NXCD, r = nwg % NXCD, xcd = wgid % NXCD, off = wgid / NXCD; wgid = (xcd < r ? xcd * (q + 1) : r * (q + 1) + (xcd - r) * q) + off; }
        const int nig = WGM * nN, gid = wgid / nig, fm = gid * WGM, gsz = (nM - fm) < WGM ? (nM - fm) : WGM;
        u.pm = __builtin_amdgcn_readfirstlane(fm + ((wgid % nig) % gsz)); u.pn = __builtin_amdgcn_readfirstlane((wgid % nig) / gsz); u.z = 0; return true;
    }
    __device__ __forceinline__ bool next(int i, Unit& u) const { return tile((long)i * G + c, u); }
    __device__ __forceinline__ const char* a_ptr(const Gemm& g, const Unit& u) const { return (const char*)g.A + (size_t)u.pm * (BM * 2) * g.lda; }
    __device__ __forceinline__ const char* b_ptr(const Gemm& g, const Unit& u) const { return (const char*)g.Bt + (size_t)u.pn * (BM * 2) * g.ldb; }
    __device__ __forceinline__ unsigned row_off(const Gemm&, const Unit&, int) const { return 0u; }
};

typedef __bf16 bf16x2_t __attribute__((ext_vector_type(2)));
__device__ __forceinline__ unsigned cvt_pk_bf16(float lo, float hi) { f32x2 v = {lo, hi}; bf16x2_t b = __builtin_convertvector(v, bf16x2_t); return __builtin_bit_cast(unsigned, b); }
__device__ __forceinline__ float bf_lo(unsigned w) { return __uint_as_float(w << 16); }
__device__ __forceinline__ float bf_hi(unsigned w) { return __uint_as_float(w & 0xffff0000u); }
__device__ __forceinline__ float sigmoidf_(float v) { return __builtin_amdgcn_rcpf(1.0f + __builtin_amdgcn_exp2f(-1.4426950408889634f * v)); }

struct EpiBf16 {
    static constexpr bool PERM = true;
    bf16_t* O; int ldc; float scale = 1.0f;
    __device__ __forceinline__ bool keep(const Unit&) const { return false; }
    __device__ __forceinline__ void operator()(const f32x4 (&acc)[2][2][4][2], const Unit& u, int wr, int wc, int fr, int fq) const {
        const int row0 = u.pm * BM + wr * 64 + fr, col0 = u.pn * BM + wc * 32 + 8 * fq;
#pragma unroll
        for (int ai = 0; ai < 2; ++ai)
#pragma unroll
            for (int m = 0; m < 4; ++m) { bf16_t* rowp = O + (size_t)(row0 + ai * HALF + m * 16) * ldc + col0;
#pragma unroll
                for (int bj = 0; bj < 2; ++bj) { const f32x4 v0 = acc[ai][bj][m][0] * scale, v1 = acc[ai][bj][m][1] * scale;
                    u32x4 w; w.x = cvt_pk_bf16(v0[0], v0[1]); w.y = cvt_pk_bf16(v0[2], v0[3]); w.z = cvt_pk_bf16(v1[0], v1[1]); w.w = cvt_pk_bf16(v1[2], v1[3]);
                    __builtin_nontemporal_store(w, (u32x4*)(rowp + bj * HALF)); } }
    }
};
struct EpiSigmoid {
    static constexpr bool PERM = true;
    bf16_t* O; int ldc; const float* bias; float scale = 1.0f;
    __device__ __forceinline__ bool keep(const Unit&) const { return false; }
    __device__ __forceinline__ void operator()(const f32x4 (&acc)[2][2][4][2], const Unit& u, int wr, int wc, int fr, int fq) const {
        const int row0 = u.pm * BM + wr * 64 + fr, col0 = u.pn * BM + wc * 32 + 8 * fq;
        f32x4 bv[2][2];
#pragma unroll
        for (int bj = 0; bj < 2; ++bj)
#pragma unroll
            for (int n = 0; n < 2; ++n) bv[bj][n] = *(const f32x4*)(bias + col0 + bj * HALF + 4 * n);
#pragma unroll
        for (int ai = 0; ai < 2; ++ai)
#pragma unroll
            for (int m = 0; m < 4; ++m) { bf16_t* rowp = O + (size_t)(row0 + ai * HALF + m * 16) * ldc + col0;
#pragma unroll
                for (int bj = 0; bj < 2; ++bj) { const f32x4 v0 = acc[ai][bj][m][0] * scale + bv[bj][0], v1 = acc[ai][bj][m][1] * scale + bv[bj][1];
                    u32x4 w; w.x = cvt_pk_bf16(sigmoidf_(v0[0]), sigmoidf_(v0[1])); w.y = cvt_pk_bf16(sigmoidf_(v0[2]), sigmoidf_(v0[3]));
                    w.z = cvt_pk_bf16(sigmoidf_(v1[0]), sigmoidf_(v1[1])); w.w = cvt_pk_bf16(sigmoidf_(v1[2]), sigmoidf_(v1[3]));
                    __builtin_nontemporal_store(w, (u32x4*)(rowp + bj * HALF)); } }
    }
};
struct EpiSigmoidU8 {
    static constexpr bool PERM = true;
    unsigned char* O; int ldc; const float* bias; float scale;
    __device__ __forceinline__ bool keep(const Unit&) const { return false; }
    static __device__ __forceinline__ float q255(float t) { return __builtin_amdgcn_rcpf(__builtin_fmaf(fminf(__builtin_amdgcn_exp2f(t), 254.0f), 1.0f / 255.0f, 1.0f / 255.0f)); }
    __device__ __forceinline__ void operator()(const f32x4 (&acc)[2][2][4][2], const Unit& u, int wr, int wc, int fr, int fq) const {
        const int col0 = u.pn * BM + wc * 32 + 8 * fq;
        f32x4 bv[2][2];
#pragma unroll
        for (int bj = 0; bj < 2; ++bj)
#pragma unroll
            for (int n = 0; n < 2; ++n) bv[bj][n] = *(const f32x4*)(bias + col0 + bj * HALF + 4 * n) * -1.4426950408889634f;
        const float sc2 = scale * -1.4426950408889634f;
        unsigned char* tp = O + ((size_t)(u.pm * 16 + u.pn) << 16) + ((wr * 4 + wc) << 13) + (fq * 16 + fr) * 8;
#pragma unroll
        for (int ai = 0; ai < 2; ++ai)
#pragma unroll
            for (int m = 0; m < 4; ++m) {
#pragma unroll
                for (int bj = 0; bj < 2; ++bj) { const f32x4 v0 = acc[ai][bj][m][0] * sc2 + bv[bj][0], v1 = acc[ai][bj][m][1] * sc2 + bv[bj][1];
                    u32x2 w; w.x = 0u; w.y = 0u;
#pragma unroll
                    for (int e = 0; e < 4; ++e) { w.x = __builtin_amdgcn_cvt_pk_u8_f32(q255(v0[e]), e, w.x); w.y = __builtin_amdgcn_cvt_pk_u8_f32(q255(v1[e]), e, w.y); }
                    __builtin_nontemporal_store(w, (u32x2*)(tp + (((ai * 4 + m) * 2 + bj) << 9))); } }
    }
};
struct EpiSwiGLU {
    static constexpr bool PERM = true;
    bf16_t* O; int ldc; int row_base;
    __device__ __forceinline__ bool keep(const Unit&) const { return false; }
    __device__ __forceinline__ void operator()(const f32x4 (&acc)[2][2][4][2], const Unit& u, int wr, int wc, int fr, int fq) const {
        const int row0 = row_base + u.pm * BM + wr * 64 + fr, col0 = u.pn * HALF + wc * 32 + 8 * fq;
#pragma unroll
        for (int ai = 0; ai < 2; ++ai)
#pragma unroll
            for (int m = 0; m < 4; ++m) { bf16_t* rowp = O + (size_t)(row0 + ai * HALF + m * 16) * ldc + col0;
                float r[8];
#pragma unroll
                for (int n = 0; n < 2; ++n)
#pragma unroll
                    for (int j = 0; j < 4; ++j) { const float gt = acc[ai][0][m][n][j], up = acc[ai][1][m][n][j]; r[n * 4 + j] = gt * sigmoidf_(gt) * up; }
                u32x4 w; w.x = cvt_pk_bf16(r[0], r[1]); w.y = cvt_pk_bf16(r[2], r[3]); w.z = cvt_pk_bf16(r[4], r[5]); w.w = cvt_pk_bf16(r[6], r[7]);
                __builtin_nontemporal_store(w, (u32x4*)rowp); }
    }
};
__device__ __forceinline__ unsigned cvt4_fp8(float a, float b, float c, float d) { int w = __builtin_amdgcn_cvt_pk_fp8_f32(a, b, 0, false); w = __builtin_amdgcn_cvt_pk_fp8_f32(c, d, w, true); return (unsigned)w; }
struct EpiSwiGLU8 {
    static constexpr bool PERM = true;
    unsigned char* O; int ldc; float in_scale, out_scale;
    __device__ __forceinline__ bool keep(const Unit&) const { return false; }
    __device__ __forceinline__ void operator()(const f32x4 (&acc)[2][2][4][2], const Unit& u, int wr, int wc, int fr, int fq) const {
        const int row0 = u.pm * BM + wr * 64 + fr, col0 = u.pn * HALF + wc * 32 + 8 * fq;
        const float k1 = in_scale * -1.4426950408889634f, k2 = in_scale * in_scale * out_scale;
#pragma unroll
        for (int ai = 0; ai < 2; ++ai)
#pragma unroll
            for (int m = 0; m < 4; ++m) { unsigned char* rowp = O + (size_t)(row0 + ai * HALF + m * 16) * ldc + col0;
                float r[8];
#pragma unroll
                for (int n = 0; n < 2; ++n)
#pragma unroll
                    for (int j = 0; j < 4; ++j) { const float a = acc[ai][0][m][n][j], b = acc[ai][1][m][n][j];
                        r[n * 4 + j] = (a * b) * (k2 * __builtin_amdgcn_rcpf(1.0f + __builtin_amdgcn_exp2f(a * k1))); }
                u32x2 w; w.x = cvt4_fp8(r[0], r[1], r[2], r[3]); w.y = cvt4_fp8(r[4], r[5], r[6], r[7]);
                __builtin_nontemporal_store(w, (u32x2*)rowp); }
    }
};
template <bool BASE_BF, bool OUT_BF>
struct EpiResidX {
    static constexpr bool PERM = false;
    const void* base; void* out; int ldc; float scale = 1.0f;
    __device__ __forceinline__ bool keep(const Unit&) const { return false; }
    __device__ __forceinline__ void operator()(const f32x4 (&acc)[2][2][4][2], const Unit& u, int wr, int wc, int fr, int fq) const {
        const int row0 = u.pm * BM + wr * 64 + fr, col0 = u.pn * BM + wc * 32 + 4 * fq;
#pragma unroll
        for (int ai = 0; ai < 2; ++ai)
#pragma unroll
            for (int mp = 0; mp < 2; ++mp) {
                f32x4 b[2][2][2];
#pragma unroll
                for (int mm = 0; mm < 2; ++mm) { const size_t off = (size_t)(row0 + ai * HALF + (2 * mp + mm) * 16) * ldc + col0;
#pragma unroll
                    for (int bj = 0; bj < 2; ++bj)
#pragma unroll
                        for (int n = 0; n < 2; ++n) {
                            if constexpr (BASE_BF) { const u32x2 w = *(const u32x2*)((const bf16_t*)base + off + bj * HALF + n * 16);
                                b[mm][bj][n] = (f32x4){bf_lo(w.x), bf_hi(w.x), bf_lo(w.y), bf_hi(w.y)}; }
                            else b[mm][bj][n] = *(const f32x4*)((const float*)base + off + bj * HALF + n * 16); } }
#pragma unroll
                for (int mm = 0; mm < 2; ++mm) { const size_t off = (size_t)(row0 + ai * HALF + (2 * mp + mm) * 16) * ldc + col0;
#pragma unroll
                    for (int bj = 0; bj < 2; ++bj)
#pragma unroll
                        for (int n = 0; n < 2; ++n) { const f32x4 v = b[mm][bj][n] + acc[ai][bj][2 * mp + mm][n] * scale;
                            if constexpr (OUT_BF) { u32x2 w; w.x = cvt_pk_bf16(v[0], v[1]); w.y = cvt_pk_bf16(v[2], v[3]); __builtin_nontemporal_store(w, (u32x2*)((bf16_t*)out + off + bj * HALF + n * 16)); }
                            else *(f32x4*)((float*)out + off + bj * HALF + n * 16) = v; } }
                asm volatile("" ::: "memory"); }
    }
};

typedef int i32x8 __attribute__((ext_vector_type(8)));
typedef short s16x16 __attribute__((ext_vector_type(16)));
typedef float f32x8 __attribute__((ext_vector_type(8)));
template <class Epi, class Sched, bool ALIGN_EPI, bool GATHER, bool FP8 = false>
__device__ __forceinline__ void gemm_phase(PG8_LAS unsigned char* lds, const Gemm g, const Sched& S, const Epi& E, int wave0) {
    int tid; asm volatile("v_mbcnt_lo_u32_b32 %0, -1, 0\n\tv_mbcnt_hi_u32_b32 %0, -1, %0" : "=v"(tid)); tid = (tid + wave0 * 64) & 511;
    const int wid = __builtin_amdgcn_readfirstlane(tid >> 6), lane = tid & 63, wr = wid >> 2, wc = wid & 3, fr = lane & 15, fq = lane >> 4;
    int K = g.K; asm volatile("" : "+s"(K));
    const int nt = K / BK;
    unsigned voffB[2], offC[2][2], offN[2][2]; int Rr[2], Cc[2];
#pragma unroll
    for (int i = 0; i < 2; ++i) { int R, C; stage_rc(tid * 16 + i * 8192, R, C); const int Rb = Epi::PERM ? ((R & ~31) + perm32(R & 31)) : R;
        voffB[i] = (unsigned)(Rb * g.ldb + C) * 2u; Rr[i] = R; Cc[i] = C;
        offC[0][i] = (unsigned)(R * g.lda + C) * 2u; offC[1][i] = (unsigned)((R + HALF) * g.lda + C) * 2u; offN[0][i] = offC[0][i]; offN[1][i] = offC[1][i]; }
    const size_t dB64 = (size_t)64 * g.ldb * 2, dA64 = (size_t)64 * g.lda * 2, dAh = (size_t)HALF * g.lda * 2;
    const size_t kstep = (size_t)(BK * 2);
    const size_t hstepB = (size_t)HALF * g.ldb * 2;
    const unsigned ldsw = (unsigned)wid * 1024u;
    const int aoff = lds_byte(wr * 64 + fr, fq * 8), boff = lds_byte(wc * 32 + fr, fq * 8);
#define PG8_SA(b, h) (((b) * 2 + (h)) * HTB)
#define PG8_SB(b, h) ((4 + (b) * 2 + (h)) * HTB)
#define PG8_STAGE_B(bufoff, gbase) do { _Pragma("unroll") for (int _i = 0; _i < 2; ++_i) \
        __builtin_amdgcn_global_load_lds((const unsigned*)((const char*)(gbase) + (size_t)_i * dB64 + voffB[0]), (PG8_LAS unsigned*)(lds + (bufoff) + ldsw + _i * 8192), 16, 0, 0); } while (0)
#define PG8_STAGE_A(bufoff, gbase, O, h) do { _Pragma("unroll") for (int _i = 0; _i < 2; ++_i) { \
        if constexpr (GATHER) __builtin_amdgcn_global_load_lds((const unsigned*)((const char*)(gbase) + O[h][_i]), (PG8_LAS unsigned*)(lds + (bufoff) + ldsw + _i * 8192), 16, 0, 0); \
        else __builtin_amdgcn_global_load_lds((const unsigned*)((const char*)(gbase) + (size_t)(h) * dAh + (size_t)_i * dA64 + O[0][0]), (PG8_LAS unsigned*)(lds + (bufoff) + ldsw + _i * 8192), 16, 0, 0); } } while (0)
#define PG8_LD8(addr) __builtin_bit_cast(i32x8, __builtin_shufflevector(*(const PG8_LAS bf16x8*)(lds + (addr)), *(const PG8_LAS bf16x8*)(lds + (addr) + 1024), 0, 1, 2, 3, 4, 5, 6, 7, 8, 9, 10, 11, 12, 13, 14, 15))
#define PG8_LDA8(dst, b, h) do { _Pragma("unroll") for (int m = 0; m < 4; ++m) dst[m] = PG8_LD8(PG8_SA(b, h) + aoff + m * 2048); } while (0)
#define PG8_LDB8(dst, b, h) do { _Pragma("unroll") for (int n = 0; n < 2; ++n) dst[n] = PG8_LD8(PG8_SB(b, h) + boff + n * 2048); } while (0)
#define PG8_MMA8(ai, bj, At, Bt) do { __builtin_amdgcn_s_setprio(1); _Pragma("unroll") for (int m = 0; m < 4; ++m) _Pragma("unroll") for (int n = 0; n < 2; ++n) \
        asm volatile("v_mfma_f32_16x16x128_f8f6f4 %0, %1, %2, %0" : "+v"(acc[ai][bj][m][n]) : "v"(Bt[n]), "v"(At[m])); __builtin_amdgcn_s_setprio(0); } while (0)
#define PG8_LDA(dst, b, h) do { _Pragma("unroll") for (int m = 0; m < 4; ++m) _Pragma("unroll") for (int k = 0; k < 2; ++k) dst[m][k] = *(const PG8_LAS bf16x8*)(lds + PG8_SA(b, h) + aoff + m * 2048 + k * 1024); } while (0)
#define PG8_LDB(dst, b, h) do { _Pragma("unroll") for (int n = 0; n < 2; ++n) _Pragma("unroll") for (int k = 0; k < 2; ++k) dst[n][k] = *(const PG8_LAS bf16x8*)(lds + PG8_SB(b, h) + boff + n * 2048 + k * 1024); } while (0)
#define PG8_MMA(ai, bj, At, Bt) do { __builtin_amdgcn_s_setprio(1); _Pragma("unroll") for (int m = 0; m < 4; ++m) _Pragma("unroll") for (int n = 0; n < 2; ++n) _Pragma("unroll") for (int k = 0; k < 2; ++k) \
        acc[ai][bj][m][n] = __builtin_amdgcn_mfma_f32_16x16x32_bf16(Bt[n][k], At[m][k], acc[ai][bj][m][n], 0, 0, 0); __builtin_amdgcn_s_setprio(0); } while (0)
#define XLDA(b, h) do { if constexpr (FP8) PG8_LDA8(At8, b, h); else PG8_LDA(At, b, h); } while (0)
#define XLDB0(b, h) do { if constexpr (FP8) PG8_LDB8(B08, b, h); else PG8_LDB(B0, b, h); } while (0)
#define XLDB1(b, h) do { if constexpr (FP8) PG8_LDB8(B18, b, h); else PG8_LDB(B1, b, h); } while (0)
#define XMMA(ai, bj, w) do { if constexpr (FP8) { if (w) PG8_MMA8(ai, bj, At8, B18); else PG8_MMA8(ai, bj, At8, B08); } else { if (w) PG8_MMA(ai, bj, At, B1); else PG8_MMA(ai, bj, At, B0); } } while (0)
#define PG8_WAIT_V(n) asm volatile("s_waitcnt vmcnt(" #n ")" ::: "memory")
#define PG8_WAIT_L(n) asm volatile("s_waitcnt lgkmcnt(" #n ")" ::: "memory")
#define PG8_BAR __builtin_amdgcn_s_barrier()
#define PG8_SCHED __builtin_amdgcn_sched_barrier(0)
    Unit cur, nxt; int ui = 0;
    if (!S.next(0, cur)) return;
    f32x4 acc[2][2][4][2];
#pragma unroll
    for (int a = 0; a < 2; ++a)
#pragma unroll
        for (int b = 0; b < 2; ++b)
#pragma unroll
            for (int m = 0; m < 4; ++m)
#pragma unroll
                for (int n = 0; n < 2; ++n) acc[a][b][m][n] = (f32x4){0.f, 0.f, 0.f, 0.f};
    bf16x8 At[4][2], B0[2][2], B1[2][2]; i32x8 At8[4], B08[2], B18[2];
    const char* cA = S.a_ptr(g, cur); const char* cB = S.b_ptr(g, cur);
    if constexpr (GATHER) {
#pragma unroll
        for (int h = 0; h < 2; ++h)
#pragma unroll
            for (int i = 0; i < 2; ++i) offC[h][i] = S.row_off(g, cur, h * HALF + Rr[i]) + (unsigned)Cc[i] * 2u;
    }
    PG8_STAGE_B(PG8_SB(0, 0), cB); PG8_STAGE_B(PG8_SB(0, 1), cB + hstepB); PG8_STAGE_A(PG8_SA(0, 0), cA, offC, 0); PG8_STAGE_A(PG8_SA(0, 1), cA, offC, 1);
    if (wr == 1) PG8_BAR;
    PG8_WAIT_V(2); PG8_BAR;
    PG8_STAGE_B(PG8_SB(1, 0), cB + kstep); PG8_STAGE_A(PG8_SA(1, 0), cA + kstep, offC, 0); PG8_STAGE_B(PG8_SB(1, 1), cB + hstepB + kstep);
    PG8_WAIT_V(6); PG8_BAR;
    for (;;) {
        const bool has_next = S.next(ui + 1, nxt);
        const char* nA = has_next ? S.a_ptr(g, nxt) : cA; const char* nB = has_next ? S.b_ptr(g, nxt) : cB;
        if constexpr (GATHER) {
            if (has_next) {
#pragma unroll
                for (int h = 0; h < 2; ++h)
#pragma unroll
                    for (int i = 0; i < 2; ++i) offN[h][i] = S.row_off(g, nxt, h * HALF + Rr[i]) + (unsigned)Cc[i] * 2u;
            }
        }
#pragma unroll 1
        for (int t = 0; t < nt; t += 2) {
            const bool last = (t == nt - 2);
            const char* a1 = cA + (size_t)(t + 1) * kstep;
            const char* a2 = last ? nA : cA + (size_t)(t + 2) * kstep; const char* b2 = last ? nB : cB + (size_t)(t + 2) * kstep;
            const char* a3 = a2 + kstep; const char* b3 = b2 + kstep;
            unsigned o2[2][2];
#pragma unroll
            for (int h = 0; h < 2; ++h)
#pragma unroll
                for (int i = 0; i < 2; ++i) o2[h][i] = GATHER ? (last ? offN[h][i] : offC[h][i]) : offC[h][i];
            XLDB0(0, 0); XLDB1(0, 1); PG8_SCHED; XLDA(0, 0); PG8_STAGE_A(PG8_SA(1, 1), a1, offC, 1);
            PG8_WAIT_V(8); PG8_WAIT_L(0); PG8_BAR; XMMA(0, 0, 0); XMMA(0, 1, 1); PG8_BAR; PG8_SCHED;
            XLDA(0, 1); PG8_STAGE_B(PG8_SB(0, 0), b2); PG8_STAGE_B(PG8_SB(0, 1), b2 + hstepB); PG8_STAGE_A(PG8_SA(0, 0), a2, o2, 0);
            PG8_WAIT_V(8); PG8_WAIT_L(0); PG8_BAR; XMMA(1, 0, 0); XMMA(1, 1, 1); PG8_BAR; PG8_SCHED;
            XLDB0(1, 0); XLDB1(1, 1); PG8_SCHED; XLDA(1, 0); PG8_STAGE_A(PG8_SA(0, 1), a2, o2, 1);
            PG8_WAIT_V(8); PG8_WAIT_L(0); PG8_BAR; XMMA(0, 0, 0); XMMA(0, 1, 1); PG8_BAR; PG8_SCHED;
            XLDA(1, 1); PG8_STAGE_B(PG8_SB(1, 0), b3); PG8_STAGE_B(PG8_SB(1, 1), b3 + hstepB); PG8_STAGE_A(PG8_SA(1, 0), a3, o2, 0);
            PG8_WAIT_V(8); PG8_WAIT_L(0); PG8_BAR; XMMA(1, 0, 0); XMMA(1, 1, 1); PG8_BAR; PG8_SCHED;
        }
        if constexpr (ALIGN_EPI) { if (wr == 0) PG8_BAR; }
        if constexpr (FP8) {
            asm volatile("s_nop 15" : "+v"(acc[1][0][0][0]), "+v"(acc[1][0][0][1]), "+v"(acc[1][0][1][0]), "+v"(acc[1][0][1][1]), "+v"(acc[1][0][2][0]), "+v"(acc[1][0][2][1]), "+v"(acc[1][0][3][0]), "+v"(acc[1][0][3][1]));
            asm volatile("" : "+v"(acc[1][1][0][0]), "+v"(acc[1][1][0][1]), "+v"(acc[1][1][1][0]), "+v"(acc[1][1][1][1]), "+v"(acc[1][1][2][0]), "+v"(acc[1][1][2][1]), "+v"(acc[1][1][3][0]), "+v"(acc[1][1][3][1])); }
        E(acc, cur, wr, wc, fr, fq);
        if (!has_next) break;
        if (!E.keep(cur)) {
#pragma unroll
        for (int a = 0; a < 2; ++a)
#pragma unroll
            for (int b = 0; b < 2; ++b)
#pragma unroll
                for (int m = 0; m < 4; ++m)
#pragma unroll
                    for (int n = 0; n < 2; ++n) acc[a][b][m][n] = (f32x4){0.f, 0.f, 0.f, 0.f};
        }
        cur = nxt; cA = nA; cB = nB; ++ui;
        if constexpr (GATHER) {
#pragma unroll
            for (int h = 0; h < 2; ++h)
#pragma unroll
                for (int i = 0; i < 2; ++i) offC[h][i] = offN[h][i];
        }
        if constexpr (ALIGN_EPI) { if (wr == 1) PG8_BAR; }
    }
    PG8_WAIT_V(0);
    if constexpr (!ALIGN_EPI) { if (wr == 0) PG8_BAR; }
    PG8_BAR;
#undef PG8_SA
#undef PG8_SB
#undef PG8_STAGE_A
#undef PG8_STAGE_B
#undef PG8_LDA
#undef PG8_LD8
#undef PG8_LDA8
#undef PG8_LDB8
#undef PG8_MMA8
#undef XLDA
#undef XLDB0
#undef XLDB1
#undef XMMA
#undef PG8_LDB
#undef PG8_MMA
#undef PG8_WAIT_V
#undef PG8_WAIT_L
#undef PG8_BAR
#undef PG8_SCHED
}
}
namespace att {
using bf16x8 = __attribute__((ext_vector_type(8))) short;
using s16x4  = __attribute__((ext_vector_type(4))) short;
using f32x16 = __attribute__((ext_vector_type(16))) float;
using u32x4  = __attribute__((ext_vector_type(4))) unsigned;
typedef unsigned short bf16_t;
typedef float f32x4_t __attribute__((ext_vector_type(4)));
#define ALAS __attribute__((address_space(3)))
constexpr int NW = 8, QBLK = 32, KVBLK = 64;
constexpr int LDS_V = 0, LDS_K = 32768, LDS_WS = 65536;
constexpr int LDS_V3 = 0, LDS_K3 = 49152, LDS_WS3 = 98304, LDS_BYTES = LDS_WS3 + NW * 64 * 4;
constexpr float THR = 8.f;
#define KF(row) ((((row) & 7) | ((((row) >> 4) & 1) << 3)))
#define KSWZ(row, colB) ((row) * 256 + ((colB) ^ (KF(row) << 4)))
#define SBAR() __builtin_amdgcn_sched_barrier(0)
constexpr int QK2_BT = 2;
__device__ __forceinline__ int crow(int r, int hi) { return (r & 3) + 8 * (r >> 2) + 4 * hi; }
typedef float f32x2_t __attribute__((ext_vector_type(2))); typedef __bf16 bf16x2_t __attribute__((ext_vector_type(2)));
__device__ __forceinline__ unsigned cvtpk(float lo, float hi) { f32x2_t v = {lo, hi}; bf16x2_t b = __builtin_convertvector(v, bf16x2_t); return __builtin_bit_cast(unsigned, b); }

__device__ __forceinline__ void expHalf(f32x16& p0, float shift, bool use_shift) {
  if (use_shift) {
#pragma unroll
    for (int r = 0; r < 16; ++r) p0[r] = __builtin_amdgcn_exp2f(p0[r] + shift);
  } else {
#pragma unroll
    for (int r = 0; r < 16; ++r) p0[r] = __builtin_amdgcn_exp2f(p0[r]);
  }
}
__device__ __forceinline__ void finishSM(f32x16& p0, f32x16& p1, float& l_reg, bf16x8& pa0, bf16x8& pa1, bf16x8& pa2, bf16x8& pa3, float shift, bool use_shift) {
  expHalf(p1, shift, use_shift);
  float ps = 0;
#pragma unroll
  for (int r = 0; r < 16; ++r) ps += p0[r] + p1[r];
  l_reg += ps;
#define PK4(P, BASE, OUT) do { unsigned a0 = cvtpk(P[BASE + 0], P[BASE + 1]), a1 = cvtpk(P[BASE + 2], P[BASE + 3]);   \
    unsigned b0 = cvtpk(P[BASE + 4], P[BASE + 5]), b1 = cvtpk(P[BASE + 6], P[BASE + 7]);                              \
    auto r0 = __builtin_amdgcn_permlane32_swap(a0, b0, false, false); auto r1 = __builtin_amdgcn_permlane32_swap(a1, b1, false, false); \
    u32x4 w = {r0[0], r1[0], r0[1], r1[1]}; OUT = __builtin_bit_cast(bf16x8, w); } while (0)
  PK4(p0, 0, pa0); PK4(p0, 8, pa1); PK4(p1, 0, pa2); PK4(p1, 8, pa3);
#undef PK4
}
template <int DK, int COLB = 0> __device__ __forceinline__ void qkt(f32x16& p0, f32x16& p1, const ALAS char* Ks, const bf16x8* qr, int r32, int hi) {
  constexpr int ND = DK / 16, BT = ND > 4 ? ND / 2 : ND;
  p0 = f32x16{}; p1 = f32x16{};
#pragma unroll
  for (int b0 = 0; b0 < ND; b0 += BT) {
    bf16x8 k0[BT], k1[BT];
#pragma unroll
    for (int i = 0; i < BT; ++i) { const int cb = COLB + ((b0 + i) * 16 + hi * 8) * 2;
      k0[i] = *(const ALAS bf16x8*)(Ks + KSWZ(r32, cb)); k1[i] = *(const ALAS bf16x8*)(Ks + KSWZ(32 + r32, cb)); }
    SBAR();
#pragma unroll
    for (int i = 0; i < BT; ++i) {
      p0 = __builtin_amdgcn_mfma_f32_32x32x16_bf16(k0[i], qr[b0 + i], p0, 0, 0, 0);
      p1 = __builtin_amdgcn_mfma_f32_32x32x16_bf16(k1[i], qr[b0 + i], p1, 0, 0, 0); }
    SBAR();
  }
}
template <int NB> __device__ __forceinline__ int v_st(int k, int c) { const int kk = (k & ~0xC) | ((k & 4) << 1) | ((k & 8) >> 1); return ((kk >> 3) * NB + (c >> 5)) * 512 + ((kk & 7) * 32 + (c & 31)) * 2; }
__device__ __forceinline__ int v_rd_base(int lane) { return ((lane & 3) << 3) | (((lane >> 2) & 3) << 6) | (((lane >> 4) & 1) << 5) | (((lane >> 5) & 1) << 8); }
template <int OFF> __device__ __forceinline__ s16x4 tr_read(int vb) {
  s16x4 r; asm volatile("ds_read_b64_tr_b16 %0, %1 offset:%2" : "=&v"(r) : "v"(vb), "i"(OFF) : "memory"); return r;
}
template <int NB, int D0> __device__ __forceinline__ void pv_one(f32x16& od, int vb, bf16x8 pa0, bf16x8 pa1, bf16x8 pa2, bf16x8 pa3) {
#define VOFF(ks, half) (D0 * 512 + (ks) * (1024 * NB) + (half) * (512 * NB))
  const s16x4 l0 = tr_read<VOFF(0, 0)>(vb), h0 = tr_read<VOFF(0, 1)>(vb), l1 = tr_read<VOFF(1, 0)>(vb), h1 = tr_read<VOFF(1, 1)>(vb);
  const s16x4 l2 = tr_read<VOFF(2, 0)>(vb), h2 = tr_read<VOFF(2, 1)>(vb), l3 = tr_read<VOFF(3, 0)>(vb), h3 = tr_read<VOFF(3, 1)>(vb);
#undef VOFF
  asm volatile("s_waitcnt lgkmcnt(0)" ::: "memory"); SBAR();
#define PK(L, H) (bf16x8){L[0], L[1], L[2], L[3], H[0], H[1], H[2], H[3]}
  od = __builtin_amdgcn_mfma_f32_32x32x16_bf16(pa0, PK(l0, h0), od, 0, 0, 0);
  od = __builtin_amdgcn_mfma_f32_32x32x16_bf16(pa1, PK(l1, h1), od, 0, 0, 0);
  od = __builtin_amdgcn_mfma_f32_32x32x16_bf16(pa2, PK(l2, h2), od, 0, 0, 0);
  od = __builtin_amdgcn_mfma_f32_32x32x16_bf16(pa3, PK(l3, h3), od, 0, 0, 0);
#undef PK
}
template <int NB> __device__ __forceinline__ void pv_all(f32x16* o, int vb, bf16x8 pa0, bf16x8 pa1, bf16x8 pa2, bf16x8 pa3) {
  pv_one<NB, 0>(o[0], vb, pa0, pa1, pa2, pa3); pv_one<NB, 1>(o[1], vb, pa0, pa1, pa2, pa3);
  if constexpr (NB == 4) { pv_one<NB, 2>(o[2], vb, pa0, pa1, pa2, pa3); pv_one<NB, 3>(o[3], vb, pa0, pa1, pa2, pa3); }
}

struct QPrep { const float* g; const float* c1; const float* s1; const float* c2; const float* s2; int pos0; };
template <int DK, int QMODE>
__device__ __forceinline__ void load_q(bf16x8 (&qr)[DK / 16], const bf16_t* Qw, const QPrep& qp, float qscale, int wid, int r32, int hi) {
  constexpr int ND = DK / 16;
  float x[ND * 8];
#pragma unroll
  for (int d0 = 0; d0 < ND; ++d0) { const u32x4 w = *reinterpret_cast<const u32x4*>(Qw + d0 * 16);
#pragma unroll
    for (int e = 0; e < 4; ++e) { x[d0 * 8 + 2 * e] = __uint_as_float(w[e] << 16); x[d0 * 8 + 2 * e + 1] = __uint_as_float(w[e] & 0xffff0000u); } }
  if constexpr (QMODE != 0) {
    float ss = 0.f;
#pragma unroll
    for (int i = 0; i < ND * 8; ++i) ss += x[i] * x[i];
    { auto rr = __builtin_amdgcn_permlane32_swap(__float_as_uint(ss), __float_as_uint(ss), false, false); ss = __uint_as_float(rr[0]) + __uint_as_float(rr[1]); }
    const float rstd = __builtin_amdgcn_rsqf(ss * (1.f / DK) + 1e-6f);
#pragma unroll
    for (int d0 = 0; d0 < ND; ++d0) { const f32x4_t g0 = *reinterpret_cast<const f32x4_t*>(qp.g + d0 * 16 + hi * 8), g1 = *reinterpret_cast<const f32x4_t*>(qp.g + d0 * 16 + hi * 8 + 4);
#pragma unroll
      for (int e = 0; e < 4; ++e) { x[d0 * 8 + e] *= rstd * g0[e]; x[d0 * 8 + 4 + e] *= rstd * g1[e]; } }
    const int pos = qp.pos0 + wid * QBLK + r32;
#define ROPE_PAIR(dA, dB, CT, ST) do { const f32x4_t c0 = *reinterpret_cast<const f32x4_t*>((CT) + hi * 8), c1_ = *reinterpret_cast<const f32x4_t*>((CT) + hi * 8 + 4), s0 = *reinterpret_cast<const f32x4_t*>((ST) + hi * 8), s1_ = *reinterpret_cast<const f32x4_t*>((ST) + hi * 8 + 4); \
      _Pragma("unroll") for (int e = 0; e < 8; ++e) { const float c = e < 4 ? c0[e & 3] : c1_[e & 3], s = e < 4 ? s0[e & 3] : s1_[e & 3]; const float xa = x[(dA) * 8 + e], xb = x[(dB) * 8 + e]; \
        x[(dA) * 8 + e] = xa * c - xb * s; x[(dB) * 8 + e] = xb * c + xa * s; } } while (0)
    if constexpr (QMODE == 1) {
#pragma unroll
      for (int d0 = 0; d0 < ND / 2; ++d0) ROPE_PAIR(d0, d0 + ND / 2, qp.c1 + (size_t)pos * (DK / 2) + d0 * 16, qp.s1 + (size_t)pos * (DK / 2) + d0 * 16);
    } else if constexpr (QMODE == 2) {
      const int grow = pos >> 6, gcol = pos & 63;
      ROPE_PAIR(0, 1, qp.c1 + grow * 16, qp.s1 + grow * 16); ROPE_PAIR(2, 3, qp.c2 + gcol * 16, qp.s2 + gcol * 16);
    } else if constexpr (QMODE == 3) {
      ROPE_PAIR(4, 5, qp.c1 + pos * 16, qp.s1 + pos * 16);
    }
#undef ROPE_PAIR
  }
#pragma unroll
  for (int d0 = 0; d0 < ND; ++d0) { u32x4 w;
#pragma unroll
    for (int e = 0; e < 4; ++e) w[e] = cvtpk(x[d0 * 8 + 2 * e] * qscale, x[d0 * 8 + 2 * e + 1] * qscale);
    qr[d0] = __builtin_bit_cast(bf16x8, w); }
}

struct DiffEpi { const bf16_t* O1; int ldo1; float lam; const float* g; int layer; };
template <int DK, int DV, int SDEPTH, int QMODE, int PIPE = 2, bool DIFF2 = false>
__device__ __forceinline__ void attn_unit(const bf16_t* Qb, int ldq, const bf16_t* __restrict__ Kh, int ldk, const bf16_t* __restrict__ Vh, int ldv,
                                          bf16_t* Ob, int ldo, int nkeys, float qscale, float negb_, const QPrep& qp, ALAS char* lds, int wave0, float omul = 1.0f, const DiffEpi* de = nullptr) {
  constexpr int NB = DV / 32, KC = DK / 8, VC = DV / 8;
  constexpr int NKC = 64 * KC, NVC = 64 * VC, KPT = (NKC + 511) / 512, VPT = (NVC + 511) / 512;
  constexpr int SHM_V = KVBLK * DV * 2, SHM_K = 16384;
  int tid; asm volatile("v_mbcnt_lo_u32_b32 %0, -1, 0\n\tv_mbcnt_hi_u32_b32 %0, -1, %0" : "=v"(tid)); tid = (tid + wave0 * 64) & 511;
  const int wid = tid >> 6, lane = tid & 63, r32 = lane & 31, hi = lane >> 5;
  ALAS char* V_lds = lds + (PIPE == 3 ? LDS_V3 : LDS_V); ALAS char* K_lds = lds + (PIPE == 3 ? LDS_K3 : LDS_K);
  ALAS float* ws = (ALAS float*)(lds + (PIPE == 3 ? LDS_WS3 : LDS_WS)) + wid * 64; ALAS float* li_l = ws;
  float l_reg = 0; f32x16 o[NB]; bf16x8 qr[DK / 16];
  const bool use_shift = negb_ < -60.f;
  load_q<DK, QMODE>(qr, Qb + (long)(wid * QBLK + r32) * ldq + hi * 8, qp, qscale, wid, r32, hi);
  SBAR();
#pragma unroll
  for (int d = 0; d < NB; ++d) o[d] = f32x16{};
  int kgo[KPT], klo[KPT], vgo[VPT], vlo[VPT]; bool kok[KPT], vok[VPT];
#pragma unroll
  for (int i = 0; i < KPT; ++i) { const int c = tid + 512 * i; kok[i] = (512 * (i + 1) <= NKC) || (c < NKC); const int row = c / KC, col = (c % KC) * 8; kgo[i] = row * ldk + col; klo[i] = KSWZ(row, col * 2); }
#pragma unroll
  for (int i = 0; i < VPT; ++i) { const int c = tid + 512 * i; vok[i] = (512 * (i + 1) <= NVC) || (c < NVC); const int row = c / VC, col = (c % VC) * 8; vgo[i] = row * ldv + col; vlo[i] = v_st<NB>(row, col); }
  const int vb0 = (int)(unsigned)(unsigned long)V_lds + v_rd_base(lane);
  struct { bf16x8 ks[KPT], vs[VPT]; } sr_[SDEPTH];
#define SLOAD(s, k0) do { _Pragma("unroll") for (int i_ = 0; i_ < KPT; ++i_) if (kok[i_]) sr_[s].ks[i_] = *reinterpret_cast<const bf16x8*>(Kh + (long)(k0) * ldk + kgo[i_]); \
    _Pragma("unroll") for (int i_ = 0; i_ < VPT; ++i_) if (vok[i_]) sr_[s].vs[i_] = *reinterpret_cast<const bf16x8*>(Vh + (long)(k0) * ldv + vgo[i_]); } while (0)
#define SWRITE(b, s) do { _Pragma("unroll") for (int i_ = 0; i_ < KPT; ++i_) if (kok[i_]) *(ALAS bf16x8*)(K_lds + (b) * SHM_K + klo[i_]) = sr_[s].ks[i_]; \
    _Pragma("unroll") for (int i_ = 0; i_ < VPT; ++i_) if (vok[i_]) *(ALAS bf16x8*)(V_lds + (b) * SHM_V + vlo[i_]) = sr_[s].vs[i_]; } while (0)
#define SWAIT() do { if constexpr (SDEPTH == 2) asm volatile("s_waitcnt vmcnt(%0)" :: "n"(KPT + VPT) : "memory"); else asm volatile("s_waitcnt vmcnt(0)" ::: "memory"); } while (0)
  bf16x8 pa0, pa1, pa2, pa3; const int NT = nkeys / KVBLK;
  if constexpr (PIPE == 1) {
    f32x16 pA0, pA1;
    SLOAD(0, 0); asm volatile("s_waitcnt vmcnt(0)" ::: "memory"); SWRITE(0, 0); __syncthreads();
    for (int j = 0; j < NT; ++j) {
      const int bsel = j & 1;
      if (j + 1 < NT) SLOAD(0, (j + 1) * KVBLK);
      SBAR(); qkt<DK>(pA0, pA1, K_lds + bsel * SHM_K, qr, r32, hi); expHalf(pA0, negb_, use_shift);
      finishSM(pA0, pA1, l_reg, pa0, pa1, pa2, pa3, negb_, use_shift); SBAR();
      pv_all<NB>(o, vb0 + bsel * SHM_V, pa0, pa1, pa2, pa3);
      if (j + 1 < NT) { asm volatile("s_waitcnt vmcnt(0)" ::: "memory"); SWRITE(bsel ^ 1, 0); }
      __syncthreads();
    }
  } else if constexpr (PIPE == 4) {
    f32x16 pA0, pA1;
    SLOAD(0, 0); asm volatile("s_waitcnt vmcnt(0)" ::: "memory"); SWRITE(0, 0); __syncthreads();
    if (wave0 < 4) {
      for (int j = 0; j < NT; ++j) {
        const int bsel = j & 1;
        if (j + 1 < NT) SLOAD(0, (j + 1) * KVBLK);
        SBAR(); qkt<DK>(pA0, pA1, K_lds + bsel * SHM_K, qr, r32, hi); expHalf(pA0, negb_, use_shift);
        finishSM(pA0, pA1, l_reg, pa0, pa1, pa2, pa3, negb_, use_shift); SBAR();
        __builtin_amdgcn_s_barrier(); SBAR();
        pv_all<NB>(o, vb0 + bsel * SHM_V, pa0, pa1, pa2, pa3);
        if (j + 1 < NT) { asm volatile("s_waitcnt vmcnt(0)" ::: "memory"); SWRITE(bsel ^ 1, 0); }
        __syncthreads();
      }
    } else {
      for (int j = 0; j < NT; ++j) {
        const int bsel = j & 1;
        if (j + 1 < NT) SLOAD(0, (j + 1) * KVBLK);
        SBAR(); if (j > 0) pv_all<NB>(o, vb0 + (bsel ^ 1) * SHM_V, pa0, pa1, pa2, pa3);
        SBAR(); qkt<DK>(pA0, pA1, K_lds + bsel * SHM_K, qr, r32, hi); SBAR();
        __builtin_amdgcn_s_barrier(); SBAR();
        expHalf(pA0, negb_, use_shift); finishSM(pA0, pA1, l_reg, pa0, pa1, pa2, pa3, negb_, use_shift); SBAR();
        if (j + 1 < NT) { asm volatile("s_waitcnt vmcnt(0)" ::: "memory"); SWRITE(bsel ^ 1, 0); }
        __syncthreads();
      }
      pv_all<NB>(o, vb0 + ((NT - 1) & 1) * SHM_V, pa0, pa1, pa2, pa3);
    }
  } else if constexpr (PIPE == 3) {
    f32x16 pA0, pA1, pB0, pB1;
    struct { bf16x8 ks[KPT], vs[VPT]; } st_;
#define GLK(k0) do { _Pragma("unroll") for (int i_ = 0; i_ < KPT; ++i_) if (kok[i_]) st_.ks[i_] = *reinterpret_cast<const bf16x8*>(Kh + (long)(k0) * ldk + kgo[i_]); } while (0)
#define GLV(k0) do { _Pragma("unroll") for (int i_ = 0; i_ < VPT; ++i_) if (vok[i_]) st_.vs[i_] = *reinterpret_cast<const bf16x8*>(Vh + (long)(k0) * ldv + vgo[i_]); } while (0)
#define WRK(off) do { _Pragma("unroll") for (int i_ = 0; i_ < KPT; ++i_) if (kok[i_]) *(ALAS bf16x8*)(K_lds + (off) + klo[i_]) = st_.ks[i_]; } while (0)
#define WRV(off) do { _Pragma("unroll") for (int i_ = 0; i_ < VPT; ++i_) if (vok[i_]) *(ALAS bf16x8*)(V_lds + (off) + vlo[i_]) = st_.vs[i_]; } while (0)
#define ROT3(x, S) ((x) == 2 * (S) ? 0 : (x) + (S))
    GLK(0); GLV(0); asm volatile("s_waitcnt vmcnt(0)" ::: "memory"); WRK(0); WRV(0);
    GLK(KVBLK); asm volatile("s_waitcnt vmcnt(0)" ::: "memory"); WRK(SHM_K);
    if (2 < NT) GLK(2 * KVBLK);
    GLV(KVBLK);
    __syncthreads();
    int kr = 0, vr = 0, kw = 2 * SHM_K, vw = SHM_V;
#define STEP3(PC0, PC1, PP0, PP1, t, HASPREV) do { \
      SBAR(); qkt<DK>(PC0, PC1, K_lds + kr, qr, r32, hi); \
      if (HASPREV) { finishSM(PP0, PP1, l_reg, pa0, pa1, pa2, pa3, negb_, use_shift); SBAR(); pv_all<NB>(o, vb0 + vr, pa0, pa1, pa2, pa3); vr = ROT3(vr, SHM_V); } \
      expHalf(PC0, negb_, use_shift); \
      asm volatile("s_waitcnt vmcnt(0)" ::: "memory"); \
      if ((t) + 2 < NT) WRK(kw); if ((t) + 1 < NT) WRV(vw); \
      if ((t) + 3 < NT) GLK(((t) + 3) * KVBLK); if ((t) + 2 < NT) GLV(((t) + 2) * KVBLK); \
      kr = ROT3(kr, SHM_K); kw = ROT3(kw, SHM_K); vw = ROT3(vw, SHM_V); \
      __syncthreads(); } while (0)
    STEP3(pA0, pA1, pB0, pB1, 0, false);
    for (int t = 1; t + 1 < NT; t += 2) {
      STEP3(pB0, pB1, pA0, pA1, t, true);
      STEP3(pA0, pA1, pB0, pB1, t + 1, true);
    }
    STEP3(pB0, pB1, pA0, pA1, NT - 1, true);
    finishSM(pB0, pB1, l_reg, pa0, pa1, pa2, pa3, negb_, use_shift); SBAR();
    pv_all<NB>(o, vb0 + vr, pa0, pa1, pa2, pa3);
#undef GLK
#undef GLV
#undef WRK
#undef WRV
#undef ROT3
#undef STEP3
  } else {
  f32x16 pA0, pA1, pB0, pB1;
  constexpr int SE = 0, SO = SDEPTH - 1;
  SLOAD(SE, 0); asm volatile("s_waitcnt vmcnt(0)" ::: "memory"); SWRITE(0, SE); __syncthreads();
  qkt<DK>(pA0, pA1, K_lds, qr, r32, hi); expHalf(pA0, negb_, use_shift);
  SLOAD(SO, KVBLK); if constexpr (SDEPTH == 2) { if (2 < NT) SLOAD(SE, 2 * KVBLK); }
  SWAIT(); SWRITE(1, SO); __syncthreads();
  for (int j = 1; j + 1 < NT; j += 2) {
    SBAR(); qkt<DK>(pB0, pB1, K_lds + SHM_K, qr, r32, hi);
    finishSM(pA0, pA1, l_reg, pa0, pa1, pa2, pa3, negb_, use_shift); SBAR();
    SLOAD(SO, (j + SDEPTH) * KVBLK); SBAR();
    pv_all<NB>(o, vb0, pa0, pa1, pa2, pa3); expHalf(pB0, negb_, use_shift);
    __syncthreads(); SWAIT(); SWRITE(0, SE);
    __syncthreads();
    SBAR(); qkt<DK>(pA0, pA1, K_lds, qr, r32, hi);
    finishSM(pB0, pB1, l_reg, pa0, pa1, pa2, pa3, negb_, use_shift); SBAR();
    if (SDEPTH == 1 || j + 3 < NT) SLOAD(SE, (j + 1 + SDEPTH) * KVBLK); SBAR();
    pv_all<NB>(o, vb0 + SHM_V, pa0, pa1, pa2, pa3); expHalf(pA0, negb_, use_shift);
    __syncthreads(); SWAIT(); SWRITE(1, SO);
    __syncthreads();
  }
  SBAR(); qkt<DK>(pB0, pB1, K_lds + SHM_K, qr, r32, hi);
  finishSM(pA0, pA1, l_reg, pa0, pa1, pa2, pa3, negb_, use_shift); SBAR();
  pv_all<NB>(o, vb0, pa0, pa1, pa2, pa3); expHalf(pB0, negb_, use_shift);
  finishSM(pB0, pB1, l_reg, pa0, pa1, pa2, pa3, negb_, use_shift); SBAR();
  pv_all<NB>(o, vb0 + SHM_V, pa0, pa1, pa2, pa3);
  }
  { auto rr = __builtin_amdgcn_permlane32_swap(__float_as_uint(l_reg), __float_as_uint(l_reg), false, false); l_reg = __uint_as_float(rr[0]) + __uint_as_float(rr[1]); }
  if (hi == 0) li_l[r32] = l_reg; asm volatile("s_waitcnt lgkmcnt(0)" ::: "memory");
  float rli[16];
#pragma unroll
  for (int r = 0; r < 16; ++r) rli[r] = __builtin_amdgcn_rcpf(li_l[crow(r, hi)]) * omul;
  bf16_t* Ow = Ob + (long)(wid * QBLK) * ldo;
  if constexpr (DIFF2) {
    const bf16_t* O1w = de->O1 + (long)(wid * QBLK) * de->ldo1;
    float gcol[NB];
    int ly_ = de->layer; asm volatile("" : "+s"(ly_));
    const float post_ = (ly_ == 0) ? 0.8f : (1.0f - (0.8f - 0.6f * 0.74081822068171788f));
#pragma unroll
    for (int d0 = 0; d0 < NB; ++d0) gcol[d0] = de->g[d0 * 32 + r32] * post_;
#pragma unroll
    for (int r = 0; r < 16; ++r) { const int orow = crow(r, hi); float d[NB]; float ss = 0.f;
#pragma unroll
      for (int d0 = 0; d0 < NB; ++d0) { const float o1 = __uint_as_float((unsigned)O1w[(long)orow * de->ldo1 + d0 * 32 + r32] << 16); d[d0] = o1 - de->lam * (o[d0][r] * rli[r]); ss += d[d0] * d[d0]; }
      ss += __int_as_float(__builtin_amdgcn_ds_swizzle(__float_as_int(ss), (1 << 10) | 0x1f)); ss += __int_as_float(__builtin_amdgcn_ds_swizzle(__float_as_int(ss), (2 << 10) | 0x1f));
      ss += __int_as_float(__builtin_amdgcn_ds_swizzle(__float_as_int(ss), (4 << 10) | 0x1f)); ss += __int_as_float(__builtin_amdgcn_ds_swizzle(__float_as_int(ss), (8 << 10) | 0x1f));
      ss += __int_as_float(__builtin_amdgcn_ds_swizzle(__float_as_int(ss), (16 << 10) | 0x1f));
      const float rstd = __builtin_amdgcn_rsqf(ss * (1.f / 128.f) + 1e-6f);
#pragma unroll
      for (int d0 = 0; d0 < NB; ++d0) { const float v = d[d0] * rstd * gcol[d0]; Ow[(long)orow * ldo + d0 * 32 + r32] = (bf16_t)(cvtpk(v, v) & 0xffffu); } }
  } else {
#pragma unroll
  for (int r = 0; r < 16; ++r) { const int orow = crow(r, hi);
#pragma unroll
    for (int d0 = 0; d0 < NB; ++d0) { const float v = o[d0][r] * rli[r]; Ow[(long)orow * ldo + d0 * 32 + r32] = (bf16_t)(cvtpk(v, v) & 0xffffu); } }
  }
  __syncthreads();
#undef SLOAD
#undef SWRITE
#undef SWAIT
}
template <int DK> __device__ __forceinline__ void qkt2(f32x16 (&p)[2][2], const ALAS char* Ks, const bf16x8 (&qr)[2][DK / 16], int r32, int hi) {
  constexpr int ND = DK / 16, BT = QK2_BT < ND ? QK2_BT : ND;
  p[0][0] = f32x16{}; p[0][1] = f32x16{}; p[1][0] = f32x16{}; p[1][1] = f32x16{};
#pragma unroll
  for (int b0 = 0; b0 < ND; b0 += BT) {
    bf16x8 k0[BT], k1[BT];
#pragma unroll
    for (int i = 0; i < BT; ++i) { const int cb = ((b0 + i) * 16 + hi * 8) * 2;
      k0[i] = *(const ALAS bf16x8*)(Ks + KSWZ(r32, cb)); k1[i] = *(const ALAS bf16x8*)(Ks + KSWZ(32 + r32, cb)); }
    SBAR();
#pragma unroll
    for (int i = 0; i < BT; ++i) {
      p[0][0] = __builtin_amdgcn_mfma_f32_32x32x16_bf16(k0[i], qr[0][b0 + i], p[0][0], 0, 0, 0);
      p[1][0] = __builtin_amdgcn_mfma_f32_32x32x16_bf16(k0[i], qr[1][b0 + i], p[1][0], 0, 0, 0);
      p[0][1] = __builtin_amdgcn_mfma_f32_32x32x16_bf16(k1[i], qr[0][b0 + i], p[0][1], 0, 0, 0);
      p[1][1] = __builtin_amdgcn_mfma_f32_32x32x16_bf16(k1[i], qr[1][b0 + i], p[1][1], 0, 0, 0); }
    SBAR();
  }
}
template <int NB, int D0> __device__ __forceinline__ void pv_one2(f32x16& oa, f32x16& ob, int vb, const bf16x8 (&pa)[2][4]) {
#define VOFF(ks, half) (D0 * 512 + (ks) * (1024 * NB) + (half) * (512 * NB))
  const s16x4 l0 = tr_read<VOFF(0, 0)>(vb), h0 = tr_read<VOFF(0, 1)>(vb), l1 = tr_read<VOFF(1, 0)>(vb), h1 = tr_read<VOFF(1, 1)>(vb);
  const s16x4 l2 = tr_read<VOFF(2, 0)>(vb), h2 = tr_read<VOFF(2, 1)>(vb), l3 = tr_read<VOFF(3, 0)>(vb), h3 = tr_read<VOFF(3, 1)>(vb);
#undef VOFF
  asm volatile("s_waitcnt lgkmcnt(0)" ::: "memory"); SBAR();
#define PK(L, H) (bf16x8){L[0], L[1], L[2], L[3], H[0], H[1], H[2], H[3]}
  oa = __builtin_amdgcn_mfma_f32_32x32x16_bf16(pa[0][0], PK(l0, h0), oa, 0, 0, 0);
  ob = __builtin_amdgcn_mfma_f32_32x32x16_bf16(pa[1][0], PK(l0, h0), ob, 0, 0, 0);
  oa = __builtin_amdgcn_mfma_f32_32x32x16_bf16(pa[0][1], PK(l1, h1), oa, 0, 0, 0);
  ob = __builtin_amdgcn_mfma_f32_32x32x16_bf16(pa[1][1], PK(l1, h1), ob, 0, 0, 0);
  oa = __builtin_amdgcn_mfma_f32_32x32x16_bf16(pa[0][2], PK(l2, h2), oa, 0, 0, 0);
  ob = __builtin_amdgcn_mfma_f32_32x32x16_bf16(pa[1][2], PK(l2, h2), ob, 0, 0, 0);
  oa = __builtin_amdgcn_mfma_f32_32x32x16_bf16(pa[0][3], PK(l3, h3), oa, 0, 0, 0);
  ob = __builtin_amdgcn_mfma_f32_32x32x16_bf16(pa[1][3], PK(l3, h3), ob, 0, 0, 0);
#undef PK
}
template <int DK, int QMODE, bool SHAREK = true>
__device__ __forceinline__ void attn_unit2(const bf16_t* Qb, int ldq, const bf16_t* __restrict__ Kh, int ldk, const bf16_t* __restrict__ Vh, int ldv,
                                           bf16_t* Ob, int ldo, int nkeys, float qscale, float negb_, const QPrep& qp, ALAS char* lds, int wave0) {
  constexpr int DV = 64, NB = 2, KC = DK / 8, VC = DV / 8;
  constexpr int NKC = 64 * KC, NVC = 64 * VC, KPT = (NKC + 511) / 512, VPT = (NVC + 511) / 512;
  constexpr int SHM_V = KVBLK * DV * 2, SHM_K = 16384;
  int tid; asm volatile("v_mbcnt_lo_u32_b32 %0, -1, 0\n\tv_mbcnt_hi_u32_b32 %0, -1, %0" : "=v"(tid)); tid = (tid + wave0 * 64) & 511;
  const int wid = tid >> 6, lane = tid & 63, r32 = lane & 31, hi = lane >> 5;
  ALAS char* V_lds = lds + LDS_V; ALAS char* K_lds = lds + LDS_K;
  ALAS float* ws = (ALAS float*)(lds + LDS_WS) + wid * 64;
  const bool use_shift = negb_ < -60.f;
  float l_reg[2] = {0.f, 0.f}; f32x16 o[2][NB]; bf16x8 qr[2][DK / 16];
  { QPrep q2 = qp;
    load_q<DK, QMODE>(qr[0], Qb + (long)(wid * QBLK + r32) * ldq + hi * 8, q2, qscale, wid, r32, hi);
    SBAR();
    q2.pos0 = qp.pos0 + 256;
    load_q<DK, QMODE>(qr[1], Qb + (long)(256 + wid * QBLK + r32) * ldq + hi * 8, q2, qscale, wid, r32, hi); }
  SBAR();
#pragma unroll
  for (int q = 0; q < 2; ++q)
#pragma unroll
    for (int d = 0; d < NB; ++d) o[q][d] = f32x16{};
  int kgo[KPT], klo[KPT], vgo[VPT], vlo[VPT]; bool kok[KPT], vok[VPT];
#pragma unroll
  for (int i = 0; i < KPT; ++i) { const int c = tid + 512 * i; kok[i] = (512 * (i + 1) <= NKC) || (c < NKC); const int row = c / KC, col = (c % KC) * 8; kgo[i] = row * ldk + col; klo[i] = KSWZ(row, col * 2); }
#pragma unroll
  for (int i = 0; i < VPT; ++i) { const int c = tid + 512 * i; vok[i] = (512 * (i + 1) <= NVC) || (c < NVC); const int row = c / VC, col = (c % VC) * 8; vgo[i] = row * ldv + col; vlo[i] = v_st<NB>(row, col); }
  const int vb0 = (int)(unsigned)(unsigned long)V_lds + v_rd_base(lane);
  struct { bf16x8 ks[KPT], vs[VPT]; } sr_;
#define SLOAD2(k0) do { _Pragma("unroll") for (int i_ = 0; i_ < KPT; ++i_) if (kok[i_]) sr_.ks[i_] = *reinterpret_cast<const bf16x8*>(Kh + (long)(k0) * ldk + kgo[i_]); \
    _Pragma("unroll") for (int i_ = 0; i_ < VPT; ++i_) if (vok[i_]) sr_.vs[i_] = *reinterpret_cast<const bf16x8*>(Vh + (long)(k0) * ldv + vgo[i_]); } while (0)
#define SWRITE2(b) do { _Pragma("unroll") for (int i_ = 0; i_ < KPT; ++i_) if (kok[i_]) *(ALAS bf16x8*)(K_lds + (b) * SHM_K + klo[i_]) = sr_.ks[i_]; \
    _Pragma("unroll") for (int i_ = 0; i_ < VPT; ++i_) if (vok[i_]) *(ALAS bf16x8*)(V_lds + (b) * SHM_V + vlo[i_]) = sr_.vs[i_]; } while (0)
  const int NT = nkeys / KVBLK;
  f32x16 p[2][2]; bf16x8 pa[2][4];
  SLOAD2(0); asm volatile("s_waitcnt vmcnt(0)" ::: "memory"); SWRITE2(0); __syncthreads();
  for (int j = 0; j < NT; ++j) {
    const int bsel = j & 1;
    if (j + 1 < NT) SLOAD2((j + 1) * KVBLK);
    if constexpr (SHAREK) {
      SBAR(); qkt2<DK>(p, K_lds + bsel * SHM_K, qr, r32, hi);
      expHalf(p[0][0], negb_, use_shift); finishSM(p[0][0], p[0][1], l_reg[0], pa[0][0], pa[0][1], pa[0][2], pa[0][3], negb_, use_shift);
      expHalf(p[1][0], negb_, use_shift); finishSM(p[1][0], p[1][1], l_reg[1], pa[1][0], pa[1][1], pa[1][2], pa[1][3], negb_, use_shift); SBAR();
    } else {
      SBAR(); qkt<DK>(p[0][0], p[0][1], K_lds + bsel * SHM_K, qr[0], r32, hi);
      expHalf(p[0][0], negb_, use_shift); finishSM(p[0][0], p[0][1], l_reg[0], pa[0][0], pa[0][1], pa[0][2], pa[0][3], negb_, use_shift); SBAR();
      qkt<DK>(p[0][0], p[0][1], K_lds + bsel * SHM_K, qr[1], r32, hi);
      expHalf(p[0][0], negb_, use_shift); finishSM(p[0][0], p[0][1], l_reg[1], pa[1][0], pa[1][1], pa[1][2], pa[1][3], negb_, use_shift); SBAR();
    }
    pv_one2<NB, 0>(o[0][0], o[1][0], vb0 + bsel * SHM_V, pa); pv_one2<NB, 1>(o[0][1], o[1][1], vb0 + bsel * SHM_V, pa);
    if (j + 1 < NT) { asm volatile("s_waitcnt vmcnt(0)" ::: "memory"); SWRITE2(bsel ^ 1); }
    __syncthreads();
  }
#pragma unroll
  for (int q = 0; q < 2; ++q) {
    float lq = l_reg[q];
    { auto rr = __builtin_amdgcn_permlane32_swap(__float_as_uint(lq), __float_as_uint(lq), false, false); lq = __uint_as_float(rr[0]) + __uint_as_float(rr[1]); }
    if (hi == 0) ws[q * 32 + r32] = lq;
  }
  asm volatile("s_waitcnt lgkmcnt(0)" ::: "memory");
#pragma unroll
  for (int q = 0; q < 2; ++q) {
    float rli[16];
#pragma unroll
    for (int r = 0; r < 16; ++r) rli[r] = __builtin_amdgcn_rcpf(ws[q * 32 + crow(r, hi)]);
    bf16_t* Ow = Ob + (long)(q * 256 + wid * QBLK) * ldo;
#pragma unroll
    for (int r = 0; r < 16; ++r) { const int orow = crow(r, hi);
#pragma unroll
      for (int d0 = 0; d0 < NB; ++d0) { const float v = o[q][d0][r] * rli[r]; Ow[(long)orow * ldo + d0 * 32 + r32] = (bf16_t)(cvtpk(v, v) & 0xffffu); } }
  }
  __syncthreads();
#undef SLOAD2
#undef SWRITE2
}
template <int DK, int QMODE, bool SHAREK = true>
__device__ __forceinline__ void attn_unit2d(const bf16_t* Qb, int ldq, const bf16_t* __restrict__ Kh, int ldk, const bf16_t* __restrict__ Vh, int ldv,
                                           bf16_t* Ob, int ldo, int nkeys, float qscale, float negb_, const QPrep& qp, ALAS char* lds, int wave0) {
  constexpr int DV = 64, NB = 2, KC = DK / 8, VC = DV / 8;
  constexpr int NKC = 64 * KC, NVC = 64 * VC, KPT = (NKC + 511) / 512, VPT = (NVC + 511) / 512;
  constexpr int SHM_V = KVBLK * DV * 2, SHM_K = 16384;
  int tid; asm volatile("v_mbcnt_lo_u32_b32 %0, -1, 0\n\tv_mbcnt_hi_u32_b32 %0, -1, %0" : "=v"(tid)); tid = (tid + wave0 * 64) & 511;
  const int wid = tid >> 6, lane = tid & 63, r32 = lane & 31, hi = lane >> 5;
  ALAS char* V_lds = lds + LDS_V; ALAS char* K_lds = lds + LDS_K;
  ALAS float* ws = (ALAS float*)(lds + LDS_WS) + wid * 64;
  const bool use_shift = negb_ < -60.f;
  float l_reg[2] = {0.f, 0.f}; f32x16 o[2][NB]; bf16x8 qr[2][DK / 16];
  { QPrep q2 = qp;
    load_q<DK, QMODE>(qr[0], Qb + (long)(wid * QBLK + r32) * ldq + hi * 8, q2, qscale, wid, r32, hi);
    SBAR();
    q2.pos0 = qp.pos0 + 256;
    load_q<DK, QMODE>(qr[1], Qb + (long)(256 + wid * QBLK + r32) * ldq + hi * 8, q2, qscale, wid, r32, hi); }
  SBAR();
#pragma unroll
  for (int q = 0; q < 2; ++q)
#pragma unroll
    for (int d = 0; d < NB; ++d) o[q][d] = f32x16{};
  const int widu = __builtin_amdgcn_readfirstlane(wid);
  constexpr int KINST = 2, VINST = (64 * DV * 2) / (512 * 16);
  int kg[KINST], vg[VINST]; bool kv_[KINST];
#pragma unroll
  for (int i = 0; i < KINST; ++i) { const int q = (i * 8 + wid) * 64 + lane, row = q >> 4, pos = q & 15, c = pos ^ KF(row); kv_[i] = c < KC; kg[i] = row * ldk + c * 8; }
#pragma unroll
  for (int i = 0; i < VINST; ++i) { const int q = (i * 8 + wid) * 64 + lane, o_ = q * 16, sub = o_ >> 9, e = (o_ & 511) >> 1, kk = (sub / NB) * 8 + (e >> 5), k = (kk & ~0xC) | ((kk & 4) << 1) | ((kk & 8) >> 1), c = (sub % NB) * 32 + (e & 31); vg[i] = k * ldv + c; }
  const int vb0 = (int)(unsigned)(unsigned long)V_lds + v_rd_base(lane);
#define DMA_KV(b, k0) do { \
    _Pragma("unroll") for (int i_ = 0; i_ < KINST; ++i_) if (kv_[i_]) __builtin_amdgcn_global_load_lds((const unsigned*)(Kh + (long)(k0) * ldk + kg[i_]), (ALAS unsigned*)(K_lds + (b) * SHM_K + (i_ * 8 + widu) * 1024), 16, 0, 0); \
    _Pragma("unroll") for (int i_ = 0; i_ < VINST; ++i_) __builtin_amdgcn_global_load_lds((const unsigned*)(Vh + (long)(k0) * ldv + vg[i_]), (ALAS unsigned*)(V_lds + (b) * SHM_V + (i_ * 8 + widu) * 1024), 16, 0, 0); } while (0)
  const int NT = nkeys / KVBLK;
  f32x16 p[2][2]; bf16x8 pa[2][4];
  DMA_KV(0, 0); asm volatile("s_waitcnt vmcnt(0)" ::: "memory"); __syncthreads();
  for (int j = 0; j < NT; ++j) {
    const int bsel = j & 1;
    if (j + 1 < NT) DMA_KV(bsel ^ 1, (j + 1) * KVBLK);
    if constexpr (SHAREK) {
      SBAR(); qkt2<DK>(p, K_lds + bsel * SHM_K, qr, r32, hi);
      expHalf(p[0][0], negb_, use_shift); finishSM(p[0][0], p[0][1], l_reg[0], pa[0][0], pa[0][1], pa[0][2], pa[0][3], negb_, use_shift);
      expHalf(p[1][0], negb_, use_shift); finishSM(p[1][0], p[1][1], l_reg[1], pa[1][0], pa[1][1], pa[1][2], pa[1][3], negb_, use_shift); SBAR();
    } else {
      SBAR(); qkt<DK>(p[0][0], p[0][1], K_lds + bsel * SHM_K, qr[0], r32, hi);
      expHalf(p[0][0], negb_, use_shift); finishSM(p[0][0], p[0][1], l_reg[0], pa[0][0], pa[0][1], pa[0][2], pa[0][3], negb_, use_shift); SBAR();
      qkt<DK>(p[0][0], p[0][1], K_lds + bsel * SHM_K, qr[1], r32, hi);
      expHalf(p[0][0], negb_, use_shift); finishSM(p[0][0], p[0][1], l_reg[1], pa[1][0], pa[1][1], pa[1][2], pa[1][3], negb_, use_shift); SBAR();
    }
    pv_one2<NB, 0>(o[0][0], o[1][0], vb0 + bsel * SHM_V, pa); pv_one2<NB, 1>(o[0][1], o[1][1], vb0 + bsel * SHM_V, pa);
    asm volatile("s_waitcnt vmcnt(0)" ::: "memory");
    __syncthreads();
  }
#pragma unroll
  for (int q = 0; q < 2; ++q) {
    float lq = l_reg[q];
    { auto rr = __builtin_amdgcn_permlane32_swap(__float_as_uint(lq), __float_as_uint(lq), false, false); lq = __uint_as_float(rr[0]) + __uint_as_float(rr[1]); }
    if (hi == 0) ws[q * 32 + r32] = lq;
  }
  asm volatile("s_waitcnt lgkmcnt(0)" ::: "memory");
#pragma unroll
  for (int q = 0; q < 2; ++q) {
    float rli[16];
#pragma unroll
    for (int r = 0; r < 16; ++r) rli[r] = __builtin_amdgcn_rcpf(ws[q * 32 + crow(r, hi)]);
    bf16_t* Ow = Ob + (long)(q * 256 + wid * QBLK) * ldo;
#pragma unroll
    for (int r = 0; r < 16; ++r) { const int orow = crow(r, hi);
#pragma unroll
      for (int d0 = 0; d0 < NB; ++d0) { const float v = o[q][d0][r] * rli[r]; Ow[(long)orow * ldo + d0 * 32 + r32] = (bf16_t)(cvtpk(v, v) & 0xffffu); } }
  }
  __syncthreads();
#undef DMA_KV
}
__device__ __forceinline__ void attn_unit_diff(const bf16_t* Qb, int ldq, const bf16_t* __restrict__ Kh, int ldk, const bf16_t* __restrict__ Vh, int ldv,
                                               bf16_t* Ob, int ldo, int nkeys, float qscale, float negb_, const QPrep& qp, ALAS char* lds, int wave0, float lam, const float* g, float post) {
  constexpr int DK = 64, DV = 128, NB = 4, KC = 16, VC = 16, KPT = 2, VPT = 2, SHM_V = KVBLK * DV * 2, SHM_K = 16384;
  int tid; asm volatile("v_mbcnt_lo_u32_b32 %0, -1, 0\n\tv_mbcnt_hi_u32_b32 %0, -1, %0" : "=v"(tid)); tid = (tid + wave0 * 64) & 511;
  const int wid = tid >> 6, lane = tid & 63, r32 = lane & 31, hi = lane >> 5;
  ALAS char* V_lds = lds + LDS_V; ALAS char* K_lds = lds + LDS_K;
  ALAS float* ws = (ALAS float*)(lds + LDS_WS) + wid * 64;
  const bool use_shift = negb_ < -60.f;
  float l_reg[2] = {0.f, 0.f}; f32x16 o[2][NB]; bf16x8 qr[2][DK / 16];
  load_q<DK, 1>(qr[0], Qb + (long)(wid * QBLK + r32) * ldq + hi * 8, qp, qscale, wid, r32, hi);
  SBAR();
  load_q<DK, 1>(qr[1], Qb + 64 + (long)(wid * QBLK + r32) * ldq + hi * 8, qp, qscale, wid, r32, hi);
  SBAR();
#pragma unroll
  for (int q = 0; q < 2; ++q)
#pragma unroll
    for (int d = 0; d < NB; ++d) o[q][d] = f32x16{};
  int kgo[KPT], klo[KPT], vgo[VPT], vlo[VPT];
#pragma unroll
  for (int i = 0; i < KPT; ++i) { const int c = tid + 512 * i; const int row = c / KC, col = (c % KC) * 8; kgo[i] = row * ldk + col; klo[i] = KSWZ(row, col * 2); }
#pragma unroll
  for (int i = 0; i < VPT; ++i) { const int c = tid + 512 * i; const int row = c / VC, col = (c % VC) * 8; vgo[i] = row * ldv + col; vlo[i] = v_st<NB>(row, col); }
  const int vb0 = (int)(unsigned)(unsigned long)V_lds + v_rd_base(lane);
  struct { bf16x8 ks[KPT], vs[VPT]; } sr_;
#define SLOADD(k0) do { _Pragma("unroll") for (int i_ = 0; i_ < KPT; ++i_) sr_.ks[i_] = *reinterpret_cast<const bf16x8*>(Kh + (long)(k0) * ldk + kgo[i_]); \
    _Pragma("unroll") for (int i_ = 0; i_ < VPT; ++i_) sr_.vs[i_] = *reinterpret_cast<const bf16x8*>(Vh + (long)(k0) * ldv + vgo[i_]); } while (0)
#define SWRITED(b) do { _Pragma("unroll") for (int i_ = 0; i_ < KPT; ++i_) *(ALAS bf16x8*)(K_lds + (b) * SHM_K + klo[i_]) = sr_.ks[i_]; \
    _Pragma("unroll") for (int i_ = 0; i_ < VPT; ++i_) *(ALAS bf16x8*)(V_lds + (b) * SHM_V + vlo[i_]) = sr_.vs[i_]; } while (0)
  const int NT = nkeys / KVBLK;
  f32x16 p0, p1; bf16x8 pa0, pa1, pa2, pa3;
  SLOADD(0); asm volatile("s_waitcnt vmcnt(0)" ::: "memory"); SWRITED(0); __syncthreads();
  for (int j = 0; j < NT; ++j) {
    const int bsel = j & 1;
    if (j + 1 < NT) SLOADD((j + 1) * KVBLK);
    SBAR(); qkt<DK, 0>(p0, p1, K_lds + bsel * SHM_K, qr[0], r32, hi); expHalf(p0, negb_, use_shift);
    finishSM(p0, p1, l_reg[0], pa0, pa1, pa2, pa3, negb_, use_shift); SBAR();
    pv_all<NB>(o[0], vb0 + bsel * SHM_V, pa0, pa1, pa2, pa3);
    SBAR(); qkt<DK, 128>(p0, p1, K_lds + bsel * SHM_K, qr[1], r32, hi); expHalf(p0, negb_, use_shift);
    finishSM(p0, p1, l_reg[1], pa0, pa1, pa2, pa3, negb_, use_shift); SBAR();
    pv_all<NB>(o[1], vb0 + bsel * SHM_V, pa0, pa1, pa2, pa3);
    if (j + 1 < NT) { asm volatile("s_waitcnt vmcnt(0)" ::: "memory"); SWRITED(bsel ^ 1); }
    __syncthreads();
  }
#pragma unroll
  for (int q = 0; q < 2; ++q) { float lq = l_reg[q];
    { auto rr = __builtin_amdgcn_permlane32_swap(__float_as_uint(lq), __float_as_uint(lq), false, false); lq = __uint_as_float(rr[0]) + __uint_as_float(rr[1]); }
    if (hi == 0) ws[q * 32 + r32] = lq; }
  asm volatile("s_waitcnt lgkmcnt(0)" ::: "memory");
  float gcol[NB];
#pragma unroll
  for (int d0 = 0; d0 < NB; ++d0) gcol[d0] = g[d0 * 32 + r32] * post;
  bf16_t* Ow = Ob + (long)(wid * QBLK) * ldo;
#pragma unroll
  for (int r = 0; r < 16; ++r) { const int orow = crow(r, hi); const float r1 = __builtin_amdgcn_rcpf(ws[crow(r, hi)]), r2 = __builtin_amdgcn_rcpf(ws[32 + crow(r, hi)]) * lam; float d[NB]; float ss = 0.f;
#pragma unroll
    for (int d0 = 0; d0 < NB; ++d0) { d[d0] = o[0][d0][r] * r1 - o[1][d0][r] * r2; ss += d[d0] * d[d0]; }
    ss += __int_as_float(__builtin_amdgcn_ds_swizzle(__float_as_int(ss), (1 << 10) | 0x1f)); ss += __int_as_float(__builtin_amdgcn_ds_swizzle(__float_as_int(ss), (2 << 10) | 0x1f));
    ss += __int_as_float(__builtin_amdgcn_ds_swizzle(__float_as_int(ss), (4 << 10) | 0x1f)); ss += __int_as_float(__builtin_amdgcn_ds_swizzle(__float_as_int(ss), (8 << 10) | 0x1f));
    ss += __int_as_float(__builtin_amdgcn_ds_swizzle(__float_as_int(ss), (16 << 10) | 0x1f));
    const float rstd = __builtin_amdgcn_rsqf(ss * (1.f / 128.f) + 1e-6f);
#pragma unroll
    for (int d0 = 0; d0 < NB; ++d0) { const float v = d[d0] * rstd * gcol[d0]; Ow[(long)orow * ldo + d0 * 32 + r32] = (bf16_t)(cvtpk(v, v) & 0xffffu); } }
  __syncthreads();
#undef SLOADD
#undef SWRITED
}
#undef KSWZ
#undef KF
#undef SBAR
}
#define GAS __attribute__((address_space(1)))
#define LAS __attribute__((address_space(3)))
typedef unsigned short bf16;
typedef unsigned v4u __attribute__((ext_vector_type(4)));
typedef unsigned v2u __attribute__((ext_vector_type(2)));
typedef float f32x4 __attribute__((ext_vector_type(4)));
typedef float f32x2 __attribute__((ext_vector_type(2)));
typedef GAS unsigned gu32;
#define RLX_AGENT __ATOMIC_RELAXED, __HIP_MEMORY_SCOPE_AGENT
#define LDS_WAIT() asm volatile("s_waitcnt lgkmcnt(0)" ::: "memory")
#define VM_WAIT() asm volatile("s_waitcnt vmcnt(0)" ::: "memory")
__device__ __forceinline__ unsigned f2bf(float f) { unsigned u = __builtin_bit_cast(unsigned, f); return (u + 0x7fffu + ((u >> 16) & 1u)) >> 16; }
__device__ __forceinline__ unsigned pk2(float lo, float hi) { return pg8::cvt_pk_bf16(lo, hi); }
__device__ __forceinline__ float bflo(unsigned w) { return __uint_as_float(w << 16); }
__device__ __forceinline__ float bfhi(unsigned w) { return __uint_as_float(w & 0xffff0000u); }

__device__ __forceinline__ int lane_id() { int l; asm volatile("v_mbcnt_lo_u32_b32 %0, -1, 0\n\tv_mbcnt_hi_u32_b32 %0, -1, %0" : "=v"(l)); return l; }

#define XB_TMO      128
#define XB_XCNT(j)  (256  + 64 * (j))
#define XB_XSUB(j)  (1280 + 64 * (j))
#define XB_XGEN(j)  (2304 + 64 * (j))
#define XB_TOP      3328
#define XB_TOPGEN   3392
#define XCD_BAR_WORDS 3456
#define XB_SPIN_CAP (1u << 18)

__device__ __forceinline__ unsigned xb_ld(unsigned* p)              { return __hip_atomic_load(p, __ATOMIC_RELAXED, __HIP_MEMORY_SCOPE_AGENT); }
__device__ __forceinline__ unsigned xb_add(unsigned* p, unsigned v) { return __hip_atomic_fetch_add(p, v, __ATOMIC_RELAXED, __HIP_MEMORY_SCOPE_AGENT); }
__device__ __forceinline__ unsigned xb_xcc_id() { return (unsigned)__builtin_amdgcn_s_getreg((3 << 11) | 20) & 0xFu; }
#define XB_SPIN(cond, bar) do { unsigned _sp = 0; while (cond) { __builtin_amdgcn_s_sleep(1); \
    if ((++_sp & 255u) == 0u) { if (xb_ld(&(bar)[XB_TMO])) break; if (_sp > XB_SPIN_CAP) { atomicAdd(&(bar)[XB_TMO], 1u); break; } } } } while (0)

struct XcdBarrier {
    unsigned* bar; unsigned x;
    volatile LAS unsigned* st;
};
__device__ __forceinline__ XcdBarrier xcd_barrier_post(unsigned* bar, volatile LAS unsigned* st, int wave0) {
    XcdBarrier b; b.bar = bar; b.x = xb_xcc_id(); b.st = st;
    if (wave0 == 0 && lane_id() == 0) (void)xb_add(&bar[XB_XCNT(b.x)], 1u);
    return b;
}
__device__ __forceinline__ void xcd_barrier_complete(unsigned* bar, unsigned x, unsigned& nloc, unsigned& nx) {
    const unsigned G = gridDim.x * gridDim.y * gridDim.z;
    unsigned sum, cnt, mine, sp = 0u;
    for (;;) {
        sum = 0u; cnt = 0u; mine = 0u;
#pragma unroll
        for (unsigned j = 0; j < 16; ++j) { const unsigned c = xb_ld(&bar[XB_XCNT(j)]); sum += c; cnt += (c > 0u) ? 1u : 0u; mine = (j == x) ? c : mine; }
        if (sum == G) break;
        __builtin_amdgcn_s_sleep(1);
        if ((++sp & 255u) == 0u) { if (xb_ld(&bar[XB_TMO])) break; if (sp > XB_SPIN_CAP) { atomicAdd(&bar[XB_TMO], 1u); break; } }
    }
    nloc = mine > 0u ? mine : 1u; nx = cnt > 0u ? cnt : 1u;
}
__device__ __forceinline__ void xcd_barrier(const XcdBarrier& b, int wave0) {
    asm volatile("s_waitcnt vmcnt(0)" ::: "memory");
    __syncthreads();
    if (wave0 == 0 && lane_id() == 0) {
        unsigned* bar = b.bar;
        __builtin_amdgcn_s_waitcnt(0);
        unsigned nloc = b.st[0], nx = b.st[1];
        if (nloc == 0u) { xcd_barrier_complete(bar, b.x, nloc, nx); b.st[0] = nloc; b.st[1] = nx; }
        const unsigned old = xb_add(&bar[XB_XSUB(b.x)], 1u);
        const unsigned gen = old / nloc;
        if (old + 1u == (gen + 1u) * nloc) {
            __builtin_amdgcn_fence(__ATOMIC_RELEASE, "agent");
            asm volatile("s_waitcnt vmcnt(0)" ::: "memory");
            const unsigned og = xb_add(&bar[XB_TOP], 1u);
            const unsigned tg = og / nx;
            if (og + 1u == (tg + 1u) * nx) xb_add(&bar[XB_TOPGEN], 1u);
            else XB_SPIN(xb_ld(&bar[XB_TOPGEN]) == tg, bar);
            __builtin_amdgcn_fence(__ATOMIC_ACQUIRE, "agent");
            xb_add(&bar[XB_XGEN(b.x)], 1u);
            asm volatile("s_waitcnt vmcnt(0)" ::: "memory");
        } else {
            XB_SPIN(xb_ld(&bar[XB_XGEN(b.x)]) == gen, bar);
            __builtin_amdgcn_fence(__ATOMIC_ACQUIRE, "agent");
            asm volatile("s_waitcnt vmcnt(0)" ::: "memory");
        }
    }
    __syncthreads();
}

template <int CTRL> __device__ __forceinline__ float dpp_f(float v) { return __int_as_float(__builtin_amdgcn_update_dpp(0, __float_as_int(v), CTRL, 0xf, 0xf, true)); }
template <int CTRL> __device__ __forceinline__ int dpp_i(int v) { return __builtin_amdgcn_update_dpp(0, v, CTRL, 0xf, 0xf, true); }
template <int K> __device__ __forceinline__ float xshfl(float v) {
    static_assert(K == 1 || K == 2 || K == 4 || K == 8, "xshfl: K");
    if constexpr (K == 1) return dpp_f<0xB1>(v);
    else if constexpr (K == 2) return dpp_f<0x4E>(v);
    else if constexpr (K == 4) return dpp_f<0x1B>(dpp_f<0x141>(v));
    else return dpp_f<0x128>(v);
}
__device__ __forceinline__ float xshfl16(float v, int lane) { const auto rr = __builtin_amdgcn_permlane16_swap(__float_as_uint(v), __float_as_uint(v), false, false); return __uint_as_float((lane & 16) ? rr[0] : rr[1]); }
__device__ __forceinline__ float sum8(float v) { v += dpp_f<0xB1>(v); v += dpp_f<0x4E>(v); v += dpp_f<0x141>(v); return v; }
__device__ __forceinline__ float sum16(float v) { v = sum8(v); v += dpp_f<0x140>(v); return v; }
__device__ __forceinline__ float half_sum(float v) { v = sum16(v); const auto rr = __builtin_amdgcn_permlane16_swap(__float_as_uint(v), __float_as_uint(v), false, false); return __uint_as_float(rr[0]) + __uint_as_float(rr[1]); }
__device__ __forceinline__ float wave_sum(float v) {
    v = half_sum(v);
    const auto rr = __builtin_amdgcn_permlane32_swap(__float_as_uint(v), __float_as_uint(v), false, false);
    return __uint_as_float(rr[0]) + __uint_as_float(rr[1]);
}
__device__ __forceinline__ float wave_max(float v) {
    v = fmaxf(v, dpp_f<0xB1>(v)); v = fmaxf(v, dpp_f<0x4E>(v)); v = fmaxf(v, dpp_f<0x141>(v)); v = fmaxf(v, dpp_f<0x140>(v));
    { const auto rr = __builtin_amdgcn_permlane16_swap(__float_as_uint(v), __float_as_uint(v), false, false); v = fmaxf(__uint_as_float(rr[0]), __uint_as_float(rr[1])); }
    const auto rr = __builtin_amdgcn_permlane32_swap(__float_as_uint(v), __float_as_uint(v), false, false);
    return fmaxf(__uint_as_float(rr[0]), __uint_as_float(rr[1]));
}
__device__ __forceinline__ int wave_sum_i(int v) {
    v += dpp_i<0xB1>(v); v += dpp_i<0x4E>(v); v += dpp_i<0x141>(v); v += dpp_i<0x140>(v);
    { const auto rr = __builtin_amdgcn_permlane16_swap((unsigned)v, (unsigned)v, false, false); v = (int)(rr[0] + rr[1]); }
    const auto rr = __builtin_amdgcn_permlane32_swap((unsigned)v, (unsigned)v, false, false);
    return (int)(rr[0] + rr[1]);
}
__device__ __forceinline__ float xshfl32(float v, int hi) { const auto rr = __builtin_amdgcn_permlane32_swap(__float_as_uint(v), __float_as_uint(v), false, false); return __uint_as_float(hi ? rr[0] : rr[1]); }
constexpr float NEPS = 1e-6f;
template <int HW, int ROPE>
__device__ __forceinline__ unsigned head_norm_rope(unsigned w, const float* g, const float* cs0, const float* sn0, const float* cs1, const float* sn1, int lane) {
    const int j = (HW == 64) ? (lane & 31) : lane;
    float a = bflo(w), b = bfhi(w);
    float ss = a * a + b * b;
    ss = (HW == 64) ? half_sum(ss) : wave_sum(ss);
    const float rstd = __builtin_amdgcn_rsqf(ss * (1.f / HW) + NEPS);
    const f32x2 gg = *(const f32x2*)(g + 2 * j);
    a = a * rstd * gg.x; b = b * rstd * gg.y;
    if (ROPE == 1) {
        constexpr int HALF_ = HW / 2;
        const float pa = (HALF_ / 2 == 32) ? xshfl32(a, lane >> 5) : xshfl16(a, lane), pb = (HALF_ / 2 == 32) ? xshfl32(b, lane >> 5) : xshfl16(b, lane);
        const int e = 2 * j, f = e % HALF_; const bool first = e < HALF_;
        const f32x2 c = *(const f32x2*)(cs0 + f), s = *(const f32x2*)(sn0 + f);
        a = first ? (a * c.x - pa * s.x) : (a * c.x + pa * s.x);
        b = first ? (b * c.y - pb * s.y) : (b * c.y + pb * s.y);
    } else if (ROPE == 2) {
        const float pa = xshfl<8>(a), pb = xshfl<8>(b);
        const int e = (2 * j) & 31, f = e & 15; const bool first = e < 16; const bool blk1 = (2 * j) >= 32;
        const float* ct = blk1 ? cs1 : cs0; const float* st = blk1 ? sn1 : sn0;
        const f32x2 c = *(const f32x2*)(ct + f), s = *(const f32x2*)(st + f);
        a = first ? (a * c.x - pa * s.x) : (a * c.x + pa * s.x);
        b = first ? (b * c.y - pb * s.y) : (b * c.y + pb * s.y);
    }
    return pk2(a, b);
}
__device__ __forceinline__ unsigned mla_head(float a, float b, const float* g, const float* cs, const float* sn, int lane) {
    const float ss = wave_sum(a * a + b * b);
    const float rstd = __builtin_amdgcn_rsqf(ss * (1.f / 96.f) + NEPS);
    const int jj = lane < 48 ? lane : 0;
    const f32x2 gg = *(const f32x2*)(g + 2 * jj);
    a = a * rstd * gg.x; b = b * rstd * gg.y;
    const float pa = xshfl<8>(a), pb = xshfl<8>(b);
    if (lane >= 32 && lane < 48) {
        const int e = 2 * lane - 64, f = e & 15; const bool first = e < 16;
        const f32x2 c = *(const f32x2*)(cs + f), s = *(const f32x2*)(sn + f);
        a = first ? (a * c.x - pa * s.x) : (a * c.x + pa * s.x);
        b = first ? (b * c.y - pb * s.y) : (b * c.y + pb * s.y);
    }
    return pk2(a, b);
}

template <int HW, int ROPE>
__device__ __forceinline__ unsigned head_apply(unsigned w, f32x2 g2, f32x2 c2, f32x2 s2, int lane) {
    const int j = (HW == 64) ? (lane & 31) : lane;
    float a = bflo(w), b = bfhi(w);
    float ss = a * a + b * b;
    ss = (HW == 64) ? half_sum(ss) : wave_sum(ss);
    const float rstd = __builtin_amdgcn_rsqf(ss * (1.f / HW) + NEPS);
    a = a * rstd * g2.x; b = b * rstd * g2.y;
    if (ROPE == 1) {
        constexpr int HALF_ = HW / 2;
        const float pa = (HALF_ / 2 == 32) ? xshfl32(a, lane >> 5) : xshfl16(a, lane), pb = (HALF_ / 2 == 32) ? xshfl32(b, lane >> 5) : xshfl16(b, lane);
        const bool first = 2 * j < HALF_;
        a = first ? (a * c2.x - pa * s2.x) : (a * c2.x + pa * s2.x);
        b = first ? (b * c2.y - pb * s2.y) : (b * c2.y + pb * s2.y);
    } else if (ROPE == 2) {
        const float pa = xshfl<8>(a), pb = xshfl<8>(b);
        const bool first = ((2 * j) & 31) < 16;
        a = first ? (a * c2.x - pa * s2.x) : (a * c2.x + pa * s2.x);
        b = first ? (b * c2.y - pb * s2.y) : (b * c2.y + pb * s2.y);
    }
    return pk2(a, b);
}
__device__ __forceinline__ unsigned mla_apply(float a, float b, f32x2 g2, f32x2 c2, f32x2 s2, int lane) {
    const float ss = wave_sum(a * a + b * b);
    const float rstd = __builtin_amdgcn_rsqf(ss * (1.f / 96.f) + NEPS);
    a = a * rstd * g2.x; b = b * rstd * g2.y;
    const float pa = xshfl<8>(a), pb = xshfl<8>(b);
    if (lane >= 32 && lane < 48) {
        const bool first = (2 * lane - 64) < 16;
        a = first ? (a * c2.x - pa * s2.x) : (a * c2.x + pa * s2.x);
        b = first ? (b * c2.y - pb * s2.y) : (b * c2.y + pb * s2.y);
    }
    return pk2(a, b);
}
constexpr int NWAVES = 8;
constexpr int BATCH = 16, SEQ = 2048, DM = 1024, M = BATCH * SEQ, MEML = 256, MMEM = BATCH * MEML;
constexpr int FF = 3584, NEXP = 8, DEPTH = 2;
constexpr int RAWW = 3328;
constexpr int C_DQ = 0, C_DK = 512, C_DV = 1024, C_QLAT = 1536, C_KVLAT = 1792, C_KROPE = 1920, C_GQ = 2048, C_GK = 2560, C_GV = 2688, C_MEMQ = 2816;
constexpr int C_OA = 0, C_OB = 1536, C_OC = 2048, C_OD = 2816;
constexpr int MLAW = 1792;
enum { I_X = 0, I_MEM, I_NORM_ATTN_G, I_NORM_MEM_G, I_W_IN, I_DQ_G, I_DK_G, I_DLAMBDA, I_DSUBLN_G, I_MLA_QLAT_G, I_MLA_KVLAT_G, I_W_QUP, I_W_KVUP, I_MLA_Q_G, I_MLA_K_G,
       I_GQA_Q_G, I_GQA_K_G, I_W_MEMKV, I_MEM_Q_G, I_MEM_K_G, I_W_BRANCH, I_W_GATE, I_B_GATE, I_W_OUT, I_NORM_FFN_G, I_DW1, I_DW3, I_DW2, I_ROUTER, I_MW1, I_MW3, I_MW2, N_IN };
constexpr size_t MiB = 1u << 20;
constexpr size_t WS_CTL = 0, CTL_ZERO_BYTES = 64 * 1024;
constexpr size_t WS_TAB = 1 * MiB;
constexpr size_t T_DC = 0, T_DS = T_DC + 2048 * 32 * 4, T_MC = T_DS + 2048 * 32 * 4, T_MS = T_MC + 2048 * 16 * 4, T_QC = T_MS + 2048 * 16 * 4, T_QS = T_QC + 2048 * 64 * 4,
                 T_RC = T_QS + 2048 * 64 * 4, T_RS = T_RC + 32 * 16 * 4, T_CC = T_RS + 32 * 16 * 4, T_CS = T_CC + 64 * 16 * 4, T_END = T_CS + 64 * 16 * 4;
static_assert(T_END <= 2 * MiB, "tables");
constexpr size_t WS_MOE = 3 * MiB;
constexpr size_t WS_AW = 4 * MiB;
constexpr size_t AW_IN = 0, AW_GATE = AW_IN + (size_t)RAWW * DM * 2, AW_BR = AW_GATE + (size_t)4096 * DM * 2, AW_OUT = AW_BR + (size_t)4096 * 512 * 2,
                 AW_QUP = AW_OUT + (size_t)DM * DM * 2, AW_KVUP = AW_QUP + (size_t)768 * 256 * 2, AW_MEMKV = AW_KVUP + (size_t)1024 * 256 * 2, AW_END = AW_MEMKV + (size_t)DM * DM * 2;
static_assert(AW_END <= 32 * MiB, "attention weights");
constexpr size_t WS_HB = 36 * MiB;
constexpr size_t WS_RAW = 100 * MiB;
constexpr size_t WS_G = 308 * MiB;
constexpr size_t WS_MLARAW = 308 * MiB, WS_KMLA = 420 * MiB, WS_ODIFF = 468 * MiB, WS_LATN = 468 * MiB, WS_MEMKV = 532 * MiB, WS_MEMN = 540 * MiB;
constexpr size_t WS_FW = 100 * MiB;
constexpr size_t WS_U = 268 * MiB;
constexpr size_t WS_Y = 380 * MiB;
constexpr size_t WS_XS8 = 184 * MiB;
constexpr size_t WS_XB = 36 * MiB;
constexpr size_t WS_HBM8 = 512 * MiB, WS_TAILP = 544 * MiB;
constexpr size_t WS_HBA = 436 * MiB;
constexpr size_t WS_HBF = 121 * MiB;
constexpr size_t WS_MERGED = 436 * MiB;
constexpr size_t WS_HB8 = 564 * MiB;
constexpr size_t WS_END = 600 * MiB;
constexpr int CW_BAR = 4096;
constexpr int MOE_SLOTS = 2 * M + NEXP * 256;
constexpr size_t MO_SLOT_TOK = 0, MO_TOK_SLOT = 278528, MO_TOK_GATE = MO_TOK_SLOT + (size_t)M * 8, MO_WGCNT = MO_TOK_GATE + (size_t)M * 8, MO_END = MO_WGCNT + 256 * 8 * 4;
static_assert((size_t)MOE_SLOTS * 4 <= MO_TOK_SLOT && MO_END <= 1 * MiB, "MoE lists");
constexpr size_t EXPERT_BYTES = (size_t)3 * FF * DM, W2_OFF = (size_t)2 * FF * DM;
constexpr int MOE_CHUNK_TILES = 128;
constexpr float S_H8 = 16.f, S_W13 = 32.f, S_U8 = 4.f, S_W2 = 64.f, S_WG = 32.f;
constexpr int RING_OFF = 0, RING_BYTES = 131072;
constexpr int LDSCTL_OFF = RING_BYTES, MISC_OFF = LDSCTL_OFF + 320, PTAB_OFF = LDSCTL_OFF + 1024, MOE_LDS = LDSCTL_OFF + 2048;
constexpr int ML_SEL = 0, ML_RNK = 256, ML_CNT = 512, ML_TOT = 520, ML_PRE = 528, ML_SEGB = 536, ML_TE = 576;
constexpr int LDS_BYTES = 147456;
static_assert(att::LDS_BYTES <= RING_BYTES, "attention LDS");

struct Args { const float* in[N_IN]; float* out; unsigned char* ws; };
__device__ __forceinline__ unsigned char* launder(unsigned char* p) { GAS unsigned char* q = (GAS unsigned char*)p; asm volatile("" : "+s"(q)); return (unsigned char*)q; }
__device__ __forceinline__ const float* inp(LAS unsigned char* lds, int i) {
    const volatile LAS unsigned* p = (const volatile LAS unsigned*)(lds + PTAB_OFF) + 2 * i;
    const unsigned lo = __builtin_amdgcn_readfirstlane(p[0]), hi = __builtin_amdgcn_readfirstlane(p[1]);
    const GAS float* q = (const GAS float*)(((unsigned long long)hi << 32) | lo); asm volatile("" : "+s"(q)); return (const float*)q;
}
#define IN(i) inp(lds, (i))

__device__ __forceinline__ void transpose_item(const float* W, int ldw, int k0, int n0, bf16* WT, int ldk, int drow0, LAS float* scr, int lane) {
    f32x4 v[8];
#pragma unroll
    for (int i = 0; i < 8; ++i) v[i] = *(const GAS f32x4*)(W + (size_t)(k0 + 8 * i + (lane >> 3)) * ldw + n0 + 4 * (lane & 7));
#pragma unroll
    for (int i = 0; i < 8; ++i) { LAS float* d = scr + (8 * i + (lane >> 3)) * 33 + 4 * (lane & 7); d[0] = v[i].x; d[1] = v[i].y; d[2] = v[i].z; d[3] = v[i].w; }
    LDS_WAIT(); asm volatile("" ::: "memory");
    const int c = lane & 7;
#pragma unroll
    for (int j = 0; j < 4; ++j) { const int n = (lane >> 3) + 8 * j; const LAS float* s = scr + (8 * c) * 33 + n;
        v4u o; o.x = pk2(s[0 * 33], s[1 * 33]); o.y = pk2(s[2 * 33], s[3 * 33]); o.z = pk2(s[4 * 33], s[5 * 33]); o.w = pk2(s[6 * 33], s[7 * 33]);
        *(GAS v4u*)(WT + (size_t)(drow0 + n) * ldk + k0 + 8 * c) = o; }
    LDS_WAIT(); asm volatile("" ::: "memory");
}
__device__ __forceinline__ void plain_item(int r, const float* W, int K, int N, bf16* WT, int ldk, int drow_shift, LAS float* scr, int lane) {
    const int nbn = N / 32, kb = r / nbn, nb = r % nbn; transpose_item(W, N, 64 * kb, 32 * nb, WT, ldk, 32 * nb + drow_shift, scr, lane);
}
constexpr int FFN_ITEMS_13 = (DM / 64) * (FF / 32), FFN_ITEMS_2 = (FF / 64) * (DM / 32), FFN_ITEMS = 2 * FFN_ITEMS_13 + FFN_ITEMS_2;
__device__ __forceinline__ void ffn_weight_item(int it, const float* w1, const float* w3, const float* w2, bf16* W13t, bf16* W2t, LAS float* scr, int lane) {
    if (it < 2 * FFN_ITEMS_13) { const int which = it / FFN_ITEMS_13, r = it % FFN_ITEMS_13, kb = r / (FF / 32), nb = r % (FF / 32);
        transpose_item(which ? w3 : w1, FF, 64 * kb, 32 * nb, W13t, DM, (nb >> 2) * 256 + (nb & 3) * 32 + which * 128, scr, lane); }
    else { const int r = it - 2 * FFN_ITEMS_13, kb = r / (DM / 32), nb = r % (DM / 32); transpose_item(w2, DM, 64 * kb, 32 * nb, W2t, FF, 32 * nb, scr, lane); }
}
__device__ __forceinline__ void transpose_item8(const float* W, int ldw, int k0, int n0, unsigned char* WT, int ldk, int drow0, float scale, LAS float* scr, int lane) {
    f32x4 v[8];
#pragma unroll
    for (int i = 0; i < 8; ++i) v[i] = *(const GAS f32x4*)(W + (size_t)(k0 + 8 * i + (lane >> 3)) * ldw + n0 + 4 * (lane & 7));
#pragma unroll
    for (int i = 0; i < 8; ++i) { LAS float* d = scr + (8 * i + (lane >> 3)) * 33 + 4 * (lane & 7); d[0] = v[i].x * scale; d[1] = v[i].y * scale; d[2] = v[i].z * scale; d[3] = v[i].w * scale; }
    LDS_WAIT(); asm volatile("" ::: "memory");
    const int c = lane & 7;
#pragma unroll
    for (int j = 0; j < 4; ++j) { const int n = (lane >> 3) + 8 * j; const LAS float* s = scr + (8 * c) * 33 + n;
        v2u o; o.x = pg8::cvt4_fp8(s[0 * 33], s[1 * 33], s[2 * 33], s[3 * 33]); o.y = pg8::cvt4_fp8(s[4 * 33], s[5 * 33], s[6 * 33], s[7 * 33]);
        *(GAS v2u*)(WT + (size_t)(drow0 + n) * ldk + k0 + 8 * c) = o; }
    LDS_WAIT(); asm volatile("" ::: "memory");
}
__device__ __forceinline__ void ffn_weight_item8(int it, const float* w1, const float* w3, const float* w2, unsigned char* W13t, unsigned char* W2t, LAS float* scr, int lane) {
    if (it < 2 * FFN_ITEMS_13) { const int which = it / FFN_ITEMS_13, r = it % FFN_ITEMS_13, kb = r / (FF / 32), nb = r % (FF / 32);
        transpose_item8(which ? w3 : w1, FF, 64 * kb, 32 * nb, W13t, DM, (nb >> 2) * 256 + (nb & 3) * 32 + which * 128, S_W13, scr, lane); }
    else { const int r = it - 2 * FFN_ITEMS_13, kb = r / (DM / 32), nb = r % (DM / 32); transpose_item8(w2, DM, 64 * kb, 32 * nb, W2t, FF, 32 * nb, S_W2, scr, lane); }
}
constexpr int AI_IN = 16 * 101, AI_GATE = 4 * 16 * 32, AI_BR = 4 * 8 * 32, AI_OUT = 16 * 32, AI_QUP = 4 * 24, AI_KVUP = 2 * 32, AI_MEMKV = 16 * 32;
constexpr int AI_TOTAL = AI_IN + AI_GATE + AI_BR + AI_OUT + AI_QUP + AI_KVUP + AI_MEMKV;
__device__ __forceinline__ void attn_weight_item(int it, int l, LAS unsigned char* lds, unsigned char* aw, LAS float* scr, int lane) {
    int r = it;
    if (r < AI_IN) { const int kb = r / 101, nb = r % 101;
        transpose_item(IN(I_W_IN) + (size_t)l * DM * 3232, 3232, 64 * kb, 32 * nb, (bf16*)(aw + AW_IN), DM, 32 * nb + (nb >= 61 ? 96 : 0), scr, lane); return; } r -= AI_IN;
    if (r < AI_GATE) { const int b = r / 512, rr = r % 512, kb = rr / 32, nb = rr % 32;
        transpose_item8(IN(I_W_GATE) + ((size_t)l * 4 + b) * DM * DM, DM, 64 * kb, 32 * nb, aw + AW_GATE, DM, 32 * nb + b * 1024, S_WG, scr, lane); return; } r -= AI_GATE;
    if (r < AI_BR) { const int b = r / 256; plain_item(r % 256, IN(I_W_BRANCH) + ((size_t)l * 4 + b) * 512 * DM, 512, DM, (bf16*)(aw + AW_BR), 512, b * 1024, scr, lane); return; } r -= AI_BR;
    if (r < AI_OUT) { plain_item(r, IN(I_W_OUT) + (size_t)l * DM * DM, DM, DM, (bf16*)(aw + AW_OUT), DM, 0, scr, lane); return; } r -= AI_OUT;
    if (r < AI_QUP) { plain_item(r, IN(I_W_QUP) + (size_t)l * 256 * 768, 256, 768, (bf16*)(aw + AW_QUP), 256, 0, scr, lane); return; } r -= AI_QUP;
    if (r < AI_KVUP) { plain_item(r, IN(I_W_KVUP) + (size_t)l * 128 * 1024, 128, 1024, (bf16*)(aw + AW_KVUP), 256, 0, scr, lane); return; } r -= AI_KVUP;
    plain_item(r, IN(I_W_MEMKV) + (size_t)l * DM * DM, DM, DM, (bf16*)(aw + AW_MEMKV), DM, 0, scr, lane);
}
template <bool IN_BF> __device__ __forceinline__ f32x4 rr_load(const float* X, int m, int lane, int j) {
    if constexpr (IN_BF) { const v2u w = ((const GAS v2u*)((const bf16*)X + (size_t)m * DM) + lane)[64 * j]; return (f32x4){bflo(w.x), bfhi(w.x), bflo(w.y), bfhi(w.y)}; }
    else return ((const GAS f32x4*)(X + (size_t)m * DM) + lane)[64 * j];
}
template <bool F8COPY = false, bool BF = true, bool IN_BF = false>
__device__ __forceinline__ void rms_rows_to_bf16(const float* X, const float* g, bf16* O, int nrows, int gw, int NGW, int lane, unsigned char* O8 = nullptr, float s8 = 1.0f) {
    f32x4 gg[4];
#pragma unroll
    for (int j = 0; j < 4; ++j) gg[j] = ((const GAS f32x4*)g + lane)[64 * j];
    if (gw >= nrows) return;
    f32x4 cur[4], nxt[4];
#pragma unroll
    for (int j = 0; j < 4; ++j) { cur[j] = rr_load<IN_BF>(X, gw, lane, j); nxt[j] = cur[j]; }
    for (int m = gw; m < nrows; m += NGW) {
        const int mn = m + NGW;
        if (mn < nrows) {
#pragma unroll
            for (int j = 0; j < 4; ++j) nxt[j] = rr_load<IN_BF>(X, mn, lane, j);
        }
        float s = 0.f;
#pragma unroll
        for (int j = 0; j < 4; ++j) s += (cur[j].x * cur[j].x + cur[j].y * cur[j].y) + (cur[j].z * cur[j].z + cur[j].w * cur[j].w);
        const float rstd = __builtin_amdgcn_rsqf(wave_sum(s) * (1.f / DM) + NEPS);
        GAS unsigned long long* o8 = (GAS unsigned long long*)(O + (size_t)m * DM) + lane;
#pragma unroll
        for (int j = 0; j < 4; ++j) o8[64 * j] = (unsigned long long)pk2(cur[j].x * rstd * gg[j].x, cur[j].y * rstd * gg[j].y) | ((unsigned long long)pk2(cur[j].z * rstd * gg[j].z, cur[j].w * rstd * gg[j].w) << 32);
        if constexpr (F8COPY) { GAS unsigned* o4 = (GAS unsigned*)(O8 + (size_t)m * DM) + lane; const float r8 = rstd * s8;
#pragma unroll
            for (int j = 0; j < 4; ++j) o4[64 * j] = pg8::cvt4_fp8(cur[j].x * r8 * gg[j].x, cur[j].y * r8 * gg[j].y, cur[j].z * r8 * gg[j].z, cur[j].w * r8 * gg[j].w); }
#pragma unroll
        for (int j = 0; j < 4; ++j) cur[j] = nxt[j];
    }
}
__device__ __forceinline__ void rope_entry(int pos, int i, int dim, float* c, float* s) {
    const float e = (float)(2 * i) / (float)dim;
    const float inv = 1.0f / powf(10000.0f, e);
    const float ang = (float)pos * inv;
    const double ad = (double)ang, k = rint(ad * 0.15915494309189535), r = ad - k * 6.283185307179586;
    const float rf = (float)r;
    *c = cosf(rf); *s = sinf(rf);
}

struct UpOrder : pg8::StaticOrder {
    const bf16* wq; const bf16* wkv;
    __device__ __forceinline__ const char* a_ptr(const pg8::Gemm& g, const pg8::Unit& u) const { return (const char*)g.A + (size_t)u.pm * (256 * 2) * g.lda + (u.pn >= 3 ? 512 : 0); }
    __device__ __forceinline__ const char* b_ptr(const pg8::Gemm& g, const pg8::Unit& u) const { return u.pn >= 3 ? (const char*)wkv + (size_t)(u.pn - 3) * 256 * 256 * 2 : (const char*)wq + (size_t)u.pn * 256 * 256 * 2; }
};
struct MergeOrder : pg8::StaticOrder {
    __device__ __forceinline__ bool next(int i, pg8::Unit& u) const { if (!tile((long)(i >> 2) * G + c, u)) return false; u.z = i & 3; return true; }
    __device__ __forceinline__ const char* a_ptr(const pg8::Gemm& g, const pg8::Unit& u) const {
        const int co = u.z == 0 ? C_OA : u.z == 1 ? C_OB : u.z == 2 ? C_OC : C_OD; return (const char*)g.A + (size_t)u.pm * (256 * 2) * g.lda + co * 2; }
    __device__ __forceinline__ const char* b_ptr(const pg8::Gemm& g, const pg8::Unit& u) const { return (const char*)g.Bt + (size_t)(u.z * 1024 + u.pn * 256) * g.ldb * 2; }
};
struct MoeUpOrder : pg8::StaticOrder {
    const int* slot_tok; int tile0; const volatile LAS int* te; const char* wbase;
    __device__ __forceinline__ const char* a_ptr(const pg8::Gemm& g, const pg8::Unit&) const { return (const char*)g.A; }
    __device__ __forceinline__ const char* b_ptr(const pg8::Gemm& g, const pg8::Unit& u) const { const int e = __builtin_amdgcn_readfirstlane(te[tile0 + u.pm]); return wbase + (size_t)e * EXPERT_BYTES + (size_t)u.pn * (256 * 2) * g.ldb; }
    __device__ __forceinline__ unsigned row_off(const pg8::Gemm& g, const pg8::Unit& u, int row) const { return (unsigned)slot_tok[(tile0 + u.pm) * 256 + row] * (unsigned)(g.lda * 2); }
};
struct MoeDownOrder : pg8::StaticOrder {
    int tile0; const volatile LAS int* te; const char* wbase;
    __device__ __forceinline__ const char* b_ptr(const pg8::Gemm& g, const pg8::Unit& u) const { const int e = __builtin_amdgcn_readfirstlane(te[tile0 + u.pm]); return wbase + (size_t)e * EXPERT_BYTES + (size_t)u.pn * (256 * 2) * g.ldb; }
};
__device__ __forceinline__ float wave_max_abs(const float* g, int n, int lane) {
    float v = lane < n ? fabsf(g[lane]) : 0.f; if (lane + 64 < n) v = fmaxf(v, fabsf(g[lane + 64]));
    return wave_max(v);
}
__device__ __forceinline__ v2u tail_row(const float* P, int rows, int r, int q, float sc) {
    f32x4 s = *((const GAS f32x4*)(P + (size_t)r * DM) + q);
#pragma unroll
    for (int z = 1; z < 7; ++z) s += *((const GAS f32x4*)(P + ((size_t)z * rows + r) * DM) + q);
    v2u o; o.x = pk2(s.x * sc, s.y * sc); o.y = pk2(s.z * sc, s.w * sc); return o;
}
struct TailDownOrder : pg8::StaticOrder {
    const volatile LAS int* te; const char* wbase;
    __device__ __forceinline__ bool next(int i, pg8::Unit& u) const { const int L = i * G + c; if (L >= nwg * 7) return false; u.z = L % 7; const int t = L / 7; u.pn = __builtin_amdgcn_readfirstlane(t % nN); u.pm = __builtin_amdgcn_readfirstlane(t / nN); return true; }
    __device__ __forceinline__ const char* a_ptr(const pg8::Gemm& g, const pg8::Unit& u) const { return (const char*)g.A + (size_t)u.pm * (256 * 2) * g.lda + (size_t)u.z * 512; }
    __device__ __forceinline__ const char* b_ptr(const pg8::Gemm& g, const pg8::Unit& u) const { const int e = __builtin_amdgcn_readfirstlane(te[256 + u.pm]); return wbase + (size_t)e * EXPERT_BYTES + (size_t)u.pn * (256 * 2) * g.ldb + (size_t)u.z * 512; }
};
struct EpiPartF32 {
    static constexpr bool PERM = false;
    float* P; int rows;
    __device__ __forceinline__ bool keep(const pg8::Unit&) const { return false; }
    __device__ __forceinline__ void operator()(const pg8::f32x4 (&acc)[2][2][4][2], const pg8::Unit& u, int wr, int wc, int fr, int fq) const {
        const int row0 = u.pm * 256 + wr * 64 + fr, col0 = u.pn * 256 + wc * 32 + 4 * fq;
        GAS float* pb = (GAS float*)(P + ((size_t)u.z * rows + row0) * DM + col0);
#pragma unroll
        for (int ai = 0; ai < 2; ++ai)
#pragma unroll
            for (int m = 0; m < 4; ++m)
#pragma unroll
                for (int bj = 0; bj < 2; ++bj)
#pragma unroll
                    for (int n = 0; n < 2; ++n) *(GAS pg8::f32x4*)(pb + (size_t)(ai * 128 + m * 16) * DM + bj * 128 + n * 16) = acc[ai][bj][m][n];
    }
};
struct EpiMerge {
    static constexpr bool PERM = true;
    const unsigned char* Gq;
    bf16* Mg;
    __device__ __forceinline__ bool keep(const pg8::Unit& u) const { return u.z < 3; }
    __device__ __forceinline__ void operator()(pg8::f32x4 (&acc)[2][2][4][2], const pg8::Unit& u, int wr, int wc, int fr, int fq) const {
        const int row0 = u.pm * 256 + wr * 64 + fr, col0 = u.pn * 256 + wc * 32 + 8 * fq, z = u.z;
#pragma unroll
        for (int ai = 0; ai < 2; ++ai)
#pragma unroll
            for (int mp = 0; mp < 2; ++mp) {
                const GAS unsigned char* gb = (const GAS unsigned char*)(Gq + ((size_t)(u.pm * 16 + u.pn) << 16) + ((wr * 4 + wc) << 13) + (fq * 16 + fr) * 8);
                asm volatile("" : "+v"(gb));
                v2u gn[2][2], gd[2][2];
#pragma unroll
                for (int mm = 0; mm < 2; ++mm)
#pragma unroll
                    for (int bj = 0; bj < 2; ++bj) { const int m = 2 * mp + mm; const GAS unsigned char* gp = gb + (((ai * 4 + m) * 2 + bj) << 9);
                        gn[mm][bj] = *(const GAS v2u*)(gp + ((size_t)(z * 4) << 16)); if (z < 3) gd[mm][bj] = *(const GAS v2u*)(gp + ((size_t)(z * 4 + 4) << 16)); }
#pragma unroll
                for (int mm = 0; mm < 2; ++mm)
#pragma unroll
                    for (int bj = 0; bj < 2; ++bj) { const int m = 2 * mp + mm; const v2u g = gn[mm][bj];
                        float f[8];
#pragma unroll
                        for (int e = 0; e < 8; ++e) f[e] = (float)(((e < 4 ? g.x : g.y) >> (8 * (e & 3))) & 0xffu);
                        if (z < 3) { const v2u d = gd[mm][bj];
#pragma unroll
                            for (int e = 0; e < 8; ++e) f[e] *= __builtin_amdgcn_rcpf((float)(((e < 4 ? d.x : d.y) >> (8 * (e & 3))) & 0xffu)); }
                        else {
#pragma unroll
                            for (int e = 0; e < 8; ++e) f[e] *= (1.0f / 255.0f); }
                        pg8::f32x4& v0 = acc[ai][bj][m][0]; pg8::f32x4& v1 = acc[ai][bj][m][1];
                        v0[0] *= f[0]; v0[1] *= f[1]; v0[2] *= f[2]; v0[3] *= f[3]; v1[0] *= f[4]; v1[1] *= f[5]; v1[2] *= f[6]; v1[3] *= f[7];
                        if (z == 3) { v4u w; w.x = pg8::cvt_pk_bf16(v0[0], v0[1]); w.y = pg8::cvt_pk_bf16(v0[2], v0[3]); w.z = pg8::cvt_pk_bf16(v1[0], v1[1]); w.w = pg8::cvt_pk_bf16(v1[2], v1[3]);
                            *(GAS v4u*)(Mg + (size_t)(row0 + ai * 128 + m * 16) * 1024 + col0 + bj * 128) = w; } }
                asm volatile("" ::: "memory");
            }
    }
};

__global__ void __launch_bounds__(NWAVES * 64, 2) fwd(Args args) {
    extern __shared__ __attribute__((aligned(16))) unsigned char lds_raw[];
    LAS unsigned char* lds = (LAS unsigned char*)lds_raw;
    volatile LAS unsigned* MISC = (volatile LAS unsigned*)(lds + MISC_OFF);
    const int tid = threadIdx.x; const int wave0 = __builtin_amdgcn_readfirstlane(tid >> 6);
    constexpr int G = 256; const int bx = blockIdx.x; const int vcu = (bx % 8) * (G / 8) + bx / 8;
    unsigned char* ws = args.ws;
    gu32* ctl = (gu32*)(ws + WS_CTL);
    for (int u = tid; u < (LDS_BYTES - LDSCTL_OFF) / 4; u += NWAVES * 64) ((LAS unsigned*)(lds + LDSCTL_OFF))[u] = 0u;
    __syncthreads();
    XcdBarrier bar = xcd_barrier_post((unsigned*)(ctl + CW_BAR), MISC + 8, wave0);
    float* out = args.out;
    if (tid < N_IN) ((LAS unsigned long long*)(lds + PTAB_OFF))[tid] = (unsigned long long)args.in[tid];
    __syncthreads();
#define PHASE_PTRS unsigned char* wsp = launder(ws); int lane = lane_id(); asm volatile("" : "+v"(lane)); int wave = wave0; asm volatile("" : "+s"(wave)); \
    const int gw = vcu * NWAVES + wave, NGW = G * NWAVES; const int gt = gw * 64 + lane, NGT = NGW * 64; LAS float* scr = (LAS float*)(lds + RING_OFF + wave * 16384); \
    (void)gw; (void)NGW; (void)gt; (void)NGT; (void)scr; \
    bf16* HB = (bf16*)(wsp + WS_HB); bf16* RAW = (bf16*)(wsp + WS_RAW); bf16* GT = (bf16*)(wsp + WS_G); \
    bf16* MLARAW = (bf16*)(wsp + WS_MLARAW); bf16* KMLA = (bf16*)(wsp + WS_KMLA); bf16* ODIFF = (bf16*)(wsp + WS_ODIFF); bf16* LATN = (bf16*)(wsp + WS_LATN); \
    bf16* MEMKV = (bf16*)(wsp + WS_MEMKV); bf16* MEMN = (bf16*)(wsp + WS_MEMN); \
    bf16* W13t = (bf16*)(wsp + WS_FW); bf16* W2t = W13t + (size_t)2 * FF * DM; bf16* U = (bf16*)(wsp + WS_U); \
    unsigned char* aw = wsp + WS_AW; const float* tab = (const float*)(wsp + WS_TAB); \
    (void)HB; (void)RAW; (void)GT; (void)MLARAW; (void)KMLA; (void)ODIFF; (void)LATN; (void)MEMKV; (void)MEMN; (void)W13t; (void)W2t; (void)U; (void)aw; (void)tab

#pragma unroll 1
    for (int l = 0; l < DEPTH; ++l) {
        const float lambda_init = (l == 0) ? 0.2f : (0.8f - 0.6f * 0.74081822068171788f);
        {
            PHASE_PTRS;
            for (int it = gw; it < AI_TOTAL; it += NGW) attn_weight_item(it, l, lds, aw, scr, lane);
            unsigned zz_ = 0u; asm volatile("" : "+v"(zz_)); const v4u zero4 = {zz_, zz_, zz_, zz_};
            for (int c = gt; c < 96 * 128; c += NGT) *(GAS v4u*)(aw + AW_IN + (size_t)1952 * DM * 2 + (size_t)c * 16) = zero4;
            for (int c = gt; c < 1024 * 16; c += NGT) *(GAS v4u*)(aw + AW_KVUP + (size_t)(c >> 4) * 512 + 256 + (c & 15) * 16) = zero4;
            if (l == 0) rms_rows_to_bf16<true>(IN(I_X), IN(I_NORM_ATTN_G), (bf16*)(wsp + WS_HBA), M, gw, NGW, lane, wsp + WS_HB8, S_H8);
            else rms_rows_to_bf16<true, true, true>((const float*)(wsp + WS_XB), IN(I_NORM_ATTN_G) + DM, (bf16*)(wsp + WS_HBA), M, gw, NGW, lane, wsp + WS_HB8, S_H8);
            rms_rows_to_bf16(IN(I_MEM), IN(I_NORM_MEM_G) + l * DM, MEMN, MMEM, gw, NGW, lane);
            if (l == 0) {
                float* tw = (float*)(wsp + WS_TAB);
                for (int e = gt; e < 2048 * 32; e += NGT) rope_entry(e >> 5, e & 31, 64, tw + T_DC / 4 + e, tw + T_DS / 4 + e);
                for (int e = gt; e < 2048 * 16; e += NGT) rope_entry(e >> 4, e & 15, 32, tw + T_MC / 4 + e, tw + T_MS / 4 + e);
                for (int e = gt; e < 2048 * 64; e += NGT) rope_entry(e >> 6, e & 63, 128, tw + T_QC / 4 + e, tw + T_QS / 4 + e);
                for (int e = gt; e < 32 * 16; e += NGT) rope_entry(e >> 4, e & 15, 32, tw + T_RC / 4 + e, tw + T_RS / 4 + e);
                for (int e = gt; e < 64 * 16; e += NGT) rope_entry(e >> 4, e & 15, 32, tw + T_CC / 4 + e, tw + T_CS / 4 + e);
            }
        }
        xcd_barrier(bar, wave0);
        {
            PHASE_PTRS;
            pg8::Gemm g{(const bf16*)(wsp + WS_HBA), (const bf16*)(aw + AW_IN), DM, DM, DM}; pg8::StaticOrder S; S.init(M / 256, RAWW / 256, G, bx);
            pg8::EpiBf16 E{RAW, RAWW};
            pg8::gemm_phase<pg8::EpiBf16, pg8::StaticOrder, true, false>(lds + RING_OFF, g, S, E, wave0);
            pg8::Gemm g2{MEMN, (const bf16*)(aw + AW_MEMKV), DM, DM, DM}; pg8::StaticOrder S2; S2.init(MMEM / 256, DM / 256, G, (bx + G / 2) % G);
            pg8::EpiBf16 E2{MEMKV, DM};
            pg8::gemm_phase<pg8::EpiBf16, pg8::StaticOrder, true, false>(lds + RING_OFF, g2, S2, E2, wave0);
        }
        xcd_barrier(bar, wave0);
        {
            PHASE_PTRS;
            const int j32 = lane & 31, hh = lane >> 3, j8 = lane & 7;
            const f32x4 gdk0 = *(const GAS f32x4*)(IN(I_DK_G) + l * 64 + 4 * j8), gdk1 = *(const GAS f32x4*)(IN(I_DK_G) + l * 64 + 32 + 4 * j8);
            const f32x2 ggk = *((const f32x2*)(IN(I_GQA_K_G) + l * 64) + j32);
            const f32x2 gmk = *((const f32x2*)(IN(I_MEM_K_G) + l * 128) + lane);
            const f32x2 gql0 = *((const f32x2*)(IN(I_MLA_QLAT_G) + l * 256) + lane), gql1 = *((const f32x2*)(IN(I_MLA_QLAT_G) + l * 256 + 128) + lane), gkl = *((const f32x2*)(IN(I_MLA_KVLAT_G) + l * 128) + lane);
            const int fa = (2 * j32) & 15, fm = (2 * lane) & 63; const bool ablk1 = (2 * j32) >= 32;
#define T1_LOAD(K0_, K1_, W_, DC_, DS_, AC_, AS_, mm) do { const int pos_ = (mm) & (SEQ - 1), grow_ = pos_ >> 6, gcol_ = pos_ & 63; const GAS unsigned* rp_ = (const GAS unsigned*)(RAW + (size_t)(mm) * RAWW) + lane; \
                K0_ = *(const GAS v2u*)(RAW + (size_t)(mm) * RAWW + C_DK + 64 * hh + 4 * j8); K1_ = *(const GAS v2u*)(RAW + (size_t)(mm) * RAWW + C_DK + 64 * hh + 32 + 4 * j8); \
                W_[0] = rp_[64 * 12]; W_[1] = rp_[64 * 13]; W_[2] = rp_[64 * 14]; W_[3] = rp_[64 * 20]; \
                DC_ = *(const GAS f32x4*)(tab + T_DC / 4 + pos_ * 32 + 4 * j8); DS_ = *(const GAS f32x4*)(tab + T_DS / 4 + pos_ * 32 + 4 * j8); \
                AC_ = *(const GAS f32x2*)(tab + (ablk1 ? T_CC / 4 + gcol_ * 16 : T_RC / 4 + grow_ * 16) + fa); AS_ = *(const GAS f32x2*)(tab + (ablk1 ? T_CS / 4 + gcol_ * 16 : T_RS / 4 + grow_ * 16) + fa); } while (0)
            v2u k0, k1, k0n, k1n; unsigned w[4], wn[4]; f32x4 dc, ds, dcn, dsn; f32x2 ac, as, acn, asn;
            T1_LOAD(k0, k1, w, dc, ds, ac, as, gw);
            k0n = k0; k1n = k1; dcn = dc; dsn = ds; acn = ac; asn = as;
#pragma unroll
            for (int c = 0; c < 4; ++c) wn[c] = w[c];
            for (int m = gw; m < M; m += NGW) {
                if (m + NGW < M) { T1_LOAD(k0n, k1n, wn, dcn, dsn, acn, asn, m + NGW); }
                v2u o0, o1;
                { float a[4] = {bflo(k0.x), bfhi(k0.x), bflo(k0.y), bfhi(k0.y)}, b[4] = {bflo(k1.x), bfhi(k1.x), bflo(k1.y), bfhi(k1.y)};
                  float ss = 0.f;
#pragma unroll
                  for (int i = 0; i < 4; ++i) ss += a[i] * a[i] + b[i] * b[i];
                  const float rstd = __builtin_amdgcn_rsqf(sum8(ss) * (1.f / 64.f) + NEPS);
                  float y0[4], y1[4];
#pragma unroll
                  for (int i = 0; i < 4; ++i) { const float p = a[i] * rstd * gdk0[i], q = b[i] * rstd * gdk1[i]; y0[i] = p * dc[i] - q * ds[i]; y1[i] = q * dc[i] + p * ds[i]; }
                  o0.x = pk2(y0[0], y0[1]); o0.y = pk2(y0[2], y0[3]); o1.x = pk2(y1[0], y1[1]); o1.y = pk2(y1[2], y1[3]); }
                const unsigned wg = head_apply<64, 2>(w[3], ggk, ac, as, lane);
                unsigned l0, l1, l2;
                { const float a0 = bflo(w[0]), a1 = bfhi(w[0]), a2 = bflo(w[1]), a3 = bfhi(w[1]);
                  const float rstd = __builtin_amdgcn_rsqf(wave_sum(a0 * a0 + a1 * a1 + a2 * a2 + a3 * a3) * (1.f / 256.f) + NEPS);
                  l0 = pk2(a0 * rstd * gql0.x, a1 * rstd * gql0.y); l1 = pk2(a2 * rstd * gql1.x, a3 * rstd * gql1.y); }
                { const float a0 = bflo(w[2]), a1 = bfhi(w[2]);
                  const float rstd = __builtin_amdgcn_rsqf(wave_sum(a0 * a0 + a1 * a1) * (1.f / 128.f) + NEPS); l2 = pk2(a0 * rstd * gkl.x, a1 * rstd * gkl.y); }
                GAS bf16* kp = (GAS bf16*)(RAW + (size_t)m * RAWW + C_DK + 64 * hh + 4 * j8);
                *(GAS v2u*)kp = o0; *(GAS v2u*)(kp + 32) = o1;
                ((GAS unsigned*)(RAW + (size_t)m * RAWW) + lane)[64 * 20] = wg;
                GAS unsigned* lp = (GAS unsigned*)(LATN + (size_t)m * 512) + lane;
                lp[0] = l0; lp[64] = l1; lp[128] = l2; lp[192] = 0u;
                k0 = k0n; k1 = k1n; dc = dcn; ds = dsn; ac = acn; as = asn;
#pragma unroll
                for (int c = 0; c < 4; ++c) w[c] = wn[c];
            }
#undef T1_LOAD
            for (int m = gw; m < MMEM; m += NGW) {
                const int pos = m & (MEML - 1);
                GAS unsigned* kp = (GAS unsigned*)(MEMKV + (size_t)m * DM) + lane;
                unsigned w[4];
#pragma unroll
                for (int h = 0; h < 4; ++h) w[h] = kp[128 * h];
                const f32x2 qc = *(const GAS f32x2*)(tab + T_QC / 4 + pos * 64 + fm), qs = *(const GAS f32x2*)(tab + T_QS / 4 + pos * 64 + fm);
#pragma unroll
                for (int h = 0; h < 4; ++h) w[h] = head_apply<128, 1>(w[h], gmk, qc, qs, lane);
#pragma unroll
                for (int h = 0; h < 4; ++h) kp[128 * h] = w[h];
            }
        }
        xcd_barrier(bar, wave0);
        {
            PHASE_PTRS;
            pg8::Gemm g{LATN, nullptr, 512, 256, 256}; UpOrder S; S.init(M / 256, 7, G, bx); S.wq = (const bf16*)(aw + AW_QUP); S.wkv = (const bf16*)(aw + AW_KVUP);
            pg8::EpiBf16 E{MLARAW, MLAW};
            pg8::gemm_phase<pg8::EpiBf16, UpOrder, true, false>(lds + RING_OFF, g, S, E, wave0);
        }
        xcd_barrier(bar, wave0);
        {
            PHASE_PTRS;
            const int hh = lane >> 3, j = lane & 7;
            const float* gkp = IN(I_MLA_K_G) + l * 96;
            const f32x4 gn0 = *(const GAS f32x4*)(gkp + 8 * j), gn1 = *(const GAS f32x4*)(gkp + 8 * j + 4), gr = *(const GAS f32x4*)(gkp + 64 + 4 * j);
            const bool first = j < 4;
#define T2_LOAD(KN_, KR_, MC_, MS_, mm) do { const int pos_ = (mm) & (SEQ - 1); \
                KN_ = *(const GAS v4u*)(MLARAW + (size_t)(mm) * MLAW + 768 + 128 * hh + 8 * j); KR_ = *(const GAS v2u*)(RAW + (size_t)(mm) * RAWW + C_KROPE + 4 * j); \
                MC_ = *(const GAS f32x4*)(tab + T_MC / 4 + pos_ * 16 + 4 * (j & 3)); MS_ = *(const GAS f32x4*)(tab + T_MS / 4 + pos_ * 16 + 4 * (j & 3)); } while (0)
            v4u kn, knn; v2u kr, krn; f32x4 mc, ms, mcn, msn;
            T2_LOAD(kn, kr, mc, ms, gw);
            knn = kn; krn = kr; mcn = mc; msn = ms;
            for (int m = gw; m < M; m += NGW) {
                if (m + NGW < M) { T2_LOAD(knn, krn, mcn, msn, m + NGW); }
                float a[8] = {bflo(kn.x), bfhi(kn.x), bflo(kn.y), bfhi(kn.y), bflo(kn.z), bfhi(kn.z), bflo(kn.w), bfhi(kn.w)};
                float r[4] = {bflo(kr.x), bfhi(kr.x), bflo(kr.y), bfhi(kr.y)};
                float ss = 0.f;
#pragma unroll
                for (int i = 0; i < 8; ++i) ss += a[i] * a[i];
#pragma unroll
                for (int i = 0; i < 4; ++i) ss += r[i] * r[i];
                ss = sum8(ss);
                const float rstd = __builtin_amdgcn_rsqf(ss * (1.f / 96.f) + NEPS);
                v4u on; on.x = pk2(a[0] * rstd * gn0.x, a[1] * rstd * gn0.y); on.y = pk2(a[2] * rstd * gn0.z, a[3] * rstd * gn0.w);
                on.z = pk2(a[4] * rstd * gn1.x, a[5] * rstd * gn1.y); on.w = pk2(a[6] * rstd * gn1.z, a[7] * rstd * gn1.w);
#pragma unroll
                for (int i = 0; i < 4; ++i) { r[i] = r[i] * rstd * gr[i]; }
                float y[4];
#pragma unroll
                for (int i = 0; i < 4; ++i) { const float pr = xshfl<4>(r[i]); y[i] = first ? (r[i] * mc[i] - pr * ms[i]) : (r[i] * mc[i] + pr * ms[i]); }
                v2u orp; orp.x = pk2(y[0], y[1]); orp.y = pk2(y[2], y[3]);
                GAS bf16* kp = (GAS bf16*)(KMLA + (size_t)m * 768 + 96 * hh);
                *(GAS v4u*)(kp + 8 * j) = on; *(GAS v2u*)(kp + 64 + 4 * j) = orp;
                kn = knn; kr = krn; mc = mcn; ms = msn;
            }
#undef T2_LOAD
        }
        xcd_barrier(bar, wave0);
        {
            PHASE_PTRS;
            LAS char* al = (LAS char*)(lds + RING_OFF);
            constexpr float L2E = 1.4426950408889634f;
#define NBOUND(c, gq, gk, n) __uint_as_float(__builtin_amdgcn_readfirstlane(__float_as_uint(-(c) * L2E * wave_max_abs((gq), (n), lane) * wave_max_abs((gk), (n), lane))))
            const float nb_diff = NBOUND(8.0f, IN(I_DQ_G) + l * 64, IN(I_DK_G) + l * 64, 64);
            const float nb_mla = NBOUND(9.797958971f, IN(I_MLA_Q_G) + l * 96, IN(I_MLA_K_G) + l * 96, 96);
            const float nb_gqa = NBOUND(8.0f, IN(I_GQA_Q_G) + l * 64, IN(I_GQA_K_G) + l * 64, 64);
            const float nb_mem = NBOUND(11.3137085f, IN(I_MEM_Q_G) + l * 128, IN(I_MEM_K_G) + l * 128, 128);
            const float* lp_ = IN(I_DLAMBDA) + l * 256;
            const float lam = __uint_as_float(__builtin_amdgcn_readfirstlane(__float_as_uint(expf(wave_sum(lp_[lane] * lp_[64 + lane])) - expf(wave_sum(lp_[128 + lane] * lp_[192 + lane])) + lambda_init)));
            for (int u = vcu; u < 512; u += G) {
                const int qb = u & 7, h = (u >> 3) & 3, b = u >> 5; const size_t r0 = (size_t)b * SEQ;
                const att::QPrep qp{IN(I_DQ_G) + l * 64, tab + T_DC / 4, tab + T_DS / 4, nullptr, nullptr, qb * 256};
                att::attn_unit<64, 128, 1, 1, 4>(RAW + (r0 + qb * 256) * RAWW + C_DQ + (2 * h) * 64, RAWW, RAW + r0 * RAWW + C_DK + (2 * h) * 64, RAWW, RAW + r0 * RAWW + C_DV + h * 128, RAWW,
                                                 ODIFF + (r0 + qb * 256) * 1024 + h * 128, 1024, SEQ, 0.125f * L2E, nb_diff, qp, al, wave0);
                const att::DiffEpi de{ODIFF + (r0 + qb * 256) * 1024 + h * 128, 1024, lam, IN(I_DSUBLN_G) + l * 128, l};
                att::attn_unit<64, 128, 1, 1, 4, true>(RAW + (r0 + qb * 256) * RAWW + C_DQ + (2 * h + 1) * 64, RAWW, RAW + r0 * RAWW + C_DK + (2 * h + 1) * 64, RAWW, RAW + r0 * RAWW + C_DV + h * 128, RAWW,
                                                       RAW + (r0 + qb * 256) * RAWW + C_OA + h * 128, RAWW, SEQ, 0.125f * L2E, nb_diff, qp, al, wave0, 1.0f, &de);
            }
            for (int u = vcu; u < 512; u += G) {
                const int qb = u & 3, h = (u >> 2) & 7, b = u >> 5; const size_t r0 = (size_t)b * SEQ;
                const att::QPrep qp{IN(I_MLA_Q_G) + l * 96, tab + T_MC / 4, tab + T_MS / 4, nullptr, nullptr, qb * 512};
                att::attn_unit2d<96, 3, true>(MLARAW + (r0 + qb * 512) * MLAW + h * 96, MLAW, KMLA + r0 * 768 + h * 96, 768, MLARAW + r0 * MLAW + 768 + h * 128 + 64, MLAW,
                                                  RAW + (r0 + qb * 512) * RAWW + C_OB + h * 64, RAWW, SEQ, 0.10206207261596575f * L2E, nb_mla, qp, al, wave0);
            }
            for (int u = vcu; u < 512; u += G) {
                const int qb = u & 3, qh = (u >> 2) & 7, b = u >> 5; const size_t r0 = (size_t)b * SEQ;
                const att::QPrep qp{IN(I_GQA_Q_G) + l * 64, tab + T_RC / 4, tab + T_RS / 4, tab + T_CC / 4, tab + T_CS / 4, qb * 512};
                att::attn_unit2d<64, 2>(RAW + (r0 + qb * 512) * RAWW + C_GQ + qh * 64, RAWW, RAW + r0 * RAWW + C_GK + (qh >> 2) * 64, RAWW, RAW + r0 * RAWW + C_GV + (qh >> 2) * 64, RAWW,
                                       RAW + (r0 + qb * 512) * RAWW + C_OC + qh * 64, RAWW, SEQ, 0.125f * L2E, nb_gqa, qp, al, wave0);
            }
            for (int u = vcu; u < 512; u += G) {
                const int qb = u & 7, h = (u >> 3) & 3, b = u >> 5; const size_t r0 = (size_t)b * SEQ;
                const att::QPrep qp{IN(I_MEM_Q_G) + l * 128, tab + T_QC / 4, tab + T_QS / 4, nullptr, nullptr, qb * 256};
                att::attn_unit<128, 128, 1, 1, 4>(RAW + (r0 + qb * 256) * RAWW + C_MEMQ + h * 128, RAWW, MEMKV + (size_t)b * MEML * DM + h * 256, DM, MEMKV + (size_t)b * MEML * DM + h * 256 + 128, DM,
                                               RAW + (r0 + qb * 256) * RAWW + C_OD + h * 128, RAWW, MEML, 0.08838834764831845f * L2E, nb_mem, qp, al, wave0);
            }
        }
        xcd_barrier(bar, wave0);
        {
            PHASE_PTRS;
            pg8::Gemm g{(const bf16*)(wsp + WS_HB8), (const bf16*)(aw + AW_GATE), DM / 2, DM / 2, DM / 2}; pg8::StaticOrder S; S.init(M / 256, 16, G, bx);
            pg8::EpiSigmoidU8 E{(unsigned char*)GT, 4096, IN(I_B_GATE) + l * 4096, 1.0f / (S_H8 * S_WG)};
            pg8::gemm_phase<pg8::EpiSigmoidU8, pg8::StaticOrder, true, false, true>(lds + RING_OFF, g, S, E, wave0);
        }
        xcd_barrier(bar, wave0);
        {
            PHASE_PTRS;
            pg8::Gemm g{RAW, (const bf16*)(aw + AW_BR), RAWW, 512, 512}; MergeOrder S; S.init(M / 256, 4, G, bx);
            EpiMerge E{(const unsigned char*)GT, (bf16*)(wsp + WS_MERGED)};
            pg8::gemm_phase<EpiMerge, MergeOrder, true, false>(lds + RING_OFF, g, S, E, wave0);
        }
        xcd_barrier(bar, wave0);
        {
            PHASE_PTRS;
            pg8::Gemm g{(const bf16*)(wsp + WS_MERGED), (const bf16*)(aw + AW_OUT), DM, DM, DM}; pg8::StaticOrder S; S.init(M / 256, 4, G, bx);
            if (l == 0) { pg8::EpiResidX<false, true> E{IN(I_X), wsp + WS_XB, DM};
                pg8::gemm_phase<pg8::EpiResidX<false, true>, pg8::StaticOrder, true, false>(lds + RING_OFF, g, S, E, wave0); }
            else { pg8::EpiResidX<true, true> E{wsp + WS_XB, wsp + WS_XB, DM};
                pg8::gemm_phase<pg8::EpiResidX<true, true>, pg8::StaticOrder, true, false>(lds + RING_OFF, g, S, E, wave0); }
        }
        xcd_barrier(bar, wave0);
        if (l == 0) {
            {
                PHASE_PTRS;
                for (int it = gw; it < FFN_ITEMS; it += NGW) ffn_weight_item(it, IN(I_DW1), IN(I_DW3), IN(I_DW2), W13t, W2t, scr, lane);
                rms_rows_to_bf16<false, true, true>((const float*)(wsp + WS_XB), IN(I_NORM_FFN_G), (bf16*)(wsp + WS_HBF), M, gw, NGW, lane);
            }
            xcd_barrier(bar, wave0);
            {
                PHASE_PTRS;
                pg8::Gemm g{(const bf16*)(wsp + WS_HBF), W13t, DM, DM, DM}; pg8::StaticOrder S; S.init(M / 256, 2 * FF / 256, G, bx);
                pg8::EpiSwiGLU E{U, FF, 0};
                pg8::gemm_phase<pg8::EpiSwiGLU, pg8::StaticOrder, true, false>(lds + RING_OFF, g, S, E, wave0);
            }
            xcd_barrier(bar, wave0);
            {
                PHASE_PTRS;
                pg8::Gemm g{U, W2t, FF, FF, FF}; pg8::StaticOrder S; S.init(M / 256, DM / 256, G, bx);
                pg8::EpiResidX<true, true> E{wsp + WS_XB, wsp + WS_XB, DM};
                pg8::gemm_phase<pg8::EpiResidX<true, true>, pg8::StaticOrder, true, false>(lds + RING_OFF, g, S, E, wave0);
            }
            xcd_barrier(bar, wave0);
        }

        if (l == 1) {
            {
                PHASE_PTRS;
                volatile LAS int* ml = (volatile LAS int*)(lds + MOE_LDS);
                int* slot_tok = (int*)(wsp + WS_MOE + MO_SLOT_TOK); float* tok_gate = (float*)(wsp + WS_MOE + MO_TOK_GATE); int* wgcnt = (int*)(wsp + WS_MOE + MO_WGCNT);
                for (int it = gw; it < NEXP * FFN_ITEMS; it += NGW) { const int e = it / FFN_ITEMS; unsigned char* w13 = (unsigned char*)W13t + (size_t)e * EXPERT_BYTES;
                    ffn_weight_item8(it % FFN_ITEMS, IN(I_MW1) + (size_t)e * DM * FF, IN(I_MW3) + (size_t)e * DM * FF, IN(I_MW2) + (size_t)e * FF * DM, w13, w13 + W2_OFF, scr, lane); }
                for (int c = gt; c < MOE_SLOTS; c += NGT) slot_tok[c] = 0;
                const float* wr_ = IN(I_ROUTER); const float* gf = IN(I_NORM_FFN_G) + DM;
                f32x4 rw[4][4][2];
#pragma unroll
                for (int j = 0; j < 4; ++j)
#pragma unroll
                    for (int q = 0; q < 4; ++q) { const GAS f32x4* rp = (const GAS f32x4*)(wr_ + (size_t)(4 * (lane + 64 * j) + q) * 8); rw[j][q][0] = rp[0]; rw[j][q][1] = rp[1]; }
                f32x4 v[4], vn[4], ggv[4];
#pragma unroll
                for (int j = 0; j < 4; ++j) ggv[j] = ((const GAS f32x4*)gf + lane)[64 * j];
                { const float* xb_ = (const float*)(wsp + WS_XB);
#pragma unroll
                  for (int j = 0; j < 4; ++j) { v[j] = rr_load<true>(xb_, vcu * 128 + wave * 16, lane, j); vn[j] = v[j]; } }
                for (int i = 0; i < 16; ++i) {
                    const int tl = wave * 16 + i, t = vcu * 128 + tl;
                    if (i + 1 < 16) { const float* xb_ = (const float*)(wsp + WS_XB);
#pragma unroll
                        for (int j = 0; j < 4; ++j) vn[j] = rr_load<true>(xb_, t + 1, lane, j); }
                    float s = 0.f;
#pragma unroll
                    for (int j = 0; j < 4; ++j) { s += (v[j].x * v[j].x + v[j].y * v[j].y) + (v[j].z * v[j].z + v[j].w * v[j].w); }
                    const float rstd = __builtin_amdgcn_rsqf(wave_sum(s) * (1.f / DM) + NEPS);
                    GAS unsigned* o4 = (GAS unsigned*)(wsp + WS_HBM8 + (size_t)t * DM) + lane;
                    float lg[8] = {0.f, 0.f, 0.f, 0.f, 0.f, 0.f, 0.f, 0.f};
#pragma unroll
                    for (int j = 0; j < 4; ++j) { const f32x4 gg = ggv[j]; const float h0 = v[j].x * rstd * gg.x, h1 = v[j].y * rstd * gg.y, h2 = v[j].z * rstd * gg.z, h3 = v[j].w * rstd * gg.w;
                        o4[64 * j] = pg8::cvt4_fp8(h0 * S_H8, h1 * S_H8, h2 * S_H8, h3 * S_H8);
#pragma unroll
                        for (int e = 0; e < 8; ++e) lg[e] += h0 * rw[j][0][e >> 2][e & 3] + h1 * rw[j][1][e >> 2][e & 3] + h2 * rw[j][2][e >> 2][e & 3] + h3 * rw[j][3][e >> 2][e & 3]; }
#pragma unroll
                    for (int e = 0; e < 8; ++e) lg[e] = wave_sum(lg[e]);
                    int e1 = 0; float l1 = lg[0];
#pragma unroll
                    for (int e = 1; e < 8; ++e) if (lg[e] > l1) { l1 = lg[e]; e1 = e; }
                    int e2 = -1; float l2 = -3.0e38f;
#pragma unroll
                    for (int e = 0; e < 8; ++e) if (e != e1 && lg[e] > l2) { l2 = lg[e]; e2 = e; }
                    const float ex = expf(l2 - l1), g1 = 1.0f / (1.0f + ex), g2 = ex / (1.0f + ex);
                    if (lane == 0) { ml[ML_SEL + 2 * tl] = e1; ml[ML_SEL + 2 * tl + 1] = e2; tok_gate[2 * t] = g1; tok_gate[2 * t + 1] = g2; }
#pragma unroll
                    for (int j = 0; j < 4; ++j) v[j] = vn[j];
                }
                LDS_WAIT(); __syncthreads();
                if (wave == 0) {
                    int base[8] = {0, 0, 0, 0, 0, 0, 0, 0}; const unsigned long long lt = (1ull << lane) - 1ull;
#pragma unroll
                    for (int j = 0; j < 4; ++j) { const int a = 64 * j + lane, e = ml[ML_SEL + a]; int r = 0;
#pragma unroll
                        for (int ee = 0; ee < 8; ++ee) { const unsigned long long mk = __ballot(e == ee); if (e == ee) r = base[ee] + __popcll(mk & lt); base[ee] += __popcll(mk); }
                        ml[ML_RNK + a] = r; }
                    int cv = 0;
#pragma unroll
                    for (int ee = 0; ee < 8; ++ee) if (lane == ee) cv = base[ee];
                    if (lane < 8) wgcnt[vcu * 8 + lane] = cv;
                }
            }
            xcd_barrier(bar, wave0);
            {
                PHASE_PTRS;
                volatile LAS int* ml = (volatile LAS int*)(lds + MOE_LDS);
                int* slot_tok = (int*)(wsp + WS_MOE + MO_SLOT_TOK); int* tok_slot = (int*)(wsp + WS_MOE + MO_TOK_SLOT); const int* wgcnt = (const int*)(wsp + WS_MOE + MO_WGCNT);
                { int s = 0, p = 0;
#pragma unroll
                  for (int q = 0; q < 4; ++q) { const int w = 4 * lane + q; const int c = wgcnt[w * 8 + wave]; s += c; if (w < vcu) p += c; }
                  s = wave_sum_i(s); p = wave_sum_i(p);
                  if (lane == 0) { ml[ML_TOT + wave] = s; ml[ML_PRE + wave] = p; } }
                LDS_WAIT(); __syncthreads();
                if (wave == 0 && lane == 0) { int b = 0; for (int e = 0; e < 8; ++e) { ml[ML_SEGB + e] = b; b += (ml[ML_TOT + e] + 255) & ~255; } ml[ML_SEGB + 8] = b; }
                LDS_WAIT(); __syncthreads();
                { const int a = wave * 64 + lane;
                  if (a < 272) { int e = 0;
#pragma unroll
                      for (int q = 1; q < 8; ++q) if (ml[ML_SEGB + q] <= 256 * a) e = q;
                      ml[ML_TE + a] = e; }
                  if (a < 256) { const int e = ml[ML_SEL + a], slot = ml[ML_SEGB + e] + ml[ML_PRE + e] + ml[ML_RNK + a], t = vcu * 128 + (a >> 1);
                      slot_tok[slot] = t; tok_slot[2 * t + (a & 1)] = slot; } }
                LDS_WAIT(); __syncthreads();
                for (int i = 0; i < 32; i += 4) {
                    v4u r[4]; int sl[4];
#pragma unroll
                    for (int q = 0; q < 4; ++q) { const int a = wave * 32 + i + q, e = ml[ML_SEL + a]; sl[q] = ml[ML_SEGB + e] + ml[ML_PRE + e] + ml[ML_RNK + a];
                        r[q] = *((const GAS v4u*)(wsp + WS_HBM8 + (size_t)(vcu * 128 + (a >> 1)) * DM) + lane); }
#pragma unroll
                    for (int q = 0; q < 4; ++q) *((GAS v4u*)(wsp + WS_XS8 + (size_t)sl[q] * DM) + lane) = r[q];
                }
            }
            xcd_barrier(bar, wave0);
            const int n_tiles = __builtin_amdgcn_readfirstlane(((volatile LAS int*)(lds + MOE_LDS))[ML_SEGB + 8]) >> 8;
            const int n_full = n_tiles < 256 ? n_tiles : 256, n_tail = n_tiles - n_full;
#pragma unroll 1
            for (int ch = 0; ch * MOE_CHUNK_TILES < n_full; ++ch) {
                const int tile0 = ch * MOE_CHUNK_TILES, nt_c = (n_full - tile0) < MOE_CHUNK_TILES ? (n_full - tile0) : MOE_CHUNK_TILES;
                {
                    PHASE_PTRS;
                    pg8::Gemm g{(const bf16*)(wsp + WS_XS8 + (size_t)tile0 * 256 * DM), nullptr, DM / 2, DM / 2, DM / 2}; MoeDownOrder S; S.init(nt_c, 2 * FF / 256, G, bx);
                    S.tile0 = tile0; S.te = (const volatile LAS int*)(lds + MOE_LDS) + ML_TE; S.wbase = (const char*)W13t;
                    pg8::EpiSwiGLU8 E{(unsigned char*)U, FF, 1.0f / (S_H8 * S_W13), S_U8};
                    pg8::gemm_phase<pg8::EpiSwiGLU8, MoeDownOrder, true, false, true>(lds + RING_OFF, g, S, E, wave0);
                }
                xcd_barrier(bar, wave0);
                {
                    PHASE_PTRS;
                    pg8::Gemm g{U, nullptr, FF / 2, FF / 2, FF / 2}; MoeDownOrder S; S.init(nt_c, DM / 256, G, bx);
                    S.tile0 = tile0; S.te = (const volatile LAS int*)(lds + MOE_LDS) + ML_TE; S.wbase = (const char*)W13t + W2_OFF;
                    pg8::EpiBf16 E{(bf16*)(wsp + WS_Y) + (size_t)tile0 * 256 * DM, DM, 1.0f / (S_U8 * S_W2)};
                    pg8::gemm_phase<pg8::EpiBf16, MoeDownOrder, true, false, true>(lds + RING_OFF, g, S, E, wave0);
                }
                xcd_barrier(bar, wave0);
            }
            if (n_tail > 0) {
                {
                    PHASE_PTRS;
                    pg8::Gemm g{(const bf16*)(wsp + WS_XS8 + (size_t)256 * 256 * DM), nullptr, DM / 2, DM / 2, DM / 2}; MoeDownOrder S; S.init(n_tail, 2 * FF / 256, G, bx);
                    S.tile0 = 256; S.te = (const volatile LAS int*)(lds + MOE_LDS) + ML_TE; S.wbase = (const char*)W13t;
                    pg8::EpiSwiGLU8 E{(unsigned char*)U, FF, 1.0f / (S_H8 * S_W13), S_U8};
                    pg8::gemm_phase<pg8::EpiSwiGLU8, MoeDownOrder, true, false, true>(lds + RING_OFF, g, S, E, wave0);
                }
                xcd_barrier(bar, wave0);
                {
                    PHASE_PTRS;
                    pg8::Gemm g{U, nullptr, FF / 2, FF / 2, 256}; TailDownOrder S; S.init(n_tail, DM / 256, G, bx);
                    S.te = (const volatile LAS int*)(lds + MOE_LDS) + ML_TE; S.wbase = (const char*)W13t + W2_OFF;
                    EpiPartF32 E{(float*)(wsp + WS_TAILP), n_tail * 256};
                    pg8::gemm_phase<EpiPartF32, TailDownOrder, true, false, true>(lds + RING_OFF, g, S, E, wave0);
                }
                xcd_barrier(bar, wave0);
            }
            {
                PHASE_PTRS;
                const int* tok_slot = (const int*)(wsp + WS_MOE + MO_TOK_SLOT); const float* tok_gate = (const float*)(wsp + WS_MOE + MO_TOK_GATE); const bf16* Y = (const bf16*)(wsp + WS_Y);
#define MC_IDX(S1_, S2_, G1_, G2_, tt) do { const int t_ = (tt) < M ? (tt) : gw; S1_ = tok_slot[2 * t_]; S2_ = tok_slot[2 * t_ + 1]; G1_ = tok_gate[2 * t_]; G2_ = tok_gate[2 * t_ + 1]; } while (0)
#define MC_ROWS(X_, A_, B_, S1_, S2_, tt) do { const int t_ = (tt) < M ? (tt) : gw; \
                    const GAS v2u* y1_ = (const GAS v2u*)(Y + (size_t)(S1_) * DM) + lane; const GAS v2u* y2_ = (const GAS v2u*)(Y + (size_t)(S2_) * DM) + lane; \
                    _Pragma("unroll") for (int j = 0; j < 4; ++j) { X_[j] = rr_load<true>(XBp, t_, lane, j); A_[j] = (S1_) >= 65536 ? tail_row(PT, n_tail * 256, (S1_) - 65536, lane + 64 * j, TSC) : y1_[64 * j]; B_[j] = (S2_) >= 65536 ? tail_row(PT, n_tail * 256, (S2_) - 65536, lane + 64 * j, TSC) : y2_[64 * j]; } } while (0)
                const float* PT = (const float*)(wsp + WS_TAILP); const float* XBp = (const float*)(wsp + WS_XB); constexpr float TSC = 1.0f / (S_U8 * S_W2);
                int s1a, s2a, s1b, s2b, s1c, s2c; float g1a, g2a, g1b, g2b, g1c, g2c; f32x4 xc[4], xn[4]; v2u ac[4], bc[4], an[4], bn[4];
                MC_IDX(s1a, s2a, g1a, g2a, gw); MC_IDX(s1b, s2b, g1b, g2b, gw + NGW);
                MC_ROWS(xc, ac, bc, s1a, s2a, gw);
                for (int t = gw; t < M; t += NGW) {
                    MC_IDX(s1c, s2c, g1c, g2c, t + 2 * NGW);
                    MC_ROWS(xn, an, bn, s1b, s2b, t + NGW);
                    GAS f32x4* xr = (GAS f32x4*)(out + (size_t)t * DM) + lane;
#pragma unroll
                    for (int j = 0; j < 4; ++j) { f32x4 x = xc[j]; const v2u a = ac[j], b = bc[j];
                        x.x += g1a * bflo(a.x) + g2a * bflo(b.x); x.y += g1a * bfhi(a.x) + g2a * bfhi(b.x); x.z += g1a * bflo(a.y) + g2a * bflo(b.y); x.w += g1a * bfhi(a.y) + g2a * bfhi(b.y);
                        xr[64 * j] = x; }
#pragma unroll
                    for (int j = 0; j < 4; ++j) { xc[j] = xn[j]; ac[j] = an[j]; bc[j] = bn[j]; }
                    s1a = s1b; s2a = s2b; g1a = g1b; g2a = g2b; s1b = s1c; s2b = s2c; g1b = g1c; g2b = g2c;
                }
#undef MC_IDX
#undef MC_ROWS
            }
        }
    }
}

extern "C" void kernel_launch(void* const* d_in, const int* in_sizes, int n_in, void* d_out, int out_size, void* d_ws, size_t ws_size, hipStream_t stream) {
    static int grid = 0;
    if (grid == 0) {
        if (n_in != N_IN || in_sizes[0] != M * DM || out_size != M * DM || ws_size < WS_END) { fprintf(stderr, "kernel_launch: shape/workspace mismatch (n_in %d, ws %zu)\n", n_in, ws_size); grid = -1; return; }
        int dev = 0, cus = 0;
        if (hipGetDevice(&dev) != hipSuccess || hipDeviceGetAttribute(&cus, hipDeviceAttributeMultiprocessorCount, dev) != hipSuccess) { grid = -1; return; }
        if (hipFuncSetAttribute((const void*)fwd, hipFuncAttributeMaxDynamicSharedMemorySize, LDS_BYTES) != hipSuccess) { grid = -1; return; }
        int per_cu = 0;
        if (hipOccupancyMaxActiveBlocksPerMultiprocessor(&per_cu, (const void*)fwd, NWAVES * 64, LDS_BYTES) != hipSuccess || per_cu < 1) { fprintf(stderr, "kernel_launch: occupancy query says %d\n", per_cu); }
        (void)hipGetLastError();
        if (cus != 256) { fprintf(stderr, "kernel_launch: built for 256 CUs, got %d\n", cus); grid = -1; return; }
        grid = cus;
    }
    if (grid < 0) return;
    if (hipMemsetAsync((char*)d_ws + WS_CTL, 0, CTL_ZERO_BYTES, stream) != hipSuccess) return;
    Args a{};
    for (int i = 0; i < N_IN; ++i) a.in[i] = (const float*)d_in[i];
    a.out = (float*)d_out; a.ws = (unsigned char*)d_ws;
    hipLaunchKernelGGL(fwd, dim3(grid), dim3(NWAVES * 64), LDS_BYTES, stream, a);
}
```

```cpp
#include <hip/hip_runtime.h>
#include <cstdio>
#include <cstdint>
namespace pg8 {
#define PG8_LAS __attribute__((address_space(3)))
typedef unsigned short bf16_t;
typedef short bf16x8 __attribute__((ext_vector_type(8)));
typedef float f32x4 __attribute__((ext_vector_type(4)));
typedef float f32x2 __attribute__((ext_vector_type(2)));
typedef unsigned u32x4 __attribute__((ext_vector_type(4)));
typedef unsigned u32x2 __attribute__((ext_vector_type(2)));
constexpr int BM = 256, BK = 64, HALF = 128, HTB = HALF * BK * 2  , STAGE_BYTES = 8 * HTB, NXCD = 8, WGM = 8;

__host__ __device__ __forceinline__ int lds_byte(int r, int c) { const int st = (r >> 4) * 2 + (c >> 5), rr = r & 15, cc = c & 31, ob = rr * 64 + cc * 2; return st * 1024 + (ob ^ (((ob >> 9) & 1) << 5)); }
__host__ __device__ __forceinline__ void stage_rc(int b, int& R, int& C) { const int st = b / 1024, sb = b % 1024, swz = sb ^ (((sb >> 9) & 1) << 5); R = (st >> 1) * 16 + swz / 64; C = (st & 1) * 32 + (swz % 64) / 2; }
__host__ __device__ __forceinline__ int perm32(int rho) { const int n = rho >> 4, i = rho & 15; return 8 * (i >> 2) + 4 * n + (i & 3); }

struct Unit { int pm, pn, z; };
struct Gemm { const bf16_t* A; const bf16_t* Bt; int lda, ldb, K; };

struct StaticOrder {
    int nM, nN, nwg, G, c;
    __device__ __forceinline__ void init(int nM_, int nN_, int G_, int c_) { nM = nM_; nN = nN_; nwg = nM * nN; G = G_; c = c_; }
    __device__ __forceinline__ bool tile(long L, Unit& u) const {
        if (L >= nwg) return false;
        int wgid = (int)L; { const int q = nwg / NXCD, r = nwg % NXCD, xcd = wgid % NXCD, off = wgid / NXCD; wgid = (xcd < r ? xcd * (q + 1) : r * (q + 1) + (xcd - r) * q) + off; }
        const int nig = WGM * nN, gid = wgid / nig, fm = gid * WGM, gsz = (nM - fm) < WGM ? (nM - fm) : WGM;
        u.pm = __builtin_amdgcn_readfirstlane(fm + ((wgid % nig) % gsz)); u.pn = __builtin_amdgcn_readfirstlane((wgid % nig) / gsz); u.z = 0; return true;
    }
    __device__ __forceinline__ bool next(int i, Unit& u) const { return tile((long)i * G + c, u); }
    __device__ __forceinline__ const char* a_ptr(const Gemm& g, const Unit& u) const { return (const char*)g.A + (size_t)u.pm * (BM * 2) * g.lda; }
    __device__ __forceinline__ const char* b_ptr(const Gemm& g, const Unit& u) const { return (const char*)g.Bt + (size_t)u.pn * (BM * 2) * g.ldb; }
    __device__ __forceinline__ unsigned row_off(const Gemm&, const Unit&, int) const { return 0u; }
};

typedef __bf16 bf16x2_t __attribute__((ext_vector_type(2)));
__device__ __forceinline__ unsigned cvt_pk_bf16(float lo, float hi) { f32x2 v = {lo, hi}; bf16x2_t b = __builtin_convertvector(v, bf16x2_t); return __builtin_bit_cast(unsigned, b); }
__device__ __forceinline__ float bf_lo(unsigned w) { return __uint_as_float(w << 16); }
__device__ __forceinline__ float bf_hi(unsigned w) { return __uint_as_float(w & 0xffff0000u); }
__device__ __forceinline__ float sigmoidf_(float v) { return __builtin_amdgcn_rcpf(1.0f + __builtin_amdgcn_exp2f(-1.4426950408889634f * v)); }

struct EpiBf16 {
    static constexpr bool PERM = true;
    bf16_t* O; int ldc; float scale = 1.0f;
    __device__ __forceinline__ bool keep(const Unit&) const { return false; }
    __device__ __forceinline__ void operator()(const f32x4 (&acc)[2][2][4][2], const Unit& u, int wr, int wc, int fr, int fq) const {
        const int row0 = u.pm * BM + wr * 64 + fr, col0 = u.pn * BM + wc * 32 + 8 * fq;
#pragma unroll
        for (int ai = 0; ai < 2; ++ai)
#pragma unroll
            for (int m = 0; m < 4; ++m) { bf16_t* rowp = O + (size_t)(row0 + ai * HALF + m * 16) * ldc + col0;
#pragma unroll
                for (int bj = 0; bj < 2; ++bj) { const f32x4 v0 = acc[ai][bj][m][0] * scale, v1 = acc[ai][bj][m][1] * scale;
                    u32x4 w; w.x = cvt_pk_bf16(v0[0], v0[1]); w.y = cvt_pk_bf16(v0[2], v0[3]); w.z = cvt_pk_bf16(v1[0], v1[1]); w.w = cvt_pk_bf16(v1[2], v1[3]);
                    __builtin_nontemporal_store(w, (u32x4*)(rowp + bj * HALF)); } }
    }
};
struct EpiSigmoid {
    static constexpr bool PERM = true;
    bf16_t* O; int ldc; const float* bias; float scale = 1.0f;
    __device__ __forceinline__ bool keep(const Unit&) const { return false; }
    __device__ __forceinline__ void operator()(const f32x4 (&acc)[2][2][4][2], const Unit& u, int wr, int wc, int fr, int fq) const {
        const int row0 = u.pm * BM + wr * 64 + fr, col0 = u.pn * BM + wc * 32 + 8 * fq;
        f32x4 bv[2][2];
#pragma unroll
        for (int bj = 0; bj < 2; ++bj)
#pragma unroll
            for (int n = 0; n < 2; ++n) bv[bj][n] = *(const f32x4*)(bias + col0 + bj * HALF + 4 * n);
#pragma unroll
        for (int ai = 0; ai < 2; ++ai)
#pragma unroll
            for (int m = 0; m < 4; ++m) { bf16_t* rowp = O + (size_t)(row0 + ai * HALF + m * 16) * ldc + col0;
#pragma unroll
                for (int bj = 0; bj < 2; ++bj) { const f32x4 v0 = acc[ai][bj][m][0] * scale + bv[bj][0], v1 = acc[ai][bj][m][1] * scale + bv[bj][1];
                    u32x4 w; w.x = cvt_pk_bf16(sigmoidf_(v0[0]), sigmoidf_(v0[1])); w.y = cvt_pk_bf16(sigmoidf_(v0[2]), sigmoidf_(v0[3]));
                    w.z = cvt_pk_bf16(sigmoidf_(v1[0]), sigmoidf_(v1[1])); w.w = cvt_pk_bf16(sigmoidf_(v1[2]), sigmoidf_(v1[3]));
                    __builtin_nontemporal_store(w, (u32x4*)(rowp + bj * HALF)); } }
    }
};
struct EpiSigmoidU8 {
    static constexpr bool PERM = true;
    unsigned char* O; int ldc; const float* bias; float scale;
    __device__ __forceinline__ bool keep(const Unit&) const { return false; }
    static __device__ __forceinline__ float q255(float t) { return __builtin_amdgcn_rcpf(__builtin_fmaf(fminf(__builtin_amdgcn_exp2f(t), 254.0f), 1.0f / 255.0f, 1.0f / 255.0f)); }
    __device__ __forceinline__ void operator()(const f32x4 (&acc)[2][2][4][2], const Unit& u, int wr, int wc, int fr, int fq) const {
        const int col0 = u.pn * BM + wc * 32 + 8 * fq;
        f32x4 bv[2][2];
#pragma unroll
        for (int bj = 0; bj < 2; ++bj)
#pragma unroll
            for (int n = 0; n < 2; ++n) bv[bj][n] = *(const f32x4*)(bias + col0 + bj * HALF + 4 * n) * -1.4426950408889634f;
        const float sc2 = scale * -1.4426950408889634f;
        unsigned char* tp = O + ((size_t)(u.pm * 16 + u.pn) << 16) + ((wr * 4 + wc) << 13) + (fq * 16 + fr) * 8;
#pragma unroll
        for (int ai = 0; ai < 2; ++ai)
#pragma unroll
            for (int m = 0; m < 4; ++m) {
#pragma unroll
                for (int bj = 0; bj < 2; ++bj) { const f32x4 v0 = acc[ai][bj][m][0] * sc2 + bv[bj][0], v1 = acc[ai][bj][m][1] * sc2 + bv[bj][1];
                    u32x2 w; w.x = 0u; w.y = 0u;
#pragma unroll
                    for (int e = 0; e < 4; ++e) { w.x = __builtin_amdgcn_cvt_pk_u8_f32(q255(v0[e]), e, w.x); w.y = __builtin_amdgcn_cvt_pk_u8_f32(q255(v1[e]), e, w.y); }
                    __builtin_nontemporal_store(w, (u32x2*)(tp + (((ai * 4 + m) * 2 + bj) << 9))); } }
    }
};
struct EpiSwiGLU {
    static constexpr bool PERM = true;
    bf16_t* O; int ldc; int row_base;
    __device__ __forceinline__ bool keep(const Unit&) const { return false; }
    __device__ __forceinline__ void operator()(const f32x4 (&acc)[2][2][4][2], const Unit& u, int wr, int wc, int fr, int fq) const {
        const int row0 = row_base + u.pm * BM + wr * 64 + fr, col0 = u.pn * HALF + wc * 32 + 8 * fq;
#pragma unroll
        for (int ai = 0; ai < 2; ++ai)
#pragma unroll
            for (int m = 0; m < 4; ++m) { bf16_t* rowp = O + (size_t)(row0 + ai * HALF + m * 16) * ldc + col0;
                float r[8];
#pragma unroll
                for (int n = 0; n < 2; ++n)
#pragma unroll
                    for (int j = 0; j < 4; ++j) { const float gt = acc[ai][0][m][n][j], up = acc[ai][1][m][n][j]; r[n * 4 + j] = gt * sigmoidf_(gt) * up; }
                u32x4 w; w.x = cvt_pk_bf16(r[0], r[1]); w.y = cvt_pk_bf16(r[2], r[3]); w.z = cvt_pk_bf16(r[4], r[5]); w.w = cvt_pk_bf16(r[6], r[7]);
                __builtin_nontemporal_store(w, (u32x4*)rowp); }
    }
};
__device__ __forceinline__ unsigned cvt4_fp8(float a, float b, float c, float d) { int w = __builtin_amdgcn_cvt_pk_fp8_f32(a, b, 0, false); w = __builtin_amdgcn_cvt_pk_fp8_f32(c, d, w, true); return (unsigned)w; }
struct EpiSwiGLU8 {
    static constexpr bool PERM = true;
    unsigned char* O; int ldc; float in_scale, out_scale;
    __device__ __forceinline__ bool keep(const Unit&) const { return false; }
    __device__ __forceinline__ void operator()(const f32x4 (&acc)[2][2][4][2], const Unit& u, int wr, int wc, int fr, int fq) const {
        const int row0 = u.pm * BM + wr * 64 + fr, col0 = u.pn * HALF + wc * 32 + 8 * fq;
        const float k1 = in_scale * -1.4426950408889634f, k2 = in_scale * in_scale * out_scale;
#pragma unroll
        for (int ai = 0; ai < 2; ++ai)
#pragma unroll
            for (int m = 0; m < 4; ++m) { unsigned char* rowp = O + (size_t)(row0 + ai * HALF + m * 16) * ldc + col0;
                float r[8];
#pragma unroll
                for (int n = 0; n < 2; ++n)
#pragma unroll
                    for (int j = 0; j < 4; ++j) { const float a = acc[ai][0][m][n][j], b = acc[ai][1][m][n][j];
                        r[n * 4 + j] = (a * b) * (k2 * __builtin_amdgcn_rcpf(1.0f + __builtin_amdgcn_exp2f(a * k1))); }
                u32x2 w; w.x = cvt4_fp8(r[0], r[1], r[2], r[3]); w.y = cvt4_fp8(r[4], r[5], r[6], r[7]);
                __builtin_nontemporal_store(w, (u32x2*)rowp); }
    }
};
template <bool BASE_BF, bool OUT_BF>
struct EpiResidX {
    static constexpr bool PERM = false;
    const void* base; void* out; int ldc; float scale = 1.0f;
    __device__ __forceinline__ bool keep(const Unit&) const { return false; }
    __device__ __forceinline__ void operator()(const f32x4 (&acc)[2][2][4][2], const Unit& u, int wr, int wc, int fr, int fq) const {
        const int row0 = u.pm * BM + wr * 64 + fr, col0 = u.pn * BM + wc * 32 + 4 * fq;
#pragma unroll
        for (int ai = 0; ai < 2; ++ai)
#pragma unroll
            for (int mp = 0; mp < 2; ++mp) {
                f32x4 b[2][2][2];
#pragma unroll
                for (int mm = 0; mm < 2; ++mm) { const size_t off = (size_t)(row0 + ai * HALF + (2 * mp + mm) * 16) * ldc + col0;
#pragma unroll
                    for (int bj = 0; bj < 2; ++bj)
#pragma unroll
                        for (int n = 0; n < 2; ++n) {
                            if constexpr (BASE_BF) { const u32x2 w = *(const u32x2*)((const bf16_t*)base + off + bj * HALF + n * 16);
                                b[mm][bj][n] = (f32x4){bf_lo(w.x), bf_hi(w.x), bf_lo(w.y), bf_hi(w.y)}; }
                            else b[mm][bj][n] = *(const f32x4*)((const float*)base + off + bj * HALF + n * 16); } }
#pragma unroll
                for (int mm = 0; mm < 2; ++mm) { const size_t off = (size_t)(row0 + ai * HALF + (2 * mp + mm) * 16) * ldc + col0;
#pragma unroll
                    for (int bj = 0; bj < 2; ++bj)
#pragma unroll
                        for (int n = 0; n < 2; ++n) { const f32x4 v = b[mm][bj][n] + acc[ai][bj][2 * mp + mm][n] * scale;
                            if constexpr (OUT_BF) { u32x2 w; w.x = cvt_pk_bf16(v[0], v[1]); w.y = cvt_pk_bf16(v[2], v[3]); __builtin_nontemporal_store(w, (u32x2*)((bf16_t*)out + off + bj * HALF + n * 16)); }
                            else *(f32x4*)((float*)out + off + bj * HALF + n * 16) = v; } }
                asm volatile("" ::: "memory"); }
    }
};

typedef int i32x8 __attribute__((ext_vector_type(8)));
typedef short s16x16 __attribute__((ext_vector_type(16)));
typedef float f32x8 __attribute__((ext_vector_type(8)));
template <class Epi, class Sched, bool ALIGN_EPI, bool GATHER, bool FP8 = false>
__device__ __forceinline__ void gemm_phase(PG8_LAS unsigned char* lds, const Gemm g, const Sched& S, const Epi& E, int wave0) {
    int tid; asm volatile("v_mbcnt_lo_u32_b32 %0, -1, 0\n\tv_mbcnt_hi_u32_b32 %0, -1, %0" : "=v"(tid)); tid = (tid + wave0 * 64) & 511;
    const int wid = __builtin_amdgcn_readfirstlane(tid >> 6), lane = tid & 63, wr = wid >> 2, wc = wid & 3, fr = lane & 15, fq = lane >> 4;
    int K = g.K; asm volatile("" : "+s"(K));
    const int nt = K / BK;
    unsigned voffB[2], offC[2][2], offN[2][2]; int Rr[2], Cc[2];
#pragma unroll
    for (int i = 0; i < 2; ++i) { int R, C; stage_rc(tid * 16 + i * 8192, R, C); const int Rb = Epi::PERM ? ((R & ~31) + perm32(R & 31)) : R;
        voffB[i] = (unsigned)(Rb * g.ldb + C) * 2u; Rr[i] = R; Cc[i] = C;
        offC[0][i] = (unsigned)(R * g.lda + C) * 2u; offC[1][i] = (unsigned)((R + HALF) * g.lda + C) * 2u; offN[0][i] = offC[0][i]; offN[1][i] = offC[1][i]; }
    const size_t dB64 = (size_t)64 * g.ldb * 2, dA64 = (size_t)64 * g.lda * 2, dAh = (size_t)HALF * g.lda * 2;
    const size_t kstep = (size_t)(BK * 2);
    const size_t hstepB = (size_t)HALF * g.ldb * 2;
    const unsigned ldsw = (unsigned)wid * 1024u;
    const int aoff = lds_byte(wr * 64 + fr, fq * 8), boff = lds_byte(wc * 32 + fr, fq * 8);
#define PG8_SA(b, h) (((b) * 2 + (h)) * HTB)
#define PG8_SB(b, h) ((4 + (b) * 2 + (h)) * HTB)
#define PG8_STAGE_B(bufoff, gbase) do { _Pragma("unroll") for (int _i = 0; _i < 2; ++_i) \
        __builtin_amdgcn_global_load_lds((const unsigned*)((const char*)(gbase) + (size_t)_i * dB64 + voffB[0]), (PG8_LAS unsigned*)(lds + (bufoff) + ldsw + _i * 8192), 16, 0, 0); } while (0)
#define PG8_STAGE_A(bufoff, gbase, O, h) do { _Pragma("unroll") for (int _i = 0; _i < 2; ++_i) { \
        if constexpr (GATHER) __builtin_amdgcn_global_load_lds((const unsigned*)((const char*)(gbase) + O[h][_i]), (PG8_LAS unsigned*)(lds + (bufoff) + ldsw + _i * 8192), 16, 0, 0); \
        else __builtin_amdgcn_global_load_lds((const unsigned*)((const char*)(gbase) + (size_t)(h) * dAh + (size_t)_i * dA64 + O[0][0]), (PG8_LAS unsigned*)(lds + (bufoff) + ldsw + _i * 8192), 16, 0, 0); } } while (0)
#define PG8_LD8(addr) __builtin_bit_cast(i32x8, __builtin_shufflevector(*(const PG8_LAS bf16x8*)(lds + (addr)), *(const PG8_LAS bf16x8*)(lds + (addr) + 1024), 0, 1, 2, 3, 4, 5, 6, 7, 8, 9, 10, 11, 12, 13, 14, 15))
#define PG8_LDA8(dst, b, h) do { _Pragma("unroll") for (int m = 0; m < 4; ++m) dst[m] = PG8_LD8(PG8_SA(b, h) + aoff + m * 2048); } while (0)
#define PG8_LDB8(dst, b, h) do { _Pragma("unroll") for (int n = 0; n < 2; ++n) dst[n] = PG8_LD8(PG8_SB(b, h) + boff + n * 2048); } while (0)
#define PG8_MMA8(ai, bj, At, Bt) do { __builtin_amdgcn_s_setprio(1); _Pragma("unroll") for (int m = 0; m < 4; ++m) _Pragma("unroll") for (int n = 0; n < 2; ++n) \
        asm volatile("v_mfma_f32_16x16x128_f8f6f4 %0, %1, %2, %0" : "+v"(acc[ai][bj][m][n]) : "v"(Bt[n]), "v"(At[m])); __builtin_amdgcn_s_setprio(0); } while (0)
#define PG8_LDA(dst, b, h) do { _Pragma("unroll") for (int m = 0; m < 4; ++m) _Pragma("unroll") for (int k = 0; k < 2; ++k) dst[m][k] = *(const PG8_LAS bf16x8*)(lds + PG8_SA(b, h) + aoff + m * 2048 + k * 1024); } while (0)
#define PG8_LDB(dst, b, h) do { _Pragma("unroll") for (int n = 0; n < 2; ++n) _Pragma("unroll") for (int k = 0; k < 2; ++k) dst[n][k] = *(const PG8_LAS bf16x8*)(lds + PG8_SB(b, h) + boff + n * 2048 + k * 1024); } while (0)
#define PG8_MMA(ai, bj, At, Bt) do { __builtin_amdgcn_s_setprio(1); _Pragma("unroll") for (int m = 0; m < 4; ++m) _Pragma("unroll") for (int n = 0; n < 2; ++n) _Pragma("unroll") for (int k = 0; k < 2; ++k) \
        acc[ai][bj][m][n] = __builtin_amdgcn_mfma_f32_16x16x32_bf16(Bt[n][k], At[m][k], acc[ai][bj][m][n], 0, 0, 0); __builtin_amdgcn_s_setprio(0); } while (0)
#define XLDA(b, h) do { if constexpr (FP8) PG8_LDA8(At8, b, h); else PG8_LDA(At, b, h); } while (0)
#define XLDB0(b, h) do { if constexpr (FP8) PG8_LDB8(B08, b, h); else PG8_LDB(B0, b, h); } while (0)
#define XLDB1(b, h) do { if constexpr (FP8) PG8_LDB8(B18, b, h); else PG8_LDB(B1, b, h); } while (0)
#define XMMA(ai, bj, w) do { if constexpr (FP8) { if (w) PG8_MMA8(ai, bj, At8, B18); else PG8_MMA8(ai, bj, At8, B08); } else { if (w) PG8_MMA(ai, bj, At, B1); else PG8_MMA(ai, bj, At, B0); } } while (0)
#define PG8_WAIT_V(n) asm volatile("s_waitcnt vmcnt(" #n ")" ::: "memory")
#define PG8_WAIT_L(n) asm volatile("s_waitcnt lgkmcnt(" #n ")" ::: "memory")
#define PG8_BAR __builtin_amdgcn_s_barrier()
#define PG8_SCHED __builtin_amdgcn_sched_barrier(0)
    Unit cur, nxt; int ui = 0;
    if (!S.next(0, cur)) return;
    f32x4 acc[2][2][4][2];
#pragma unroll
    for (int a = 0; a < 2; ++a)
#pragma unroll
        for (int b = 0; b < 2; ++b)
#pragma unroll
            for (int m = 0; m < 4; ++m)
#pragma unroll
                for (int n = 0; n < 2; ++n) acc[a][b][m][n] = (f32x4){0.f, 0.f, 0.f, 0.f};
    bf16x8 At[4][2], B0[2][2], B1[2][2]; i32x8 At8[4], B08[2], B18[2];
    const char* cA = S.a_ptr(g, cur); const char* cB = S.b_ptr(g, cur);
    if constexpr (GATHER) {
#pragma unroll
        for (int h = 0; h < 2; ++h)
#pragma unroll
            for (int i = 0; i < 2; ++i) offC[h][i] = S.row_off(g, cur, h * HALF + Rr[i]) + (unsigned)Cc[i] * 2u;
    }
    PG8_STAGE_B(PG8_SB(0, 0), cB); PG8_STAGE_B(PG8_SB(0, 1), cB + hstepB); PG8_STAGE_A(PG8_SA(0, 0), cA, offC, 0); PG8_STAGE_A(PG8_SA(0, 1), cA, offC, 1);
    if (wr == 1) PG8_BAR;
    PG8_WAIT_V(2); PG8_BAR;
    PG8_STAGE_B(PG8_SB(1, 0), cB + kstep); PG8_STAGE_A(PG8_SA(1, 0), cA + kstep, offC, 0); PG8_STAGE_B(PG8_SB(1, 1), cB + hstepB + kstep);
    PG8_WAIT_V(6); PG8_BAR;
    for (;;) {
        const bool has_next = S.next(ui + 1, nxt);
        const char* nA = has_next ? S.a_ptr(g, nxt) : cA; const char* nB = has_next ? S.b_ptr(g, nxt) : cB;
        if constexpr (GATHER) {
            if (has_next) {
#pragma unroll
                for (int h = 0; h < 2; ++h)
#pragma unroll
                    for (int i = 0; i < 2; ++i) offN[h][i] = S.row_off(g, nxt, h * HALF + Rr[i]) + (unsigned)Cc[i] * 2u;
            }
        }
#pragma unroll 1
        for (int t = 0; t < nt; t += 2) {
            const bool last = (t == nt - 2);
            const char* a1 = cA + (size_t)(t + 1) * kstep;
            const char* a2 = last ? nA : cA + (size_t)(t + 2) * kstep; const char* b2 = last ? nB : cB + (size_t)(t + 2) * kstep;
            const char* a3 = a2 + kstep; const char* b3 = b2 + kstep;
            unsigned o2[2][2];
#pragma unroll
            for (int h = 0; h < 2; ++h)
#pragma unroll
                for (int i = 0; i < 2; ++i) o2[h][i] = GATHER ? (last ? offN[h][i] : offC[h][i]) : offC[h][i];
            XLDB0(0, 0); XLDB1(0, 1); PG8_SCHED; XLDA(0, 0); PG8_STAGE_A(PG8_SA(1, 1), a1, offC, 1);
            PG8_WAIT_V(8); PG8_WAIT_L(0); PG8_BAR; XMMA(0, 0, 0); XMMA(0, 1, 1); PG8_BAR; PG8_SCHED;
            XLDA(0, 1); PG8_STAGE_B(PG8_SB(0, 0), b2); PG8_STAGE_B(PG8_SB(0, 1), b2 + hstepB); PG8_STAGE_A(PG8_SA(0, 0), a2, o2, 0);
            PG8_WAIT_V(8); PG8_WAIT_L(0); PG8_BAR; XMMA(1, 0, 0); XMMA(1, 1, 1); PG8_BAR; PG8_SCHED;
            XLDB0(1, 0); XLDB1(1, 1); PG8_SCHED; XLDA(1, 0); PG8_STAGE_A(PG8_SA(0, 1), a2, o2, 1);
            PG8_WAIT_V(8); PG8_WAIT_L(0); PG8_BAR; XMMA(0, 0, 0); XMMA(0, 1, 1); PG8_BAR; PG8_SCHED;
            XLDA(1, 1); PG8_STAGE_B(PG8_SB(1, 0), b3); PG8_STAGE_B(PG8_SB(1, 1), b3 + hstepB); PG8_STAGE_A(PG8_SA(1, 0), a3, o2, 0);
            PG8_WAIT_V(8); PG8_WAIT_L(0); PG8_BAR; XMMA(1, 0, 0); XMMA(1, 1, 1); PG8_BAR; PG8_SCHED;
        }
        if constexpr (ALIGN_EPI) { if (wr == 0) PG8_BAR; }
        if constexpr (FP8) {
            asm volatile("s_nop 15" : "+v"(acc[1][0][0][0]), "+v"(acc[1][0][0][1]), "+v"(acc[1][0][1][0]), "+v"(acc[1][0][1][1]), "+v"(acc[1][0][2][0]), "+v"(acc[1][0][2][1]), "+v"(acc[1][0][3][0]), "+v"(acc[1][0][3][1]));
            asm volatile("" : "+v"(acc[1][1][0][0]), "+v"(acc[1][1][0][1]), "+v"(acc[1][1][1][0]), "+v"(acc[1][1][1][1]), "+v"(acc[1][1][2][0]), "+v"(acc[1][1][2][1]), "+v"(acc[1][1][3][0]), "+v"(acc[1][1][3][1])); }
        E(acc, cur, wr, wc, fr, fq);
        if (!has_next) break;
        if (!E.keep(cur)) {
#pragma unroll
        for (int a = 0; a < 2; ++a)
#pragma unroll
            for (int b = 0; b < 2; ++b)
#pragma unroll
                for (int m = 0; m < 4; ++m)
#pragma unroll
                    for (int n = 0; n < 2; ++n) acc[a][b][m][n] = (f32x4){0.f, 0.f, 0.f, 0.f};
        }
        cur = nxt; cA = nA; cB = nB; ++ui;
        if constexpr (GATHER) {
#pragma unroll
            for (int h = 0; h < 2; ++h)
#pragma unroll
                for (int i = 0; i < 2; ++i) offC[h][i] = offN[h][i];
        }
        if constexpr (ALIGN_EPI) { if (wr == 1) PG8_BAR; }
    }
    PG8_WAIT_V(0);
    if constexpr (!ALIGN_EPI) { if (wr == 0) PG8_BAR; }
    PG8_BAR;
#undef PG8_SA
#undef PG8_SB
#undef PG8_STAGE_A
#undef PG8_STAGE_B
#undef PG8_LDA
#undef PG8_LD8
#undef PG8_LDA8
#undef PG8_LDB8
#undef PG8_MMA8
#undef XLDA
#undef XLDB0
#undef XLDB1
#undef XMMA
#undef PG8_LDB
#undef PG8_MMA
#undef PG8_WAIT_V
#undef PG8_WAIT_L
#undef PG8_BAR
#undef PG8_SCHED
}
}
namespace att {
using bf16x8 = __attribute__((ext_vector_type(8))) short;
using s16x4  = __attribute__((ext_vector_type(4))) short;
using f32x16 = __attribute__((ext_vector_type(16))) float;
using u32x4  = __attribute__((ext_vector_type(4))) unsigned;
typedef unsigned short bf16_t;
typedef float f32x4_t __attribute__((ext_vector_type(4)));
#define ALAS __attribute__((address_space(3)))
constexpr int NW = 8, QBLK = 32, KVBLK = 64;
constexpr int LDS_V = 0, LDS_K = 32768, LDS_WS = 65536;
constexpr int LDS_V3 = 0, LDS_K3 = 49152, LDS_WS3 = 98304, LDS_BYTES = LDS_WS3 + NW * 64 * 4;
constexpr float THR = 8.f;
#define KF(row) ((((row) & 7) | ((((row) >> 4) & 1) << 3)))
#define KSWZ(row, colB) ((row) * 256 + ((colB) ^ (KF(row) << 4)))
#define SBAR() __builtin_amdgcn_sched_barrier(0)
constexpr int QK2_BT = 2;
__device__ __forceinline__ int crow(int r, int hi) { return (r & 3) + 8 * (r >> 2) + 4 * hi; }
typedef float f32x2_t __attribute__((ext_vector_type(2))); typedef __bf16 bf16x2_t __attribute__((ext_vector_type(2)));
__device__ __forceinline__ unsigned cvtpk(float lo, float hi) { f32x2_t v = {lo, hi}; bf16x2_t b = __builtin_convertvector(v, bf16x2_t); return __builtin_bit_cast(unsigned, b); }

__device__ __forceinline__ void expHalf(f32x16& p0, float shift, bool use_shift) {
  if (use_shift) {
#pragma unroll
    for (int r = 0; r < 16; ++r) p0[r] = __builtin_amdgcn_exp2f(p0[r] + shift);
  } else {
#pragma unroll
    for (int r = 0; r < 16; ++r) p0[r] = __builtin_amdgcn_exp2f(p0[r]);
  }
}
__device__ __forceinline__ void finishSM(f32x16& p0, f32x16& p1, float& l_reg, bf16x8& pa0, bf16x8& pa1, bf16x8& pa2, bf16x8& pa3, float shift, bool use_shift) {
  expHalf(p1, shift, use_shift);
  float ps = 0;
#pragma unroll
  for (int r = 0; r < 16; ++r) ps += p0[r] + p1[r];
  l_reg += ps;
#define PK4(P, BASE, OUT) do { unsigned a0 = cvtpk(P[BASE + 0], P[BASE + 1]), a1 = cvtpk(P[BASE + 2], P[BASE + 3]);   \
    unsigned b0 = cvtpk(P[BASE + 4], P[BASE + 5]), b1 = cvtpk(P[BASE + 6], P[BASE + 7]);                              \
    auto r0 = __builtin_amdgcn_permlane32_swap(a0, b0, false, false); auto r1 = __builtin_amdgcn_permlane32_swap(a1, b1, false, false); \
    u32x4 w = {r0[0], r1[0], r0[1], r1[1]}; OUT = __builtin_bit_cast(bf16x8, w); } while (0)
  PK4(p0, 0, pa0); PK4(p0, 8, pa1); PK4(p1, 0, pa2); PK4(p1, 8, pa3);
#undef PK4
}
template <int DK, int COLB = 0> __device__ __forceinline__ void qkt(f32x16& p0, f32x16& p1, const ALAS char* Ks, const bf16x8* qr, int r32, int hi) {
  constexpr int ND = DK / 16, BT = ND > 4 ? ND / 2 : ND;
  p0 = f32x16{}; p1 = f32x16{};
#pragma unroll
  for (int b0 = 0; b0 < ND; b0 += BT) {
    bf16x8 k0[BT], k1[BT];
#pragma unroll
    for (int i = 0; i < BT; ++i) { const int cb = COLB + ((b0 + i) * 16 + hi * 8) * 2;
      k0[i] = *(const ALAS bf16x8*)(Ks + KSWZ(r32, cb)); k1[i] = *(const ALAS bf16x8*)(Ks + KSWZ(32 + r32, cb)); }
    SBAR();
#pragma unroll
    for (int i = 0; i < BT; ++i) {
      p0 = __builtin_amdgcn_mfma_f32_32x32x16_bf16(k0[i], qr[b0 + i], p0, 0, 0, 0);
      p1 = __builtin_amdgcn_mfma_f32_32x32x16_bf16(k1[i], qr[b0 + i], p1, 0, 0, 0); }
    SBAR();
  }
}
template <int NB> __device__ __forceinline__ int v_st(int k, int c) { const int kk = (k & ~0xC) | ((k & 4) << 1) | ((k & 8) >> 1); return ((kk >> 3) * NB + (c >> 5)) * 512 + ((kk & 7) * 32 + (c & 31)) * 2; }
__device__ __forceinline__ int v_rd_base(int lane) { return ((lane & 3) << 3) | (((lane >> 2) & 3) << 6) | (((lane >> 4) & 1) << 5) | (((lane >> 5) & 1) << 8); }
template <int OFF> __device__ __forceinline__ s16x4 tr_read(int vb) {
  s16x4 r; asm volatile("ds_read_b64_tr_b16 %0, %1 offset:%2" : "=&v"(r) : "v"(vb), "i"(OFF) : "memory"); return r;
}
template <int NB, int D0> __device__ __forceinline__ void pv_one(f32x16& od, int vb, bf16x8 pa0, bf16x8 pa1, bf16x8 pa2, bf16x8 pa3) {
#define VOFF(ks, half) (D0 * 512 + (ks) * (1024 * NB) + (half) * (512 * NB))
  const s16x4 l0 = tr_read<VOFF(0, 0)>(vb), h0 = tr_read<VOFF(0, 1)>(vb), l1 = tr_read<VOFF(1, 0)>(vb), h1 = tr_read<VOFF(1, 1)>(vb);
  const s16x4 l2 = tr_read<VOFF(2, 0)>(vb), h2 = tr_read<VOFF(2, 1)>(vb), l3 = tr_read<VOFF(3, 0)>(vb), h3 = tr_read<VOFF(3, 1)>(vb);
#undef VOFF
  asm volatile("s_waitcnt lgkmcnt(0)" ::: "memory"); SBAR();
#define PK(L, H) (bf16x8){L[0], L[1], L[2], L[3], H[0], H[1], H[2], H[3]}
  od = __builtin_amdgcn_mfma_f32_32x32x16_bf16(pa0, PK(l0, h0), od, 0, 0, 0);
  od = __builtin_amdgcn_mfma_f32_32x32x16_bf16(pa1, PK(l1, h1), od, 0, 0, 0);
  od = __builtin_amdgcn_mfma_f32_32x32x16_bf16(pa2, PK(l2, h2), od, 0, 0, 0);
  od = __builtin_amdgcn_mfma_f32_32x32x16_bf16(pa3, PK(l3, h3), od, 0, 0, 0);
#undef PK
}
template <int NB> __device__ __forceinline__ void pv_all(f32x16* o, int vb, bf16x8 pa0, bf16x8 pa1, bf16x8 pa2, bf16x8 pa3) {
  pv_one<NB, 0>(o[0], vb, pa0, pa1, pa2, pa3); pv_one<NB, 1>(o[1], vb, pa0, pa1, pa2, pa3);
  if constexpr (NB == 4) { pv_one<NB, 2>(o[2], vb, pa0, pa1, pa2, pa3); pv_one<NB, 3>(o[3], vb, pa0, pa1, pa2, pa3); }
}

struct QPrep { const float* g; const float* c1; const float* s1; const float* c2; const float* s2; int pos0; };
template <int DK, int QMODE>
__device__ __forceinline__ void load_q(bf16x8 (&qr)[DK / 16], const bf16_t* Qw, const QPrep& qp, float qscale, int wid, int r32, int hi) {
  constexpr int ND = DK / 16;
  float x[ND * 8];
#pragma unroll
  for (int d0 = 0; d0 < ND; ++d0) { const u32x4 w = *reinterpret_cast<const u32x4*>(Qw + d0 * 16);
#pragma unroll
    for (int e = 0; e < 4; ++e) { x[d0 * 8 + 2 * e] = __uint_as_float(w[e] << 16); x[d0 * 8 + 2 * e + 1] = __uint_as_float(w[e] & 0xffff0000u); } }
  if constexpr (QMODE != 0) {
    float ss = 0.f;
#pragma unroll
    for (int i = 0; i < ND * 8; ++i) ss += x[i] * x[i];
    { auto rr = __builtin_amdgcn_permlane32_swap(__float_as_uint(ss), __float_as_uint(ss), false, false); ss = __uint_as_float(rr[0]) + __uint_as_float(rr[1]); }
    const float rstd = __builtin_amdgcn_rsqf(ss * (1.f / DK) + 1e-6f);
#pragma unroll
    for (int d0 = 0; d0 < ND; ++d0) { const f32x4_t g0 = *reinterpret_cast<const f32x4_t*>(qp.g + d0 * 16 + hi * 8), g1 = *reinterpret_cast<const f32x4_t*>(qp.g + d0 * 16 + hi * 8 + 4);
#pragma unroll
      for (int e = 0; e < 4; ++e) { x[d0 * 8 + e] *= rstd * g0[e]; x[d0 * 8 + 4 + e] *= rstd * g1[e]; } }
    const int pos = qp.pos0 + wid * QBLK + r32;
#define ROPE_PAIR(dA, dB, CT, ST) do { const f32x4_t c0 = *reinterpret_cast<const f32x4_t*>((CT) + hi * 8), c1_ = *reinterpret_cast<const f32x4_t*>((CT) + hi * 8 + 4), s0 = *reinterpret_cast<const f32x4_t*>((ST) + hi * 8), s1_ = *reinterpret_cast<const f32x4_t*>((ST) + hi * 8 + 4); \
      _Pragma("unroll") for (int e = 0; e < 8; ++e) { const float c = e < 4 ? c0[e & 3] : c1_[e & 3], s = e < 4 ? s0[e & 3] : s1_[e & 3]; const float xa = x[(dA) * 8 + e], xb = x[(dB) * 8 + e]; \
        x[(dA) * 8 + e] = xa * c - xb * s; x[(dB) * 8 + e] = xb * c + xa * s; } } while (0)
    if constexpr (QMODE == 1) {
#pragma unroll
      for (int d0 = 0; d0 < ND / 2; ++d0) ROPE_PAIR(d0, d0 + ND / 2, qp.c1 + (size_t)pos * (DK / 2) + d0 * 16, qp.s1 + (size_t)pos * (DK / 2) + d0 * 16);
    } else if constexpr (QMODE == 2) {
      const int grow = pos >> 6, gcol = pos & 63;
      ROPE_PAIR(0, 1, qp.c1 + grow * 16, qp.s1 + grow * 16); ROPE_PAIR(2, 3, qp.c2 + gcol * 16, qp.s2 + gcol * 16);
    } else if constexpr (QMODE == 3) {
      ROPE_PAIR(4, 5, qp.c1 + pos * 16, qp.s1 + pos * 16);
    }
#undef ROPE_PAIR
  }
#pragma unroll
  for (int d0 = 0; d0 < ND; ++d0) { u32x4 w;
#pragma unroll
    for (int e = 0; e < 4; ++e) w[e] = cvtpk(x[d0 * 8 + 2 * e] * qscale, x[d0 * 8 + 2 * e + 1] * qscale);
    qr[d0] = __builtin_bit_cast(bf16x8, w); }
}

struct DiffEpi { const bf16_t* O1; int ldo1; float lam; const float* g; int layer; };
template <int DK, int DV, int SDEPTH, int QMODE, int PIPE = 2, bool DIFF2 = false>
__device__ __forceinline__ void attn_unit(const bf16_t* Qb, int ldq, const bf16_t* __restrict__ Kh, int ldk, const bf16_t* __restrict__ Vh, int ldv,
                                          bf16_t* Ob, int ldo, int nkeys, float qscale, float negb_, const QPrep& qp, ALAS char* lds, int wave0, float omul = 1.0f, const DiffEpi* de = nullptr) {
  constexpr int NB = DV / 32, KC = DK / 8, VC = DV / 8;
  constexpr int NKC = 64 * KC, NVC = 64 * VC, KPT = (NKC + 511) / 512, VPT = (NVC + 511) / 512;
  constexpr int SHM_V = KVBLK * DV * 2, SHM_K = 16384;
  int tid; asm volatile("v_mbcnt_lo_u32_b32 %0, -1, 0\n\tv_mbcnt_hi_u32_b32 %0, -1, %0" : "=v"(tid)); tid = (tid + wave0 * 64) & 511;
  const int wid = tid >> 6, lane = tid & 63, r32 = lane & 31, hi = lane >> 5;
  ALAS char* V_lds = lds + (PIPE == 3 ? LDS_V3 : LDS_V); ALAS char* K_lds = lds + (PIPE == 3 ? LDS_K3 : LDS_K);
  ALAS float* ws = (ALAS float*)(lds + (PIPE == 3 ? LDS_WS3 : LDS_WS)) + wid * 64; ALAS float* li_l = ws;
  float l_reg = 0; f32x16 o[NB]; bf16x8 qr[DK / 16];
  const bool use_shift = negb_ < -60.f;
  load_q<DK, QMODE>(qr, Qb + (long)(wid * QBLK + r32) * ldq + hi * 8, qp, qscale, wid, r32, hi);
  SBAR();
#pragma unroll
  for (int d = 0; d < NB; ++d) o[d] = f32x16{};
  int kgo[KPT], klo[KPT], vgo[VPT], vlo[VPT]; bool kok[KPT], vok[VPT];
#pragma unroll
  for (int i = 0; i < KPT; ++i) { const int c = tid + 512 * i; kok[i] = (512 * (i + 1) <= NKC) || (c < NKC); const int row = c / KC, col = (c % KC) * 8; kgo[i] = row * ldk + col; klo[i] = KSWZ(row, col * 2); }
#pragma unroll
  for (int i = 0; i < VPT; ++i) { const int c = tid + 512 * i; vok[i] = (512 * (i + 1) <= NVC) || (c < NVC); const int row = c / VC, col = (c % VC) * 8; vgo[i] = row * ldv + col; vlo[i] = v_st<NB>(row, col); }
  const int vb0 = (int)(unsigned)(unsigned long)V_lds + v_rd_base(lane);
  struct { bf16x8 ks[KPT], vs[VPT]; } sr_[SDEPTH];
#define SLOAD(s, k0) do { _Pragma("unroll") for (int i_ = 0; i_ < KPT; ++i_) if (kok[i_]) sr_[s].ks[i_] = *reinterpret_cast<const bf16x8*>(Kh + (long)(k0) * ldk + kgo[i_]); \
    _Pragma("unroll") for (int i_ = 0; i_ < VPT; ++i_) if (vok[i_]) sr_[s].vs[i_] = *reinterpret_cast<const bf16x8*>(Vh + (long)(k0) * ldv + vgo[i_]); } while (0)
#define SWRITE(b, s) do { _Pragma("unroll") for (int i_ = 0; i_ < KPT; ++i_) if (kok[i_]) *(ALAS bf16x8*)(K_lds + (b) * SHM_K + klo[i_]) = sr_[s].ks[i_]; \
    _Pragma("unroll") for (int i_ = 0; i_ < VPT; ++i_) if (vok[i_]) *(ALAS bf16x8*)(V_lds + (b) * SHM_V + vlo[i_]) = sr_[s].vs[i_]; } while (0)
#define SWAIT() do { if constexpr (SDEPTH == 2) asm volatile("s_waitcnt vmcnt(%0)" :: "n"(KPT + VPT) : "memory"); else asm volatile("s_waitcnt vmcnt(0)" ::: "memory"); } while (0)
  bf16x8 pa0, pa1, pa2, pa3; const int NT = nkeys / KVBLK;
  if constexpr (PIPE == 1) {
    f32x16 pA0, pA1;
    SLOAD(0, 0); asm volatile("s_waitcnt vmcnt(0)" ::: "memory"); SWRITE(0, 0); __syncthreads();
    for (int j = 0; j < NT; ++j) {
      const int bsel = j & 1;
      if (j + 1 < NT) SLOAD(0, (j + 1) * KVBLK);
      SBAR(); qkt<DK>(pA0, pA1, K_lds + bsel * SHM_K, qr, r32, hi); expHalf(pA0, negb_, use_shift);
      finishSM(pA0, pA1, l_reg, pa0, pa1, pa2, pa3, negb_, use_shift); SBAR();
      pv_all<NB>(o, vb0 + bsel * SHM_V, pa0, pa1, pa2, pa3);
      if (j + 1 < NT) { asm volatile("s_waitcnt vmcnt(0)" ::: "memory"); SWRITE(bsel ^ 1, 0); }
      __syncthreads();
    }
  } else if constexpr (PIPE == 4) {
    f32x16 pA0, pA1;
    SLOAD(0, 0); asm volatile("s_waitcnt vmcnt(0)" ::: "memory"); SWRITE(0, 0); __syncthreads();
    if (wave0 < 4) {
      for (int j = 0; j < NT; ++j) {
        const int bsel = j & 1;
        if (j + 1 < NT) SLOAD(0, (j + 1) * KVBLK);
        SBAR(); qkt<DK>(pA0, pA1, K_lds + bsel * SHM_K, qr, r32, hi); expHalf(pA0, negb_, use_shift);
        finishSM(pA0, pA1, l_reg, pa0, pa1, pa2, pa3, negb_, use_shift); SBAR();
        __builtin_amdgcn_s_barrier(); SBAR();
        pv_all<NB>(o, vb0 + bsel * SHM_V, pa0, pa1, pa2, pa3);
        if (j + 1 < NT) { asm volatile("s_waitcnt vmcnt(0)" ::: "memory"); SWRITE(bsel ^ 1, 0); }
        __syncthreads();
      }
    } else {
      for (int j = 0; j < NT; ++j) {
        const int bsel = j & 1;
        if (j + 1 < NT) SLOAD(0, (j + 1) * KVBLK);
        SBAR(); if (j > 0) pv_all<NB>(o, vb0 + (bsel ^ 1) * SHM_V, pa0, pa1, pa2, pa3);
        SBAR(); qkt<DK>(pA0, pA1, K_lds + bsel * SHM_K, qr, r32, hi); SBAR();
        __builtin_amdgcn_s_barrier(); SBAR();
        expHalf(pA0, negb_, use_shift); finishSM(pA0, pA1, l_reg, pa0, pa1, pa2, pa3, negb_, use_shift); SBAR();
        if (j + 1 < NT) { asm volatile("s_waitcnt vmcnt(0)" ::: "memory"); SWRITE(bsel ^ 1, 0); }
        __syncthreads();
      }
      pv_all<NB>(o, vb0 + ((NT - 1) & 1) * SHM_V, pa0, pa1, pa2, pa3);
    }
  } else if constexpr (PIPE == 3) {
    f32x16 pA0, pA1, pB0, pB1;
    struct { bf16x8 ks[KPT], vs[VPT]; } st_;
#define GLK(k0) do { _Pragma("unroll") for (int i_ = 0; i_ < KPT; ++i_) if (kok[i_]) st_.ks[i_] = *reinterpret_cast<const bf16x8*>(Kh + (long)(k0) * ldk + kgo[i_]); } while (0)
#define GLV(k0) do { _Pragma("unroll") for (int i_ = 0; i_ < VPT; ++i_) if (vok[i_]) st_.vs[i_] = *reinterpret_cast<const bf16x8*>(Vh + (long)(k0) * ldv + vgo[i_]); } while (0)
#define WRK(off) do { _Pragma("unroll") for (int i_ = 0; i_ < KPT; ++i_) if (kok[i_]) *(ALAS bf16x8*)(K_lds + (off) + klo[i_]) = st_.ks[i_]; } while (0)
#define WRV(off) do { _Pragma("unroll") for (int i_ = 0; i_ < VPT; ++i_) if (vok[i_]) *(ALAS bf16x8*)(V_lds + (off) + vlo[i_]) = st_.vs[i_]; } while (0)
#define ROT3(x, S) ((x) == 2 * (S) ? 0 : (x) + (S))
    GLK(0); GLV(0); asm volatile("s_waitcnt vmcnt(0)" ::: "memory"); WRK(0); WRV(0);
    GLK(KVBLK); asm volatile("s_waitcnt vmcnt(0)" ::: "memory"); WRK(SHM_K);
    if (2 < NT) GLK(2 * KVBLK);
    GLV(KVBLK);
    __syncthreads();
    int kr = 0, vr = 0, kw = 2 * SHM_K, vw = SHM_V;
#define STEP3(PC0, PC1, PP0, PP1, t, HASPREV) do { \
      SBAR(); qkt<DK>(PC0, PC1, K_lds + kr, qr, r32, hi); \
      if (HASPREV) { finishSM(PP0, PP1, l_reg, pa0, pa1, pa2, pa3, negb_, use_shift); SBAR(); pv_all<NB>(o, vb0 + vr, pa0, pa1, pa2, pa3); vr = ROT3(vr, SHM_V); } \
      expHalf(PC0, negb_, use_shift); \
      asm volatile("s_waitcnt vmcnt(0)" ::: "memory"); \
      if ((t) + 2 < NT) WRK(kw); if ((t) + 1 < NT) WRV(vw); \
      if ((t) + 3 < NT) GLK(((t) + 3) * KVBLK); if ((t) + 2 < NT) GLV(((t) + 2) * KVBLK); \
      kr = ROT3(kr, SHM_K); kw = ROT3(kw, SHM_K); vw = ROT3(vw, SHM_V); \
      __syncthreads(); } while (0)
    STEP3(pA0, pA1, pB0, pB1, 0, false);
    for (int t = 1; t + 1 < NT; t += 2) {
      STEP3(pB0, pB1, pA0, pA1, t, true);
      STEP3(pA0, pA1, pB0, pB1, t + 1, true);
    }
    STEP3(pB0, pB1, pA0, pA1, NT - 1, true);
    finishSM(pB0, pB1, l_reg, pa0, pa1, pa2, pa3, negb_, use_shift); SBAR();
    pv_all<NB>(o, vb0 + vr, pa0, pa1, pa2, pa3);
#undef GLK
#undef GLV
#undef WRK
#undef WRV
#undef ROT3
#undef STEP3
  } else {
  f32x16 pA0, pA1, pB0, pB1;
  constexpr int SE = 0, SO = SDEPTH - 1;
  SLOAD(SE, 0); asm volatile("s_waitcnt vmcnt(0)" ::: "memory"); SWRITE(0, SE); __syncthreads();
  qkt<DK>(pA0, pA1, K_lds, qr, r32, hi); expHalf(pA0, negb_, use_shift);
  SLOAD(SO, KVBLK); if constexpr (SDEPTH == 2) { if (2 < NT) SLOAD(SE, 2 * KVBLK); }
  SWAIT(); SWRITE(1, SO); __syncthreads();
  for (int j = 1; j + 1 < NT; j += 2) {
    SBAR(); qkt<DK>(pB0, pB1, K_lds + SHM_K, qr, r32, hi);
    finishSM(pA0, pA1, l_reg, pa0, pa1, pa2, pa3, negb_, use_shift); SBAR();
    SLOAD(SO, (j + SDEPTH) * KVBLK); SBAR();
    pv_all<NB>(o, vb0, pa0, pa1, pa2, pa3); expHalf(pB0, negb_, use_shift);
    __syncthreads(); SWAIT(); SWRITE(0, SE);
    __syncthreads();
    SBAR(); qkt<DK>(pA0, pA1, K_lds, qr, r32, hi);
    finishSM(pB0, pB1, l_reg, pa0, pa1, pa2, pa3, negb_, use_shift); SBAR();
    if (SDEPTH == 1 || j + 3 < NT) SLOAD(SE, (j + 1 + SDEPTH) * KVBLK); SBAR();
    pv_all<NB>(o, vb0 + SHM_V, pa0, pa1, pa2, pa3); expHalf(pA0, negb_, use_shift);
    __syncthreads(); SWAIT(); SWRITE(1, SO);
    __syncthreads();
  }
  SBAR(); qkt<DK>(pB0, pB1, K_lds + SHM_K, qr, r32, hi);
  finishSM(pA0, pA1, l_reg, pa0, pa1, pa2, pa3, negb_, use_shift); SBAR();
  pv_all<NB>(o, vb0, pa0, pa1, pa2, pa3); expHalf(pB0, negb_, use_shift);
  finishSM(pB0, pB1, l_reg, pa0, pa1, pa2, pa3, negb_, use_shift); SBAR();
  pv_all<NB>(o, vb0 + SHM_V, pa0, pa1, pa2, pa3);
  }
  { auto rr = __builtin_amdgcn_permlane32_swap(__float_as_uint(l_reg), __float_as_uint(l_reg), false, false); l_reg = __uint_as_float(rr[0]) + __uint_as_float(rr[1]); }
  if (hi == 0) li_l[r32] = l_reg; asm volatile("s_waitcnt lgkmcnt(0)" ::: "memory");
  float rli[16];
#pragma unroll
  for (int r = 0; r < 16; ++r) rli[r] = __builtin_amdgcn_rcpf(li_l[crow(r, hi)]) * omul;
  bf16_t* Ow = Ob + (long)(wid * QBLK) * ldo;
  if constexpr (DIFF2) {
    const bf16_t* O1w = de->O1 + (long)(wid * QBLK) * de->ldo1;
    float gcol[NB];
    int ly_ = de->layer; asm volatile("" : "+s"(ly_));
    const float post_ = (ly_ == 0) ? 0.8f : (1.0f - (0.8f - 0.6f * 0.74081822068171788f));
#pragma unroll
    for (int d0 = 0; d0 < NB; ++d0) gcol[d0] = de->g[d0 * 32 + r32] * post_;
#pragma unroll
    for (int r = 0; r < 16; ++r) { const int orow = crow(r, hi); float d[NB]; float ss = 0.f;
#pragma unroll
      for (int d0 = 0; d0 < NB; ++d0) { const float o1 = __uint_as_float((unsigned)O1w[(long)orow * de->ldo1 + d0 * 32 + r32] << 16); d[d0] = o1 - de->lam * (o[d0][r] * rli[r]); ss += d[d0] * d[d0]; }
      ss += __int_as_float(__builtin_amdgcn_ds_swizzle(__float_as_int(ss), (1 << 10) | 0x1f)); ss += __int_as_float(__builtin_amdgcn_ds_swizzle(__float_as_int(ss), (2 << 10) | 0x1f));
      ss += __int_as_float(__builtin_amdgcn_ds_swizzle(__float_as_int(ss), (4 << 10) | 0x1f)); ss += __int_as_float(__builtin_amdgcn_ds_swizzle(__float_as_int(ss), (8 << 10) | 0x1f));
      ss += __int_as_float(__builtin_amdgcn_ds_swizzle(__float_as_int(ss), (16 << 10) | 0x1f));
      const float rstd = __builtin_amdgcn_rsqf(ss * (1.f / 128.f) + 1e-6f);
#pragma unroll
      for (int d0 = 0; d0 < NB; ++d0) { const float v = d[d0] * rstd * gcol[d0]; Ow[(long)orow * ldo + d0 * 32 + r32] = (bf16_t)(cvtpk(v, v) & 0xffffu); } }
  } else {
#pragma unroll
  for (int r = 0; r < 16; ++r) { const int orow = crow(r, hi);
#pragma unroll
    for (int d0 = 0; d0 < NB; ++d0) { const float v = o[d0][r] * rli[r]; Ow[(long)orow * ldo + d0 * 32 + r32] = (bf16_t)(cvtpk(v, v) & 0xffffu); } }
  }
  __syncthreads();
#undef SLOAD
#undef SWRITE
#undef SWAIT
}
template <int DK> __device__ __forceinline__ void qkt2(f32x16 (&p)[2][2], const ALAS char* Ks, const bf16x8 (&qr)[2][DK / 16], int r32, int hi) {
  constexpr int ND = DK / 16, BT = QK2_BT < ND ? QK2_BT : ND;
  p[0][0] = f32x16{}; p[0][1] = f32x16{}; p[1][0] = f32x16{}; p[1][1] = f32x16{};
#pragma unroll
  for (int b0 = 0; b0 < ND; b0 += BT) {
    bf16x8 k0[BT], k1[BT];
#pragma unroll
    for (int i = 0; i < BT; ++i) { const int cb = ((b0 + i) * 16 + hi * 8) * 2;
      k0[i] = *(const ALAS bf16x8*)(Ks + KSWZ(r32, cb)); k1[i] = *(const ALAS bf16x8*)(Ks + KSWZ(32 + r32, cb)); }
    SBAR();
#pragma unroll
    for (int i = 0; i < BT; ++i) {
      p[0][0] = __builtin_amdgcn_mfma_f32_32x32x16_bf16(k0[i], qr[0][b0 + i], p[0][0], 0, 0, 0);
      p[1][0] = __builtin_amdgcn_mfma_f32_32x32x16_bf16(k0[i], qr[1][b0 + i], p[1][0], 0, 0, 0);
      p[0][1] = __builtin_amdgcn_mfma_f32_32x32x16_bf16(k1[i], qr[0][b0 + i], p[0][1], 0, 0, 0);
      p[1][1] = __builtin_amdgcn_mfma_f32_32x32x16_bf16(k1[i], qr[1][b0 + i], p[1][1], 0, 0, 0); }
    SBAR();
  }
}
template <int NB, int D0> __device__ __forceinline__ void pv_one2(f32x16& oa, f32x16& ob, int vb, const bf16x8 (&pa)[2][4]) {
#define VOFF(ks, half) (D0 * 512 + (ks) * (1024 * NB) + (half) * (512 * NB))
  const s16x4 l0 = tr_read<VOFF(0, 0)>(vb), h0 = tr_read<VOFF(0, 1)>(vb), l1 = tr_read<VOFF(1, 0)>(vb), h1 = tr_read<VOFF(1, 1)>(vb);
  const s16x4 l2 = tr_read<VOFF(2, 0)>(vb), h2 = tr_read<VOFF(2, 1)>(vb), l3 = tr_read<VOFF(3, 0)>(vb), h3 = tr_read<VOFF(3, 1)>(vb);
#undef VOFF
  asm volatile("s_waitcnt lgkmcnt(0)" ::: "memory"); SBAR();
#define PK(L, H) (bf16x8){L[0], L[1], L[2], L[3], H[0], H[1], H[2], H[3]}
  oa = __builtin_amdgcn_mfma_f32_32x32x16_bf16(pa[0][0], PK(l0, h0), oa, 0, 0, 0);
  ob = __builtin_amdgcn_mfma_f32_32x32x16_bf16(pa[1][0], PK(l0, h0), ob, 0, 0, 0);
  oa = __builtin_amdgcn_mfma_f32_32x32x16_bf16(pa[0][1], PK(l1, h1), oa, 0, 0, 0);
  ob = __builtin_amdgcn_mfma_f32_32x32x16_bf16(pa[1][1], PK(l1, h1), ob, 0, 0, 0);
  oa = __builtin_amdgcn_mfma_f32_32x32x16_bf16(pa[0][2], PK(l2, h2), oa, 0, 0, 0);
  ob = __builtin_amdgcn_mfma_f32_32x32x16_bf16(pa[1][2], PK(l2, h2), ob, 0, 0, 0);
  oa = __builtin_amdgcn_mfma_f32_32x32x16_bf16(pa[0][3], PK(l3, h3), oa, 0, 0, 0);
  ob = __builtin_amdgcn_mfma_f32_32x32x16_bf16(pa[1][3], PK(l3, h3), ob, 0, 0, 0);
#undef PK
}
template <int DK, int QMODE, bool SHAREK = true>
__device__ __forceinline__ void attn_unit2(const bf16_t* Qb, int ldq, const bf16_t* __restrict__ Kh, int ldk, const bf16_t* __restrict__ Vh, int ldv,
                                           bf16_t* Ob, int ldo, int nkeys, float qscale, float negb_, const QPrep& qp, ALAS char* lds, int wave0) {
  constexpr int DV = 64, NB = 2, KC = DK / 8, VC = DV / 8;
  constexpr int NKC = 64 * KC, NVC = 64 * VC, KPT = (NKC + 511) / 512, VPT = (NVC + 511) / 512;
  constexpr int SHM_V = KVBLK * DV * 2, SHM_K = 16384;
  int tid; asm volatile("v_mbcnt_lo_u32_b32 %0, -1, 0\n\tv_mbcnt_hi_u32_b32 %0, -1, %0" : "=v"(tid)); tid = (tid + wave0 * 64) & 511;
  const int wid = tid >> 6, lane = tid & 63, r32 = lane & 31, hi = lane >> 5;
  ALAS char* V_lds = lds + LDS_V; ALAS char* K_lds = lds + LDS_K;
  ALAS float* ws = (ALAS float*)(lds + LDS_WS) + wid * 64;
  const bool use_shift = negb_ < -60.f;
  float l_reg[2] = {0.f, 0.f}; f32x16 o[2][NB]; bf16x8 qr[2][DK / 16];
  { QPrep q2 = qp;
    load_q<DK, QMODE>(qr[0], Qb + (long)(wid * QBLK + r32) * ldq + hi * 8, q2, qscale, wid, r32, hi);
    SBAR();
    q2.pos0 = qp.pos0 + 256;
    load_q<DK, QMODE>(qr[1], Qb + (long)(256 + wid * QBLK + r32) * ldq + hi * 8, q2, qscale, wid, r32, hi); }
  SBAR();
#pragma unroll
  for (int q = 0; q < 2; ++q)
#pragma unroll
    for (int d = 0; d < NB; ++d) o[q][d] = f32x16{};
  int kgo[KPT], klo[KPT], vgo[VPT], vlo[VPT]; bool kok[KPT], vok[VPT];
#pragma unroll
  for (int i = 0; i < KPT; ++i) { const int c = tid + 512 * i; kok[i] = (512 * (i + 1) <= NKC) || (c < NKC); const int row = c / KC, col = (c % KC) * 8; kgo[i] = row * ldk + col; klo[i] = KSWZ(row, col * 2); }
#pragma unroll
  for (int i = 0; i < VPT; ++i) { const int c = tid + 512 * i; vok[i] = (512 * (i + 1) <= NVC) || (c < NVC); const int row = c / VC, col = (c % VC) * 8; vgo[i] = row * ldv + col; vlo[i] = v_st<NB>(row, col); }
  const int vb0 = (int)(unsigned)(unsigned long)V_lds + v_rd_base(lane);
  struct { bf16x8 ks[KPT], vs[VPT]; } sr_;
#define SLOAD2(k0) do { _Pragma("unroll") for (int i_ = 0; i_ < KPT; ++i_) if (kok[i_]) sr_.ks[i_] = *reinterpret_cast<const bf16x8*>(Kh + (long)(k0) * ldk + kgo[i_]); \
    _Pragma("unroll") for (int i_ = 0; i_ < VPT; ++i_) if (vok[i_]) sr_.vs[i_] = *reinterpret_cast<const bf16x8*>(Vh + (long)(k0) * ldv + vgo[i_]); } while (0)
#define SWRITE2(b) do { _Pragma("unroll") for (int i_ = 0; i_ < KPT; ++i_) if (kok[i_]) *(ALAS bf16x8*)(K_lds + (b) * SHM_K + klo[i_]) = sr_.ks[i_]; \
    _Pragma("unroll") for (int i_ = 0; i_ < VPT; ++i_) if (vok[i_]) *(ALAS bf16x8*)(V_lds + (b) * SHM_V + vlo[i_]) = sr_.vs[i_]; } while (0)
  const int NT = nkeys / KVBLK;
  f32x16 p[2][2]; bf16x8 pa[2][4];
  SLOAD2(0); asm volatile("s_waitcnt vmcnt(0)" ::: "memory"); SWRITE2(0); __syncthreads();
  for (int j = 0; j < NT; ++j) {
    const int bsel = j & 1;
    if (j + 1 < NT) SLOAD2((j + 1) * KVBLK);
    if constexpr (SHAREK) {
      SBAR(); qkt2<DK>(p, K_lds + bsel * SHM_K, qr, r32, hi);
      expHalf(p[0][0], negb_, use_shift); finishSM(p[0][0], p[0][1], l_reg[0], pa[0][0], pa[0][1], pa[0][2], pa[0][3], negb_, use_shift);
      expHalf(p[1][0], negb_, use_shift); finishSM(p[1][0], p[1][1], l_reg[1], pa[1][0], pa[1][1], pa[1][2], pa[1][3], negb_, use_shift); SBAR();
    } else {
      SBAR(); qkt<DK>(p[0][0], p[0][1], K_lds + bsel * SHM_K, qr[0], r32, hi);
      expHalf(p[0][0], negb_, use_shift); finishSM(p[0][0], p[0][1], l_reg[0], pa[0][0], pa[0][1], pa[0][2], pa[0][3], negb_, use_shift); SBAR();
      qkt<DK>(p[0][0], p[0][1], K_lds + bsel * SHM_K, qr[1], r32, hi);
      expHalf(p[0][0], negb_, use_shift); finishSM(p[0][0], p[0][1], l_reg[1], pa[1][0], pa[1][1], pa[1][2], pa[1][3], negb_, use_shift); SBAR();
    }
    pv_one2<NB, 0>(o[0][0], o[1][0], vb0 + bsel * SHM_V, pa); pv_one2<NB, 1>(o[0][1], o[1][1], vb0 + bsel * SHM_V, pa);
    if (j + 1 < NT) { asm volatile("s_waitcnt vmcnt(0)" ::: "memory"); SWRITE2(bsel ^ 1); }
    __syncthreads();
  }
#pragma unroll
  for (int q = 0; q < 2; ++q) {
    float lq = l_reg[q];
    { auto rr = __builtin_amdgcn_permlane32_swap(__float_as_uint(lq), __float_as_uint(lq), false, false); lq = __uint_as_float(rr[0]) + __uint_as_float(rr[1]); }
    if (hi == 0) ws[q * 32 + r32] = lq;
  }
  asm volatile("s_waitcnt lgkmcnt(0)" ::: "memory");
#pragma unroll
  for (int q = 0; q < 2; ++q) {
    float rli[16];
#pragma unroll
    for (int r = 0; r < 16; ++r) rli[r] = __builtin_amdgcn_rcpf(ws[q * 32 + crow(r, hi)]);
    bf16_t* Ow = Ob + (long)(q * 256 + wid * QBLK) * ldo;
#pragma unroll
    for (int r = 0; r < 16; ++r) { const int orow = crow(r, hi);
#pragma unroll
      for (int d0 = 0; d0 < NB; ++d0) { const float v = o[q][d0][r] * rli[r]; Ow[(long)orow * ldo + d0 * 32 + r32] = (bf16_t)(cvtpk(v, v) & 0xffffu); } }
  }
  __syncthreads();
#undef SLOAD2
#undef SWRITE2
}
template <int DK, int QMODE, bool SHAREK = true>
__device__ __forceinline__ void attn_unit2d(const bf16_t* Qb, int ldq, const bf16_t* __restrict__ Kh, int ldk, const bf16_t* __restrict__ Vh, int ldv,
                                           bf16_t* Ob, int ldo, int nkeys, float qscale, float negb_, const QPrep& qp, ALAS char* lds, int wave0) {
  constexpr int DV = 64, NB = 2, KC = DK / 8, VC = DV / 8;
  constexpr int NKC = 64 * KC, NVC = 64 * VC, KPT = (NKC + 511) / 512, VPT = (NVC + 511) / 512;
  constexpr int SHM_V = KVBLK * DV * 2, SHM_K = 16384;
  int tid; asm volatile("v_mbcnt_lo_u32_b32 %0, -1, 0\n\tv_mbcnt_hi_u32_b32 %0, -1, %0" : "=v"(tid)); tid = (tid + wave0 * 64) & 511;
  const int wid = tid >> 6, lane = tid & 63, r32 = lane & 31, hi = lane >> 5;
  ALAS char* V_lds = lds + LDS_V; ALAS char* K_lds = lds + LDS_K;
  ALAS float* ws = (ALAS float*)(lds + LDS_WS) + wid * 64;
  const bool use_shift = negb_ < -60.f;
  float l_reg[2] = {0.f, 0.f}; f32x16 o[2][NB]; bf16x8 qr[2][DK / 16];
  { QPrep q2 = qp;
    load_q<DK, QMODE>(qr[0], Qb + (long)(wid * QBLK + r32) * ldq + hi * 8, q2, qscale, wid, r32, hi);
    SBAR();
    q2.pos0 = qp.pos0 + 256;
    load_q<DK, QMODE>(qr[1], Qb + (long)(256 + wid * QBLK + r32) * ldq + hi * 8, q2, qscale, wid, r32, hi); }
  SBAR();
#pragma unroll
  for (int q = 0; q < 2; ++q)
#pragma unroll
    for (int d = 0; d < NB; ++d) o[q][d] = f32x16{};
  const int widu = __builtin_amdgcn_readfirstlane(wid);
  constexpr int KINST = 2, VINST = (64 * DV * 2) / (512 * 16);
  int kg[KINST], vg[VINST]; bool kv_[KINST];
#pragma unroll
  for (int i = 0; i < KINST; ++i) { const int q = (i * 8 + wid) * 64 + lane, row = q >> 4, pos = q & 15, c = pos ^ KF(row); kv_[i] = c < KC; kg[i] = row * ldk + c * 8; }
#pragma unroll
  for (int i = 0; i < VINST; ++i) { const int q = (i * 8 + wid) * 64 + lane, o_ = q * 16, sub = o_ >> 9, e = (o_ & 511) >> 1, kk = (sub / NB) * 8 + (e >> 5), k = (kk & ~0xC) | ((kk & 4) << 1) | ((kk & 8) >> 1), c = (sub % NB) * 32 + (e & 31); vg[i] = k * ldv + c; }
  const int vb0 = (int)(unsigned)(unsigned long)V_lds + v_rd_base(lane);
#define DMA_KV(b, k0) do { \
    _Pragma("unroll") for (int i_ = 0; i_ < KINST; ++i_) if (kv_[i_]) __builtin_amdgcn_global_load_lds((const unsigned*)(Kh + (long)(k0) * ldk + kg[i_]), (ALAS unsigned*)(K_lds + (b) * SHM_K + (i_ * 8 + widu) * 1024), 16, 0, 0); \
    _Pragma("unroll") for (int i_ = 0; i_ < VINST; ++i_) __builtin_amdgcn_global_load_lds((const unsigned*)(Vh + (long)(k0) * ldv + vg[i_]), (ALAS unsigned*)(V_lds + (b) * SHM_V + (i_ * 8 + widu) * 1024), 16, 0, 0); } while (0)
  const int NT = nkeys / KVBLK;
  f32x16 p[2][2]; bf16x8 pa[2][4];
  DMA_KV(0, 0); asm volatile("s_waitcnt vmcnt(0)" ::: "memory"); __syncthreads();
  for (int j = 0; j < NT; ++j) {
    const int bsel = j & 1;
    if (j + 1 < NT) DMA_KV(bsel ^ 1, (j + 1) * KVBLK);
    if constexpr (SHAREK) {
      SBAR(); qkt2<DK>(p, K_lds + bsel * SHM_K, qr, r32, hi);
      expHalf(p[0][0], negb_, use_shift); finishSM(p[0][0], p[0][1], l_reg[0], pa[0][0], pa[0][1], pa[0][2], pa[0][3], negb_, use_shift);
      expHalf(p[1][0], negb_, use_shift); finishSM(p[1][0], p[1][1], l_reg[1], pa[1][0], pa[1][1], pa[1][2], pa[1][3], negb_, use_shift); SBAR();
    } else {
      SBAR(); qkt<DK>(p[0][0], p[0][1], K_lds + bsel * SHM_K, qr[0], r32, hi);
      expHalf(p[0][0], negb_, use_shift); finishSM(p[0][0], p[0][1], l_reg[0], pa[0][0], pa[0][1], pa[0][2], pa[0][3], negb_, use_shift); SBAR();
      qkt<DK>(p[0][0], p[0][1], K_lds + bsel * SHM_K, qr[1], r32, hi);
      expHalf(p[0][0], negb_, use_shift); finishSM(p[0][0], p[0][1], l_reg[1], pa[1][0], pa[1][1], pa[1][2], pa[1][3], negb_, use_shift); SBAR();
    }
    pv_one2<NB, 0>(o[0][0], o[1][0], vb0 + bsel * SHM_V, pa); pv_one2<NB, 1>(o[0][1], o[1][1], vb0 + bsel * SHM_V, pa);
    asm volatile("s_waitcnt vmcnt(0)" ::: "memory");
    __syncthreads();
  }
#pragma unroll
  for (int q = 0; q < 2; ++q) {
    float lq = l_reg[q];
    { auto rr = __builtin_amdgcn_permlane32_swap(__float_as_uint(lq), __float_as_uint(lq), false, false); lq = __uint_as_float(rr[0]) + __uint_as_float(rr[1]); }
    if (hi == 0) ws[q * 32 + r32] = lq;
  }
  asm volatile("s_waitcnt lgkmcnt(0)" ::: "memory");
#pragma unroll
  for (int q = 0; q < 2; ++q) {
    float rli[16];
#pragma unroll
    for (int r = 0; r < 16; ++r) rli[r] = __builtin_amdgcn_rcpf(ws[q * 32 + crow(r, hi)]);
    bf16_t* Ow = Ob + (long)(q * 256 + wid * QBLK) * ldo;
#pragma unroll
    for (int r = 0; r < 16; ++r) { const int orow = crow(r, hi);
#pragma unroll
      for (int d0 = 0; d0 < NB; ++d0) { const float v = o[q][d0][r] * rli[r]; Ow[(long)orow * ldo + d0 * 32 + r32] = (bf16_t)(cvtpk(v, v) & 0xffffu); } }
  }
  __syncthreads();
#undef DMA_KV
}
__device__ __forceinline__ void attn_unit_diff(const bf16_t* Qb, int ldq, const bf16_t* __restrict__ Kh, int ldk, const bf16_t* __restrict__ Vh, int ldv,
                                               bf16_t* Ob, int ldo, int nkeys, float qscale, float negb_, const QPrep& qp, ALAS char* lds, int wave0, float lam, const float* g, float post) {
  constexpr int DK = 64, DV = 128, NB = 4, KC = 16, VC = 16, KPT = 2, VPT = 2, SHM_V = KVBLK * DV * 2, SHM_K = 16384;
  int tid; asm volatile("v_mbcnt_lo_u32_b32 %0, -1, 0\n\tv_mbcnt_hi_u32_b32 %0, -1, %0" : "=v"(tid)); tid = (tid + wave0 * 64) & 511;
  const int wid = tid >> 6, lane = tid & 63, r32 = lane & 31, hi = lane >> 5;
  ALAS char* V_lds = lds + LDS_V; ALAS char* K_lds = lds + LDS_K;
  ALAS float* ws = (ALAS float*)(lds + LDS_WS) + wid * 64;
  const bool use_shift = negb_ < -60.f;
  float l_reg[2] = {0.f, 0.f}; f32x16 o[2][NB]; bf16x8 qr[2][DK / 16];
  load_q<DK, 1>(qr[0], Qb + (long)(wid * QBLK + r32) * ldq + hi * 8, qp, qscale, wid, r32, hi);
  SBAR();
  load_q<DK, 1>(qr[1], Qb + 64 + (long)(wid * QBLK + r32) * ldq + hi * 8, qp, qscale, wid, r32, hi);
  SBAR();
#pragma unroll
  for (int q = 0; q < 2; ++q)
#pragma unroll
    for (int d = 0; d < NB; ++d) o[q][d] = f32x16{};
  int kgo[KPT], klo[KPT], vgo[VPT], vlo[VPT];
#pragma unroll
  for (int i = 0; i < KPT; ++i) { const int c = tid + 512 * i; const int row = c / KC, col = (c % KC) * 8; kgo[i] = row * ldk + col; klo[i] = KSWZ(row, col * 2); }
#pragma unroll
  for (int i = 0; i < VPT; ++i) { const int c = tid + 512 * i; const int row = c / VC, col = (c % VC) * 8; vgo[i] = row * ldv + col; vlo[i] = v_st<NB>(row, col); }
  const int vb0 = (int)(unsigned)(unsigned long)V_lds + v_rd_base(lane);
  struct { bf16x8 ks[KPT], vs[VPT]; } sr_;
#define SLOADD(k0) do { _Pragma("unroll") for (int i_ = 0; i_ < KPT; ++i_) sr_.ks[i_] = *reinterpret_cast<const bf16x8*>(Kh + (long)(k0) * ldk + kgo[i_]); \
    _Pragma("unroll") for (int i_ = 0; i_ < VPT; ++i_) sr_.vs[i_] = *reinterpret_cast<const bf16x8*>(Vh + (long)(k0) * ldv + vgo[i_]); } while (0)
#define SWRITED(b) do { _Pragma("unroll") for (int i_ = 0; i_ < KPT; ++i_) *(ALAS bf16x8*)(K_lds + (b) * SHM_K + klo[i_]) = sr_.ks[i_]; \
    _Pragma("unroll") for (int i_ = 0; i_ < VPT; ++i_) *(ALAS bf16x8*)(V_lds + (b) * SHM_V + vlo[i_]) = sr_.vs[i_]; } while (0)
  const int NT = nkeys / KVBLK;
  f32x16 p0, p1; bf16x8 pa0, pa1, pa2, pa3;
  SLOADD(0); asm volatile("s_waitcnt vmcnt(0)" ::: "memory"); SWRITED(0); __syncthreads();
  for (int j = 0; j < NT; ++j) {
    const int bsel = j & 1;
    if (j + 1 < NT) SLOADD((j + 1) * KVBLK);
    SBAR(); qkt<DK, 0>(p0, p1, K_lds + bsel * SHM_K, qr[0], r32, hi); expHalf(p0, negb_, use_shift);
    finishSM(p0, p1, l_reg[0], pa0, pa1, pa2, pa3, negb_, use_shift); SBAR();
    pv_all<NB>(o[0], vb0 + bsel * SHM_V, pa0, pa1, pa2, pa3);
    SBAR(); qkt<DK, 128>(p0, p1, K_lds + bsel * SHM_K, qr[1], r32, hi); expHalf(p0, negb_, use_shift);
    finishSM(p0, p1, l_reg[1], pa0, pa1, pa2, pa3, negb_, use_shift); SBAR();
    pv_all<NB>(o[1], vb0 + bsel * SHM_V, pa0, pa1, pa2, pa3);
    if (j + 1 < NT) { asm volatile("s_waitcnt vmcnt(0)" ::: "memory"); SWRITED(bsel ^ 1); }
    __syncthreads();
  }
#pragma unroll
  for (int q = 0; q < 2; ++q) { float lq = l_reg[q];
    { auto rr = __builtin_amdgcn_permlane32_swap(__float_as_uint(lq), __float_as_uint(lq), false, false); lq = __uint_as_float(rr[0]) + __uint_as_float(rr[1]); }
    if (hi == 0) ws[q * 32 + r32] = lq; }
  asm volatile("s_waitcnt lgkmcnt(0)" ::: "memory");
  float gcol[NB];
#pragma unroll
  for (int d0 = 0; d0 < NB; ++d0) gcol[d0] = g[d0 * 32 + r32] * post;
  bf16_t* Ow = Ob + (long)(wid * QBLK) * ldo;
#pragma unroll
  for (int r = 0; r < 16; ++r) { const int orow = crow(r, hi); const float r1 = __builtin_amdgcn_rcpf(ws[crow(r, hi)]), r2 = __builtin_amdgcn_rcpf(ws[32 + crow(r, hi)]) * lam; float d[NB]; float ss = 0.f;
#pragma unroll
    for (int d0 = 0; d0 < NB; ++d0) { d[d0] = o[0][d0][r] * r1 - o[1][d0][r] * r2; ss += d[d0] * d[d0]; }
    ss += __int_as_float(__builtin_amdgcn_ds_swizzle(__float_as_int(ss), (1 << 10) | 0x1f)); ss += __int_as_float(__builtin_amdgcn_ds_swizzle(__float_as_int(ss), (2 << 10) | 0x1f));
    ss += __int_as_float(__builtin_amdgcn_ds_swizzle(__float_as_int(ss), (4 << 10) | 0x1f)); ss += __int_as_float(__builtin_amdgcn_ds_swizzle(__float_as_int(ss), (8 << 10) | 0x1f));
    ss += __int_as_float(__builtin_amdgcn_ds_swizzle(__float_as_int(ss), (16 << 10) | 0x1f));
    const float rstd = __builtin_amdgcn_rsqf(ss * (1.f / 128.f) + 1e-6f);
#pragma unroll
    for (int d0 = 0; d0 < NB; ++d0) { const float v = d[d0] * rstd * gcol[d0]; Ow[(long)orow * ldo + d0 * 32 + r32] = (bf16_t)(cvtpk(v, v) & 0xffffu); } }
  __syncthreads();
#undef SLOADD
#undef SWRITED
}
#undef KSWZ
#undef KF
#undef SBAR
}
#define GAS __attribute__((address_space(1)))
#define LAS __attribute__((address_space(3)))
typedef unsigned short bf16;
typedef unsigned v4u __attribute__((ext_vector_type(4)));
typedef unsigned v2u __attribute__((ext_vector_type(2)));
typedef float f32x4 __attribute__((ext_vector_type(4)));
typedef float f32x2 __attribute__((ext_vector_type(2)));
typedef GAS unsigned gu32;
#define RLX_AGENT __ATOMIC_RELAXED, __HIP_MEMORY_SCOPE_AGENT
#define LDS_WAIT() asm volatile("s_waitcnt lgkmcnt(0)" ::: "memory")
#define VM_WAIT() asm volatile("s_waitcnt vmcnt(0)" ::: "memory")
__device__ __forceinline__ unsigned f2bf(float f) { unsigned u = __builtin_bit_cast(unsigned, f); return (u + 0x7fffu + ((u >> 16) & 1u)) >> 16; }
__device__ __forceinline__ unsigned pk2(float lo, float hi) { return pg8::cvt_pk_bf16(lo, hi); }
__device__ __forceinline__ float bflo(unsigned w) { return __uint_as_float(w << 16); }
__device__ __forceinline__ float bfhi(unsigned w) { return __uint_as_float(w & 0xffff0000u); }

__device__ __forceinline__ int lane_id() { int l; asm volatile("v_mbcnt_lo_u32_b32 %0, -1, 0\n\tv_mbcnt_hi_u32_b32 %0, -1, %0" : "=v"(l)); return l; }

#define XB_TMO      128
#define XB_XCNT(j)  (256  + 64 * (j))
#define XB_XSUB(j)  (1280 + 64 * (j))
#define XB_XGEN(j)  (2304 + 64 * (j))
#define XB_TOP      3328
#define XB_TOPGEN   3392
#define XCD_BAR_WORDS 3456
#define XB_SPIN_CAP (1u << 18)

__device__ __forceinline__ unsigned xb_ld(unsigned* p)              { return __hip_atomic_load(p, __ATOMIC_RELAXED, __HIP_MEMORY_SCOPE_AGENT); }
__device__ __forceinline__ unsigned xb_add(unsigned* p, unsigned v) { return __hip_atomic_fetch_add(p, v, __ATOMIC_RELAXED, __HIP_MEMORY_SCOPE_AGENT); }
__device__ __forceinline__ unsigned xb_xcc_id() { return (unsigned)__builtin_amdgcn_s_getreg((3 << 11) | 20) & 0xFu; }
#define XB_SPIN(cond, bar) do { unsigned _sp = 0; while (cond) { __builtin_amdgcn_s_sleep(1); \
    if ((++_sp & 255u) == 0u) { if (xb_ld(&(bar)[XB_TMO])) break; if (_sp > XB_SPIN_CAP) { atomicAdd(&(bar)[XB_TMO], 1u); break; } } } } while (0)

struct XcdBarrier {
    unsigned* bar; unsigned x;
    volatile LAS unsigned* st;
};
__device__ __forceinline__ XcdBarrier xcd_barrier_post(unsigned* bar, volatile LAS unsigned* st, int wave0) {
    XcdBarrier b; b.bar = bar; b.x = xb_xcc_id(); b.st = st;
    if (wave0 == 0 && lane_id() == 0) (void)xb_add(&bar[XB_XCNT(b.x)], 1u);
    return b;
}
__device__ __forceinline__ void xcd_barrier_complete(unsigned* bar, unsigned x, unsigned& nloc, unsigned& nx) {
    const unsigned G = gridDim.x * gridDim.y * gridDim.z;
    unsigned sum, cnt, mine, sp = 0u;
    for (;;) {
        sum = 0u; cnt = 0u; mine = 0u;
#pragma unroll
        for (unsigned j = 0; j < 16; ++j) { const unsigned c = xb_ld(&bar[XB_XCNT(j)]); sum += c; cnt += (c > 0u) ? 1u : 0u; mine = (j == x) ? c : mine; }
        if (sum == G) break;
        __builtin_amdgcn_s_sleep(1);
        if ((++sp & 255u) == 0u) { if (xb_ld(&bar[XB_TMO])) break; if (sp > XB_SPIN_CAP) { atomicAdd(&bar[XB_TMO], 1u); break; } }
    }
    nloc = mine > 0u ? mine : 1u; nx = cnt > 0u ? cnt : 1u;
}
__device__ __forceinline__ void xcd_barrier(const XcdBarrier& b, int wave0) {
    asm volatile("s_waitcnt vmcnt(0)" ::: "memory");
    __syncthreads();
    if (wave0 == 0 && lane_id() == 0) {
        unsigned* bar = b.bar;
        __builtin_amdgcn_s_waitcnt(0);
        unsigned nloc = b.st[0], nx = b.st[1];
        if (nloc == 0u) { xcd_barrier_complete(bar, b.x, nloc, nx); b.st[0] = nloc; b.st[1] = nx; }
        const unsigned old = xb_add(&bar[XB_XSUB(b.x)], 1u);
        const unsigned gen = old / nloc;
        if (old + 1u == (gen + 1u) * nloc) {
            __builtin_amdgcn_fence(__ATOMIC_RELEASE, "agent");
            asm volatile("s_waitcnt vmcnt(0)" ::: "memory");
            const unsigned og = xb_add(&bar[XB_TOP], 1u);
            const unsigned tg = og / nx;
            if (og + 1u == (tg + 1u) * nx) xb_add(&bar[XB_TOPGEN], 1u);
            else XB_SPIN(xb_ld(&bar[XB_TOPGEN]) == tg, bar);
            __builtin_amdgcn_fence(__ATOMIC_ACQUIRE, "agent");
            xb_add(&bar[XB_XGEN(b.x)], 1u);
            asm volatile("s_waitcnt vmcnt(0)" ::: "memory");
        } else {
            XB_SPIN(xb_ld(&bar[XB_XGEN(b.x)]) == gen, bar);
            __builtin_amdgcn_fence(__ATOMIC_ACQUIRE, "agent");
            asm volatile("s_waitcnt vmcnt(0)" ::: "memory");
        }
    }
    __syncthreads();
}

template <int CTRL> __device__ __forceinline__ float dpp_f(float v) { return __int_as_float(__builtin_amdgcn_update_dpp(0, __float_as_int(v), CTRL, 0xf, 0xf, true)); }
template <int CTRL> __device__ __forceinline__ int dpp_i(int v) { return __builtin_amdgcn_update_dpp(0, v, CTRL, 0xf, 0xf, true); }
template <int K> __device__ __forceinline__ float xshfl(float v) {
    static_assert(K == 1 || K == 2 || K == 4 || K == 8, "xshfl: K");
    if constexpr (K == 1) return dpp_f<0xB1>(v);
    else if constexpr (K == 2) return dpp_f<0x4E>(v);
    else if constexpr (K == 4) return dpp_f<0x1B>(dpp_f<0x141>(v));
    else return dpp_f<0x128>(v);
}
__device__ __forceinline__ float xshfl16(float v, int lane) { const auto rr = __builtin_amdgcn_permlane16_swap(__float_as_uint(v), __float_as_uint(v), false, false); return __uint_as_float((lane & 16) ? rr[0] : rr[1]); }
__device__ __forceinline__ float sum8(float v) { v += dpp_f<0xB1>(v); v += dpp_f<0x4E>(v); v += dpp_f<0x141>(v); return v; }
__device__ __forceinline__ float sum16(float v) { v = sum8(v); v += dpp_f<0x140>(v); return v; }
__device__ __forceinline__ float half_sum(float v) { v = sum16(v); const auto rr = __builtin_amdgcn_permlane16_swap(__float_as_uint(v), __float_as_uint(v), false, false); return __uint_as_float(rr[0]) + __uint_as_float(rr[1]); }
__device__ __forceinline__ float wave_sum(float v) {
    v = half_sum(v);
    const auto rr = __builtin_amdgcn_permlane32_swap(__float_as_uint(v), __float_as_uint(v), false, false);
    return __uint_as_float(rr[0]) + __uint_as_float(rr[1]);
}
__device__ __forceinline__ float wave_max(float v) {
    v = fmaxf(v, dpp_f<0xB1>(v)); v = fmaxf(v, dpp_f<0x4E>(v)); v = fmaxf(v, dpp_f<0x141>(v)); v = fmaxf(v, dpp_f<0x140>(v));
    { const auto rr = __builtin_amdgcn_permlane16_swap(__float_as_uint(v), __float_as_uint(v), false, false); v = fmaxf(__uint_as_float(rr[0]), __uint_as_float(rr[1])); }
    const auto rr = __builtin_amdgcn_permlane32_swap(__float_as_uint(v), __float_as_uint(v), false, false);
    return fmaxf(__uint_as_float(rr[0]), __uint_as_float(rr[1]));
}
__device__ __forceinline__ int wave_sum_i(int v) {
    v += dpp_i<0xB1>(v); v += dpp_i<0x4E>(v); v += dpp_i<0x141>(v); v += dpp_i<0x140>(v);
    { const auto rr = __builtin_amdgcn_permlane16_swap((unsigned)v, (unsigned)v, false, false); v = (int)(rr[0] + rr[1]); }
    const auto rr = __builtin_amdgcn_permlane32_swap((unsigned)v, (unsigned)v, false, false);
    return (int)(rr[0] + rr[1]);
}
__device__ __forceinline__ float xshfl32(float v, int hi) { const auto rr = __builtin_amdgcn_permlane32_swap(__float_as_uint(v), __float_as_uint(v), false, false); return __uint_as_float(hi ? rr[0] : rr[1]); }
constexpr float NEPS = 1e-6f;
template <int HW, int ROPE>
__device__ __forceinline__ unsigned head_norm_rope(unsigned w, const float* g, const float* cs0, const float* sn0, const float* cs1, const float* sn1, int lane) {
    const int j = (HW == 64) ? (lane & 31) : lane;
    float a = bflo(w), b = bfhi(w);
    float ss = a * a + b * b;
    ss = (HW == 64) ? half_sum(ss) : wave_sum(ss);
    const float rstd = __builtin_amdgcn_rsqf(ss * (1.f / HW) + NEPS);
    const f32x2 gg = *(const f32x2*)(g + 2 * j);
    a = a * rstd * gg.x; b = b * rstd * gg.y;
    if (ROPE == 1) {
        constexpr int HALF_ = HW / 2;
        const float pa = (HALF_ / 2 == 32) ? xshfl32(a, lane >> 5) : xshfl16(a, lane), pb = (HALF_ / 2 == 32) ? xshfl32(b, lane >> 5) : xshfl16(b, lane);
        const int e = 2 * j, f = e % HALF_; const bool first = e < HALF_;
        const f32x2 c = *(const f32x2*)(cs0 + f), s = *(const f32x2*)(sn0 + f);
        a = first ? (a * c.x - pa * s.x) : (a * c.x + pa * s.x);
        b = first ? (b * c.y - pb * s.y) : (b * c.y + pb * s.y);
    } else if (ROPE == 2) {
        const float pa = xshfl<8>(a), pb = xshfl<8>(b);
        const int e = (2 * j) & 31, f = e & 15; const bool first = e < 16; const bool blk1 = (2 * j) >= 32;
        const float* ct = blk1 ? cs1 : cs0; const float* st = blk1 ? sn1 : sn0;
        const f32x2 c = *(const f32x2*)(ct + f), s = *(const f32x2*)(st + f);
        a = first ? (a * c.x - pa * s.x) : (a * c.x + pa * s.x);
        b = first ? (b * c.y - pb * s.y) : (b * c.y + pb * s.y);
    }
    return pk2(a, b);
}
__device__ __forceinline__ unsigned mla_head(float a, float b, const float* g, const float* cs, const float* sn, int lane) {
    const float ss = wave_sum(a * a + b * b);
    const float rstd = __builtin_amdgcn_rsqf(ss * (1.f / 96.f) + NEPS);
    const int jj = lane < 48 ? lane : 0;
    const f32x2 gg = *(const f32x2*)(g + 2 * jj);
    a = a * rstd * gg.x; b = b * rstd * gg.y;
    const float pa = xshfl<8>(a), pb = xshfl<8>(b);
    if (lane >= 32 && lane < 48) {
        const int e = 2 * lane - 64, f = e & 15; const bool first = e < 16;
        const f32x2 c = *(const f32x2*)(cs + f), s = *(const f32x2*)(sn + f);
        a = first ? (a * c.x - pa * s.x) : (a * c.x + pa * s.x);
        b = first ? (b * c.y - pb * s.y) : (b * c.y + pb * s.y);
    }
    return pk2(a, b);
}

template <int HW, int ROPE>
__device__ __forceinline__ unsigned head_apply(unsigned w, f32x2 g2, f32x2 c2, f32x2 s2, int lane) {
    const int j = (HW == 64) ? (lane & 31) : lane;
    float a = bflo(w), b = bfhi(w);
    float ss = a * a + b * b;
    ss = (HW == 64) ? half_sum(ss) : wave_sum(ss);
    const float rstd = __builtin_amdgcn_rsqf(ss * (1.f / HW) + NEPS);
    a = a * rstd * g2.x; b = b * rstd * g2.y;
    if (ROPE == 1) {
        constexpr int HALF_ = HW / 2;
        const float pa = (HALF_ / 2 == 32) ? xshfl32(a, lane >> 5) : xshfl16(a, lane), pb = (HALF_ / 2 == 32) ? xshfl32(b, lane >> 5) : xshfl16(b, lane);
        const bool first = 2 * j < HALF_;
        a = first ? (a * c2.x - pa * s2.x) : (a * c2.x + pa * s2.x);
        b = first ? (b * c2.y - pb * s2.y) : (b * c2.y + pb * s2.y);
    } else if (ROPE == 2) {
        const float pa = xshfl<8>(a), pb = xshfl<8>(b);
        const bool first = ((2 * j) & 31) < 16;
        a = first ? (a * c2.x - pa * s2.x) : (a * c2.x + pa * s2.x);
        b = first ? (b * c2.y - pb * s2.y) : (b * c2.y + pb * s2.y);
    }
    return pk2(a, b);
}
__device__ __forceinline__ unsigned mla_apply(float a, float b, f32x2 g2, f32x2 c2, f32x2 s2, int lane) {
    const float ss = wave_sum(a * a + b * b);
    const float rstd = __builtin_amdgcn_rsqf(ss * (1.f / 96.f) + NEPS);
    a = a * rstd * g2.x; b = b * rstd * g2.y;
    const float pa = xshfl<8>(a), pb = xshfl<8>(b);
    if (lane >= 32 && lane < 48) {
        const bool first = (2 * lane - 64) < 16;
        a = first ? (a * c2.x - pa * s2.x) : (a * c2.x + pa * s2.x);
        b = first ? (b * c2.y - pb * s2.y) : (b * c2.y + pb * s2.y);
    }
    return pk2(a, b);
}
constexpr int NWAVES = 8;
constexpr int BATCH = 16, SEQ = 2048, DM = 1024, M = BATCH * SEQ, MEML = 256, MMEM = BATCH * MEML;
constexpr int FF = 3584, NEXP = 8, DEPTH = 2;
constexpr int RAWW = 3328;
constexpr int C_DQ = 0, C_DK = 512, C_DV = 1024, C_QLAT = 1536, C_KVLAT = 1792, C_KROPE = 1920, C_GQ = 2048, C_GK = 2560, C_GV = 2688, C_MEMQ = 2816;
constexpr int C_OA = 0, C_OB = 1536, C_OC = 2048, C_OD = 2816;
constexpr int MLAW = 1792;
enum { I_X = 0, I_MEM, I_NORM_ATTN_G, I_NORM_MEM_G, I_W_IN, I_DQ_G, I_DK_G, I_DLAMBDA, I_DSUBLN_G, I_MLA_QLAT_G, I_MLA_KVLAT_G, I_W_QUP, I_W_KVUP, I_MLA_Q_G, I_MLA_K_G,
       I_GQA_Q_G, I_GQA_K_G, I_W_MEMKV, I_MEM_Q_G, I_MEM_K_G, I_W_BRANCH, I_W_GATE, I_B_GATE, I_W_OUT, I_NORM_FFN_G, I_DW1, I_DW3, I_DW2, I_ROUTER, I_MW1, I_MW3, I_MW2, N_IN };
constexpr size_t MiB = 1u << 20;
constexpr size_t WS_CTL = 0, CTL_ZERO_BYTES = 64 * 1024;
constexpr size_t WS_TAB = 1 * MiB;
constexpr size_t T_DC = 0, T_DS = T_DC + 2048 * 32 * 4, T_MC = T_DS + 2048 * 32 * 4, T_MS = T_MC + 2048 * 16 * 4, T_QC = T_MS + 2048 * 16 * 4, T_QS = T_QC + 2048 * 64 * 4,
                 T_RC = T_QS + 2048 * 64 * 4, T_RS = T_RC + 32 * 16 * 4, T_CC = T_RS + 32 * 16 * 4, T_CS = T_CC + 64 * 16 * 4, T_END = T_CS + 64 * 16 * 4;
static_assert(T_END <= 2 * MiB, "tables");
constexpr size_t WS_MOE = 3 * MiB;
constexpr size_t WS_AW = 4 * MiB;
constexpr size_t AW_IN = 0, AW_GATE = AW_IN + (size_t)RAWW * DM * 2, AW_BR = AW_GATE + (size_t)4096 * DM * 2, AW_OUT = AW_BR + (size_t)4096 * 512 * 2,
                 AW_QUP = AW_OUT + (size_t)DM * DM * 2, AW_KVUP = AW_QUP + (size_t)768 * 256 * 2, AW_MEMKV = AW_KVUP + (size_t)1024 * 256 * 2, AW_END = AW_MEMKV + (size_t)DM * DM * 2;
static_assert(AW_END <= 32 * MiB, "attention weights");
constexpr size_t WS_HB = 36 * MiB;
constexpr size_t WS_RAW = 100 * MiB;
constexpr size_t WS_G = 308 * MiB;
constexpr size_t WS_MLARAW = 308 * MiB, WS_KMLA = 420 * MiB, WS_ODIFF = 468 * MiB, WS_LATN = 468 * MiB, WS_MEMKV = 532 * MiB, WS_MEMN = 540 * MiB;
constexpr size_t WS_FW = 100 * MiB;
constexpr size_t WS_U = 268 * MiB;
constexpr size_t WS_Y = 474 * MiB;
constexpr size_t WS_UM = 250 * MiB;
constexpr size_t WS_XS8 = 184 * MiB;
constexpr size_t WS_XB = 36 * MiB;
constexpr size_t WS_HBM8 = 512 * MiB, WS_TAILP = 184 * MiB;
constexpr size_t WS_HBA = 436 * MiB;
constexpr size_t WS_HBF = 121 * MiB;
constexpr size_t WS_MERGED = 436 * MiB;
constexpr size_t WS_HB8 = 564 * MiB;
constexpr size_t WS_END = 606 * MiB;
constexpr int CW_BAR = 4096;
constexpr int MOE_SLOTS = 2 * M + NEXP * 256;
constexpr size_t MO_SLOT_TOK = 0, MO_TOK_SLOT = 278528, MO_TOK_GATE = MO_TOK_SLOT + (size_t)M * 8, MO_WGCNT = MO_TOK_GATE + (size_t)M * 8, MO_END = MO_WGCNT + 256 * 8 * 4;
static_assert((size_t)MOE_SLOTS * 4 <= MO_TOK_SLOT && MO_END <= 1 * MiB, "MoE lists");
constexpr size_t EXPERT_BYTES = (size_t)3 * FF * DM, W2_OFF = (size_t)2 * FF * DM;
constexpr int MOE_CHUNK_TILES = 256;
constexpr float S_H8 = 16.f, S_W13 = 32.f, S_U8 = 4.f, S_W2 = 64.f, S_WG = 32.f;
constexpr int RING_OFF = 0, RING_BYTES = 131072;
constexpr int LDSCTL_OFF = RING_BYTES, MISC_OFF = LDSCTL_OFF + 320, PTAB_OFF = LDSCTL_OFF + 1024, MOE_LDS = LDSCTL_OFF + 2048;
constexpr int ML_SEL = 0, ML_RNK = 256, ML_CNT = 512, ML_TOT = 520, ML_PRE = 528, ML_SEGB = 536, ML_TE = 576;
constexpr int LDS_BYTES = 147456;
static_assert(att::LDS_BYTES <= RING_BYTES, "attention LDS");

struct Args { const float* in[N_IN]; float* out; unsigned char* ws; };
__device__ __forceinline__ unsigned char* launder(unsigned char* p) { GAS unsigned char* q = (GAS unsigned char*)p; asm volatile("" : "+s"(q)); return (unsigned char*)q; }
__device__ __forceinline__ const float* inp(LAS unsigned char* lds, int i) {
    const volatile LAS unsigned* p = (const volatile LAS unsigned*)(lds + PTAB_OFF) + 2 * i;
    const unsigned lo = __builtin_amdgcn_readfirstlane(p[0]), hi = __builtin_amdgcn_readfirstlane(p[1]);
    const GAS float* q = (const GAS float*)(((unsigned long long)hi << 32) | lo); asm volatile("" : "+s"(q)); return (const float*)q;
}
#define IN(i) inp(lds, (i))

__device__ __forceinline__ void transpose_item(const float* W, int ldw, int k0, int n0, bf16* WT, int ldk, int drow0, LAS float* scr, int lane) {
    f32x4 v[8];
#pragma unroll
    for (int i = 0; i < 8; ++i) v[i] = *(const GAS f32x4*)(W + (size_t)(k0 + 8 * i + (lane >> 3)) * ldw + n0 + 4 * (lane & 7));
#pragma unroll
    for (int i = 0; i < 8; ++i) { LAS float* d = scr + (8 * i + (lane >> 3)) * 33 + 4 * (lane & 7); d[0] = v[i].x; d[1] = v[i].y; d[2] = v[i].z; d[3] = v[i].w; }
    LDS_WAIT(); asm volatile("" ::: "memory");
    const int c = lane & 7;
#pragma unroll
    for (int j = 0; j < 4; ++j) { const int n = (lane >> 3) + 8 * j; const LAS float* s = scr + (8 * c) * 33 + n;
        v4u o; o.x = pk2(s[0 * 33], s[1 * 33]); o.y = pk2(s[2 * 33], s[3 * 33]); o.z = pk2(s[4 * 33], s[5 * 33]); o.w = pk2(s[6 * 33], s[7 * 33]);
        *(GAS v4u*)(WT + (size_t)(drow0 + n) * ldk + k0 + 8 * c) = o; }
    LDS_WAIT(); asm volatile("" ::: "memory");
}
__device__ __forceinline__ void plain_item(int r, const float* W, int K, int N, bf16* WT, int ldk, int drow_shift, LAS float* scr, int lane) {
    const int nbn = N / 32, kb = r / nbn, nb = r % nbn; transpose_item(W, N, 64 * kb, 32 * nb, WT, ldk, 32 * nb + drow_shift, scr, lane);
}
constexpr int FFN_ITEMS_13 = (DM / 64) * (FF / 32), FFN_ITEMS_2 = (FF / 64) * (DM / 32), FFN_ITEMS = 2 * FFN_ITEMS_13 + FFN_ITEMS_2;
__device__ __forceinline__ void ffn_weight_item(int it, const float* w1, const float* w3, const float* w2, bf16* W13t, bf16* W2t, LAS float* scr, int lane) {
    if (it < 2 * FFN_ITEMS_13) { const int which = it / FFN_ITEMS_13, r = it % FFN_ITEMS_13, kb = r / (FF / 32), nb = r % (FF / 32);
        transpose_item(which ? w3 : w1, FF, 64 * kb, 32 * nb, W13t, DM, (nb >> 2) * 256 + (nb & 3) * 32 + which * 128, scr, lane); }
    else { const int r = it - 2 * FFN_ITEMS_13, kb = r / (DM / 32), nb = r % (DM / 32); transpose_item(w2, DM, 64 * kb, 32 * nb, W2t, FF, 32 * nb, scr, lane); }
}
__device__ __forceinline__ void transpose_item8(const float* W, int ldw, int k0, int n0, unsigned char* WT, int ldk, int drow0, float scale, LAS float* scr, int lane) {
    f32x4 v[8];
#pragma unroll
    for (int i = 0; i < 8; ++i) v[i] = *(const GAS f32x4*)(W + (size_t)(k0 + 8 * i + (lane >> 3)) * ldw + n0 + 4 * (lane & 7));
#pragma unroll
    for (int i = 0; i < 8; ++i) { LAS float* d = scr + (8 * i + (lane >> 3)) * 33 + 4 * (lane & 7); d[0] = v[i].x * scale; d[1] = v[i].y * scale; d[2] = v[i].z * scale; d[3] = v[i].w * scale; }
    LDS_WAIT(); asm volatile("" ::: "memory");
    const int c = lane & 7;
#pragma unroll
    for (int j = 0; j < 4; ++j) { const int n = (lane >> 3) + 8 * j; const LAS float* s = scr + (8 * c) * 33 + n;
        v2u o; o.x = pg8::cvt4_fp8(s[0 * 33], s[1 * 33], s[2 * 33], s[3 * 33]); o.y = pg8::cvt4_fp8(s[4 * 33], s[5 * 33], s[6 * 33], s[7 * 33]);
        *(GAS v2u*)(WT + (size_t)(drow0 + n) * ldk + k0 + 8 * c) = o; }
    LDS_WAIT(); asm volatile("" ::: "memory");
}
__device__ __forceinline__ void ffn_weight_item8(int it, const float* w1, const float* w3, const float* w2, unsigned char* W13t, unsigned char* W2t, LAS float* scr, int lane) {
    if (it < 2 * FFN_ITEMS_13) { const int which = it / FFN_ITEMS_13, r = it % FFN_ITEMS_13, kb = r / (FF / 32), nb = r % (FF / 32);
        transpose_item8(which ? w3 : w1, FF, 64 * kb, 32 * nb, W13t, DM, (nb >> 2) * 256 + (nb & 3) * 32 + which * 128, S_W13, scr, lane); }
    else { const int r = it - 2 * FFN_ITEMS_13, kb = r / (DM / 32), nb = r % (DM / 32); transpose_item8(w2, DM, 64 * kb, 32 * nb, W2t, FF, 32 * nb, S_W2, scr, lane); }
}
constexpr int AI_IN = 16 * 101, AI_GATE = 4 * 16 * 32, AI_BR = 4 * 8 * 32, AI_OUT = 16 * 32, AI_QUP = 4 * 24, AI_KVUP = 2 * 32, AI_MEMKV = 16 * 32;
constexpr int AI_TOTAL = AI_IN + AI_GATE + AI_BR + AI_OUT + AI_QUP + AI_KVUP + AI_MEMKV;
__device__ __forceinline__ void attn_weight_item(int it, int l, LAS unsigned char* lds, unsigned char* aw, LAS float* scr, int lane) {
    int r = it;
    if (r < AI_IN) { const int kb = r / 101, nb = r % 101;
        transpose_item(IN(I_W_IN) + (size_t)l * DM * 3232, 3232, 64 * kb, 32 * nb, (bf16*)(aw + AW_IN), DM, 32 * nb + (nb >= 61 ? 96 : 0), scr, lane); return; } r -= AI_IN;
    if (r < AI_GATE) { const int b = r / 512, rr = r % 512, kb = rr / 32, nb = rr % 32;
        transpose_item8(IN(I_W_GATE) + ((size_t)l * 4 + b) * DM * DM, DM, 64 * kb, 32 * nb, aw + AW_GATE, DM, 32 * nb + b * 1024, S_WG, scr, lane); return; } r -= AI_GATE;
    if (r < AI_BR) { const int b = r / 256; plain_item(r % 256, IN(I_W_BRANCH) + ((size_t)l * 4 + b) * 512 * DM, 512, DM, (bf16*)(aw + AW_BR), 512, b * 1024, scr, lane); return; } r -= AI_BR;
    if (r < AI_OUT) { plain_item(r, IN(I_W_OUT) + (size_t)l * DM * DM, DM, DM, (bf16*)(aw + AW_OUT), DM, 0, scr, lane); return; } r -= AI_OUT;
    if (r < AI_QUP) { plain_item(r, IN(I_W_QUP) + (size_t)l * 256 * 768, 256, 768, (bf16*)(aw + AW_QUP), 256, 0, scr, lane); return; } r -= AI_QUP;
    if (r < AI_KVUP) { plain_item(r, IN(I_W_KVUP) + (size_t)l * 128 * 1024, 128, 1024, (bf16*)(aw + AW_KVUP), 256, 0, scr, lane); return; } r -= AI_KVUP;
    plain_item(r, IN(I_W_MEMKV) + (size_t)l * DM * DM, DM, DM, (bf16*)(aw + AW_MEMKV), DM, 0, scr, lane);
}
template <bool IN_BF> __device__ __forceinline__ f32x4 rr_load(const float* X, int m, int lane, int j) {
    if constexpr (IN_BF) { const v2u w = ((const GAS v2u*)((const bf16*)X + (size_t)m * DM) + lane)[64 * j]; return (f32x4){bflo(w.x), bfhi(w.x), bflo(w.y), bfhi(w.y)}; }
    else return ((const GAS f32x4*)(X + (size_t)m * DM) + lane)[64 * j];
}
template <bool F8COPY = false, bool BF = true, bool IN_BF = false>
__device__ __forceinline__ void rms_rows_to_bf16(const float* X, const float* g, bf16* O, int nrows, int gw, int NGW, int lane, unsigned char* O8 = nullptr, float s8 = 1.0f) {
    f32x4 gg[4];
#pragma unroll
    for (int j = 0; j < 4; ++j) gg[j] = ((const GAS f32x4*)g + lane)[64 * j];
    if (gw >= nrows) return;
    f32x4 cur[4], nxt[4];
#pragma unroll
    for (int j = 0; j < 4; ++j) { cur[j] = rr_load<IN_BF>(X, gw, lane, j); nxt[j] = cur[j]; }
    for (int m = gw; m < nrows; m += NGW) {
        const int mn = m + NGW;
        if (mn < nrows) {
#pragma unroll
            for (int j = 0; j < 4; ++j) nxt[j] = rr_load<IN_BF>(X, mn, lane, j);
        }
        float s = 0.f;
#pragma unroll
        for (int j = 0; j < 4; ++j) s += (cur[j].x * cur[j].x + cur[j].y * cur[j].y) + (cur[j].z * cur[j].z + cur[j].w * cur[j].w);
        const float rstd = __builtin_amdgcn_rsqf(wave_sum(s) * (1.f / DM) + NEPS);
        GAS unsigned long long* o8 = (GAS unsigned long long*)(O + (size_t)m * DM) + lane;
#pragma unroll
        for (int j = 0; j < 4; ++j) o8[64 * j] = (unsigned long long)pk2(cur[j].x * rstd * gg[j].x, cur[j].y * rstd * gg[j].y) | ((unsigned long long)pk2(cur[j].z * rstd * gg[j].z, cur[j].w * rstd * gg[j].w) << 32);
        if constexpr (F8COPY) { GAS unsigned* o4 = (GAS unsigned*)(O8 + (size_t)m * DM) + lane; const float r8 = rstd * s8;
#pragma unroll
            for (int j = 0; j < 4; ++j) o4[64 * j] = pg8::cvt4_fp8(cur[j].x * r8 * gg[j].x, cur[j].y * r8 * gg[j].y, cur[j].z * r8 * gg[j].z, cur[j].w * r8 * gg[j].w); }
#pragma unroll
        for (int j = 0; j < 4; ++j) cur[j] = nxt[j];
    }
}
__device__ __forceinline__ void rope_entry(int pos, int i, int dim, float* c, float* s) {
    const float e = (float)(2 * i) / (float)dim;
    const float inv = 1.0f / powf(10000.0f, e);
    const float ang = (float)pos * inv;
    const double ad = (double)ang, k = rint(ad * 0.15915494309189535), r = ad - k * 6.283185307179586;
    const float rf = (float)r;
    *c = cosf(rf); *s = sinf(rf);
}

struct UpOrder : pg8::StaticOrder {
    const bf16* wq; const bf16* wkv;
    __device__ __forceinline__ const char* a_ptr(const pg8::Gemm& g, const pg8::Unit& u) const { return (const char*)g.A + (size_t)u.pm * (256 * 2) * g.lda + (u.pn >= 3 ? 512 : 0); }
    __device__ __forceinline__ const char* b_ptr(const pg8::Gemm& g, const pg8::Unit& u) const { return u.pn >= 3 ? (const char*)wkv + (size_t)(u.pn - 3) * 256 * 256 * 2 : (const char*)wq + (size_t)u.pn * 256 * 256 * 2; }
};
struct MergeOrder : pg8::StaticOrder {
    __device__ __forceinline__ bool next(int i, pg8::Unit& u) const { if (!tile((long)(i >> 2) * G + c, u)) return false; u.z = i & 3; return true; }
    __device__ __forceinline__ const char* a_ptr(const pg8::Gemm& g, const pg8::Unit& u) const {
        const int co = u.z == 0 ? C_OA : u.z == 1 ? C_OB : u.z == 2 ? C_OC : C_OD; return (const char*)g.A + (size_t)u.pm * (256 * 2) * g.lda + co * 2; }
    __device__ __forceinline__ const char* b_ptr(const pg8::Gemm& g, const pg8::Unit& u) const { return (const char*)g.Bt + (size_t)(u.z * 1024 + u.pn * 256) * g.ldb * 2; }
};
struct MoeUpOrder : pg8::StaticOrder {
    const int* slot_tok; int tile0; const volatile LAS int* te; const char* wbase;
    __device__ __forceinline__ const char* a_ptr(const pg8::Gemm& g, const pg8::Unit&) const { return (const char*)g.A; }
    __device__ __forceinline__ const char* b_ptr(const pg8::Gemm& g, const pg8::Unit& u) const { const int e = __builtin_amdgcn_readfirstlane(te[tile0 + u.pm]); return wbase + (size_t)e * EXPERT_BYTES + (size_t)u.pn * (256 * 2) * g.ldb; }
    __device__ __forceinline__ unsigned row_off(const pg8::Gemm& g, const pg8::Unit& u, int row) const { return (unsigned)slot_tok[(tile0 + u.pm) * 256 + row] * (unsigned)(g.lda * 2); }
};
struct MoeDownOrder : pg8::StaticOrder {
    int tile0; const volatile LAS int* te; const char* wbase;
    __device__ __forceinline__ const char* b_ptr(const pg8::Gemm& g, const pg8::Unit& u) const { const int e = __builtin_amdgcn_readfirstlane(te[tile0 + u.pm]); return wbase + (size_t)e * EXPERT_BYTES + (size_t)u.pn * (256 * 2) * g.ldb; }
};
__device__ __forceinline__ float wave_max_abs(const float* g, int n, int lane) {
    float v = lane < n ? fabsf(g[lane]) : 0.f; if (lane + 64 < n) v = fmaxf(v, fabsf(g[lane + 64]));
    return wave_max(v);
}
__device__ __forceinline__ v2u tail_row(const float* P, int rows, int r, int q, float sc) {
    f32x4 s = *((const GAS f32x4*)(P + (size_t)r * DM) + q);
#pragma unroll
    for (int z = 1; z < 7; ++z) s += *((const GAS f32x4*)(P + ((size_t)z * rows + r) * DM) + q);
    v2u o; o.x = pk2(s.x * sc, s.y * sc); o.y = pk2(s.z * sc, s.w * sc); return o;
}
struct TailDownOrder : pg8::StaticOrder {
    const volatile LAS int* te; const char* wbase;
    __device__ __forceinline__ bool next(int i, pg8::Unit& u) const { const int L = i * G + c; if (L >= nwg * 7) return false; u.z = L % 7; const int t = L / 7; u.pn = __builtin_amdgcn_readfirstlane(t % nN); u.pm = __builtin_amdgcn_readfirstlane(t / nN); return true; }
    __device__ __forceinline__ const char* a_ptr(const pg8::Gemm& g, const pg8::Unit& u) const { return (const char*)g.A + (size_t)u.pm * (256 * 2) * g.lda + (size_t)u.z * 512; }
    __device__ __forceinline__ const char* b_ptr(const pg8::Gemm& g, const pg8::Unit& u) const { const int e = __builtin_amdgcn_readfirstlane(te[256 + u.pm]); return wbase + (size_t)e * EXPERT_BYTES + (size_t)u.pn * (256 * 2) * g.ldb + (size_t)u.z * 512; }
};
struct EpiPartF32 {
    static constexpr bool PERM = false;
    float* P; int rows;
    __device__ __forceinline__ bool keep(const pg8::Unit&) const { return false; }
    __device__ __forceinline__ void operator()(const pg8::f32x4 (&acc)[2][2][4][2], const pg8::Unit& u, int wr, int wc, int fr, int fq) const {
        const int row0 = u.pm * 256 + wr * 64 + fr, col0 = u.pn * 256 + wc * 32 + 4 * fq;
        GAS float* pb = (GAS float*)(P + ((size_t)u.z * rows + row0) * DM + col0);
#pragma unroll
        for (int ai = 0; ai < 2; ++ai)
#pragma unroll
            for (int m = 0; m < 4; ++m)
#pragma unroll
                for (int bj = 0; bj < 2; ++bj)
#pragma unroll
                    for (int n = 0; n < 2; ++n) *(GAS pg8::f32x4*)(pb + (size_t)(ai * 128 + m * 16) * DM + bj * 128 + n * 16) = acc[ai][bj][m][n];
    }
};
struct EpiMerge {
    static constexpr bool PERM = true;
    const unsigned char* Gq;
    bf16* Mg;
    __device__ __forceinline__ bool keep(const pg8::Unit& u) const { return u.z < 3; }
    __device__ __forceinline__ void operator()(pg8::f32x4 (&acc)[2][2][4][2], const pg8::Unit& u, int wr, int wc, int fr, int fq) const {
        const int row0 = u.pm * 256 + wr * 64 + fr, col0 = u.pn * 256 + wc * 32 + 8 * fq, z = u.z;
#pragma unroll
        for (int ai = 0; ai < 2; ++ai)
#pragma unroll
            for (int mp = 0; mp < 2; ++mp) {
                const GAS unsigned char* gb = (const GAS unsigned char*)(Gq + ((size_t)(u.pm * 16 + u.pn) << 16) + ((wr * 4 + wc) << 13) + (fq * 16 + fr) * 8);
                asm volatile("" : "+v"(gb));
                v2u gn[2][2], gd[2][2];
#pragma unroll
                for (int mm = 0; mm < 2; ++mm)
#pragma unroll
                    for (int bj = 0; bj < 2; ++bj) { const int m = 2 * mp + mm; const GAS unsigned char* gp = gb + (((ai * 4 + m) * 2 + bj) << 9);
                        gn[mm][bj] = *(const GAS v2u*)(gp + ((size_t)(z * 4) << 16)); if (z < 3) gd[mm][bj] = *(const GAS v2u*)(gp + ((size_t)(z * 4 + 4) << 16)); }
#pragma unroll
                for (int mm = 0; mm < 2; ++mm)
#pragma unroll
                    for (int bj = 0; bj < 2; ++bj) { const int m = 2 * mp + mm; const v2u g = gn[mm][bj];
                        float f[8];
#pragma unroll
                        for (int e = 0; e < 8; ++e) f[e] = (float)(((e < 4 ? g.x : g.y) >> (8 * (e & 3))) & 0xffu);
                        if (z < 3) { const v2u d = gd[mm][bj];
#pragma unroll
                            for (int e = 0; e < 8; ++e) f[e] *= __builtin_amdgcn_rcpf((float)(((e < 4 ? d.x : d.y) >> (8 * (e & 3))) & 0xffu)); }
                        else {
#pragma unroll
                            for (int e = 0; e < 8; ++e) f[e] *= (1.0f / 255.0f); }
                        pg8::f32x4& v0 = acc[ai][bj][m][0]; pg8::f32x4& v1 = acc[ai][bj][m][1];
                        v0[0] *= f[0]; v0[1] *= f[1]; v0[2] *= f[2]; v0[3] *= f[3]; v1[0] *= f[4]; v1[1] *= f[5]; v1[2] *= f[6]; v1[3] *= f[7];
                        if (z == 3) { v4u w; w.x = pg8::cvt_pk_bf16(v0[0], v0[1]); w.y = pg8::cvt_pk_bf16(v0[2], v0[3]); w.z = pg8::cvt_pk_bf16(v1[0], v1[1]); w.w = pg8::cvt_pk_bf16(v1[2], v1[3]);
                            *(GAS v4u*)(Mg + (size_t)(row0 + ai * 128 + m * 16) * 1024 + col0 + bj * 128) = w; } }
                asm volatile("" ::: "memory");
            }
    }
};

__global__ void __launch_bounds__(NWAVES * 64, 2) fwd(Args args) {
    extern __shared__ __attribute__((aligned(16))) unsigned char lds_raw[];
    LAS unsigned char* lds = (LAS unsigned char*)lds_raw;
    volatile LAS unsigned* MISC = (volatile LAS unsigned*)(lds + MISC_OFF);
    const int tid = threadIdx.x; const int wave0 = __builtin_amdgcn_readfirstlane(tid >> 6);
    constexpr int G = 256; const int bx = blockIdx.x; const int vcu = (bx % 8) * (G / 8) + bx / 8;
    unsigned char* ws = args.ws;
    gu32* ctl = (gu32*)(ws + WS_CTL);
    for (int u = tid; u < (LDS_BYTES - LDSCTL_OFF) / 4; u += NWAVES * 64) ((LAS unsigned*)(lds + LDSCTL_OFF))[u] = 0u;
    __syncthreads();
    XcdBarrier bar = xcd_barrier_post((unsigned*)(ctl + CW_BAR), MISC + 8, wave0);
    float* out = args.out;
    if (tid < N_IN) ((LAS unsigned long long*)(lds + PTAB_OFF))[tid] = (unsigned long long)args.in[tid];
    __syncthreads();
#define PHASE_PTRS unsigned char* wsp = launder(ws); int lane = lane_id(); asm volatile("" : "+v"(lane)); int wave = wave0; asm volatile("" : "+s"(wave)); \
    const int gw = vcu * NWAVES + wave, NGW = G * NWAVES; const int gt = gw * 64 + lane, NGT = NGW * 64; LAS float* scr = (LAS float*)(lds + RING_OFF + wave * 16384); \
    (void)gw; (void)NGW; (void)gt; (void)NGT; (void)scr; \
    bf16* HB = (bf16*)(wsp + WS_HB); bf16* RAW = (bf16*)(wsp + WS_RAW); bf16* GT = (bf16*)(wsp + WS_G); \
    bf16* MLARAW = (bf16*)(wsp + WS_MLARAW); bf16* KMLA = (bf16*)(wsp + WS_KMLA); bf16* ODIFF = (bf16*)(wsp + WS_ODIFF); bf16* LATN = (bf16*)(wsp + WS_LATN); \
    bf16* MEMKV = (bf16*)(wsp + WS_MEMKV); bf16* MEMN = (bf16*)(wsp + WS_MEMN); \
    bf16* W13t = (bf16*)(wsp + WS_FW); bf16* W2t = W13t + (size_t)2 * FF * DM; bf16* U = (bf16*)(wsp + WS_U); \
    unsigned char* aw = wsp + WS_AW; const float* tab = (const float*)(wsp + WS_TAB); \
    (void)HB; (void)RAW; (void)GT; (void)MLARAW; (void)KMLA; (void)ODIFF; (void)LATN; (void)MEMKV; (void)MEMN; (void)W13t; (void)W2t; (void)U; (void)aw; (void)tab

#pragma unroll 1
    for (int l = 0; l < DEPTH; ++l) {
        const float lambda_init = (l == 0) ? 0.2f : (0.8f - 0.6f * 0.74081822068171788f);
        {
            PHASE_PTRS;
            for (int it = gw; it < AI_TOTAL; it += NGW) attn_weight_item(it, l, lds, aw, scr, lane);
            unsigned zz_ = 0u; asm volatile("" : "+v"(zz_)); const v4u zero4 = {zz_, zz_, zz_, zz_};
            for (int c = gt; c < 96 * 128; c += NGT) *(GAS v4u*)(aw + AW_IN + (size_t)1952 * DM * 2 + (size_t)c * 16) = zero4;
            for (int c = gt; c < 1024 * 16; c += NGT) *(GAS v4u*)(aw + AW_KVUP + (size_t)(c >> 4) * 512 + 256 + (c & 15) * 16) = zero4;
            if (l == 0) rms_rows_to_bf16<true>(IN(I_X), IN(I_NORM_ATTN_G), (bf16*)(wsp + WS_HBA), M, gw, NGW, lane, wsp + WS_HB8, S_H8);
            else rms_rows_to_bf16<true, true, true>((const float*)(wsp + WS_XB), IN(I_NORM_ATTN_G) + DM, (bf16*)(wsp + WS_HBA), M, gw, NGW, lane, wsp + WS_HB8, S_H8);
            rms_rows_to_bf16(IN(I_MEM), IN(I_NORM_MEM_G) + l * DM, MEMN, MMEM, gw, NGW, lane);
            if (l == 0) {
                float* tw = (float*)(wsp + WS_TAB);
                for (int e = gt; e < 2048 * 32; e += NGT) rope_entry(e >> 5, e & 31, 64, tw + T_DC / 4 + e, tw + T_DS / 4 + e);
                for (int e = gt; e < 2048 * 16; e += NGT) rope_entry(e >> 4, e & 15, 32, tw + T_MC / 4 + e, tw + T_MS / 4 + e);
                for (int e = gt; e < 2048 * 64; e += NGT) rope_entry(e >> 6, e & 63, 128, tw + T_QC / 4 + e, tw + T_QS / 4 + e);
                for (int e = gt; e < 32 * 16; e += NGT) rope_entry(e >> 4, e & 15, 32, tw + T_RC / 4 + e, tw + T_RS / 4 + e);
                for (int e = gt; e < 64 * 16; e += NGT) rope_entry(e >> 4, e & 15, 32, tw + T_CC / 4 + e, tw + T_CS / 4 + e);
            }
        }
        xcd_barrier(bar, wave0);
        {
            PHASE_PTRS;
            pg8::Gemm g{(const bf16*)(wsp + WS_HBA), (const bf16*)(aw + AW_IN), DM, DM, DM}; pg8::StaticOrder S; S.init(M / 256, RAWW / 256, G, bx);
            pg8::EpiBf16 E{RAW, RAWW};
            pg8::gemm_phase<pg8::EpiBf16, pg8::StaticOrder, true, false>(lds + RING_OFF, g, S, E, wave0);
            pg8::Gemm g2{MEMN, (const bf16*)(aw + AW_MEMKV), DM, DM, DM}; pg8::StaticOrder S2; S2.init(MMEM / 256, DM / 256, G, (bx + G / 2) % G);
            pg8::EpiBf16 E2{MEMKV, DM};
            pg8::gemm_phase<pg8::EpiBf16, pg8::StaticOrder, true, false>(lds + RING_OFF, g2, S2, E2, wave0);
        }
        xcd_barrier(bar, wave0);
        {
            PHASE_PTRS;
            const int j32 = lane & 31, hh = lane >> 3, j8 = lane & 7;
            const f32x4 gdk0 = *(const GAS f32x4*)(IN(I_DK_G) + l * 64 + 4 * j8), gdk1 = *(const GAS f32x4*)(IN(I_DK_G) + l * 64 + 32 + 4 * j8);
            const f32x2 ggk = *((const f32x2*)(IN(I_GQA_K_G) + l * 64) + j32);
            const f32x2 gmk = *((const f32x2*)(IN(I_MEM_K_G) + l * 128) + lane);
            const f32x2 gql0 = *((const f32x2*)(IN(I_MLA_QLAT_G) + l * 256) + lane), gql1 = *((const f32x2*)(IN(I_MLA_QLAT_G) + l * 256 + 128) + lane), gkl = *((const f32x2*)(IN(I_MLA_KVLAT_G) + l * 128) + lane);
            const int fa = (2 * j32) & 15, fm = (2 * lane) & 63; const bool ablk1 = (2 * j32) >= 32;
#define T1_LOAD(K0_, K1_, W_, DC_, DS_, AC_, AS_, mm) do { const int pos_ = (mm) & (SEQ - 1), grow_ = pos_ >> 6, gcol_ = pos_ & 63; const GAS unsigned* rp_ = (const GAS unsigned*)(RAW + (size_t)(mm) * RAWW) + lane; \
                K0_ = *(const GAS v2u*)(RAW + (size_t)(mm) * RAWW + C_DK + 64 * hh + 4 * j8); K1_ = *(const GAS v2u*)(RAW + (size_t)(mm) * RAWW + C_DK + 64 * hh + 32 + 4 * j8); \
                W_[0] = rp_[64 * 12]; W_[1] = rp_[64 * 13]; W_[2] = rp_[64 * 14]; W_[3] = rp_[64 * 20]; \
                DC_ = *(const GAS f32x4*)(tab + T_DC / 4 + pos_ * 32 + 4 * j8); DS_ = *(const GAS f32x4*)(tab + T_DS / 4 + pos_ * 32 + 4 * j8); \
                AC_ = *(const GAS f32x2*)(tab + (ablk1 ? T_CC / 4 + gcol_ * 16 : T_RC / 4 + grow_ * 16) + fa); AS_ = *(const GAS f32x2*)(tab + (ablk1 ? T_CS / 4 + gcol_ * 16 : T_RS / 4 + grow_ * 16) + fa); } while (0)
            v2u k0, k1, k0n, k1n; unsigned w[4], wn[4]; f32x4 dc, ds, dcn, dsn; f32x2 ac, as, acn, asn;
            T1_LOAD(k0, k1, w, dc, ds, ac, as, gw);
            k0n = k0; k1n = k1; dcn = dc; dsn = ds; acn = ac; asn = as;
#pragma unroll
            for (int c = 0; c < 4; ++c) wn[c] = w[c];
            for (int m = gw; m < M; m += NGW) {
                if (m + NGW < M) { T1_LOAD(k0n, k1n, wn, dcn, dsn, acn, asn, m + NGW); }
                v2u o0, o1;
                { float a[4] = {bflo(k0.x), bfhi(k0.x), bflo(k0.y), bfhi(k0.y)}, b[4] = {bflo(k1.x), bfhi(k1.x), bflo(k1.y), bfhi(k1.y)};
                  float ss = 0.f;
#pragma unroll
                  for (int i = 0; i < 4; ++i) ss += a[i] * a[i] + b[i] * b[i];
                  const float rstd = __builtin_amdgcn_rsqf(sum8(ss) * (1.f / 64.f) + NEPS);
                  float y0[4], y1[4];
#pragma unroll
                  for (int i = 0; i < 4; ++i) { const float p = a[i] * rstd * gdk0[i], q = b[i] * rstd * gdk1[i]; y0[i] = p * dc[i] - q * ds[i]; y1[i] = q * dc[i] + p * ds[i]; }
                  o0.x = pk2(y0[0], y0[1]); o0.y = pk2(y0[2], y0[3]); o1.x = pk2(y1[0], y1[1]); o1.y = pk2(y1[2], y1[3]); }
                const unsigned wg = head_apply<64, 2>(w[3], ggk, ac, as, lane);
                unsigned l0, l1, l2;
                { const float a0 = bflo(w[0]), a1 = bfhi(w[0]), a2 = bflo(w[1]), a3 = bfhi(w[1]);
                  const float rstd = __builtin_amdgcn_rsqf(wave_sum(a0 * a0 + a1 * a1 + a2 * a2 + a3 * a3) * (1.f / 256.f) + NEPS);
                  l0 = pk2(a0 * rstd * gql0.x, a1 * rstd * gql0.y); l1 = pk2(a2 * rstd * gql1.x, a3 * rstd * gql1.y); }
                { const float a0 = bflo(w[2]), a1 = bfhi(w[2]);
                  const float rstd = __builtin_amdgcn_rsqf(wave_sum(a0 * a0 + a1 * a1) * (1.f / 128.f) + NEPS); l2 = pk2(a0 * rstd * gkl.x, a1 * rstd * gkl.y); }
                GAS bf16* kp = (GAS bf16*)(RAW + (size_t)m * RAWW + C_DK + 64 * hh + 4 * j8);
                *(GAS v2u*)kp = o0; *(GAS v2u*)(kp + 32) = o1;
                ((GAS unsigned*)(RAW + (size_t)m * RAWW) + lane)[64 * 20] = wg;
                GAS unsigned* lp = (GAS unsigned*)(LATN + (size_t)m * 512) + lane;
                lp[0] = l0; lp[64] = l1; lp[128] = l2; lp[192] = 0u;
                k0 = k0n; k1 = k1n; dc = dcn; ds = dsn; ac = acn; as = asn;
#pragma unroll
                for (int c = 0; c < 4; ++c) w[c] = wn[c];
            }
#undef T1_LOAD
            for (int m = gw; m < MMEM; m += NGW) {
                const int pos = m & (MEML - 1);
                GAS unsigned* kp = (GAS unsigned*)(MEMKV + (size_t)m * DM) + lane;
                unsigned w[4];
#pragma unroll
                for (int h = 0; h < 4; ++h) w[h] = kp[128 * h];
                const f32x2 qc = *(const GAS f32x2*)(tab + T_QC / 4 + pos * 64 + fm), qs = *(const GAS f32x2*)(tab + T_QS / 4 + pos * 64 + fm);
#pragma unroll
                for (int h = 0; h < 4; ++h) w[h] = head_apply<128, 1>(w[h], gmk, qc, qs, lane);
#pragma unroll
                for (int h = 0; h < 4; ++h) kp[128 * h] = w[h];
            }
        }
        xcd_barrier(bar, wave0);
        {
            PHASE_PTRS;
            pg8::Gemm g{LATN, nullptr, 512, 256, 256}; UpOrder S; S.init(M / 256, 7, G, bx); S.wq = (const bf16*)(aw + AW_QUP); S.wkv = (const bf16*)(aw + AW_KVUP);
            pg8::EpiBf16 E{MLARAW, MLAW};
            pg8::gemm_phase<pg8::EpiBf16, UpOrder, true, false>(lds + RING_OFF, g, S, E, wave0);
        }
        xcd_barrier(bar, wave0);
        {
            PHASE_PTRS;
            const int hh = lane >> 3, j = lane & 7;
            const float* gkp = IN(I_MLA_K_G) + l * 96;
            const f32x4 gn0 = *(const GAS f32x4*)(gkp + 8 * j), gn1 = *(const GAS f32x4*)(gkp + 8 * j + 4), gr = *(const GAS f32x4*)(gkp + 64 + 4 * j);
            const bool first = j < 4;
#define T2_LOAD(KN_, KR_, MC_, MS_, mm) do { const int pos_ = (mm) & (SEQ - 1); \
                KN_ = *(const GAS v4u*)(MLARAW + (size_t)(mm) * MLAW + 768 + 128 * hh + 8 * j); KR_ = *(const GAS v2u*)(RAW + (size_t)(mm) * RAWW + C_KROPE + 4 * j); \
                MC_ = *(const GAS f32x4*)(tab + T_MC / 4 + pos_ * 16 + 4 * (j & 3)); MS_ = *(const GAS f32x4*)(tab + T_MS / 4 + pos_ * 16 + 4 * (j & 3)); } while (0)
            v4u kn, knn; v2u kr, krn; f32x4 mc, ms, mcn, msn;
            T2_LOAD(kn, kr, mc, ms, gw);
            knn = kn; krn = kr; mcn = mc; msn = ms;
            for (int m = gw; m < M; m += NGW) {
                if (m + NGW < M) { T2_LOAD(knn, krn, mcn, msn, m + NGW); }
                float a[8] = {bflo(kn.x), bfhi(kn.x), bflo(kn.y), bfhi(kn.y), bflo(kn.z), bfhi(kn.z), bflo(kn.w), bfhi(kn.w)};
                float r[4] = {bflo(kr.x), bfhi(kr.x), bflo(kr.y), bfhi(kr.y)};
                float ss = 0.f;
#pragma unroll
                for (int i = 0; i < 8; ++i) ss += a[i] * a[i];
#pragma unroll
                for (int i = 0; i < 4; ++i) ss += r[i] * r[i];
                ss = sum8(ss);
                const float rstd = __builtin_amdgcn_rsqf(ss * (1.f / 96.f) + NEPS);
                v4u on; on.x = pk2(a[0] * rstd * gn0.x, a[1] * rstd * gn0.y); on.y = pk2(a[2] * rstd * gn0.z, a[3] * rstd * gn0.w);
                on.z = pk2(a[4] * rstd * gn1.x, a[5] * rstd * gn1.y); on.w = pk2(a[6] * rstd * gn1.z, a[7] * rstd * gn1.w);
#pragma unroll
                for (int i = 0; i < 4; ++i) { r[i] = r[i] * rstd * gr[i]; }
                float y[4];
#pragma unroll
                for (int i = 0; i < 4; ++i) { const float pr = xshfl<4>(r[i]); y[i] = first ? (r[i] * mc[i] - pr * ms[i]) : (r[i] * mc[i] + pr * ms[i]); }
                v2u orp; orp.x = pk2(y[0], y[1]); orp.y = pk2(y[2], y[3]);
                GAS bf16* kp = (GAS bf16*)(KMLA + (size_t)m * 768 + 96 * hh);
                *(GAS v4u*)(kp + 8 * j) = on; *(GAS v2u*)(kp + 64 + 4 * j) = orp;
                kn = knn; kr = krn; mc = mcn; ms = msn;
            }
#undef T2_LOAD
        }
        xcd_barrier(bar, wave0);
        {
            PHASE_PTRS;
            LAS char* al = (LAS char*)(lds + RING_OFF);
            constexpr float L2E = 1.4426950408889634f;
#define NBOUND(c, gq, gk, n) __uint_as_float(__builtin_amdgcn_readfirstlane(__float_as_uint(-(c) * L2E * wave_max_abs((gq), (n), lane) * wave_max_abs((gk), (n), lane))))
            const float nb_diff = NBOUND(8.0f, IN(I_DQ_G) + l * 64, IN(I_DK_G) + l * 64, 64);
            const float nb_mla = NBOUND(9.797958971f, IN(I_MLA_Q_G) + l * 96, IN(I_MLA_K_G) + l * 96, 96);
            const float nb_gqa = NBOUND(8.0f, IN(I_GQA_Q_G) + l * 64, IN(I_GQA_K_G) + l * 64, 64);
            const float nb_mem = NBOUND(11.3137085f, IN(I_MEM_Q_G) + l * 128, IN(I_MEM_K_G) + l * 128, 128);
            const float* lp_ = IN(I_DLAMBDA) + l * 256;
            const float lam = __uint_as_float(__builtin_amdgcn_readfirstlane(__float_as_uint(expf(wave_sum(lp_[lane] * lp_[64 + lane])) - expf(wave_sum(lp_[128 + lane] * lp_[192 + lane])) + lambda_init)));
            for (int u = vcu; u < 512; u += G) {
                const int qb = u & 7, h = (u >> 3) & 3, b = u >> 5; const size_t r0 = (size_t)b * SEQ;
                const att::QPrep qp{IN(I_DQ_G) + l * 64, tab + T_DC / 4, tab + T_DS / 4, nullptr, nullptr, qb * 256};
                att::attn_unit<64, 128, 1, 1, 4>(RAW + (r0 + qb * 256) * RAWW + C_DQ + (2 * h) * 64, RAWW, RAW + r0 * RAWW + C_DK + (2 * h) * 64, RAWW, RAW + r0 * RAWW + C_DV + h * 128, RAWW,
                                                 ODIFF + (r0 + qb * 256) * 1024 + h * 128, 1024, SEQ, 0.125f * L2E, nb_diff, qp, al, wave0);
                const att::DiffEpi de{ODIFF + (r0 + qb * 256) * 1024 + h * 128, 1024, lam, IN(I_DSUBLN_G) + l * 128, l};
                att::attn_unit<64, 128, 1, 1, 4, true>(RAW + (r0 + qb * 256) * RAWW + C_DQ + (2 * h + 1) * 64, RAWW, RAW + r0 * RAWW + C_DK + (2 * h + 1) * 64, RAWW, RAW + r0 * RAWW + C_DV + h * 128, RAWW,
                                                       RAW + (r0 + qb * 256) * RAWW + C_OA + h * 128, RAWW, SEQ, 0.125f * L2E, nb_diff, qp, al, wave0, 1.0f, &de);
            }
            for (int u = vcu; u < 512; u += G) {
                const int qb = u & 3, h = (u >> 2) & 7, b = u >> 5; const size_t r0 = (size_t)b * SEQ;
                const att::QPrep qp{IN(I_MLA_Q_G) + l * 96, tab + T_MC / 4, tab + T_MS / 4, nullptr, nullptr, qb * 512};
                att::attn_unit2d<96, 3, true>(MLARAW + (r0 + qb * 512) * MLAW + h * 96, MLAW, KMLA + r0 * 768 + h * 96, 768, MLARAW + r0 * MLAW + 768 + h * 128 + 64, MLAW,
                                                  RAW + (r0 + qb * 512) * RAWW + C_OB + h * 64, RAWW, SEQ, 0.10206207261596575f * L2E, nb_mla, qp, al, wave0);
            }
            for (int u = vcu; u < 512; u += G) {
                const int qb = u & 3, qh = (u >> 2) & 7, b = u >> 5; const size_t r0 = (size_t)b * SEQ;
                const att::QPrep qp{IN(I_GQA_Q_G) + l * 64, tab + T_RC / 4, tab + T_RS / 4, tab + T_CC / 4, tab + T_CS / 4, qb * 512};
                att::attn_unit2d<64, 2>(RAW + (r0 + qb * 512) * RAWW + C_GQ + qh * 64, RAWW, RAW + r0 * RAWW + C_GK + (qh >> 2) * 64, RAWW, RAW + r0 * RAWW + C_GV + (qh >> 2) * 64, RAWW,
                                       RAW + (r0 + qb * 512) * RAWW + C_OC + qh * 64, RAWW, SEQ, 0.125f * L2E, nb_gqa, qp, al, wave0);
            }
            for (int u = vcu; u < 512; u += G) {
                const int qb = u & 7, h = (u >> 3) & 3, b = u >> 5; const size_t r0 = (size_t)b * SEQ;
                const att::QPrep qp{IN(I_MEM_Q_G) + l * 128, tab + T_QC / 4, tab + T_QS / 4, nullptr, nullptr, qb * 256};
                att::attn_unit<128, 128, 1, 1, 4>(RAW + (r0 + qb * 256) * RAWW + C_MEMQ + h * 128, RAWW, MEMKV + (size_t)b * MEML * DM + h * 256, DM, MEMKV + (size_t)b * MEML * DM + h * 256 + 128, DM,
                                               RAW + (r0 + qb * 256) * RAWW + C_OD + h * 128, RAWW, MEML, 0.08838834764831845f * L2E, nb_mem, qp, al, wave0);
            }
        }
        xcd_barrier(bar, wave0);
        {
            PHASE_PTRS;
            pg8::Gemm g{(const bf16*)(wsp + WS_HB8), (const bf16*)(aw + AW_GATE), DM / 2, DM / 2, DM / 2}; pg8::StaticOrder S; S.init(M / 256, 16, G, bx);
            pg8::EpiSigmoidU8 E{(unsigned char*)GT, 4096, IN(I_B_GATE) + l * 4096, 1.0f / (S_H8 * S_WG)};
            pg8::gemm_phase<pg8::EpiSigmoidU8, pg8::StaticOrder, true, false, true>(lds + RING_OFF, g, S, E, wave0);
        }
        xcd_barrier(bar, wave0);
        {
            PHASE_PTRS;
            pg8::Gemm g{RAW, (const bf16*)(aw + AW_BR), RAWW, 512, 512}; MergeOrder S; S.init(M / 256, 4, G, bx);
            EpiMerge E{(const unsigned char*)GT, (bf16*)(wsp + WS_MERGED)};
            pg8::gemm_phase<EpiMerge, MergeOrder, true, false>(lds + RING_OFF, g, S, E, wave0);
        }
        xcd_barrier(bar, wave0);
        {
            PHASE_PTRS;
            pg8::Gemm g{(const bf16*)(wsp + WS_MERGED), (const bf16*)(aw + AW_OUT), DM, DM, DM}; pg8::StaticOrder S; S.init(M / 256, 4, G, bx);
            if (l == 0) { pg8::EpiResidX<false, true> E{IN(I_X), wsp + WS_XB, DM};
                pg8::gemm_phase<pg8::EpiResidX<false, true>, pg8::StaticOrder, true, false>(lds + RING_OFF, g, S, E, wave0); }
            else { pg8::EpiResidX<true, true> E{wsp + WS_XB, wsp + WS_XB, DM};
                pg8::gemm_phase<pg8::EpiResidX<true, true>, pg8::StaticOrder, true, false>(lds + RING_OFF, g, S, E, wave0); }
        }
        xcd_barrier(bar, wave0);
        if (l == 0) {
            {
                PHASE_PTRS;
                for (int it = gw; it < FFN_ITEMS; it += NGW) ffn_weight_item(it, IN(I_DW1), IN(I_DW3), IN(I_DW2), W13t, W2t, scr, lane);
                rms_rows_to_bf16<false, true, true>((const float*)(wsp + WS_XB), IN(I_NORM_FFN_G), (bf16*)(wsp + WS_HBF), M, gw, NGW, lane);
            }
            xcd_barrier(bar, wave0);
            {
                PHASE_PTRS;
                pg8::Gemm g{(const bf16*)(wsp + WS_HBF), W13t, DM, DM, DM}; pg8::StaticOrder S; S.init(M / 256, 2 * FF / 256, G, bx);
                pg8::EpiSwiGLU E{U, FF, 0};
                pg8::gemm_phase<pg8::EpiSwiGLU, pg8::StaticOrder, true, false>(lds + RING_OFF, g, S, E, wave0);
            }
            xcd_barrier(bar, wave0);
            {
                PHASE_PTRS;
                pg8::Gemm g{U, W2t, FF, FF, FF}; pg8::StaticOrder S; S.init(M / 256, DM / 256, G, bx);
                pg8::EpiResidX<true, true> E{wsp + WS_XB, wsp + WS_XB, DM};
                pg8::gemm_phase<pg8::EpiResidX<true, true>, pg8::StaticOrder, true, false>(lds + RING_OFF, g, S, E, wave0);
            }
            xcd_barrier(bar, wave0);
        }

        if (l == 1) {
            {
                PHASE_PTRS;
                volatile LAS int* ml = (volatile LAS int*)(lds + MOE_LDS);
                int* slot_tok = (int*)(wsp + WS_MOE + MO_SLOT_TOK); float* tok_gate = (float*)(wsp + WS_MOE + MO_TOK_GATE); int* wgcnt = (int*)(wsp + WS_MOE + MO_WGCNT);
                for (int it = gw; it < NEXP * FFN_ITEMS; it += NGW) { const int e = it / FFN_ITEMS; unsigned char* w13 = (unsigned char*)W13t + (size_t)e * EXPERT_BYTES;
                    ffn_weight_item8(it % FFN_ITEMS, IN(I_MW1) + (size_t)e * DM * FF, IN(I_MW3) + (size_t)e * DM * FF, IN(I_MW2) + (size_t)e * FF * DM, w13, w13 + W2_OFF, scr, lane); }
                for (int c = gt; c < MOE_SLOTS; c += NGT) slot_tok[c] = 0;
                const float* wr_ = IN(I_ROUTER); const float* gf = IN(I_NORM_FFN_G) + DM;
                f32x4 rw[4][4][2];
#pragma unroll
                for (int j = 0; j < 4; ++j)
#pragma unroll
                    for (int q = 0; q < 4; ++q) { const GAS f32x4* rp = (const GAS f32x4*)(wr_ + (size_t)(4 * (lane + 64 * j) + q) * 8); rw[j][q][0] = rp[0]; rw[j][q][1] = rp[1]; }
                f32x4 v[4], vn[4], ggv[4];
#pragma unroll
                for (int j = 0; j < 4; ++j) ggv[j] = ((const GAS f32x4*)gf + lane)[64 * j];
                { const float* xb_ = (const float*)(wsp + WS_XB);
#pragma unroll
                  for (int j = 0; j < 4; ++j) { v[j] = rr_load<true>(xb_, vcu * 128 + wave * 16, lane, j); vn[j] = v[j]; } }
                for (int i = 0; i < 16; ++i) {
                    const int tl = wave * 16 + i, t = vcu * 128 + tl;
                    if (i + 1 < 16) { const float* xb_ = (const float*)(wsp + WS_XB);
#pragma unroll
                        for (int j = 0; j < 4; ++j) vn[j] = rr_load<true>(xb_, t + 1, lane, j); }
                    float s = 0.f;
#pragma unroll
                    for (int j = 0; j < 4; ++j) { s += (v[j].x * v[j].x + v[j].y * v[j].y) + (v[j].z * v[j].z + v[j].w * v[j].w); }
                    const float rstd = __builtin_amdgcn_rsqf(wave_sum(s) * (1.f / DM) + NEPS);
                    GAS unsigned* o4 = (GAS unsigned*)(wsp + WS_HBM8 + (size_t)t * DM) + lane;
                    float lg[8] = {0.f, 0.f, 0.f, 0.f, 0.f, 0.f, 0.f, 0.f};
#pragma unroll
                    for (int j = 0; j < 4; ++j) { const f32x4 gg = ggv[j]; const float h0 = v[j].x * rstd * gg.x, h1 = v[j].y * rstd * gg.y, h2 = v[j].z * rstd * gg.z, h3 = v[j].w * rstd * gg.w;
                        o4[64 * j] = pg8::cvt4_fp8(h0 * S_H8, h1 * S_H8, h2 * S_H8, h3 * S_H8);
#pragma unroll
                        for (int e = 0; e < 8; ++e) lg[e] += h0 * rw[j][0][e >> 2][e & 3] + h1 * rw[j][1][e >> 2][e & 3] + h2 * rw[j][2][e >> 2][e & 3] + h3 * rw[j][3][e >> 2][e & 3]; }
#pragma unroll
                    for (int e = 0; e < 8; ++e) lg[e] = wave_sum(lg[e]);
                    int e1 = 0; float l1 = lg[0];
#pragma unroll
                    for (int e = 1; e < 8; ++e) if (lg[e] > l1) { l1 = lg[e]; e1 = e; }
                    int e2 = -1; float l2 = -3.0e38f;
#pragma unroll
                    for (int e = 0; e < 8; ++e) if (e != e1 && lg[e] > l2) { l2 = lg[e]; e2 = e; }
                    const float ex = expf(l2 - l1), g1 = 1.0f / (1.0f + ex), g2 = ex / (1.0f + ex);
                    if (lane == 0) { ml[ML_SEL + 2 * tl] = e1; ml[ML_SEL + 2 * tl + 1] = e2; tok_gate[2 * t] = g1; tok_gate[2 * t + 1] = g2; }
#pragma unroll
                    for (int j = 0; j < 4; ++j) v[j] = vn[j];
                }
                LDS_WAIT(); __syncthreads();
                if (wave == 0) {
                    int base[8] = {0, 0, 0, 0, 0, 0, 0, 0}; const unsigned long long lt = (1ull << lane) - 1ull;
#pragma unroll
                    for (int j = 0; j < 4; ++j) { const int a = 64 * j + lane, e = ml[ML_SEL + a]; int r = 0;
#pragma unroll
                        for (int ee = 0; ee < 8; ++ee) { const unsigned long long mk = __ballot(e == ee); if (e == ee) r = base[ee] + __popcll(mk & lt); base[ee] += __popcll(mk); }
                        ml[ML_RNK + a] = r; }
                    int cv = 0;
#pragma unroll
                    for (int ee = 0; ee < 8; ++ee) if (lane == ee) cv = base[ee];
                    if (lane < 8) wgcnt[vcu * 8 + lane] = cv;
                }
            }
            xcd_barrier(bar, wave0);
            {
                PHASE_PTRS;
                volatile LAS int* ml = (volatile LAS int*)(lds + MOE_LDS);
                int* slot_tok = (int*)(wsp + WS_MOE + MO_SLOT_TOK); int* tok_slot = (int*)(wsp + WS_MOE + MO_TOK_SLOT); const int* wgcnt = (const int*)(wsp + WS_MOE + MO_WGCNT);
                { int s = 0, p = 0;
#pragma unroll
                  for (int q = 0; q < 4; ++q) { const int w = 4 * lane + q; const int c = wgcnt[w * 8 + wave]; s += c; if (w < vcu) p += c; }
                  s = wave_sum_i(s); p = wave_sum_i(p);
                  if (lane == 0) { ml[ML_TOT + wave] = s; ml[ML_PRE + wave] = p; } }
                LDS_WAIT(); __syncthreads();
                if (wave == 0 && lane == 0) { int b = 0; for (int e = 0; e < 8; ++e) { ml[ML_SEGB + e] = b; b += (ml[ML_TOT + e] + 255) & ~255; } ml[ML_SEGB + 8] = b; }
                LDS_WAIT(); __syncthreads();
                { const int a = wave * 64 + lane;
                  if (a < 272) { int e = 0;
#pragma unroll
                      for (int q = 1; q < 8; ++q) if (ml[ML_SEGB + q] <= 256 * a) e = q;
                      ml[ML_TE + a] = e; }
                  if (a < 256) { const int e = ml[ML_SEL + a], slot = ml[ML_SEGB + e] + ml[ML_PRE + e] + ml[ML_RNK + a], t = vcu * 128 + (a >> 1);
                      slot_tok[slot] = t; tok_slot[2 * t + (a & 1)] = slot; } }
                LDS_WAIT(); __syncthreads();
                for (int i = 0; i < 32; i += 4) {
                    v4u r[4]; int sl[4];
#pragma unroll
                    for (int q = 0; q < 4; ++q) { const int a = wave * 32 + i + q, e = ml[ML_SEL + a]; sl[q] = ml[ML_SEGB + e] + ml[ML_PRE + e] + ml[ML_RNK + a];
                        r[q] = *((const GAS v4u*)(wsp + WS_HBM8 + (size_t)(vcu * 128 + (a >> 1)) * DM) + lane); }
#pragma unroll
                    for (int q = 0; q < 4; ++q) *((GAS v4u*)(wsp + WS_XS8 + (size_t)sl[q] * DM) + lane) = r[q];
                }
            }
            xcd_barrier(bar, wave0);
            const int n_tiles = __builtin_amdgcn_readfirstlane(((volatile LAS int*)(lds + MOE_LDS))[ML_SEGB + 8]) >> 8;
            const int n_full = n_tiles < 256 ? n_tiles : 256, n_tail = n_tiles - n_full;
#pragma unroll 1
            for (int ch = 0; ch * MOE_CHUNK_TILES < n_full; ++ch) {
                const int tile0 = ch * MOE_CHUNK_TILES, nt_c = (n_full - tile0) < MOE_CHUNK_TILES ? (n_full - tile0) : MOE_CHUNK_TILES;
                {
                    PHASE_PTRS;
                    pg8::Gemm g{(const bf16*)(wsp + WS_XS8 + (size_t)tile0 * 256 * DM), nullptr, DM / 2, DM / 2, DM / 2}; MoeDownOrder S; S.init(nt_c, 2 * FF / 256, G, bx);
                    S.tile0 = tile0; S.te = (const volatile LAS int*)(lds + MOE_LDS) + ML_TE; S.wbase = (const char*)W13t;
                    pg8::EpiSwiGLU8 E{wsp + WS_UM, FF, 1.0f / (S_H8 * S_W13), S_U8};
                    pg8::gemm_phase<pg8::EpiSwiGLU8, MoeDownOrder, true, false, true>(lds + RING_OFF, g, S, E, wave0);
                }
                xcd_barrier(bar, wave0);
                {
                    PHASE_PTRS;
                    pg8::Gemm g{(const bf16*)(wsp + WS_UM), nullptr, FF / 2, FF / 2, FF / 2}; MoeDownOrder S; S.init(nt_c, DM / 256, G, bx);
                    S.tile0 = tile0; S.te = (const volatile LAS int*)(lds + MOE_LDS) + ML_TE; S.wbase = (const char*)W13t + W2_OFF;
                    pg8::EpiBf16 E{(bf16*)(wsp + WS_Y) + (size_t)tile0 * 256 * DM, DM, 1.0f / (S_U8 * S_W2)};
                    pg8::gemm_phase<pg8::EpiBf16, MoeDownOrder, true, false, true>(lds + RING_OFF, g, S, E, wave0);
                }
                xcd_barrier(bar, wave0);
            }
            if (n_tail > 0) {
                {
                    PHASE_PTRS;
                    pg8::Gemm g{(const bf16*)(wsp + WS_XS8 + (size_t)256 * 256 * DM), nullptr, DM / 2, DM / 2, DM / 2}; MoeDownOrder S; S.init(n_tail, 2 * FF / 256, G, bx);
                    S.tile0 = 256; S.te = (const volatile LAS int*)(lds + MOE_LDS) + ML_TE; S.wbase = (const char*)W13t;
                    pg8::EpiSwiGLU8 E{wsp + WS_UM, FF, 1.0f / (S_H8 * S_W13), S_U8};
                    pg8::gemm_phase<pg8::EpiSwiGLU8, MoeDownOrder, true, false, true>(lds + RING_OFF, g, S, E, wave0);
                }
                xcd_barrier(bar, wave0);
                {
                    PHASE_PTRS;
                    pg8::Gemm g{(const bf16*)(wsp + WS_UM), nullptr, FF / 2, FF / 2, 256}; TailDownOrder S; S.init(n_tail, DM / 256, G, bx);
                    S.te = (const volatile LAS int*)(lds + MOE_LDS) + ML_TE; S.wbase = (const char*)W13t + W2_OFF;
                    EpiPartF32 E{(float*)(wsp + WS_TAILP), n_tail * 256};
                    pg8::gemm_phase<EpiPartF32, TailDownOrder, true, false, true>(lds + RING_OFF, g, S, E, wave0);
                }
                xcd_barrier(bar, wave0);
            }
            {
                PHASE_PTRS;
                const int* tok_slot = (const int*)(wsp + WS_MOE + MO_TOK_SLOT); const float* tok_gate = (const float*)(wsp + WS_MOE + MO_TOK_GATE); const bf16* Y = (const bf16*)(wsp + WS_Y);
#define MC_IDX(S1_, S2_, G1_, G2_, tt) do { const int t_ = (tt) < M ? (tt) : gw; S1_ = tok_slot[2 * t_]; S2_ = tok_slot[2 * t_ + 1]; G1_ = tok_gate[2 * t_]; G2_ = tok_gate[2 * t_ + 1]; } while (0)
#define MC_ROWS(X_, A_, B_, S1_, S2_, tt) do { const int t_ = (tt) < M ? (tt) : gw; \
                    const GAS v2u* y1_ = (const GAS v2u*)(Y + (size_t)(S1_) * DM) + lane; const GAS v2u* y2_ = (const GAS v2u*)(Y + (size_t)(S2_) * DM) + lane; \
                    _Pragma("unroll") for (int j = 0; j < 4; ++j) { X_[j] = rr_load<true>(XBp, t_, lane, j); A_[j] = (S1_) >= 65536 ? tail_row(PT, n_tail * 256, (S1_) - 65536, lane + 64 * j, TSC) : y1_[64 * j]; B_[j] = (S2_) >= 65536 ? tail_row(PT, n_tail * 256, (S2_) - 65536, lane + 64 * j, TSC) : y2_[64 * j]; } } while (0)
                const float* PT = (const float*)(wsp + WS_TAILP); const float* XBp = (const float*)(wsp + WS_XB); constexpr float TSC = 1.0f / (S_U8 * S_W2);
                int s1a, s2a, s1b, s2b, s1c, s2c; float g1a, g2a, g1b, g2b, g1c, g2c; f32x4 xc[4], xn[4]; v2u ac[4], bc[4], an[4], bn[4];
                MC_IDX(s1a, s2a, g1a, g2a, gw); MC_IDX(s1b, s2b, g1b, g2b, gw + NGW);
                MC_ROWS(xc, ac, bc, s1a, s2a, gw);
                for (int t = gw; t < M; t += NGW) {
                    MC_IDX(s1c, s2c, g1c, g2c, t + 2 * NGW);
                    MC_ROWS(xn, an, bn, s1b, s2b, t + NGW);
                    GAS f32x4* xr = (GAS f32x4*)(out + (size_t)t * DM) + lane;
#pragma unroll
                    for (int j = 0; j < 4; ++j) { f32x4 x = xc[j]; const v2u a = ac[j], b = bc[j];
                        x.x += g1a * bflo(a.x) + g2a * bflo(b.x); x.y += g1a * bfhi(a.x) + g2a * bfhi(b.x); x.z += g1a * bflo(a.y) + g2a * bflo(b.y); x.w += g1a * bfhi(a.y) + g2a * bfhi(b.y);
                        xr[64 * j] = x; }
#pragma unroll
                    for (int j = 0; j < 4; ++j) { xc[j] = xn[j]; ac[j] = an[j]; bc[j] = bn[j]; }
                    s1a = s1b; s2a = s2b; g1a = g1b; g2a = g2b; s1b = s1c; s2b = s2c; g1b = g1c; g2b = g2c;
                }
#undef MC_IDX
#undef MC_ROWS
            }
        }
    }
}

extern "C" void kernel_launch(void* const* d_in, const int* in_sizes, int n_in, void* d_out, int out_size, void* d_ws, size_t ws_size, hipStream_t stream) {
    static int grid = 0;
    if (grid == 0) {
        if (n_in != N_IN || in_sizes[0] != M * DM || out_size != M * DM || ws_size < WS_END) { fprintf(stderr, "kernel_launch: shape/workspace mismatch (n_in %d, ws %zu)\n", n_in, ws_size); grid = -1; return; }
        int dev = 0, cus = 0;
        if (hipGetDevice(&dev) != hipSuccess || hipDeviceGetAttribute(&cus, hipDeviceAttributeMultiprocessorCount, dev) != hipSuccess) { grid = -1; return; }
        if (hipFuncSetAttribute((const void*)fwd, hipFuncAttributeMaxDynamicSharedMemorySize, LDS_BYTES) != hipSuccess) { grid = -1; return; }
        int per_cu = 0;
        if (hipOccupancyMaxActiveBlocksPerMultiprocessor(&per_cu, (const void*)fwd, NWAVES * 64, LDS_BYTES) != hipSuccess || per_cu < 1) { fprintf(stderr, "kernel_launch: occupancy query says %d\n", per_cu); }
        (void)hipGetLastError();
        if (cus != 256) { fprintf(stderr, "kernel_launch: built for 256 CUs, got %d\n", cus); grid = -1; return; }
        grid = cus;
    }
    if (grid < 0) return;
    if (hipMemsetAsync((char*)d_ws + WS_CTL, 0, CTL_ZERO_BYTES, stream) != hipSuccess) return;
    Args a{};
    for (int i = 0; i < N_IN; ++i) a.in[i] = (const float*)d_in[i];
    a.out = (float*)d_out; a.ws = (unsigned char*)d_ws;
    hipLaunchKernelGGL(fwd, dim3(grid), dim3(NWAVES * 64), LDS_BYTES, stream, a);
}
```

```cpp
#include <hip/hip_runtime.h>
#include <cstdio>
#include <cstdint>
namespace pg8 {
#define PG8_LAS __attribute__((address_space(3)))
typedef unsigned short bf16_t;
typedef short bf16x8 __attribute__((ext_vector_type(8)));
typedef float f32x4 __attribute__((ext_vector_type(4)));
typedef float f32x2 __attribute__((ext_vector_type(2)));
typedef unsigned u32x4 __attribute__((ext_vector_type(4)));
typedef unsigned u32x2 __attribute__((ext_vector_type(2)));
constexpr int BM = 256, BK = 64, HALF = 128, HTB = HALF * BK * 2  , STAGE_BYTES = 8 * HTB, NXCD = 8, WGM = 8;

__host__ __device__ __forceinline__ int lds_byte(int r, int c) { const int st = (r >> 4) * 2 + (c >> 5), rr = r & 15, cc = c & 31, ob = rr * 64 + cc * 2; return st * 1024 + (ob ^ (((ob >> 9) & 1) << 5)); }
__host__ __device__ __forceinline__ void stage_rc(int b, int& R, int& C) { const int st = b / 1024, sb = b % 1024, swz = sb ^ (((sb >> 9) & 1) << 5); R = (st >> 1) * 16 + swz / 64; C = (st & 1) * 32 + (swz % 64) / 2; }
__host__ __device__ __forceinline__ int perm32(int rho) { const int n = rho >> 4, i = rho & 15; return 8 * (i >> 2) + 4 * n + (i & 3); }

struct Unit { int pm, pn, z; };
struct Gemm { const bf16_t* A; const bf16_t* Bt; int lda, ldb, K; };

struct StaticOrder {
    int nM, nN, nwg, G, c;
    __device__ __forceinline__ void init(int nM_, int nN_, int G_, int c_) { nM = nM_; nN = nN_; nwg = nM * nN; G = G_; c = c_; }
    __device__ __forceinline__ bool tile(long L, Unit& u) const {
        if (L >= nwg) return false;
        int wgid = (int)L; { const int q = nwg / NXCD, r = nwg % NXCD, xcd = wgid % NXCD, off = wgid / NXCD; wgid = (xcd < r ? xcd * (q + 1) : r * (q + 1) + (xcd - r) * q) + off; }
        const int nig = WGM * nN, gid = wgid / nig, fm = gid * WGM, gsz = (nM - fm) < WGM ? (nM - fm) : WGM;
        u.pm = __builtin_amdgcn_readfirstlane(fm + ((wgid % nig) % gsz)); u.pn = __builtin_amdgcn_readfirstlane((wgid % nig) / gsz); u.z = 0; return true;
    }
    __device__ __forceinline__ bool next(int i, Unit& u) const { return tile((long)i * G + c, u); }
    __device__ __forceinline__ const char* a_ptr(const Gemm& g, const Unit& u) const { return (const char*)g.A + (size_t)u.pm * (BM * 2) * g.lda; }
    __device__ __forceinline__ const char* b_ptr(const Gemm& g, const Unit& u) const { return (const char*)g.Bt + (size_t)u.pn * (BM * 2) * g.ldb; }
    __device__ __forceinline__ unsigned row_off(const Gemm&, const Unit&, int) const { return 0u; }
};

typedef __bf16 bf16x2_t __attribute__((ext_vector_type(2)));
__device__ __forceinline__ unsigned cvt_pk_bf16(float lo, float hi) { f32x2 v = {lo, hi}; bf16x2_t b = __builtin_convertvector(v, bf16x2_t); return __builtin_bit_cast(unsigned, b); }
__device__ __forceinline__ float bf_lo(unsigned w) { return __uint_as_float(w << 16); }
__device__ __forceinline__ float bf_hi(unsigned w) { return __uint_as_float(w & 0xffff0000u); }
__device__ __forceinline__ float sigmoidf_(float v) { return __builtin_amdgcn_rcpf(1.0f + __builtin_amdgcn_exp2f(-1.4426950408889634f * v)); }

struct EpiBf16 {
    static constexpr bool PERM = true;
    bf16_t* O; int ldc; float scale = 1.0f;
    __device__ __forceinline__ bool keep(const Unit&) const { return false; }
    __device__ __forceinline__ void operator()(const f32x4 (&acc)[2][2][4][2], const Unit& u, int wr, int wc, int fr, int fq) const {
        const int row0 = u.pm * BM + wr * 64 + fr, col0 = u.pn * BM + wc * 32 + 8 * fq;
#pragma unroll
        for (int ai = 0; ai < 2; ++ai)
#pragma unroll
            for (int m = 0; m < 4; ++m) { bf16_t* rowp = O + (size_t)(row0 + ai * HALF + m * 16) * ldc + col0;
#pragma unroll
                for (int bj = 0; bj < 2; ++bj) { const f32x4 v0 = acc[ai][bj][m][0] * scale, v1 = acc[ai][bj][m][1] * scale;
                    u32x4 w; w.x = cvt_pk_bf16(v0[0], v0[1]); w.y = cvt_pk_bf16(v0[2], v0[3]); w.z = cvt_pk_bf16(v1[0], v1[1]); w.w = cvt_pk_bf16(v1[2], v1[3]);
                    __builtin_nontemporal_store(w, (u32x4*)(rowp + bj * HALF)); } }
    }
};
struct EpiSigmoid {
    static constexpr bool PERM = true;
    bf16_t* O; int ldc; const float* bias; float scale = 1.0f;
    __device__ __forceinline__ bool keep(const Unit&) const { return false; }
    __device__ __forceinline__ void operator()(const f32x4 (&acc)[2][2][4][2], const Unit& u, int wr, int wc, int fr, int fq) const {
        const int row0 = u.pm * BM + wr * 64 + fr, col0 = u.pn * BM + wc * 32 + 8 * fq;
        f32x4 bv[2][2];
#pragma unroll
        for (int bj = 0; bj < 2; ++bj)
#pragma unroll
            for (int n = 0; n < 2; ++n) bv[bj][n] = *(const f32x4*)(bias + col0 + bj * HALF + 4 * n);
#pragma unroll
        for (int ai = 0; ai < 2; ++ai)
#pragma unroll
            for (int m = 0; m < 4; ++m) { bf16_t* rowp = O + (size_t)(row0 + ai * HALF + m * 16) * ldc + col0;
#pragma unroll
                for (int bj = 0; bj < 2; ++bj) { const f32x4 v0 = acc[ai][bj][m][0] * scale + bv[bj][0], v1 = acc[ai][bj][m][1] * scale + bv[bj][1];
                    u32x4 w; w.x = cvt_pk_bf16(sigmoidf_(v0[0]), sigmoidf_(v0[1])); w.y = cvt_pk_bf16(sigmoidf_(v0[2]), sigmoidf_(v0[3]));
                    w.z = cvt_pk_bf16(sigmoidf_(v1[0]), sigmoidf_(v1[1])); w.w = cvt_pk_bf16(sigmoidf_(v1[2]), sigmoidf_(v1[3]));
                    __builtin_nontemporal_store(w, (u32x4*)(rowp + bj * HALF)); } }
    }
};
struct EpiSigmoidU8 {
    static constexpr bool PERM = true;
    unsigned char* O; int ldc; const float* bias; float scale;
    __device__ __forceinline__ bool keep(const Unit&) const { return false; }
    static __device__ __forceinline__ float q255(float t) { return __builtin_amdgcn_rcpf(__builtin_fmaf(fminf(__builtin_amdgcn_exp2f(t), 254.0f), 1.0f / 255.0f, 1.0f / 255.0f)); }
    __device__ __forceinline__ void operator()(const f32x4 (&acc)[2][2][4][2], const Unit& u, int wr, int wc, int fr, int fq) const {
        const int col0 = u.pn * BM + wc * 32 + 8 * fq;
        f32x4 bv[2][2];
#pragma unroll
        for (int bj = 0; bj < 2; ++bj)
#pragma unroll
            for (int n = 0; n < 2; ++n) bv[bj][n] = *(const f32x4*)(bias + col0 + bj * HALF + 4 * n) * -1.4426950408889634f;
        const float sc2 = scale * -1.4426950408889634f;
        unsigned char* tp = O + ((size_t)(u.pm * 16 + u.pn) << 16) + ((wr * 4 + wc) << 13) + (fq * 16 + fr) * 8;
#pragma unroll
        for (int ai = 0; ai < 2; ++ai)
#pragma unroll
            for (int m = 0; m < 4; ++m) {
#pragma unroll
                for (int bj = 0; bj < 2; ++bj) { const f32x4 v0 = acc[ai][bj][m][0] * sc2 + bv[bj][0], v1 = acc[ai][bj][m][1] * sc2 + bv[bj][1];
                    u32x2 w; w.x = 0u; w.y = 0u;
#pragma unroll
                    for (int e = 0; e < 4; ++e) { w.x = __builtin_amdgcn_cvt_pk_u8_f32(q255(v0[e]), e, w.x); w.y = __builtin_amdgcn_cvt_pk_u8_f32(q255(v1[e]), e, w.y); }
                    __builtin_nontemporal_store(w, (u32x2*)(tp + (((ai * 4 + m) * 2 + bj) << 9))); } }
    }
};
struct EpiSwiGLU {
    static constexpr bool PERM = true;
    bf16_t* O; int ldc; int row_base;
    __device__ __forceinline__ bool keep(const Unit&) const { return false; }
    __device__ __forceinline__ void operator()(const f32x4 (&acc)[2][2][4][2], const Unit& u, int wr, int wc, int fr, int fq) const {
        const int row0 = row_base + u.pm * BM + wr * 64 + fr, col0 = u.pn * HALF + wc * 32 + 8 * fq;
#pragma unroll
        for (int ai = 0; ai < 2; ++ai)
#pragma unroll
            for (int m = 0; m < 4; ++m) { bf16_t* rowp = O + (size_t)(row0 + ai * HALF + m * 16) * ldc + col0;
                float r[8];
#pragma unroll
                for (int n = 0; n < 2; ++n)
#pragma unroll
                    for (int j = 0; j < 4; ++j) { const float gt = acc[ai][0][m][n][j], up = acc[ai][1][m][n][j]; r[n * 4 + j] = gt * sigmoidf_(gt) * up; }
                u32x4 w; w.x = cvt_pk_bf16(r[0], r[1]); w.y = cvt_pk_bf16(r[2], r[3]); w.z = cvt_pk_bf16(r[4], r[5]); w.w = cvt_pk_bf16(r[6], r[7]);
                __builtin_nontemporal_store(w, (u32x4*)rowp); }
    }
};
__device__ __forceinline__ unsigned cvt4_fp8(float a, float b, float c, float d) { int w = __builtin_amdgcn_cvt_pk_fp8_f32(a, b, 0, false); w = __builtin_amdgcn_cvt_pk_fp8_f32(c, d, w, true); return (unsigned)w; }
struct EpiSwiGLU8 {
    static constexpr bool PERM = true;
    unsigned char* O; int ldc; float in_scale, out_scale;
    __device__ __forceinline__ bool keep(const Unit&) const { return false; }
    __device__ __forceinline__ void operator()(const f32x4 (&acc)[2][2][4][2], const Unit& u, int wr, int wc, int fr, int fq) const {
        const int row0 = u.pm * BM + wr * 64 + fr, col0 = u.pn * HALF + wc * 32 + 8 * fq;
        const float k1 = in_scale * -1.4426950408889634f, k2 = in_scale * in_scale * out_scale;
#pragma unroll
        for (int ai = 0; ai < 2; ++ai)
#pragma unroll
            for (int m = 0; m < 4; ++m) { unsigned char* rowp = O + (size_t)(row0 + ai * HALF + m * 16) * ldc + col0;
                float r[8];
#pragma unroll
                for (int n = 0; n < 2; ++n)
#pragma unroll
                    for (int jp = 0; jp < 2; ++jp) {
                        const f32x2 a = jp ? __builtin_shufflevector(acc[ai][0][m][n], acc[ai][0][m][n], 2, 3) : __builtin_shufflevector(acc[ai][0][m][n], acc[ai][0][m][n], 0, 1);
                        const f32x2 b = jp ? __builtin_shufflevector(acc[ai][1][m][n], acc[ai][1][m][n], 2, 3) : __builtin_shufflevector(acc[ai][1][m][n], acc[ai][1][m][n], 0, 1);
                        const f32x2 t = a * k1; f32x2 d = {__builtin_amdgcn_exp2f(t.x), __builtin_amdgcn_exp2f(t.y)}; d = d + 1.0f;
                        f32x2 q = {__builtin_amdgcn_rcpf(d.x), __builtin_amdgcn_rcpf(d.y)}; q = (a * b) * (q * k2);
                        r[n * 4 + 2 * jp] = q.x; r[n * 4 + 2 * jp + 1] = q.y; }
                u32x2 w; w.x = cvt4_fp8(r[0], r[1], r[2], r[3]); w.y = cvt4_fp8(r[4], r[5], r[6], r[7]);
                __builtin_nontemporal_store(w, (u32x2*)rowp); }
    }
};
template <bool BASE_BF, bool OUT_BF>
struct EpiResidX {
    static constexpr bool PERM = false;
    const void* base; void* out; int ldc; float scale = 1.0f;
    __device__ __forceinline__ bool keep(const Unit&) const { return false; }
    __device__ __forceinline__ void operator()(const f32x4 (&acc)[2][2][4][2], const Unit& u, int wr, int wc, int fr, int fq) const {
        const int row0 = u.pm * BM + wr * 64 + fr, col0 = u.pn * BM + wc * 32 + 4 * fq;
#pragma unroll
        for (int ai = 0; ai < 2; ++ai)
#pragma unroll
            for (int mp = 0; mp < 2; ++mp) {
                f32x4 b[2][2][2];
#pragma unroll
                for (int mm = 0; mm < 2; ++mm) { const size_t off = (size_t)(row0 + ai * HALF + (2 * mp + mm) * 16) * ldc + col0;
#pragma unroll
                    for (int bj = 0; bj < 2; ++bj)
#pragma unroll
                        for (int n = 0; n < 2; ++n) {
                            if constexpr (BASE_BF) { const u32x2 w = *(const u32x2*)((const bf16_t*)base + off + bj * HALF + n * 16);
                                b[mm][bj][n] = (f32x4){bf_lo(w.x), bf_hi(w.x), bf_lo(w.y), bf_hi(w.y)}; }
                            else b[mm][bj][n] = *(const f32x4*)((const float*)base + off + bj * HALF + n * 16); } }
#pragma unroll
                for (int mm = 0; mm < 2; ++mm) { const size_t off = (size_t)(row0 + ai * HALF + (2 * mp + mm) * 16) * ldc + col0;
#pragma unroll
                    for (int bj = 0; bj < 2; ++bj)
#pragma unroll
                        for (int n = 0; n < 2; ++n) { const f32x4 v = b[mm][bj][n] + acc[ai][bj][2 * mp + mm][n] * scale;
                            if constexpr (OUT_BF) { u32x2 w; w.x = cvt_pk_bf16(v[0], v[1]); w.y = cvt_pk_bf16(v[2], v[3]); __builtin_nontemporal_store(w, (u32x2*)((bf16_t*)out + off + bj * HALF + n * 16)); }
                            else *(f32x4*)((float*)out + off + bj * HALF + n * 16) = v; } }
                asm volatile("" ::: "memory"); }
    }
};

typedef int i32x8 __attribute__((ext_vector_type(8)));
typedef short s16x16 __attribute__((ext_vector_type(16)));
typedef float f32x8 __attribute__((ext_vector_type(8)));
template <class Epi, class Sched, bool ALIGN_EPI, bool GATHER, bool FP8 = false>
__device__ __forceinline__ void gemm_phase(PG8_LAS unsigned char* lds, const Gemm g, const Sched& S, const Epi& E, int wave0) {
    int tid; asm volatile("v_mbcnt_lo_u32_b32 %0, -1, 0\n\tv_mbcnt_hi_u32_b32 %0, -1, %0" : "=v"(tid)); tid = (tid + wave0 * 64) & 511;
    const int wid = __builtin_amdgcn_readfirstlane(tid >> 6), lane = tid & 63, wr = wid >> 2, wc = wid & 3, fr = lane & 15, fq = lane >> 4;
    int K = g.K; asm volatile("" : "+s"(K));
    const int nt = K / BK;
    unsigned voffB[2], offC[2][2], offN[2][2]; int Rr[2], Cc[2];
#pragma unroll
    for (int i = 0; i < 2; ++i) { int R, C; stage_rc(tid * 16 + i * 8192, R, C); const int Rb = Epi::PERM ? ((R & ~31) + perm32(R & 31)) : R;
        voffB[i] = (unsigned)(Rb * g.ldb + C) * 2u; Rr[i] = R; Cc[i] = C;
        offC[0][i] = (unsigned)(R * g.lda + C) * 2u; offC[1][i] = (unsigned)((R + HALF) * g.lda + C) * 2u; offN[0][i] = offC[0][i]; offN[1][i] = offC[1][i]; }
    const size_t dB64 = (size_t)64 * g.ldb * 2, dA64 = (size_t)64 * g.lda * 2, dAh = (size_t)HALF * g.lda * 2;
    const size_t kstep = (size_t)(BK * 2);
    const size_t hstepB = (size_t)HALF * g.ldb * 2;
    const unsigned ldsw = (unsigned)wid * 1024u;
    const int aoff = lds_byte(wr * 64 + fr, fq * 8), boff = lds_byte(wc * 32 + fr, fq * 8);
#define PG8_SA(b, h) (((b) * 2 + (h)) * HTB)
#define PG8_SB(b, h) ((4 + (b) * 2 + (h)) * HTB)
#define PG8_STAGE_B(bufoff, gbase) do { _Pragma("unroll") for (int _i = 0; _i < 2; ++_i) \
        __builtin_amdgcn_global_load_lds((const unsigned*)((const char*)(gbase) + (size_t)_i * dB64 + voffB[0]), (PG8_LAS unsigned*)(lds + (bufoff) + ldsw + _i * 8192), 16, 0, 0); } while (0)
#define PG8_STAGE_A(bufoff, gbase, O, h) do { _Pragma("unroll") for (int _i = 0; _i < 2; ++_i) { \
        if constexpr (GATHER) __builtin_amdgcn_global_load_lds((const unsigned*)((const char*)(gbase) + O[h][_i]), (PG8_LAS unsigned*)(lds + (bufoff) + ldsw + _i * 8192), 16, 0, 0); \
        else __builtin_amdgcn_global_load_lds((const unsigned*)((const char*)(gbase) + (size_t)(h) * dAh + (size_t)_i * dA64 + O[0][0]), (PG8_LAS unsigned*)(lds + (bufoff) + ldsw + _i * 8192), 16, 0, 0); } } while (0)
#define PG8_LD8(addr) __builtin_bit_cast(i32x8, __builtin_shufflevector(*(const PG8_LAS bf16x8*)(lds + (addr)), *(const PG8_LAS bf16x8*)(lds + (addr) + 1024), 0, 1, 2, 3, 4, 5, 6, 7, 8, 9, 10, 11, 12, 13, 14, 15))
#define PG8_LDA8(dst, b, h) do { _Pragma("unroll") for (int m = 0; m < 4; ++m) dst[m] = PG8_LD8(PG8_SA(b, h) + aoff + m * 2048); } while (0)
#define PG8_LDB8(dst, b, h) do { _Pragma("unroll") for (int n = 0; n < 2; ++n) dst[n] = PG8_LD8(PG8_SB(b, h) + boff + n * 2048); } while (0)
#define PG8_MMA8(ai, bj, At, Bt) do { __builtin_amdgcn_s_setprio(1); _Pragma("unroll") for (int m = 0; m < 4; ++m) _Pragma("unroll") for (int n = 0; n < 2; ++n) \
        asm volatile("v_mfma_f32_16x16x128_f8f6f4 %0, %1, %2, %0" : "+v"(acc[ai][bj][m][n]) : "v"(Bt[n]), "v"(At[m])); __builtin_amdgcn_s_setprio(0); } while (0)
#define PG8_LDA(dst, b, h) do { _Pragma("unroll") for (int m = 0; m < 4; ++m) _Pragma("unroll") for (int k = 0; k < 2; ++k) dst[m][k] = *(const PG8_LAS bf16x8*)(lds + PG8_SA(b, h) + aoff + m * 2048 + k * 1024); } while (0)
#define PG8_LDB(dst, b, h) do { _Pragma("unroll") for (int n = 0; n < 2; ++n) _Pragma("unroll") for (int k = 0; k < 2; ++k) dst[n][k] = *(const PG8_LAS bf16x8*)(lds + PG8_SB(b, h) + boff + n * 2048 + k * 1024); } while (0)
#define PG8_MMA(ai, bj, At, Bt) do { __builtin_amdgcn_s_setprio(1); _Pragma("unroll") for (int m = 0; m < 4; ++m) _Pragma("unroll") for (int n = 0; n < 2; ++n) _Pragma("unroll") for (int k = 0; k < 2; ++k) \
        acc[ai][bj][m][n] = __builtin_amdgcn_mfma_f32_16x16x32_bf16(Bt[n][k], At[m][k], acc[ai][bj][m][n], 0, 0, 0); __builtin_amdgcn_s_setprio(0); } while (0)
#define XLDA(b, h) do { if constexpr (FP8) PG8_LDA8(At8, b, h); else PG8_LDA(At, b, h); } while (0)
#define XLDB0(b, h) do { if constexpr (FP8) PG8_LDB8(B08, b, h); else PG8_LDB(B0, b, h); } while (0)
#define XLDB1(b, h) do { if constexpr (FP8) PG8_LDB8(B18, b, h); else PG8_LDB(B1, b, h); } while (0)
#define XMMA(ai, bj, w) do { if constexpr (FP8) { if (w) PG8_MMA8(ai, bj, At8, B18); else PG8_MMA8(ai, bj, At8, B08); } else { if (w) PG8_MMA(ai, bj, At, B1); else PG8_MMA(ai, bj, At, B0); } } while (0)
#define PG8_WAIT_V(n) asm volatile("s_waitcnt vmcnt(" #n ")" ::: "memory")
#define PG8_WAIT_L(n) asm volatile("s_waitcnt lgkmcnt(" #n ")" ::: "memory")
#define PG8_BAR __builtin_amdgcn_s_barrier()
#define PG8_SCHED __builtin_amdgcn_sched_barrier(0)
    Unit cur, nxt; int ui = 0;
    if (!S.next(0, cur)) return;
    f32x4 acc[2][2][4][2];
#pragma unroll
    for (int a = 0; a < 2; ++a)
#pragma unroll
        for (int b = 0; b < 2; ++b)
#pragma unroll
            for (int m = 0; m < 4; ++m)
#pragma unroll
                for (int n = 0; n < 2; ++n) acc[a][b][m][n] = (f32x4){0.f, 0.f, 0.f, 0.f};
    bf16x8 At[4][2], B0[2][2], B1[2][2]; i32x8 At8[4], B08[2], B18[2];
    const char* cA = S.a_ptr(g, cur); const char* cB = S.b_ptr(g, cur);
    if constexpr (GATHER) {
#pragma unroll
        for (int h = 0; h < 2; ++h)
#pragma unroll
            for (int i = 0; i < 2; ++i) offC[h][i] = S.row_off(g, cur, h * HALF + Rr[i]) + (unsigned)Cc[i] * 2u;
    }
    PG8_STAGE_B(PG8_SB(0, 0), cB); PG8_STAGE_B(PG8_SB(0, 1), cB + hstepB); PG8_STAGE_A(PG8_SA(0, 0), cA, offC, 0); PG8_STAGE_A(PG8_SA(0, 1), cA, offC, 1);
    if (wr == 1) PG8_BAR;
    PG8_WAIT_V(2); PG8_BAR;
    PG8_STAGE_B(PG8_SB(1, 0), cB + kstep); PG8_STAGE_A(PG8_SA(1, 0), cA + kstep, offC, 0); PG8_STAGE_B(PG8_SB(1, 1), cB + hstepB + kstep);
    PG8_WAIT_V(6); PG8_BAR;
    for (;;) {
        const bool has_next = S.next(ui + 1, nxt);
        const char* nA = has_next ? S.a_ptr(g, nxt) : cA; const char* nB = has_next ? S.b_ptr(g, nxt) : cB;
        if constexpr (GATHER) {
            if (has_next) {
#pragma unroll
                for (int h = 0; h < 2; ++h)
#pragma unroll
                    for (int i = 0; i < 2; ++i) offN[h][i] = S.row_off(g, nxt, h * HALF + Rr[i]) + (unsigned)Cc[i] * 2u;
            }
        }
#pragma unroll 1
        for (int t = 0; t < nt; t += 2) {
            const bool last = (t == nt - 2);
            const char* a1 = cA + (size_t)(t + 1) * kstep;
            const char* a2 = last ? nA : cA + (size_t)(t + 2) * kstep; const char* b2 = last ? nB : cB + (size_t)(t + 2) * kstep;
            const char* a3 = a2 + kstep; const char* b3 = b2 + kstep;
            unsigned o2[2][2];
#pragma unroll
            for (int h = 0; h < 2; ++h)
#pragma unroll
                for (int i = 0; i < 2; ++i) o2[h][i] = GATHER ? (last ? offN[h][i] : offC[h][i]) : offC[h][i];
            XLDB0(0, 0); XLDB1(0, 1); PG8_SCHED; XLDA(0, 0); PG8_STAGE_A(PG8_SA(1, 1), a1, offC, 1);
            PG8_WAIT_V(8); PG8_WAIT_L(0); PG8_BAR; XMMA(0, 0, 0); XMMA(0, 1, 1); PG8_BAR; PG8_SCHED;
            XLDA(0, 1); PG8_STAGE_B(PG8_SB(0, 0), b2); PG8_STAGE_B(PG8_SB(0, 1), b2 + hstepB); PG8_STAGE_A(PG8_SA(0, 0), a2, o2, 0);
            PG8_WAIT_V(8); PG8_WAIT_L(0); PG8_BAR; XMMA(1, 0, 0); XMMA(1, 1, 1); PG8_BAR; PG8_SCHED;
            XLDB0(1, 0); XLDB1(1, 1); PG8_SCHED; XLDA(1, 0); PG8_STAGE_A(PG8_SA(0, 1), a2, o2, 1);
            PG8_WAIT_V(8); PG8_WAIT_L(0); PG8_BAR; XMMA(0, 0, 0); XMMA(0, 1, 1); PG8_BAR; PG8_SCHED;
            XLDA(1, 1); PG8_STAGE_B(PG8_SB(1, 0), b3); PG8_STAGE_B(PG8_SB(1, 1), b3 + hstepB); PG8_STAGE_A(PG8_SA(1, 0), a3, o2, 0);
            PG8_WAIT_V(8); PG8_WAIT_L(0); PG8_BAR; XMMA(1, 0, 0); XMMA(1, 1, 1); PG8_BAR; PG8_SCHED;
        }
        if constexpr (ALIGN_EPI) { if (wr == 0) PG8_BAR; }
        if constexpr (FP8) {
            asm volatile("s_nop 15" : "+v"(acc[1][0][0][0]), "+v"(acc[1][0][0][1]), "+v"(acc[1][0][1][0]), "+v"(acc[1][0][1][1]), "+v"(acc[1][0][2][0]), "+v"(acc[1][0][2][1]), "+v"(acc[1][0][3][0]), "+v"(acc[1][0][3][1]));
            asm volatile("" : "+v"(acc[1][1][0][0]), "+v"(acc[1][1][0][1]), "+v"(acc[1][1][1][0]), "+v"(acc[1][1][1][1]), "+v"(acc[1][1][2][0]), "+v"(acc[1][1][2][1]), "+v"(acc[1][1][3][0]), "+v"(acc[1][1][3][1])); }
        E(acc, cur, wr, wc, fr, fq);
        if (!has_next) break;
        if (!E.keep(cur)) {
#pragma unroll
        for (int a = 0; a < 2; ++a)
#pragma unroll
            for (int b = 0; b < 2; ++b)
#pragma unroll
                for (int m = 0; m < 4; ++m)
#pragma unroll
                    for (int n = 0; n < 2; ++n) acc[a][b][m][n] = (f32x4){0.f, 0.f, 0.f, 0.f};
        }
        cur = nxt; cA = nA; cB = nB; ++ui;
        if constexpr (GATHER) {
#pragma unroll
            for (int h = 0; h < 2; ++h)
#pragma unroll
                for (int i = 0; i < 2; ++i) offC[h][i] = offN[h][i];
        }
        if constexpr (ALIGN_EPI) { if (wr == 1) PG8_BAR; }
    }
    PG8_WAIT_V(0);
    if constexpr (!ALIGN_EPI) { if (wr == 0) PG8_BAR; }
    PG8_BAR;
#undef PG8_SA
#undef PG8_SB
#undef PG8_STAGE_A
#undef PG8_STAGE_B
#undef PG8_LDA
#undef PG8_LD8
#undef PG8_LDA8
#undef PG8_LDB8
#undef PG8_MMA8
#undef XLDA
#undef XLDB0
#undef XLDB1
#undef XMMA
#undef PG8_LDB
#undef PG8_MMA
#undef PG8_WAIT_V
#undef PG8_WAIT_L
#undef PG8_BAR
#undef PG8_SCHED
}
}
namespace att {
using bf16x8 = __attribute__((ext_vector_type(8))) short;
using s16x4  = __attribute__((ext_vector_type(4))) short;
using f32x16 = __attribute__((ext_vector_type(16))) float;
using u32x4  = __attribute__((ext_vector_type(4))) unsigned;
typedef unsigned short bf16_t;
typedef float f32x4_t __attribute__((ext_vector_type(4)));
#define ALAS __attribute__((address_space(3)))
constexpr int NW = 8, QBLK = 32, KVBLK = 64;
constexpr int LDS_V = 0, LDS_K = 32768, LDS_WS = 65536;
constexpr int LDS_V3 = 0, LDS_K3 = 49152, LDS_WS3 = 98304, LDS_BYTES = LDS_WS3 + NW * 64 * 4;
constexpr float THR = 8.f;
#define KF(row) ((((row) & 7) | ((((row) >> 4) & 1) << 3)))
#define KSWZ(row, colB) ((row) * 256 + ((colB) ^ (KF(row) << 4)))
#define SBAR() __builtin_amdgcn_sched_barrier(0)
constexpr int QK2_BT = 2;
__device__ __forceinline__ int crow(int r, int hi) { return (r & 3) + 8 * (r >> 2) + 4 * hi; }
typedef float f32x2_t __attribute__((ext_vector_type(2))); typedef __bf16 bf16x2_t __attribute__((ext_vector_type(2)));
__device__ __forceinline__ unsigned cvtpk(float lo, float hi) { f32x2_t v = {lo, hi}; bf16x2_t b = __builtin_convertvector(v, bf16x2_t); return __builtin_bit_cast(unsigned, b); }

__device__ __forceinline__ void expHalf(f32x16& p0, float shift, bool use_shift) {
  if (use_shift) {
#pragma unroll
    for (int r = 0; r < 16; ++r) p0[r] = __builtin_amdgcn_exp2f(p0[r] + shift);
  } else {
#pragma unroll
    for (int r = 0; r < 16; ++r) p0[r] = __builtin_amdgcn_exp2f(p0[r]);
  }
}
__device__ __forceinline__ void finishSM(f32x16& p0, f32x16& p1, float& l_reg, bf16x8& pa0, bf16x8& pa1, bf16x8& pa2, bf16x8& pa3, float shift, bool use_shift) {
  expHalf(p1, shift, use_shift);
  f32x2_t ps2 = {0.f, 0.f};
#pragma unroll
  for (int r = 0; r < 16; r += 2) { ps2 += (f32x2_t){p0[r], p0[r + 1]}; ps2 += (f32x2_t){p1[r], p1[r + 1]}; }
  l_reg += ps2.x + ps2.y;
#define PK4(P, BASE, OUT) do { unsigned a0 = cvtpk(P[BASE + 0], P[BASE + 1]), a1 = cvtpk(P[BASE + 2], P[BASE + 3]);   \
    unsigned b0 = cvtpk(P[BASE + 4], P[BASE + 5]), b1 = cvtpk(P[BASE + 6], P[BASE + 7]);                              \
    auto r0 = __builtin_amdgcn_permlane32_swap(a0, b0, false, false); auto r1 = __builtin_amdgcn_permlane32_swap(a1, b1, false, false); \
    u32x4 w = {r0[0], r1[0], r0[1], r1[1]}; OUT = __builtin_bit_cast(bf16x8, w); } while (0)
  PK4(p0, 0, pa0); PK4(p0, 8, pa1); PK4(p1, 0, pa2); PK4(p1, 8, pa3);
#undef PK4
}
template <int DK, int COLB = 0> __device__ __forceinline__ void qkt(f32x16& p0, f32x16& p1, const ALAS char* Ks, const bf16x8* qr, int r32, int hi) {
  constexpr int ND = DK / 16, BT = ND > 4 ? ND / 2 : ND;
  p0 = f32x16{}; p1 = f32x16{};
#pragma unroll
  for (int b0 = 0; b0 < ND; b0 += BT) {
    bf16x8 k0[BT], k1[BT];
#pragma unroll
    for (int i = 0; i < BT; ++i) { const int cb = COLB + ((b0 + i) * 16 + hi * 8) * 2;
      k0[i] = *(const ALAS bf16x8*)(Ks + KSWZ(r32, cb)); k1[i] = *(const ALAS bf16x8*)(Ks + KSWZ(32 + r32, cb)); }
    SBAR();
#pragma unroll
    for (int i = 0; i < BT; ++i) {
      p0 = __builtin_amdgcn_mfma_f32_32x32x16_bf16(k0[i], qr[b0 + i], p0, 0, 0, 0);
      p1 = __builtin_amdgcn_mfma_f32_32x32x16_bf16(k1[i], qr[b0 + i], p1, 0, 0, 0); }
    SBAR();
  }
}
template <int DK> struct KPre { static constexpr int ND = DK / 16, BT = ND > 4 ? ND / 2 : ND; bf16x8 k0[BT], k1[BT]; };
template <int DK> __device__ __forceinline__ void qkt_pre(KPre<DK>& kp, const ALAS char* Ks, int r32, int hi) {
#pragma unroll
  for (int i = 0; i < KPre<DK>::BT; ++i) { const int cb = (i * 16 + hi * 8) * 2;
    kp.k0[i] = *(const ALAS bf16x8*)(Ks + KSWZ(r32, cb)); kp.k1[i] = *(const ALAS bf16x8*)(Ks + KSWZ(32 + r32, cb)); }
}
template <int DK> __device__ __forceinline__ void qkt_run(f32x16& p0, f32x16& p1, const KPre<DK>& kp, const ALAS char* Ks, const bf16x8* qr, int r32, int hi) {
  constexpr int ND = KPre<DK>::ND, BT = KPre<DK>::BT;
  p0 = f32x16{}; p1 = f32x16{};
#pragma unroll
  for (int i = 0; i < BT; ++i) {
    p0 = __builtin_amdgcn_mfma_f32_32x32x16_bf16(kp.k0[i], qr[i], p0, 0, 0, 0);
    p1 = __builtin_amdgcn_mfma_f32_32x32x16_bf16(kp.k1[i], qr[i], p1, 0, 0, 0); }
  SBAR();
#pragma unroll
  for (int b0 = BT; b0 < ND; b0 += BT) {
    bf16x8 k0[BT], k1[BT];
#pragma unroll
    for (int i = 0; i < BT; ++i) { const int cb = ((b0 + i) * 16 + hi * 8) * 2;
      k0[i] = *(const ALAS bf16x8*)(Ks + KSWZ(r32, cb)); k1[i] = *(const ALAS bf16x8*)(Ks + KSWZ(32 + r32, cb)); }
    SBAR();
#pragma unroll
    for (int i = 0; i < BT; ++i) {
      p0 = __builtin_amdgcn_mfma_f32_32x32x16_bf16(k0[i], qr[b0 + i], p0, 0, 0, 0);
      p1 = __builtin_amdgcn_mfma_f32_32x32x16_bf16(k1[i], qr[b0 + i], p1, 0, 0, 0); }
    SBAR();
  }
}
template <int NB> __device__ __forceinline__ int v_st(int k, int c) { const int kk = (k & ~0xC) | ((k & 4) << 1) | ((k & 8) >> 1); return ((kk >> 3) * NB + (c >> 5)) * 512 + ((kk & 7) * 32 + (c & 31)) * 2; }
__device__ __forceinline__ int v_rd_base(int lane) { return ((lane & 3) << 3) | (((lane >> 2) & 3) << 6) | (((lane >> 4) & 1) << 5) | (((lane >> 5) & 1) << 8); }
template <int OFF> __device__ __forceinline__ s16x4 tr_read(int vb) {
  s16x4 r; asm volatile("ds_read_b64_tr_b16 %0, %1 offset:%2" : "=&v"(r) : "v"(vb), "i"(OFF) : "memory"); return r;
}
template <int NB, int D0> __device__ __forceinline__ void pv_one(f32x16& od, int vb, bf16x8 pa0, bf16x8 pa1, bf16x8 pa2, bf16x8 pa3) {
#define VOFF(ks, half) (D0 * 512 + (ks) * (1024 * NB) + (half) * (512 * NB))
  const s16x4 l0 = tr_read<VOFF(0, 0)>(vb), h0 = tr_read<VOFF(0, 1)>(vb), l1 = tr_read<VOFF(1, 0)>(vb), h1 = tr_read<VOFF(1, 1)>(vb);
  const s16x4 l2 = tr_read<VOFF(2, 0)>(vb), h2 = tr_read<VOFF(2, 1)>(vb), l3 = tr_read<VOFF(3, 0)>(vb), h3 = tr_read<VOFF(3, 1)>(vb);
#undef VOFF
  asm volatile("s_waitcnt lgkmcnt(0)" ::: "memory"); SBAR();
#define PK(L, H) (bf16x8){L[0], L[1], L[2], L[3], H[0], H[1], H[2], H[3]}
  od = __builtin_amdgcn_mfma_f32_32x32x16_bf16(pa0, PK(l0, h0), od, 0, 0, 0);
  od = __builtin_amdgcn_mfma_f32_32x32x16_bf16(pa1, PK(l1, h1), od, 0, 0, 0);
  od = __builtin_amdgcn_mfma_f32_32x32x16_bf16(pa2, PK(l2, h2), od, 0, 0, 0);
  od = __builtin_amdgcn_mfma_f32_32x32x16_bf16(pa3, PK(l3, h3), od, 0, 0, 0);
#undef PK
}
template <int NB> __device__ __forceinline__ void pv_all(f32x16* o, int vb, bf16x8 pa0, bf16x8 pa1, bf16x8 pa2, bf16x8 pa3) {
  pv_one<NB, 0>(o[0], vb, pa0, pa1, pa2, pa3); pv_one<NB, 1>(o[1], vb, pa0, pa1, pa2, pa3);
  if constexpr (NB == 4) { pv_one<NB, 2>(o[2], vb, pa0, pa1, pa2, pa3); pv_one<NB, 3>(o[3], vb, pa0, pa1, pa2, pa3); }
}

struct QPrep { const float* g; const float* c1; const float* s1; const float* c2; const float* s2; int pos0; };
template <int DK, int QMODE>
__device__ __forceinline__ void load_q(bf16x8 (&qr)[DK / 16], const bf16_t* Qw, const QPrep& qp, float qscale, int wid, int r32, int hi) {
  constexpr int ND = DK / 16;
  float x[ND * 8];
#pragma unroll
  for (int d0 = 0; d0 < ND; ++d0) { const u32x4 w = *reinterpret_cast<const u32x4*>(Qw + d0 * 16);
#pragma unroll
    for (int e = 0; e < 4; ++e) { x[d0 * 8 + 2 * e] = __uint_as_float(w[e] << 16); x[d0 * 8 + 2 * e + 1] = __uint_as_float(w[e] & 0xffff0000u); } }
  if constexpr (QMODE != 0) {
    float ss = 0.f;
#pragma unroll
    for (int i = 0; i < ND * 8; ++i) ss += x[i] * x[i];
    { auto rr = __builtin_amdgcn_permlane32_swap(__float_as_uint(ss), __float_as_uint(ss), false, false); ss = __uint_as_float(rr[0]) + __uint_as_float(rr[1]); }
    const float rstd = __builtin_amdgcn_rsqf(ss * (1.f / DK) + 1e-6f);
#pragma unroll
    for (int d0 = 0; d0 < ND; ++d0) { const f32x4_t g0 = *reinterpret_cast<const f32x4_t*>(qp.g + d0 * 16 + hi * 8), g1 = *reinterpret_cast<const f32x4_t*>(qp.g + d0 * 16 + hi * 8 + 4);
#pragma unroll
      for (int e = 0; e < 4; ++e) { x[d0 * 8 + e] *= rstd * g0[e]; x[d0 * 8 + 4 + e] *= rstd * g1[e]; } }
    const int pos = qp.pos0 + wid * QBLK + r32;
#define ROPE_PAIR(dA, dB, CT, ST) do { const f32x4_t c0 = *reinterpret_cast<const f32x4_t*>((CT) + hi * 8), c1_ = *reinterpret_cast<const f32x4_t*>((CT) + hi * 8 + 4), s0 = *reinterpret_cast<const f32x4_t*>((ST) + hi * 8), s1_ = *reinterpret_cast<const f32x4_t*>((ST) + hi * 8 + 4); \
      _Pragma("unroll") for (int e = 0; e < 8; ++e) { const float c = e < 4 ? c0[e & 3] : c1_[e & 3], s = e < 4 ? s0[e & 3] : s1_[e & 3]; const float xa = x[(dA) * 8 + e], xb = x[(dB) * 8 + e]; \
        x[(dA) * 8 + e] = xa * c - xb * s; x[(dB) * 8 + e] = xb * c + xa * s; } } while (0)
    if constexpr (QMODE == 1) {
#pragma unroll
      for (int d0 = 0; d0 < ND / 2; ++d0) ROPE_PAIR(d0, d0 + ND / 2, qp.c1 + (size_t)pos * (DK / 2) + d0 * 16, qp.s1 + (size_t)pos * (DK / 2) + d0 * 16);
    } else if constexpr (QMODE == 2) {
      const int grow = pos >> 6, gcol = pos & 63;
      ROPE_PAIR(0, 1, qp.c1 + grow * 16, qp.s1 + grow * 16); ROPE_PAIR(2, 3, qp.c2 + gcol * 16, qp.s2 + gcol * 16);
    } else if constexpr (QMODE == 3) {
      ROPE_PAIR(4, 5, qp.c1 + pos * 16, qp.s1 + pos * 16);
    }
#undef ROPE_PAIR
  }
#pragma unroll
  for (int d0 = 0; d0 < ND; ++d0) { u32x4 w;
#pragma unroll
    for (int e = 0; e < 4; ++e) w[e] = cvtpk(x[d0 * 8 + 2 * e] * qscale, x[d0 * 8 + 2 * e + 1] * qscale);
    qr[d0] = __builtin_bit_cast(bf16x8, w); }
}

struct DiffEpi { const bf16_t* O1; int ldo1; float lam; const float* g; int layer; };
template <int DK, int DV, int SDEPTH, int QMODE, int PIPE = 2, bool DIFF2 = false>
__device__ __forceinline__ void attn_unit(const bf16_t* Qb, int ldq, const bf16_t* __restrict__ Kh, int ldk, const bf16_t* __restrict__ Vh, int ldv,
                                          bf16_t* Ob, int ldo, int nkeys, float qscale, float negb_, const QPrep& qp, ALAS char* lds, int wave0, float omul = 1.0f, const DiffEpi* de = nullptr) {
  constexpr int NB = DV / 32, KC = DK / 8, VC = DV / 8;
  constexpr int NKC = 64 * KC, NVC = 64 * VC, KPT = (NKC + 511) / 512, VPT = (NVC + 511) / 512;
  constexpr int SHM_V = KVBLK * DV * 2, SHM_K = 16384;
  int tid; asm volatile("v_mbcnt_lo_u32_b32 %0, -1, 0\n\tv_mbcnt_hi_u32_b32 %0, -1, %0" : "=v"(tid)); tid = (tid + wave0 * 64) & 511;
  const int wid = tid >> 6, lane = tid & 63, r32 = lane & 31, hi = lane >> 5;
  ALAS char* V_lds = lds + (PIPE == 3 ? LDS_V3 : LDS_V); ALAS char* K_lds = lds + (PIPE == 3 ? LDS_K3 : LDS_K);
  ALAS float* ws = (ALAS float*)(lds + (PIPE == 3 ? LDS_WS3 : LDS_WS)) + wid * 64; ALAS float* li_l = ws;
  float l_reg = 0; f32x16 o[NB]; bf16x8 qr[DK / 16];
  const bool use_shift = negb_ < -60.f;
  load_q<DK, QMODE>(qr, Qb + (long)(wid * QBLK + r32) * ldq + hi * 8, qp, qscale, wid, r32, hi);
  SBAR();
#pragma unroll
  for (int d = 0; d < NB; ++d) o[d] = f32x16{};
  int kgo[KPT], klo[KPT], vgo[VPT], vlo[VPT]; bool kok[KPT], vok[VPT];
#pragma unroll
  for (int i = 0; i < KPT; ++i) { const int c = tid + 512 * i; kok[i] = (512 * (i + 1) <= NKC) || (c < NKC); const int row = c / KC, col = (c % KC) * 8; kgo[i] = row * ldk + col; klo[i] = KSWZ(row, col * 2); }
#pragma unroll
  for (int i = 0; i < VPT; ++i) { const int c = tid + 512 * i; vok[i] = (512 * (i + 1) <= NVC) || (c < NVC); const int row = c / VC, col = (c % VC) * 8; vgo[i] = row * ldv + col; vlo[i] = v_st<NB>(row, col); }
  const int vb0 = (int)(unsigned)(unsigned long)V_lds + v_rd_base(lane);
  struct { bf16x8 ks[KPT], vs[VPT]; } sr_[SDEPTH];
#define SLOAD(s, k0) do { _Pragma("unroll") for (int i_ = 0; i_ < KPT; ++i_) if (kok[i_]) sr_[s].ks[i_] = *reinterpret_cast<const bf16x8*>(Kh + (long)(k0) * ldk + kgo[i_]); \
    _Pragma("unroll") for (int i_ = 0; i_ < VPT; ++i_) if (vok[i_]) sr_[s].vs[i_] = *reinterpret_cast<const bf16x8*>(Vh + (long)(k0) * ldv + vgo[i_]); } while (0)
#define SWRITE(b, s) do { _Pragma("unroll") for (int i_ = 0; i_ < KPT; ++i_) if (kok[i_]) *(ALAS bf16x8*)(K_lds + (b) * SHM_K + klo[i_]) = sr_[s].ks[i_]; \
    _Pragma("unroll") for (int i_ = 0; i_ < VPT; ++i_) if (vok[i_]) *(ALAS bf16x8*)(V_lds + (b) * SHM_V + vlo[i_]) = sr_[s].vs[i_]; } while (0)
#define SWAIT() do { if constexpr (SDEPTH == 2) asm volatile("s_waitcnt vmcnt(%0)" :: "n"(KPT + VPT) : "memory"); else asm volatile("s_waitcnt vmcnt(0)" ::: "memory"); } while (0)
  bf16x8 pa0, pa1, pa2, pa3; const int NT = nkeys / KVBLK;
  if constexpr (PIPE == 1) {
    f32x16 pA0, pA1;
    SLOAD(0, 0); asm volatile("s_waitcnt vmcnt(0)" ::: "memory"); SWRITE(0, 0); __syncthreads();
    for (int j = 0; j < NT; ++j) {
      const int bsel = j & 1;
      if (j + 1 < NT) SLOAD(0, (j + 1) * KVBLK);
      SBAR(); qkt<DK>(pA0, pA1, K_lds + bsel * SHM_K, qr, r32, hi); expHalf(pA0, negb_, use_shift);
      finishSM(pA0, pA1, l_reg, pa0, pa1, pa2, pa3, negb_, use_shift); SBAR();
      pv_all<NB>(o, vb0 + bsel * SHM_V, pa0, pa1, pa2, pa3);
      if (j + 1 < NT) { asm volatile("s_waitcnt vmcnt(0)" ::: "memory"); SWRITE(bsel ^ 1, 0); }
      __syncthreads();
    }
  } else if constexpr (PIPE == 4) {
    f32x16 pA0, pA1;
    SLOAD(0, 0); asm volatile("s_waitcnt vmcnt(0)" ::: "memory"); SWRITE(0, 0); __syncthreads();
    if (wave0 < 4) {
#define P4E_STEP(jj, bsel) do { \
        if ((jj) + 1 < NT) SLOAD(0, ((jj) + 1) * KVBLK); \
        SBAR(); qkt<DK>(pA0, pA1, K_lds + (bsel) * SHM_K, qr, r32, hi); expHalf(pA0, negb_, use_shift); \
        finishSM(pA0, pA1, l_reg, pa0, pa1, pa2, pa3, negb_, use_shift); SBAR(); \
        __builtin_amdgcn_s_barrier(); SBAR(); \
        pv_all<NB>(o, vb0 + (bsel) * SHM_V, pa0, pa1, pa2, pa3); \
        if ((jj) + 1 < NT) { asm volatile("s_waitcnt vmcnt(0)" ::: "memory"); SWRITE((bsel) ^ 1, 0); } \
        __syncthreads(); } while (0)
      for (int j = 0; j < NT; j += 2) { P4E_STEP(j, 0); P4E_STEP(j + 1, 1); }
#undef P4E_STEP
    } else {
#define P4L_STEP(jj, bsel) do { \
        if ((jj) + 1 < NT) SLOAD(0, ((jj) + 1) * KVBLK); \
        if constexpr (DK == 64) { \
          SBAR(); KPre<DK> kp_; qkt_pre<DK>(kp_, K_lds + (bsel) * SHM_K, r32, hi);       \
          SBAR(); if ((jj) > 0) pv_all<NB>(o, vb0 + ((bsel) ^ 1) * SHM_V, pa0, pa1, pa2, pa3); \
          SBAR(); qkt_run<DK>(pA0, pA1, kp_, K_lds + (bsel) * SHM_K, qr, r32, hi); SBAR(); \
        } else { \
          SBAR(); if ((jj) > 0) pv_all<NB>(o, vb0 + ((bsel) ^ 1) * SHM_V, pa0, pa1, pa2, pa3); \
          SBAR(); qkt<DK>(pA0, pA1, K_lds + (bsel) * SHM_K, qr, r32, hi); SBAR(); } \
        __builtin_amdgcn_s_barrier(); SBAR(); \
        expHalf(pA0, negb_, use_shift); finishSM(pA0, pA1, l_reg, pa0, pa1, pa2, pa3, negb_, use_shift); SBAR(); \
        if ((jj) + 1 < NT) { asm volatile("s_waitcnt vmcnt(0)" ::: "memory"); SWRITE((bsel) ^ 1, 0); } \
        __syncthreads(); } while (0)
      for (int j = 0; j < NT; j += 2) { P4L_STEP(j, 0); P4L_STEP(j + 1, 1); }
#undef P4L_STEP
      pv_all<NB>(o, vb0 + ((NT - 1) & 1) * SHM_V, pa0, pa1, pa2, pa3);
    }
  } else if constexpr (PIPE == 3) {
    f32x16 pA0, pA1, pB0, pB1;
    struct { bf16x8 ks[KPT], vs[VPT]; } st_;
#define GLK(k0) do { _Pragma("unroll") for (int i_ = 0; i_ < KPT; ++i_) if (kok[i_]) st_.ks[i_] = *reinterpret_cast<const bf16x8*>(Kh + (long)(k0) * ldk + kgo[i_]); } while (0)
#define GLV(k0) do { _Pragma("unroll") for (int i_ = 0; i_ < VPT; ++i_) if (vok[i_]) st_.vs[i_] = *reinterpret_cast<const bf16x8*>(Vh + (long)(k0) * ldv + vgo[i_]); } while (0)
#define WRK(off) do { _Pragma("unroll") for (int i_ = 0; i_ < KPT; ++i_) if (kok[i_]) *(ALAS bf16x8*)(K_lds + (off) + klo[i_]) = st_.ks[i_]; } while (0)
#define WRV(off) do { _Pragma("unroll") for (int i_ = 0; i_ < VPT; ++i_) if (vok[i_]) *(ALAS bf16x8*)(V_lds + (off) + vlo[i_]) = st_.vs[i_]; } while (0)
#define ROT3(x, S) ((x) == 2 * (S) ? 0 : (x) + (S))
    GLK(0); GLV(0); asm volatile("s_waitcnt vmcnt(0)" ::: "memory"); WRK(0); WRV(0);
    GLK(KVBLK); asm volatile("s_waitcnt vmcnt(0)" ::: "memory"); WRK(SHM_K);
    if (2 < NT) GLK(2 * KVBLK);
    GLV(KVBLK);
    __syncthreads();
    int kr = 0, vr = 0, kw = 2 * SHM_K, vw = SHM_V;
#define STEP3(PC0, PC1, PP0, PP1, t, HASPREV) do { \
      SBAR(); qkt<DK>(PC0, PC1, K_lds + kr, qr, r32, hi); \
      if (HASPREV) { finishSM(PP0, PP1, l_reg, pa0, pa1, pa2, pa3, negb_, use_shift); SBAR(); pv_all<NB>(o, vb0 + vr, pa0, pa1, pa2, pa3); vr = ROT3(vr, SHM_V); } \
      expHalf(PC0, negb_, use_shift); \
      asm volatile("s_waitcnt vmcnt(0)" ::: "memory"); \
      if ((t) + 2 < NT) WRK(kw); if ((t) + 1 < NT) WRV(vw); \
      if ((t) + 3 < NT) GLK(((t) + 3) * KVBLK); if ((t) + 2 < NT) GLV(((t) + 2) * KVBLK); \
      kr = ROT3(kr, SHM_K); kw = ROT3(kw, SHM_K); vw = ROT3(vw, SHM_V); \
      __syncthreads(); } while (0)
    STEP3(pA0, pA1, pB0, pB1, 0, false);
    for (int t = 1; t + 1 < NT; t += 2) {
      STEP3(pB0, pB1, pA0, pA1, t, true);
      STEP3(pA0, pA1, pB0, pB1, t + 1, true);
    }
    STEP3(pB0, pB1, pA0, pA1, NT - 1, true);
    finishSM(pB0, pB1, l_reg, pa0, pa1, pa2, pa3, negb_, use_shift); SBAR();
    pv_all<NB>(o, vb0 + vr, pa0, pa1, pa2, pa3);
#undef GLK
#undef GLV
#undef WRK
#undef WRV
#undef ROT3
#undef STEP3
  } else {
  f32x16 pA0, pA1, pB0, pB1;
  constexpr int SE = 0, SO = SDEPTH - 1;
  SLOAD(SE, 0); asm volatile("s_waitcnt vmcnt(0)" ::: "memory"); SWRITE(0, SE); __syncthreads();
  qkt<DK>(pA0, pA1, K_lds, qr, r32, hi); expHalf(pA0, negb_, use_shift);
  SLOAD(SO, KVBLK); if constexpr (SDEPTH == 2) { if (2 < NT) SLOAD(SE, 2 * KVBLK); }
  SWAIT(); SWRITE(1, SO); __syncthreads();
  for (int j = 1; j + 1 < NT; j += 2) {
    SBAR(); qkt<DK>(pB0, pB1, K_lds + SHM_K, qr, r32, hi);
    finishSM(pA0, pA1, l_reg, pa0, pa1, pa2, pa3, negb_, use_shift); SBAR();
    SLOAD(SO, (j + SDEPTH) * KVBLK); SBAR();
    pv_all<NB>(o, vb0, pa0, pa1, pa2, pa3); expHalf(pB0, negb_, use_shift);
    __syncthreads(); SWAIT(); SWRITE(0, SE);
    __syncthreads();
    SBAR(); qkt<DK>(pA0, pA1, K_lds, qr, r32, hi);
    finishSM(pB0, pB1, l_reg, pa0, pa1, pa2, pa3, negb_, use_shift); SBAR();
    if (SDEPTH == 1 || j + 3 < NT) SLOAD(SE, (j + 1 + SDEPTH) * KVBLK); SBAR();
    pv_all<NB>(o, vb0 + SHM_V, pa0, pa1, pa2, pa3); expHalf(pA0, negb_, use_shift);
    __syncthreads(); SWAIT(); SWRITE(1, SO);
    __syncthreads();
  }
  SBAR(); qkt<DK>(pB0, pB1, K_lds + SHM_K, qr, r32, hi);
  finishSM(pA0, pA1, l_reg, pa0, pa1, pa2, pa3, negb_, use_shift); SBAR();
  pv_all<NB>(o, vb0, pa0, pa1, pa2, pa3); expHalf(pB0, negb_, use_shift);
  finishSM(pB0, pB1, l_reg, pa0, pa1, pa2, pa3, negb_, use_shift); SBAR();
  pv_all<NB>(o, vb0 + SHM_V, pa0, pa1, pa2, pa3);
  }
  { auto rr = __builtin_amdgcn_permlane32_swap(__float_as_uint(l_reg), __float_as_uint(l_reg), false, false); l_reg = __uint_as_float(rr[0]) + __uint_as_float(rr[1]); }
  if (hi == 0) li_l[r32] = l_reg; asm volatile("s_waitcnt lgkmcnt(0)" ::: "memory");
  float rli[16];
#pragma unroll
  for (int r = 0; r < 16; ++r) rli[r] = __builtin_amdgcn_rcpf(li_l[crow(r, hi)]) * omul;
  bf16_t* Ow = Ob + (long)(wid * QBLK) * ldo;
  if constexpr (DIFF2) {
    const bf16_t* O1w = de->O1 + (long)(wid * QBLK) * de->ldo1;
    float gcol[NB];
    int ly_ = de->layer; asm volatile("" : "+s"(ly_));
    const float post_ = (ly_ == 0) ? 0.8f : (1.0f - (0.8f - 0.6f * 0.74081822068171788f));
#pragma unroll
    for (int d0 = 0; d0 < NB; ++d0) gcol[d0] = de->g[d0 * 32 + r32] * post_;
#pragma unroll
    for (int r = 0; r < 16; ++r) { const int orow = crow(r, hi); float d[NB]; float ss = 0.f;
#pragma unroll
      for (int d0 = 0; d0 < NB; ++d0) { const float o1 = __uint_as_float((unsigned)O1w[(long)orow * de->ldo1 + d0 * 32 + r32] << 16); d[d0] = o1 - de->lam * (o[d0][r] * rli[r]); ss += d[d0] * d[d0]; }
      ss += __int_as_float(__builtin_amdgcn_ds_swizzle(__float_as_int(ss), (1 << 10) | 0x1f)); ss += __int_as_float(__builtin_amdgcn_ds_swizzle(__float_as_int(ss), (2 << 10) | 0x1f));
      ss += __int_as_float(__builtin_amdgcn_ds_swizzle(__float_as_int(ss), (4 << 10) | 0x1f)); ss += __int_as_float(__builtin_amdgcn_ds_swizzle(__float_as_int(ss), (8 << 10) | 0x1f));
      ss += __int_as_float(__builtin_amdgcn_ds_swizzle(__float_as_int(ss), (16 << 10) | 0x1f));
      const float rstd = __builtin_amdgcn_rsqf(ss * (1.f / 128.f) + 1e-6f);
#pragma unroll
      for (int d0 = 0; d0 < NB; ++d0) { const float v = d[d0] * rstd * gcol[d0]; Ow[(long)orow * ldo + d0 * 32 + r32] = (bf16_t)(cvtpk(v, v) & 0xffffu); } }
  } else {
#pragma unroll
  for (int r = 0; r < 16; ++r) { const int orow = crow(r, hi);
#pragma unroll
    for (int d0 = 0; d0 < NB; ++d0) { const float v = o[d0][r] * rli[r]; Ow[(long)orow * ldo + d0 * 32 + r32] = (bf16_t)(cvtpk(v, v) & 0xffffu); } }
  }
  __syncthreads();
#undef SLOAD
#undef SWRITE
#undef SWAIT
}
template <int DK> __device__ __forceinline__ void qkt2(f32x16 (&p)[2][2], const ALAS char* Ks, const bf16x8 (&qr)[2][DK / 16], int r32, int hi) {
  constexpr int ND = DK / 16, BT = QK2_BT < ND ? QK2_BT : ND;
  p[0][0] = f32x16{}; p[0][1] = f32x16{}; p[1][0] = f32x16{}; p[1][1] = f32x16{};
#pragma unroll
  for (int b0 = 0; b0 < ND; b0 += BT) {
    bf16x8 k0[BT], k1[BT];
#pragma unroll
    for (int i = 0; i < BT; ++i) { const int cb = ((b0 + i) * 16 + hi * 8) * 2;
      k0[i] = *(const ALAS bf16x8*)(Ks + KSWZ(r32, cb)); k1[i] = *(const ALAS bf16x8*)(Ks + KSWZ(32 + r32, cb)); }
    SBAR();
#pragma unroll
    for (int i = 0; i < BT; ++i) {
      p[0][0] = __builtin_amdgcn_mfma_f32_32x32x16_bf16(k0[i], qr[0][b0 + i], p[0][0], 0, 0, 0);
      p[1][0] = __builtin_amdgcn_mfma_f32_32x32x16_bf16(k0[i], qr[1][b0 + i], p[1][0], 0, 0, 0);
      p[0][1] = __builtin_amdgcn_mfma_f32_32x32x16_bf16(k1[i], qr[0][b0 + i], p[0][1], 0, 0, 0);
      p[1][1] = __builtin_amdgcn_mfma_f32_32x32x16_bf16(k1[i], qr[1][b0 + i], p[1][1], 0, 0, 0); }
    SBAR();
  }
}
template <int NB, int D0> __device__ __forceinline__ void pv_one2(f32x16& oa, f32x16& ob, int vb, const bf16x8 (&pa)[2][4]) {
#define VOFF(ks, half) (D0 * 512 + (ks) * (1024 * NB) + (half) * (512 * NB))
  const s16x4 l0 = tr_read<VOFF(0, 0)>(vb), h0 = tr_read<VOFF(0, 1)>(vb), l1 = tr_read<VOFF(1, 0)>(vb), h1 = tr_read<VOFF(1, 1)>(vb);
  const s16x4 l2 = tr_read<VOFF(2, 0)>(vb), h2 = tr_read<VOFF(2, 1)>(vb), l3 = tr_read<VOFF(3, 0)>(vb), h3 = tr_read<VOFF(3, 1)>(vb);
#undef VOFF
  asm volatile("s_waitcnt lgkmcnt(0)" ::: "memory"); SBAR();
#define PK(L, H) (bf16x8){L[0], L[1], L[2], L[3], H[0], H[1], H[2], H[3]}
  oa = __builtin_amdgcn_mfma_f32_32x32x16_bf16(pa[0][0], PK(l0, h0), oa, 0, 0, 0);
  ob = __builtin_amdgcn_mfma_f32_32x32x16_bf16(pa[1][0], PK(l0, h0), ob, 0, 0, 0);
  oa = __builtin_amdgcn_mfma_f32_32x32x16_bf16(pa[0][1], PK(l1, h1), oa, 0, 0, 0);
  ob = __builtin_amdgcn_mfma_f32_32x32x16_bf16(pa[1][1], PK(l1, h1), ob, 0, 0, 0);
  oa = __builtin_amdgcn_mfma_f32_32x32x16_bf16(pa[0][2], PK(l2, h2), oa, 0, 0, 0);
  ob = __builtin_amdgcn_mfma_f32_32x32x16_bf16(pa[1][2], PK(l2, h2), ob, 0, 0, 0);
  oa = __builtin_amdgcn_mfma_f32_32x32x16_bf16(pa[0][3], PK(l3, h3), oa, 0, 0, 0);
  ob = __builtin_amdgcn_mfma_f32_32x32x16_bf16(pa[1][3], PK(l3, h3), ob, 0, 0, 0);
#undef PK
}
template <int DK, int QMODE, bool SHAREK = true>
__device__ __forceinline__ void attn_unit2(const bf16_t* Qb, int ldq, const bf16_t* __restrict__ Kh, int ldk, const bf16_t* __restrict__ Vh, int ldv,
                                           bf16_t* Ob, int ldo, int nkeys, float qscale, float negb_, const QPrep& qp, ALAS char* lds, int wave0) {
  constexpr int DV = 64, NB = 2, KC = DK / 8, VC = DV / 8;
  constexpr int NKC = 64 * KC, NVC = 64 * VC, KPT = (NKC + 511) / 512, VPT = (NVC + 511) / 512;
  constexpr int SHM_V = KVBLK * DV * 2, SHM_K = 16384;
  int tid; asm volatile("v_mbcnt_lo_u32_b32 %0, -1, 0\n\tv_mbcnt_hi_u32_b32 %0, -1, %0" : "=v"(tid)); tid = (tid + wave0 * 64) & 511;
  const int wid = tid >> 6, lane = tid & 63, r32 = lane & 31, hi = lane >> 5;
  ALAS char* V_lds = lds + LDS_V; ALAS char* K_lds = lds + LDS_K;
  ALAS float* ws = (ALAS float*)(lds + LDS_WS) + wid * 64;
  const bool use_shift = negb_ < -60.f;
  float l_reg[2] = {0.f, 0.f}; f32x16 o[2][NB]; bf16x8 qr[2][DK / 16];
  { QPrep q2 = qp;
    load_q<DK, QMODE>(qr[0], Qb + (long)(wid * QBLK + r32) * ldq + hi * 8, q2, qscale, wid, r32, hi);
    SBAR();
    q2.pos0 = qp.pos0 + 256;
    load_q<DK, QMODE>(qr[1], Qb + (long)(256 + wid * QBLK + r32) * ldq + hi * 8, q2, qscale, wid, r32, hi); }
  SBAR();
#pragma unroll
  for (int q = 0; q < 2; ++q)
#pragma unroll
    for (int d = 0; d < NB; ++d) o[q][d] = f32x16{};
  int kgo[KPT], klo[KPT], vgo[VPT], vlo[VPT]; bool kok[KPT], vok[VPT];
#pragma unroll
  for (int i = 0; i < KPT; ++i) { const int c = tid + 512 * i; kok[i] = (512 * (i + 1) <= NKC) || (c < NKC); const int row = c / KC, col = (c % KC) * 8; kgo[i] = row * ldk + col; klo[i] = KSWZ(row, col * 2); }
#pragma unroll
  for (int i = 0; i < VPT; ++i) { const int c = tid + 512 * i; vok[i] = (512 * (i + 1) <= NVC) || (c < NVC); const int row = c / VC, col = (c % VC) * 8; vgo[i] = row * ldv + col; vlo[i] = v_st<NB>(row, col); }
  const int vb0 = (int)(unsigned)(unsigned long)V_lds + v_rd_base(lane);
  struct { bf16x8 ks[KPT], vs[VPT]; } sr_;
#define SLOAD2(k0) do { _Pragma("unroll") for (int i_ = 0; i_ < KPT; ++i_) if (kok[i_]) sr_.ks[i_] = *reinterpret_cast<const bf16x8*>(Kh + (long)(k0) * ldk + kgo[i_]); \
    _Pragma("unroll") for (int i_ = 0; i_ < VPT; ++i_) if (vok[i_]) sr_.vs[i_] = *reinterpret_cast<const bf16x8*>(Vh + (long)(k0) * ldv + vgo[i_]); } while (0)
#define SWRITE2(b) do { _Pragma("unroll") for (int i_ = 0; i_ < KPT; ++i_) if (kok[i_]) *(ALAS bf16x8*)(K_lds + (b) * SHM_K + klo[i_]) = sr_.ks[i_]; \
    _Pragma("unroll") for (int i_ = 0; i_ < VPT; ++i_) if (vok[i_]) *(ALAS bf16x8*)(V_lds + (b) * SHM_V + vlo[i_]) = sr_.vs[i_]; } while (0)
  const int NT = nkeys / KVBLK;
  f32x16 p[2][2]; bf16x8 pa[2][4];
  SLOAD2(0); asm volatile("s_waitcnt vmcnt(0)" ::: "memory"); SWRITE2(0); __syncthreads();
  for (int j = 0; j < NT; ++j) {
    const int bsel = j & 1;
    if (j + 1 < NT) SLOAD2((j + 1) * KVBLK);
    if constexpr (SHAREK) {
      SBAR(); qkt2<DK>(p, K_lds + bsel * SHM_K, qr, r32, hi);
      expHalf(p[0][0], negb_, use_shift); finishSM(p[0][0], p[0][1], l_reg[0], pa[0][0], pa[0][1], pa[0][2], pa[0][3], negb_, use_shift);
      expHalf(p[1][0], negb_, use_shift); finishSM(p[1][0], p[1][1], l_reg[1], pa[1][0], pa[1][1], pa[1][2], pa[1][3], negb_, use_shift); SBAR();
    } else {
      SBAR(); qkt<DK>(p[0][0], p[0][1], K_lds + bsel * SHM_K, qr[0], r32, hi);
      expHalf(p[0][0], negb_, use_shift); finishSM(p[0][0], p[0][1], l_reg[0], pa[0][0], pa[0][1], pa[0][2], pa[0][3], negb_, use_shift); SBAR();
      qkt<DK>(p[0][0], p[0][1], K_lds + bsel * SHM_K, qr[1], r32, hi);
      expHalf(p[0][0], negb_, use_shift); finishSM(p[0][0], p[0][1], l_reg[1], pa[1][0], pa[1][1], pa[1][2], pa[1][3], negb_, use_shift); SBAR();
    }
    pv_one2<NB, 0>(o[0][0], o[1][0], vb0 + bsel * SHM_V, pa); pv_one2<NB, 1>(o[0][1], o[1][1], vb0 + bsel * SHM_V, pa);
    if (j + 1 < NT) { asm volatile("s_waitcnt vmcnt(0)" ::: "memory"); SWRITE2(bsel ^ 1); }
    __syncthreads();
  }
#pragma unroll
  for (int q = 0; q < 2; ++q) {
    float lq = l_reg[q];
    { auto rr = __builtin_amdgcn_permlane32_swap(__float_as_uint(lq), __float_as_uint(lq), false, false); lq = __uint_as_float(rr[0]) + __uint_as_float(rr[1]); }
    if (hi == 0) ws[q * 32 + r32] = lq;
  }
  asm volatile("s_waitcnt lgkmcnt(0)" ::: "memory");
#pragma unroll
  for (int q = 0; q < 2; ++q) {
    float rli[16];
#pragma unroll
    for (int r = 0; r < 16; ++r) rli[r] = __builtin_amdgcn_rcpf(ws[q * 32 + crow(r, hi)]);
    bf16_t* Ow = Ob + (long)(q * 256 + wid * QBLK) * ldo;
#pragma unroll
    for (int r = 0; r < 16; ++r) { const int orow = crow(r, hi);
#pragma unroll
      for (int d0 = 0; d0 < NB; ++d0) { const float v = o[q][d0][r] * rli[r]; Ow[(long)orow * ldo + d0 * 32 + r32] = (bf16_t)(cvtpk(v, v) & 0xffffu); } }
  }
  __syncthreads();
#undef SLOAD2
#undef SWRITE2
}
template <int DK, int QMODE, bool SHAREK = true>
__device__ __forceinline__ void attn_unit2d(const bf16_t* Qb, int ldq, const bf16_t* __restrict__ Kh, int ldk, const bf16_t* __restrict__ Vh, int ldv,
                                           bf16_t* Ob, int ldo, int nkeys, float qscale, float negb_, const QPrep& qp, ALAS char* lds, int wave0) {
  constexpr int DV = 64, NB = 2, KC = DK / 8, VC = DV / 8;
  constexpr int NKC = 64 * KC, NVC = 64 * VC, KPT = (NKC + 511) / 512, VPT = (NVC + 511) / 512;
  constexpr int SHM_V = KVBLK * DV * 2, SHM_K = 16384;
  int tid; asm volatile("v_mbcnt_lo_u32_b32 %0, -1, 0\n\tv_mbcnt_hi_u32_b32 %0, -1, %0" : "=v"(tid)); tid = (tid + wave0 * 64) & 511;
  const int wid = tid >> 6, lane = tid & 63, r32 = lane & 31, hi = lane >> 5;
  ALAS char* V_lds = lds + LDS_V; ALAS char* K_lds = lds + LDS_K;
  ALAS float* ws = (ALAS float*)(lds + LDS_WS) + wid * 64;
  const bool use_shift = negb_ < -60.f;
  float l_reg[2] = {0.f, 0.f}; f32x16 o[2][NB]; bf16x8 qr[2][DK / 16];
  { QPrep q2 = qp;
    load_q<DK, QMODE>(qr[0], Qb + (long)(wid * QBLK + r32) * ldq + hi * 8, q2, qscale, wid, r32, hi);
    SBAR();
    q2.pos0 = qp.pos0 + 256;
    load_q<DK, QMODE>(qr[1], Qb + (long)(256 + wid * QBLK + r32) * ldq + hi * 8, q2, qscale, wid, r32, hi); }
  SBAR();
#pragma unroll
  for (int q = 0; q < 2; ++q)
#pragma unroll
    for (int d = 0; d < NB; ++d) o[q][d] = f32x16{};
  const int widu = __builtin_amdgcn_readfirstlane(wid);
  constexpr int KINST = 2, VINST = (64 * DV * 2) / (512 * 16);
  int kg[KINST], vg[VINST]; bool kv_[KINST];
#pragma unroll
  for (int i = 0; i < KINST; ++i) { const int q = (i * 8 + wid) * 64 + lane, row = q >> 4, pos = q & 15, c = pos ^ KF(row); kv_[i] = c < KC; kg[i] = row * ldk + c * 8; }
#pragma unroll
  for (int i = 0; i < VINST; ++i) { const int q = (i * 8 + wid) * 64 + lane, o_ = q * 16, sub = o_ >> 9, e = (o_ & 511) >> 1, kk = (sub / NB) * 8 + (e >> 5), k = (kk & ~0xC) | ((kk & 4) << 1) | ((kk & 8) >> 1), c = (sub % NB) * 32 + (e & 31); vg[i] = k * ldv + c; }
  const int vb0 = (int)(unsigned)(unsigned long)V_lds + v_rd_base(lane);
#define DMA_KV(b, k0) do { \
    _Pragma("unroll") for (int i_ = 0; i_ < KINST; ++i_) if (kv_[i_]) __builtin_amdgcn_global_load_lds((const unsigned*)(Kh + (long)(k0) * ldk + kg[i_]), (ALAS unsigned*)(K_lds + (b) * SHM_K + (i_ * 8 + widu) * 1024), 16, 0, 0); \
    _Pragma("unroll") for (int i_ = 0; i_ < VINST; ++i_) __builtin_amdgcn_global_load_lds((const unsigned*)(Vh + (long)(k0) * ldv + vg[i_]), (ALAS unsigned*)(V_lds + (b) * SHM_V + (i_ * 8 + widu) * 1024), 16, 0, 0); } while (0)
  const int NT = nkeys / KVBLK;
  f32x16 p[2][2]; bf16x8 pa[2][4];
  DMA_KV(0, 0); asm volatile("s_waitcnt vmcnt(0)" ::: "memory"); __syncthreads();
  for (int j = 0; j < NT; ++j) {
    const int bsel = j & 1;
    if (j + 1 < NT) DMA_KV(bsel ^ 1, (j + 1) * KVBLK);
    if constexpr (SHAREK) {
      SBAR(); qkt2<DK>(p, K_lds + bsel * SHM_K, qr, r32, hi);
      expHalf(p[0][0], negb_, use_shift); finishSM(p[0][0], p[0][1], l_reg[0], pa[0][0], pa[0][1], pa[0][2], pa[0][3], negb_, use_shift);
      expHalf(p[1][0], negb_, use_shift); finishSM(p[1][0], p[1][1], l_reg[1], pa[1][0], pa[1][1], pa[1][2], pa[1][3], negb_, use_shift); SBAR();
    } else {
      SBAR(); qkt<DK>(p[0][0], p[0][1], K_lds + bsel * SHM_K, qr[0], r32, hi);
      expHalf(p[0][0], negb_, use_shift); finishSM(p[0][0], p[0][1], l_reg[0], pa[0][0], pa[0][1], pa[0][2], pa[0][3], negb_, use_shift); SBAR();
      qkt<DK>(p[0][0], p[0][1], K_lds + bsel * SHM_K, qr[1], r32, hi);
      expHalf(p[0][0], negb_, use_shift); finishSM(p[0][0], p[0][1], l_reg[1], pa[1][0], pa[1][1], pa[1][2], pa[1][3], negb_, use_shift); SBAR();
    }
    pv_one2<NB, 0>(o[0][0], o[1][0], vb0 + bsel * SHM_V, pa); pv_one2<NB, 1>(o[0][1], o[1][1], vb0 + bsel * SHM_V, pa);
    asm volatile("s_waitcnt vmcnt(0)" ::: "memory");
    __syncthreads();
  }
#pragma unroll
  for (int q = 0; q < 2; ++q) {
    float lq = l_reg[q];
    { auto rr = __builtin_amdgcn_permlane32_swap(__float_as_uint(lq), __float_as_uint(lq), false, false); lq = __uint_as_float(rr[0]) + __uint_as_float(rr[1]); }
    if (hi == 0) ws[q * 32 + r32] = lq;
  }
  asm volatile("s_waitcnt lgkmcnt(0)" ::: "memory");
#pragma unroll
  for (int q = 0; q < 2; ++q) {
    float rli[16];
#pragma unroll
    for (int r = 0; r < 16; ++r) rli[r] = __builtin_amdgcn_rcpf(ws[q * 32 + crow(r, hi)]);
    bf16_t* Ow = Ob + (long)(q * 256 + wid * QBLK) * ldo;
#pragma unroll
    for (int r = 0; r < 16; ++r) { const int orow = crow(r, hi);
#pragma unroll
      for (int d0 = 0; d0 < NB; ++d0) { const float v = o[q][d0][r] * rli[r]; Ow[(long)orow * ldo + d0 * 32 + r32] = (bf16_t)(cvtpk(v, v) & 0xffffu); } }
  }
  __syncthreads();
#undef DMA_KV
}
__device__ __forceinline__ void attn_unit_diff(const bf16_t* Qb, int ldq, const bf16_t* __restrict__ Kh, int ldk, const bf16_t* __restrict__ Vh, int ldv,
                                               bf16_t* Ob, int ldo, int nkeys, float qscale, float negb_, const QPrep& qp, ALAS char* lds, int wave0, float lam, const float* g, float post) {
  constexpr int DK = 64, DV = 128, NB = 4, KC = 16, VC = 16, KPT = 2, VPT = 2, SHM_V = KVBLK * DV * 2, SHM_K = 16384;
  int tid; asm volatile("v_mbcnt_lo_u32_b32 %0, -1, 0\n\tv_mbcnt_hi_u32_b32 %0, -1, %0" : "=v"(tid)); tid = (tid + wave0 * 64) & 511;
  const int wid = tid >> 6, lane = tid & 63, r32 = lane & 31, hi = lane >> 5;
  ALAS char* V_lds = lds + LDS_V; ALAS char* K_lds = lds + LDS_K;
  ALAS float* ws = (ALAS float*)(lds + LDS_WS) + wid * 64;
  const bool use_shift = negb_ < -60.f;
  float l_reg[2] = {0.f, 0.f}; f32x16 o[2][NB]; bf16x8 qr[2][DK / 16];
  load_q<DK, 1>(qr[0], Qb + (long)(wid * QBLK + r32) * ldq + hi * 8, qp, qscale, wid, r32, hi);
  SBAR();
  load_q<DK, 1>(qr[1], Qb + 64 + (long)(wid * QBLK + r32) * ldq + hi * 8, qp, qscale, wid, r32, hi);
  SBAR();
#pragma unroll
  for (int q = 0; q < 2; ++q)
#pragma unroll
    for (int d = 0; d < NB; ++d) o[q][d] = f32x16{};
  int kgo[KPT], klo[KPT], vgo[VPT], vlo[VPT];
#pragma unroll
  for (int i = 0; i < KPT; ++i) { const int c = tid + 512 * i; const int row = c / KC, col = (c % KC) * 8; kgo[i] = row * ldk + col; klo[i] = KSWZ(row, col * 2); }
#pragma unroll
  for (int i = 0; i < VPT; ++i) { const int c = tid + 512 * i; const int row = c / VC, col = (c % VC) * 8; vgo[i] = row * ldv + col; vlo[i] = v_st<NB>(row, col); }
  const int vb0 = (int)(unsigned)(unsigned long)V_lds + v_rd_base(lane);
  struct { bf16x8 ks[KPT], vs[VPT]; } sr_;
#define SLOADD(k0) do { _Pragma("unroll") for (int i_ = 0; i_ < KPT; ++i_) sr_.ks[i_] = *reinterpret_cast<const bf16x8*>(Kh + (long)(k0) * ldk + kgo[i_]); \
    _Pragma("unroll") for (int i_ = 0; i_ < VPT; ++i_) sr_.vs[i_] = *reinterpret_cast<const bf16x8*>(Vh + (long)(k0) * ldv + vgo[i_]); } while (0)
#define SWRITED(b) do { _Pragma("unroll") for (int i_ = 0; i_ < KPT; ++i_) *(ALAS bf16x8*)(K_lds + (b) * SHM_K + klo[i_]) = sr_.ks[i_]; \
    _Pragma("unroll") for (int i_ = 0; i_ < VPT; ++i_) *(ALAS bf16x8*)(V_lds + (b) * SHM_V + vlo[i_]) = sr_.vs[i_]; } while (0)
  const int NT = nkeys / KVBLK;
  f32x16 p0, p1; bf16x8 pa0, pa1, pa2, pa3;
  SLOADD(0); asm volatile("s_waitcnt vmcnt(0)" ::: "memory"); SWRITED(0); __syncthreads();
  for (int j = 0; j < NT; ++j) {
    const int bsel = j & 1;
    if (j + 1 < NT) SLOADD((j + 1) * KVBLK);
    SBAR(); qkt<DK, 0>(p0, p1, K_lds + bsel * SHM_K, qr[0], r32, hi); expHalf(p0, negb_, use_shift);
    finishSM(p0, p1, l_reg[0], pa0, pa1, pa2, pa3, negb_, use_shift); SBAR();
    pv_all<NB>(o[0], vb0 + bsel * SHM_V, pa0, pa1, pa2, pa3);
    SBAR(); qkt<DK, 128>(p0, p1, K_lds + bsel * SHM_K, qr[1], r32, hi); expHalf(p0, negb_, use_shift);
    finishSM(p0, p1, l_reg[1], pa0, pa1, pa2, pa3, negb_, use_shift); SBAR();
    pv_all<NB>(o[1], vb0 + bsel * SHM_V, pa0, pa1, pa2, pa3);
    if (j + 1 < NT) { asm volatile("s_waitcnt vmcnt(0)" ::: "memory"); SWRITED(bsel ^ 1); }
    __syncthreads();
  }
#pragma unroll
  for (int q = 0; q < 2; ++q) { float lq = l_reg[q];
    { auto rr = __builtin_amdgcn_permlane32_swap(__float_as_uint(lq), __float_as_uint(lq), false, false); lq = __uint_as_float(rr[0]) + __uint_as_float(rr[1]); }
    if (hi == 0) ws[q * 32 + r32] = lq; }
  asm volatile("s_waitcnt lgkmcnt(0)" ::: "memory");
  float gcol[NB];
#pragma unroll
  for (int d0 = 0; d0 < NB; ++d0) gcol[d0] = g[d0 * 32 + r32] * post;
  bf16_t* Ow = Ob + (long)(wid * QBLK) * ldo;
#pragma unroll
  for (int r = 0; r < 16; ++r) { const int orow = crow(r, hi); const float r1 = __builtin_amdgcn_rcpf(ws[crow(r, hi)]), r2 = __builtin_amdgcn_rcpf(ws[32 + crow(r, hi)]) * lam; float d[NB]; float ss = 0.f;
#pragma unroll
    for (int d0 = 0; d0 < NB; ++d0) { d[d0] = o[0][d0][r] * r1 - o[1][d0][r] * r2; ss += d[d0] * d[d0]; }
    ss += __int_as_float(__builtin_amdgcn_ds_swizzle(__float_as_int(ss), (1 << 10) | 0x1f)); ss += __int_as_float(__builtin_amdgcn_ds_swizzle(__float_as_int(ss), (2 << 10) | 0x1f));
    ss += __int_as_float(__builtin_amdgcn_ds_swizzle(__float_as_int(ss), (4 << 10) | 0x1f)); ss += __int_as_float(__builtin_amdgcn_ds_swizzle(__float_as_int(ss), (8 << 10) | 0x1f));
    ss += __int_as_float(__builtin_amdgcn_ds_swizzle(__float_as_int(ss), (16 << 10) | 0x1f));
    const float rstd = __builtin_amdgcn_rsqf(ss * (1.f / 128.f) + 1e-6f);
#pragma unroll
    for (int d0 = 0; d0 < NB; ++d0) { const float v = d[d0] * rstd * gcol[d0]; Ow[(long)orow * ldo + d0 * 32 + r32] = (bf16_t)(cvtpk(v, v) & 0xffffu); } }
  __syncthreads();
#undef SLOADD
#undef SWRITED
}
#undef KSWZ
#undef KF
#undef SBAR
}
#define GAS __attribute__((address_space(1)))
#define LAS __attribute__((address_space(3)))
typedef unsigned short bf16;
typedef unsigned v4u __attribute__((ext_vector_type(4)));
typedef unsigned v2u __attribute__((ext_vector_type(2)));
typedef float f32x4 __attribute__((ext_vector_type(4)));
typedef float f32x2 __attribute__((ext_vector_type(2)));
typedef GAS unsigned gu32;
#define RLX_AGENT __ATOMIC_RELAXED, __HIP_MEMORY_SCOPE_AGENT
#define LDS_WAIT() asm volatile("s_waitcnt lgkmcnt(0)" ::: "memory")
#define VM_WAIT() asm volatile("s_waitcnt vmcnt(0)" ::: "memory")
__device__ __forceinline__ unsigned f2bf(float f) { unsigned u = __builtin_bit_cast(unsigned, f); return (u + 0x7fffu + ((u >> 16) & 1u)) >> 16; }
__device__ __forceinline__ unsigned pk2(float lo, float hi) { return pg8::cvt_pk_bf16(lo, hi); }
__device__ __forceinline__ float bflo(unsigned w) { return __uint_as_float(w << 16); }
__device__ __forceinline__ float bfhi(unsigned w) { return __uint_as_float(w & 0xffff0000u); }

__device__ __forceinline__ int lane_id() { int l; asm volatile("v_mbcnt_lo_u32_b32 %0, -1, 0\n\tv_mbcnt_hi_u32_b32 %0, -1, %0" : "=v"(l)); return l; }

#define XB_TMO      128
#define XB_XCNT(j)  (256  + 64 * (j))
#define XB_XSUB(j)  (1280 + 64 * (j))
#define XB_XGEN(j)  (2304 + 64 * (j))
#define XB_TOP      3328
#define XB_TOPGEN   3392
#define XCD_BAR_WORDS 3456
#define XB_SPIN_CAP (1u << 18)

__device__ __forceinline__ unsigned xb_ld(unsigned* p)              { return __hip_atomic_load(p, __ATOMIC_RELAXED, __HIP_MEMORY_SCOPE_AGENT); }
__device__ __forceinline__ unsigned xb_add(unsigned* p, unsigned v) { return __hip_atomic_fetch_add(p, v, __ATOMIC_RELAXED, __HIP_MEMORY_SCOPE_AGENT); }
__device__ __forceinline__ unsigned xb_xcc_id() { return (unsigned)__builtin_amdgcn_s_getreg((3 << 11) | 20) & 0xFu; }
#define XB_SPIN(cond, bar) do { unsigned _sp = 0; while (cond) { __builtin_amdgcn_s_sleep(1); \
    if ((++_sp & 255u) == 0u) { if (xb_ld(&(bar)[XB_TMO])) break; if (_sp > XB_SPIN_CAP) { atomicAdd(&(bar)[XB_TMO], 1u); break; } } } } while (0)

struct XcdBarrier {
    unsigned* bar; unsigned x;
    volatile LAS unsigned* st;
};
__device__ __forceinline__ XcdBarrier xcd_barrier_post(unsigned* bar, volatile LAS unsigned* st, int wave0) {
    XcdBarrier b; b.bar = bar; b.x = xb_xcc_id(); b.st = st;
    if (wave0 == 0 && lane_id() == 0) (void)xb_add(&bar[XB_XCNT(b.x)], 1u);
    return b;
}
__device__ __forceinline__ void xcd_barrier_complete(unsigned* bar, unsigned x, unsigned& nloc, unsigned& nx) {
    const unsigned G = gridDim.x * gridDim.y * gridDim.z;
    unsigned sum, cnt, mine, sp = 0u;
    for (;;) {
        sum = 0u; cnt = 0u; mine = 0u;
#pragma unroll
        for (unsigned j = 0; j < 16; ++j) { const unsigned c = xb_ld(&bar[XB_XCNT(j)]); sum += c; cnt += (c > 0u) ? 1u : 0u; mine = (j == x) ? c : mine; }
        if (sum == G) break;
        __builtin_amdgcn_s_sleep(1);
        if ((++sp & 255u) == 0u) { if (xb_ld(&bar[XB_TMO])) break; if (sp > XB_SPIN_CAP) { atomicAdd(&bar[XB_TMO], 1u); break; } }
    }
    nloc = mine > 0u ? mine : 1u; nx = cnt > 0u ? cnt : 1u;
}
__device__ __forceinline__ void xcd_barrier(const XcdBarrier& b, int wave0) {
    asm volatile("s_waitcnt vmcnt(0)" ::: "memory");
    __syncthreads();
    if (wave0 == 0 && lane_id() == 0) {
        unsigned* bar = b.bar;
        __builtin_amdgcn_s_waitcnt(0);
        unsigned nloc = b.st[0], nx = b.st[1];
        if (nloc == 0u) { xcd_barrier_complete(bar, b.x, nloc, nx); b.st[0] = nloc; b.st[1] = nx; }
        const unsigned old = xb_add(&bar[XB_XSUB(b.x)], 1u);
        const unsigned gen = old / nloc;
        if (old + 1u == (gen + 1u) * nloc) {
            __builtin_amdgcn_fence(__ATOMIC_RELEASE, "agent");
            asm volatile("s_waitcnt vmcnt(0)" ::: "memory");
            const unsigned og = xb_add(&bar[XB_TOP], 1u);
            const unsigned tg = og / nx;
            if (og + 1u == (tg + 1u) * nx) xb_add(&bar[XB_TOPGEN], 1u);
            else XB_SPIN(xb_ld(&bar[XB_TOPGEN]) == tg, bar);
            __builtin_amdgcn_fence(__ATOMIC_ACQUIRE, "agent");
            xb_add(&bar[XB_XGEN(b.x)], 1u);
            asm volatile("s_waitcnt vmcnt(0)" ::: "memory");
        } else {
            XB_SPIN(xb_ld(&bar[XB_XGEN(b.x)]) == gen, bar);
            __builtin_amdgcn_fence(__ATOMIC_ACQUIRE, "agent");
            asm volatile("s_waitcnt vmcnt(0)" ::: "memory");
        }
    }
    __syncthreads();
}

template <int CTRL> __device__ __forceinline__ float dpp_f(float v) { return __int_as_float(__builtin_amdgcn_update_dpp(0, __float_as_int(v), CTRL, 0xf, 0xf, true)); }
template <int CTRL> __device__ __forceinline__ int dpp_i(int v) { return __builtin_amdgcn_update_dpp(0, v, CTRL, 0xf, 0xf, true); }
template <int K> __device__ __forceinline__ float xshfl(float v) {
    static_assert(K == 1 || K == 2 || K == 4 || K == 8, "xshfl: K");
    if constexpr (K == 1) return dpp_f<0xB1>(v);
    else if constexpr (K == 2) return dpp_f<0x4E>(v);
    else if constexpr (K == 4) return dpp_f<0x1B>(dpp_f<0x141>(v));
    else return dpp_f<0x128>(v);
}
__device__ __forceinline__ float xshfl16(float v, int lane) { const auto rr = __builtin_amdgcn_permlane16_swap(__float_as_uint(v), __float_as_uint(v), false, false); return __uint_as_float((lane & 16) ? rr[0] : rr[1]); }
__device__ __forceinline__ float sum8(float v) { v += dpp_f<0xB1>(v); v += dpp_f<0x4E>(v); v += dpp_f<0x141>(v); return v; }
__device__ __forceinline__ float sum16(float v) { v = sum8(v); v += dpp_f<0x140>(v); return v; }
__device__ __forceinline__ float half_sum(float v) { v = sum16(v); const auto rr = __builtin_amdgcn_permlane16_swap(__float_as_uint(v), __float_as_uint(v), false, false); return __uint_as_float(rr[0]) + __uint_as_float(rr[1]); }
__device__ __forceinline__ float wave_sum(float v) {
    v = half_sum(v);
    const auto rr = __builtin_amdgcn_permlane32_swap(__float_as_uint(v), __float_as_uint(v), false, false);
    return __uint_as_float(rr[0]) + __uint_as_float(rr[1]);
}
__device__ __forceinline__ float wave_max(float v) {
    v = fmaxf(v, dpp_f<0xB1>(v)); v = fmaxf(v, dpp_f<0x4E>(v)); v = fmaxf(v, dpp_f<0x141>(v)); v = fmaxf(v, dpp_f<0x140>(v));
    { const auto rr = __builtin_amdgcn_permlane16_swap(__float_as_uint(v), __float_as_uint(v), false, false); v = fmaxf(__uint_as_float(rr[0]), __uint_as_float(rr[1])); }
    const auto rr = __builtin_amdgcn_permlane32_swap(__float_as_uint(v), __float_as_uint(v), false, false);
    return fmaxf(__uint_as_float(rr[0]), __uint_as_float(rr[1]));
}
__device__ __forceinline__ int wave_sum_i(int v) {
    v += dpp_i<0xB1>(v); v += dpp_i<0x4E>(v); v += dpp_i<0x141>(v); v += dpp_i<0x140>(v);
    { const auto rr = __builtin_amdgcn_permlane16_swap((unsigned)v, (unsigned)v, false, false); v = (int)(rr[0] + rr[1]); }
    const auto rr = __builtin_amdgcn_permlane32_swap((unsigned)v, (unsigned)v, false, false);
    return (int)(rr[0] + rr[1]);
}
__device__ __forceinline__ float xshfl32(float v, int hi) { const auto rr = __builtin_amdgcn_permlane32_swap(__float_as_uint(v), __float_as_uint(v), false, false); return __uint_as_float(hi ? rr[0] : rr[1]); }
constexpr float NEPS = 1e-6f;
template <int HW, int ROPE>
__device__ __forceinline__ unsigned head_norm_rope(unsigned w, const float* g, const float* cs0, const float* sn0, const float* cs1, const float* sn1, int lane) {
    const int j = (HW == 64) ? (lane & 31) : lane;
    float a = bflo(w), b = bfhi(w);
    float ss = a * a + b * b;
    ss = (HW == 64) ? half_sum(ss) : wave_sum(ss);
    const float rstd = __builtin_amdgcn_rsqf(ss * (1.f / HW) + NEPS);
    const f32x2 gg = *(const f32x2*)(g + 2 * j);
    a = a * rstd * gg.x; b = b * rstd * gg.y;
    if (ROPE == 1) {
        constexpr int HALF_ = HW / 2;
        const float pa = (HALF_ / 2 == 32) ? xshfl32(a, lane >> 5) : xshfl16(a, lane), pb = (HALF_ / 2 == 32) ? xshfl32(b, lane >> 5) : xshfl16(b, lane);
        const int e = 2 * j, f = e % HALF_; const bool first = e < HALF_;
        const f32x2 c = *(const f32x2*)(cs0 + f), s = *(const f32x2*)(sn0 + f);
        a = first ? (a * c.x - pa * s.x) : (a * c.x + pa * s.x);
        b = first ? (b * c.y - pb * s.y) : (b * c.y + pb * s.y);
    } else if (ROPE == 2) {
        const float pa = xshfl<8>(a), pb = xshfl<8>(b);
        const int e = (2 * j) & 31, f = e & 15; const bool first = e < 16; const bool blk1 = (2 * j) >= 32;
        const float* ct = blk1 ? cs1 : cs0; const float* st = blk1 ? sn1 : sn0;
        const f32x2 c = *(const f32x2*)(ct + f), s = *(const f32x2*)(st + f);
        a = first ? (a * c.x - pa * s.x) : (a * c.x + pa * s.x);
        b = first ? (b * c.y - pb * s.y) : (b * c.y + pb * s.y);
    }
    return pk2(a, b);
}
__device__ __forceinline__ unsigned mla_head(float a, float b, const float* g, const float* cs, const float* sn, int lane) {
    const float ss = wave_sum(a * a + b * b);
    const float rstd = __builtin_amdgcn_rsqf(ss * (1.f / 96.f) + NEPS);
    const int jj = lane < 48 ? lane : 0;
    const f32x2 gg = *(const f32x2*)(g + 2 * jj);
    a = a * rstd * gg.x; b = b * rstd * gg.y;
    const float pa = xshfl<8>(a), pb = xshfl<8>(b);
    if (lane >= 32 && lane < 48) {
        const int e = 2 * lane - 64, f = e & 15; const bool first = e < 16;
        const f32x2 c = *(const f32x2*)(cs + f), s = *(const f32x2*)(sn + f);
        a = first ? (a * c.x - pa * s.x) : (a * c.x + pa * s.x);
        b = first ? (b * c.y - pb * s.y) : (b * c.y + pb * s.y);
    }
    return pk2(a, b);
}

template <int HW, int ROPE>
__device__ __forceinline__ unsigned head_apply(unsigned w, f32x2 g2, f32x2 c2, f32x2 s2, int lane) {
    const int j = (HW == 64) ? (lane & 31) : lane;
    float a = bflo(w), b = bfhi(w);
    float ss = a * a + b * b;
    ss = (HW == 64) ? half_sum(ss) : wave_sum(ss);
    const float rstd = __builtin_amdgcn_rsqf(ss * (1.f / HW) + NEPS);
    a = a * rstd * g2.x; b = b * rstd * g2.y;
    if (ROPE == 1) {
        constexpr int HALF_ = HW / 2;
        const float pa = (HALF_ / 2 == 32) ? xshfl32(a, lane >> 5) : xshfl16(a, lane), pb = (HALF_ / 2 == 32) ? xshfl32(b, lane >> 5) : xshfl16(b, lane);
        const bool first = 2 * j < HALF_;
        a = first ? (a * c2.x - pa * s2.x) : (a * c2.x + pa * s2.x);
        b = first ? (b * c2.y - pb * s2.y) : (b * c2.y + pb * s2.y);
    } else if (ROPE == 2) {
        const float pa = xshfl<8>(a), pb = xshfl<8>(b);
        const bool first = ((2 * j) & 31) < 16;
        a = first ? (a * c2.x - pa * s2.x) : (a * c2.x + pa * s2.x);
        b = first ? (b * c2.y - pb * s2.y) : (b * c2.y + pb * s2.y);
    }
    return pk2(a, b);
}
__device__ __forceinline__ unsigned mla_apply(float a, float b, f32x2 g2, f32x2 c2, f32x2 s2, int lane) {
    const float ss = wave_sum(a * a + b * b);
    const float rstd = __builtin_amdgcn_rsqf(ss * (1.f / 96.f) + NEPS);
    a = a * rstd * g2.x; b = b * rstd * g2.y;
    const float pa = xshfl<8>(a), pb = xshfl<8>(b);
    if (lane >= 32 && lane < 48) {
        const bool first = (2 * lane - 64) < 16;
        a = first ? (a * c2.x - pa * s2.x) : (a * c2.x + pa * s2.x);
        b = first ? (b * c2.y - pb * s2.y) : (b * c2.y + pb * s2.y);
    }
    return pk2(a, b);
}
constexpr int NWAVES = 8;
constexpr int BATCH = 16, SEQ = 2048, DM = 1024, M = BATCH * SEQ, MEML = 256, MMEM = BATCH * MEML;
constexpr int FF = 3584, NEXP = 8, DEPTH = 2;
constexpr int RAWW = 3328;
constexpr int C_DQ = 0, C_DK = 512, C_DV = 1024, C_QLAT = 1536, C_KVLAT = 1792, C_KROPE = 1920, C_GQ = 2048, C_GK = 2560, C_GV = 2688, C_MEMQ = 2816;
constexpr int C_OA = 0, C_OB = 1536, C_OC = 2048, C_OD = 2816;
constexpr int MLAW = 1792;
enum { I_X = 0, I_MEM, I_NORM_ATTN_G, I_NORM_MEM_G, I_W_IN, I_DQ_G, I_DK_G, I_DLAMBDA, I_DSUBLN_G, I_MLA_QLAT_G, I_MLA_KVLAT_G, I_W_QUP, I_W_KVUP, I_MLA_Q_G, I_MLA_K_G,
       I_GQA_Q_G, I_GQA_K_G, I_W_MEMKV, I_MEM_Q_G, I_MEM_K_G, I_W_BRANCH, I_W_GATE, I_B_GATE, I_W_OUT, I_NORM_FFN_G, I_DW1, I_DW3, I_DW2, I_ROUTER, I_MW1, I_MW3, I_MW2, N_IN };
constexpr size_t MiB = 1u << 20;
constexpr size_t WS_CTL = 0, CTL_ZERO_BYTES = 64 * 1024;
constexpr size_t WS_TAB = 1 * MiB;
constexpr size_t T_DC = 0, T_DS = T_DC + 2048 * 32 * 4, T_MC = T_DS + 2048 * 32 * 4, T_MS = T_MC + 2048 * 16 * 4, T_QC = T_MS + 2048 * 16 * 4, T_QS = T_QC + 2048 * 64 * 4,
                 T_RC = T_QS + 2048 * 64 * 4, T_RS = T_RC + 32 * 16 * 4, T_CC = T_RS + 32 * 16 * 4, T_CS = T_CC + 64 * 16 * 4, T_END = T_CS + 64 * 16 * 4;
static_assert(T_END <= 2 * MiB, "tables");
constexpr size_t WS_MOE = 3 * MiB;
constexpr size_t WS_AW = 4 * MiB;
constexpr size_t AW_IN = 0, AW_GATE = AW_IN + (size_t)RAWW * DM * 2, AW_BR = AW_GATE + (size_t)4096 * DM * 2, AW_OUT = AW_BR + (size_t)4096 * 512 * 2,
                 AW_QUP = AW_OUT + (size_t)DM * DM * 2, AW_KVUP = AW_QUP + (size_t)768 * 256 * 2, AW_MEMKV = AW_KVUP + (size_t)1024 * 256 * 2, AW_END = AW_MEMKV + (size_t)DM * DM * 2;
static_assert(AW_END <= 32 * MiB, "attention weights");
constexpr size_t WS_HB = 36 * MiB;
constexpr size_t WS_RAW = 100 * MiB;
constexpr size_t WS_G = 308 * MiB;
constexpr size_t WS_MLARAW = 308 * MiB, WS_KMLA = 420 * MiB, WS_ODIFF = 468 * MiB, WS_LATN = 468 * MiB, WS_MEMKV = 532 * MiB, WS_MEMN = 540 * MiB;
constexpr size_t WS_FW = 100 * MiB;
constexpr size_t WS_U = 268 * MiB;
constexpr size_t WS_Y = 474 * MiB;
constexpr size_t WS_UM = 250 * MiB;
constexpr size_t WS_XS8 = 184 * MiB;
constexpr size_t WS_XB = 36 * MiB;
constexpr size_t WS_HBM8 = 512 * MiB, WS_TAILP = 184 * MiB;
constexpr size_t WS_HBA = 436 * MiB;
constexpr size_t WS_HBF = 121 * MiB;
constexpr size_t WS_MERGED = 436 * MiB;
constexpr size_t WS_HB8 = 564 * MiB;
constexpr size_t WS_END = 606 * MiB;
constexpr int CW_BAR = 4096;
constexpr int MOE_SLOTS = 2 * M + NEXP * 256;
constexpr size_t MO_SLOT_TOK = 0, MO_TOK_SLOT = 278528, MO_TOK_GATE = MO_TOK_SLOT + (size_t)M * 8, MO_WGCNT = MO_TOK_GATE + (size_t)M * 8, MO_END = MO_WGCNT + 256 * 8 * 4;
static_assert((size_t)MOE_SLOTS * 4 <= MO_TOK_SLOT && MO_END <= 1 * MiB, "MoE lists");
constexpr size_t EXPERT_BYTES = (size_t)3 * FF * DM, W2_OFF = (size_t)2 * FF * DM;
constexpr int MOE_CHUNK_TILES = 256;
constexpr float S_H8 = 16.f, S_W13 = 32.f, S_U8 = 4.f, S_W2 = 64.f, S_WG = 32.f;
constexpr int RING_OFF = 0, RING_BYTES = 131072;
constexpr int LDSCTL_OFF = RING_BYTES, MISC_OFF = LDSCTL_OFF + 320, PTAB_OFF = LDSCTL_OFF + 1024, MOE_LDS = LDSCTL_OFF + 2048;
constexpr int ML_SEL = 0, ML_RNK = 256, ML_CNT = 512, ML_TOT = 520, ML_PRE = 528, ML_SEGB = 536, ML_TE = 576;
constexpr int LDS_BYTES = 147456;
static_assert(att::LDS_BYTES <= RING_BYTES, "attention LDS");

struct Args { const float* in[N_IN]; float* out; unsigned char* ws; };
__device__ __forceinline__ unsigned char* launder(unsigned char* p) { GAS unsigned char* q = (GAS unsigned char*)p; asm volatile("" : "+s"(q)); return (unsigned char*)q; }
__device__ __forceinline__ const float* inp(LAS unsigned char* lds, int i) {
    const volatile LAS unsigned* p = (const volatile LAS unsigned*)(lds + PTAB_OFF) + 2 * i;
    const unsigned lo = __builtin_amdgcn_readfirstlane(p[0]), hi = __builtin_amdgcn_readfirstlane(p[1]);
    const GAS float* q = (const GAS float*)(((unsigned long long)hi << 32) | lo); asm volatile("" : "+s"(q)); return (const float*)q;
}
#define IN(i) inp(lds, (i))

__device__ __forceinline__ void transpose_item(const float* W, int ldw, int k0, int n0, bf16* WT, int ldk, int drow0, LAS float* scr, int lane) {
    f32x4 v[8];
#pragma unroll
    for (int i = 0; i < 8; ++i) v[i] = *(const GAS f32x4*)(W + (size_t)(k0 + 8 * i + (lane >> 3)) * ldw + n0 + 4 * (lane & 7));
#pragma unroll
    for (int i = 0; i < 8; ++i) { LAS float* d = scr + (8 * i + (lane >> 3)) * 33 + 4 * (lane & 7); d[0] = v[i].x; d[1] = v[i].y; d[2] = v[i].z; d[3] = v[i].w; }
    LDS_WAIT(); asm volatile("" ::: "memory");
    const int c = lane & 7;
#pragma unroll
    for (int j = 0; j < 4; ++j) { const int n = (lane >> 3) + 8 * j; const LAS float* s = scr + (8 * c) * 33 + n;
        v4u o; o.x = pk2(s[0 * 33], s[1 * 33]); o.y = pk2(s[2 * 33], s[3 * 33]); o.z = pk2(s[4 * 33], s[5 * 33]); o.w = pk2(s[6 * 33], s[7 * 33]);
        *(GAS v4u*)(WT + (size_t)(drow0 + n) * ldk + k0 + 8 * c) = o; }
    LDS_WAIT(); asm volatile("" ::: "memory");
}
__device__ __forceinline__ void plain_item(int r, const float* W, int K, int N, bf16* WT, int ldk, int drow_shift, LAS float* scr, int lane) {
    const int nbn = N / 32, kb = r / nbn, nb = r % nbn; transpose_item(W, N, 64 * kb, 32 * nb, WT, ldk, 32 * nb + drow_shift, scr, lane);
}
constexpr int FFN_ITEMS_13 = (DM / 64) * (FF / 32), FFN_ITEMS_2 = (FF / 64) * (DM / 32), FFN_ITEMS = 2 * FFN_ITEMS_13 + FFN_ITEMS_2;
__device__ __forceinline__ void ffn_weight_item(int it, const float* w1, const float* w3, const float* w2, bf16* W13t, bf16* W2t, LAS float* scr, int lane) {
    if (it < 2 * FFN_ITEMS_13) { const int which = it / FFN_ITEMS_13, r = it % FFN_ITEMS_13, kb = r / (FF / 32), nb = r % (FF / 32);
        transpose_item(which ? w3 : w1, FF, 64 * kb, 32 * nb, W13t, DM, (nb >> 2) * 256 + (nb & 3) * 32 + which * 128, scr, lane); }
    else { const int r = it - 2 * FFN_ITEMS_13, kb = r / (DM / 32), nb = r % (DM / 32); transpose_item(w2, DM, 64 * kb, 32 * nb, W2t, FF, 32 * nb, scr, lane); }
}
__device__ __forceinline__ void transpose_item8(const float* W, int ldw, int k0, int n0, unsigned char* WT, int ldk, int drow0, float scale, LAS float* scr, int lane) {
    f32x4 v[8];
#pragma unroll
    for (int i = 0; i < 8; ++i) v[i] = *(const GAS f32x4*)(W + (size_t)(k0 + 8 * i + (lane >> 3)) * ldw + n0 + 4 * (lane & 7));
#pragma unroll
    for (int i = 0; i < 8; ++i) { LAS float* d = scr + (8 * i + (lane >> 3)) * 33 + 4 * (lane & 7); d[0] = v[i].x * scale; d[1] = v[i].y * scale; d[2] = v[i].z * scale; d[3] = v[i].w * scale; }
    LDS_WAIT(); asm volatile("" ::: "memory");
    const int c = lane & 7;
#pragma unroll
    for (int j = 0; j < 4; ++j) { const int n = (lane >> 3) + 8 * j; const LAS float* s = scr + (8 * c) * 33 + n;
        v2u o; o.x = pg8::cvt4_fp8(s[0 * 33], s[1 * 33], s[2 * 33], s[3 * 33]); o.y = pg8::cvt4_fp8(s[4 * 33], s[5 * 33], s[6 * 33], s[7 * 33]);
        *(GAS v2u*)(WT + (size_t)(drow0 + n) * ldk + k0 + 8 * c) = o; }
    LDS_WAIT(); asm volatile("" ::: "memory");
}
__device__ __forceinline__ void ffn_weight_item8(int it, const float* w1, const float* w3, const float* w2, unsigned char* W13t, unsigned char* W2t, LAS float* scr, int lane) {
    if (it < 2 * FFN_ITEMS_13) { const int which = it / FFN_ITEMS_13, r = it % FFN_ITEMS_13, kb = r / (FF / 32), nb = r % (FF / 32);
        transpose_item8(which ? w3 : w1, FF, 64 * kb, 32 * nb, W13t, DM, (nb >> 2) * 256 + (nb & 3) * 32 + which * 128, S_W13, scr, lane); }
    else { const int r = it - 2 * FFN_ITEMS_13, kb = r / (DM / 32), nb = r % (DM / 32); transpose_item8(w2, DM, 64 * kb, 32 * nb, W2t, FF, 32 * nb, S_W2, scr, lane); }
}
constexpr int AI_IN = 16 * 101, AI_GATE = 4 * 16 * 32, AI_BR = 4 * 8 * 32, AI_OUT = 16 * 32, AI_QUP = 4 * 24, AI_KVUP = 2 * 32, AI_MEMKV = 16 * 32;
constexpr int AI_TOTAL = AI_IN + AI_GATE + AI_BR + AI_OUT + AI_QUP + AI_KVUP + AI_MEMKV;
__device__ __forceinline__ void attn_weight_item(int it, int l, LAS unsigned char* lds, unsigned char* aw, LAS float* scr, int lane) {
    int r = it;
    if (r < AI_IN) { const int kb = r / 101, nb = r % 101;
        transpose_item(IN(I_W_IN) + (size_t)l * DM * 3232, 3232, 64 * kb, 32 * nb, (bf16*)(aw + AW_IN), DM, 32 * nb + (nb >= 61 ? 96 : 0), scr, lane); return; } r -= AI_IN;
    if (r < AI_GATE) { const int b = r / 512, rr = r % 512, kb = rr / 32, nb = rr % 32;
        transpose_item8(IN(I_W_GATE) + ((size_t)l * 4 + b) * DM * DM, DM, 64 * kb, 32 * nb, aw + AW_GATE, DM, 32 * nb + b * 1024, S_WG, scr, lane); return; } r -= AI_GATE;
    if (r < AI_BR) { const int b = r / 256; plain_item(r % 256, IN(I_W_BRANCH) + ((size_t)l * 4 + b) * 512 * DM, 512, DM, (bf16*)(aw + AW_BR), 512, b * 1024, scr, lane); return; } r -= AI_BR;
    if (r < AI_OUT) { plain_item(r, IN(I_W_OUT) + (size_t)l * DM * DM, DM, DM, (bf16*)(aw + AW_OUT), DM, 0, scr, lane); return; } r -= AI_OUT;
    if (r < AI_QUP) { plain_item(r, IN(I_W_QUP) + (size_t)l * 256 * 768, 256, 768, (bf16*)(aw + AW_QUP), 256, 0, scr, lane); return; } r -= AI_QUP;
    if (r < AI_KVUP) { plain_item(r, IN(I_W_KVUP) + (size_t)l * 128 * 1024, 128, 1024, (bf16*)(aw + AW_KVUP), 256, 0, scr, lane); return; } r -= AI_KVUP;
    plain_item(r, IN(I_W_MEMKV) + (size_t)l * DM * DM, DM, DM, (bf16*)(aw + AW_MEMKV), DM, 0, scr, lane);
}
template <bool IN_BF> __device__ __forceinline__ f32x4 rr_load(const float* X, int m, int lane, int j) {
    if constexpr (IN_BF) { const v2u w = ((const GAS v2u*)((const bf16*)X + (size_t)m * DM) + lane)[64 * j]; return (f32x4){bflo(w.x), bfhi(w.x), bflo(w.y), bfhi(w.y)}; }
    else return ((const GAS f32x4*)(X + (size_t)m * DM) + lane)[64 * j];
}
template <bool F8COPY = false, bool BF = true, bool IN_BF = false>
__device__ __forceinline__ void rms_rows_to_bf16(const float* X, const float* g, bf16* O, int nrows, int gw, int NGW, int lane, unsigned char* O8 = nullptr, float s8 = 1.0f) {
    f32x4 gg[4];
#pragma unroll
    for (int j = 0; j < 4; ++j) gg[j] = ((const GAS f32x4*)g + lane)[64 * j];
    if (gw >= nrows) return;
    f32x4 cur[4], nxt[4];
#pragma unroll
    for (int j = 0; j < 4; ++j) { cur[j] = rr_load<IN_BF>(X, gw, lane, j); nxt[j] = cur[j]; }
    for (int m = gw; m < nrows; m += NGW) {
        const int mn = m + NGW;
        if (mn < nrows) {
#pragma unroll
            for (int j = 0; j < 4; ++j) nxt[j] = rr_load<IN_BF>(X, mn, lane, j);
        }
        float s = 0.f;
#pragma unroll
        for (int j = 0; j < 4; ++j) s += (cur[j].x * cur[j].x + cur[j].y * cur[j].y) + (cur[j].z * cur[j].z + cur[j].w * cur[j].w);
        const float rstd = __builtin_amdgcn_rsqf(wave_sum(s) * (1.f / DM) + NEPS);
        GAS unsigned long long* o8 = (GAS unsigned long long*)(O + (size_t)m * DM) + lane;
#pragma unroll
        for (int j = 0; j < 4; ++j) o8[64 * j] = (unsigned long long)pk2(cur[j].x * rstd * gg[j].x, cur[j].y * rstd * gg[j].y) | ((unsigned long long)pk2(cur[j].z * rstd * gg[j].z, cur[j].w * rstd * gg[j].w) << 32);
        if constexpr (F8COPY) { GAS unsigned* o4 = (GAS unsigned*)(O8 + (size_t)m * DM) + lane; const float r8 = rstd * s8;
#pragma unroll
            for (int j = 0; j < 4; ++j) o4[64 * j] = pg8::cvt4_fp8(cur[j].x * r8 * gg[j].x, cur[j].y * r8 * gg[j].y, cur[j].z * r8 * gg[j].z, cur[j].w * r8 * gg[j].w); }
#pragma unroll
        for (int j = 0; j < 4; ++j) cur[j] = nxt[j];
    }
}
__device__ __forceinline__ void rope_entry(int pos, int i, int dim, float* c, float* s) {
    const float e = (float)(2 * i) / (float)dim;
    const float inv = 1.0f / powf(10000.0f, e);
    const float ang = (float)pos * inv;
    const double ad = (double)ang, k = rint(ad * 0.15915494309189535), r = ad - k * 6.283185307179586;
    const float rf = (float)r;
    *c = cosf(rf); *s = sinf(rf);
}

struct UpOrder : pg8::StaticOrder {
    const bf16* wq; const bf16* wkv;
    __device__ __forceinline__ const char* a_ptr(const pg8::Gemm& g, const pg8::Unit& u) const { return (const char*)g.A + (size_t)u.pm * (256 * 2) * g.lda + (u.pn >= 3 ? 512 : 0); }
    __device__ __forceinline__ const char* b_ptr(const pg8::Gemm& g, const pg8::Unit& u) const { return u.pn >= 3 ? (const char*)wkv + (size_t)(u.pn - 3) * 256 * 256 * 2 : (const char*)wq + (size_t)u.pn * 256 * 256 * 2; }
};
struct MergeOrder : pg8::StaticOrder {
    __device__ __forceinline__ bool next(int i, pg8::Unit& u) const { if (!tile((long)(i >> 2) * G + c, u)) return false; u.z = i & 3; return true; }
    __device__ __forceinline__ const char* a_ptr(const pg8::Gemm& g, const pg8::Unit& u) const {
        const int co = u.z == 0 ? C_OA : u.z == 1 ? C_OB : u.z == 2 ? C_OC : C_OD; return (const char*)g.A + (size_t)u.pm * (256 * 2) * g.lda + co * 2; }
    __device__ __forceinline__ const char* b_ptr(const pg8::Gemm& g, const pg8::Unit& u) const { return (const char*)g.Bt + (size_t)(u.z * 1024 + u.pn * 256) * g.ldb * 2; }
};
struct MoeUpOrder : pg8::StaticOrder {
    const int* slot_tok; int tile0; const volatile LAS int* te; const char* wbase;
    __device__ __forceinline__ const char* a_ptr(const pg8::Gemm& g, const pg8::Unit&) const { return (const char*)g.A; }
    __device__ __forceinline__ const char* b_ptr(const pg8::Gemm& g, const pg8::Unit& u) const { const int e = __builtin_amdgcn_readfirstlane(te[tile0 + u.pm]); return wbase + (size_t)e * EXPERT_BYTES + (size_t)u.pn * (256 * 2) * g.ldb; }
    __device__ __forceinline__ unsigned row_off(const pg8::Gemm& g, const pg8::Unit& u, int row) const { return (unsigned)slot_tok[(tile0 + u.pm) * 256 + row] * (unsigned)(g.lda * 2); }
};
struct MoeDownOrder : pg8::StaticOrder {
    int tile0; const volatile LAS int* te; const char* wbase;
    __device__ __forceinline__ const char* b_ptr(const pg8::Gemm& g, const pg8::Unit& u) const { const int e = __builtin_amdgcn_readfirstlane(te[tile0 + u.pm]); return wbase + (size_t)e * EXPERT_BYTES + (size_t)u.pn * (256 * 2) * g.ldb; }
};
__device__ __forceinline__ float wave_max_abs(const float* g, int n, int lane) {
    float v = lane < n ? fabsf(g[lane]) : 0.f; if (lane + 64 < n) v = fmaxf(v, fabsf(g[lane + 64]));
    return wave_max(v);
}
__device__ __forceinline__ v2u tail_row(const float* P, int rows, int r, int q, float sc) {
    f32x4 s = *((const GAS f32x4*)(P + (size_t)r * DM) + q);
#pragma unroll
    for (int z = 1; z < 7; ++z) s += *((const GAS f32x4*)(P + ((size_t)z * rows + r) * DM) + q);
    v2u o; o.x = pk2(s.x * sc, s.y * sc); o.y = pk2(s.z * sc, s.w * sc); return o;
}
struct TailDownOrder : pg8::StaticOrder {
    const volatile LAS int* te; const char* wbase;
    __device__ __forceinline__ bool next(int i, pg8::Unit& u) const { const int L = i * G + c; if (L >= nwg * 7) return false; u.z = L % 7; const int t = L / 7; u.pn = __builtin_amdgcn_readfirstlane(t % nN); u.pm = __builtin_amdgcn_readfirstlane(t / nN); return true; }
    __device__ __forceinline__ const char* a_ptr(const pg8::Gemm& g, const pg8::Unit& u) const { return (const char*)g.A + (size_t)u.pm * (256 * 2) * g.lda + (size_t)u.z * 512; }
    __device__ __forceinline__ const char* b_ptr(const pg8::Gemm& g, const pg8::Unit& u) const { const int e = __builtin_amdgcn_readfirstlane(te[256 + u.pm]); return wbase + (size_t)e * EXPERT_BYTES + (size_t)u.pn * (256 * 2) * g.ldb + (size_t)u.z * 512; }
};
struct EpiPartF32 {
    static constexpr bool PERM = false;
    float* P; int rows;
    __device__ __forceinline__ bool keep(const pg8::Unit&) const { return false; }
    __device__ __forceinline__ void operator()(const pg8::f32x4 (&acc)[2][2][4][2], const pg8::Unit& u, int wr, int wc, int fr, int fq) const {
        const int row0 = u.pm * 256 + wr * 64 + fr, col0 = u.pn * 256 + wc * 32 + 4 * fq;
        GAS float* pb = (GAS float*)(P + ((size_t)u.z * rows + row0) * DM + col0);
#pragma unroll
        for (int ai = 0; ai < 2; ++ai)
#pragma unroll
            for (int m = 0; m < 4; ++m)
#pragma unroll
                for (int bj = 0; bj < 2; ++bj)
#pragma unroll
                    for (int n = 0; n < 2; ++n) *(GAS pg8::f32x4*)(pb + (size_t)(ai * 128 + m * 16) * DM + bj * 128 + n * 16) = acc[ai][bj][m][n];
    }
};
struct EpiMerge {
    static constexpr bool PERM = true;
    const unsigned char* Gq;
    bf16* Mg;
    __device__ __forceinline__ bool keep(const pg8::Unit& u) const { return u.z < 3; }
    __device__ __forceinline__ void operator()(pg8::f32x4 (&acc)[2][2][4][2], const pg8::Unit& u, int wr, int wc, int fr, int fq) const {
        const int row0 = u.pm * 256 + wr * 64 + fr, col0 = u.pn * 256 + wc * 32 + 8 * fq, z = u.z;
#pragma unroll
        for (int ai = 0; ai < 2; ++ai)
#pragma unroll
            for (int mp = 0; mp < 2; ++mp) {
                const GAS unsigned char* gb = (const GAS unsigned char*)(Gq + ((size_t)(u.pm * 16 + u.pn) << 16) + ((wr * 4 + wc) << 13) + (fq * 16 + fr) * 8);
                asm volatile("" : "+v"(gb));
                v2u gn[2][2], gd[2][2];
#pragma unroll
                for (int mm = 0; mm < 2; ++mm)
#pragma unroll
                    for (int bj = 0; bj < 2; ++bj) { const int m = 2 * mp + mm; const GAS unsigned char* gp = gb + (((ai * 4 + m) * 2 + bj) << 9);
                        gn[mm][bj] = *(const GAS v2u*)(gp + ((size_t)(z * 4) << 16)); if (z < 3) gd[mm][bj] = *(const GAS v2u*)(gp + ((size_t)(z * 4 + 4) << 16)); }
#pragma unroll
                for (int mm = 0; mm < 2; ++mm)
#pragma unroll
                    for (int bj = 0; bj < 2; ++bj) { const int m = 2 * mp + mm; const v2u g = gn[mm][bj];
                        float f[8];
#pragma unroll
                        for (int e = 0; e < 8; ++e) f[e] = (float)(((e < 4 ? g.x : g.y) >> (8 * (e & 3))) & 0xffu);
                        if (z < 3) { const v2u d = gd[mm][bj];
#pragma unroll
                            for (int e = 0; e < 8; ++e) f[e] *= __builtin_amdgcn_rcpf((float)(((e < 4 ? d.x : d.y) >> (8 * (e & 3))) & 0xffu)); }
                        else {
#pragma unroll
                            for (int e = 0; e < 8; ++e) f[e] *= (1.0f / 255.0f); }
                        pg8::f32x4& v0 = acc[ai][bj][m][0]; pg8::f32x4& v1 = acc[ai][bj][m][1];
                        v0[0] *= f[0]; v0[1] *= f[1]; v0[2] *= f[2]; v0[3] *= f[3]; v1[0] *= f[4]; v1[1] *= f[5]; v1[2] *= f[6]; v1[3] *= f[7];
                        if (z == 3) { v4u w; w.x = pg8::cvt_pk_bf16(v0[0], v0[1]); w.y = pg8::cvt_pk_bf16(v0[2], v0[3]); w.z = pg8::cvt_pk_bf16(v1[0], v1[1]); w.w = pg8::cvt_pk_bf16(v1[2], v1[3]);
                            *(GAS v4u*)(Mg + (size_t)(row0 + ai * 128 + m * 16) * 1024 + col0 + bj * 128) = w; } }
                asm volatile("" ::: "memory");
            }
    }
};

__global__ void __launch_bounds__(NWAVES * 64, 2) fwd(Args args) {
    extern __shared__ __attribute__((aligned(16))) unsigned char lds_raw[];
    LAS unsigned char* lds = (LAS unsigned char*)lds_raw;
    volatile LAS unsigned* MISC = (volatile LAS unsigned*)(lds + MISC_OFF);
    const int tid = threadIdx.x; const int wave0 = __builtin_amdgcn_readfirstlane(tid >> 6);
    constexpr int G = 256; const int bx = blockIdx.x; const int vcu = (bx % 8) * (G / 8) + bx / 8;
    unsigned char* ws = args.ws;
    gu32* ctl = (gu32*)(ws + WS_CTL);
    for (int u = tid; u < (LDS_BYTES - LDSCTL_OFF) / 4; u += NWAVES * 64) ((LAS unsigned*)(lds + LDSCTL_OFF))[u] = 0u;
    __syncthreads();
    XcdBarrier bar = xcd_barrier_post((unsigned*)(ctl + CW_BAR), MISC + 8, wave0);
    float* out = args.out;
    if (tid < N_IN) ((LAS unsigned long long*)(lds + PTAB_OFF))[tid] = (unsigned long long)args.in[tid];
    __syncthreads();
#define PHASE_PTRS unsigned char* wsp = launder(ws); int lane = lane_id(); asm volatile("" : "+v"(lane)); int wave = wave0; asm volatile("" : "+s"(wave)); \
    const int gw = vcu * NWAVES + wave, NGW = G * NWAVES; const int gt = gw * 64 + lane, NGT = NGW * 64; LAS float* scr = (LAS float*)(lds + RING_OFF + wave * 16384); \
    (void)gw; (void)NGW; (void)gt; (void)NGT; (void)scr; \
    bf16* HB = (bf16*)(wsp + WS_HB); bf16* RAW = (bf16*)(wsp + WS_RAW); bf16* GT = (bf16*)(wsp + WS_G); \
    bf16* MLARAW = (bf16*)(wsp + WS_MLARAW); bf16* KMLA = (bf16*)(wsp + WS_KMLA); bf16* ODIFF = (bf16*)(wsp + WS_ODIFF); bf16* LATN = (bf16*)(wsp + WS_LATN); \
    bf16* MEMKV = (bf16*)(wsp + WS_MEMKV); bf16* MEMN = (bf16*)(wsp + WS_MEMN); \
    bf16* W13t = (bf16*)(wsp + WS_FW); bf16* W2t = W13t + (size_t)2 * FF * DM; bf16* U = (bf16*)(wsp + WS_U); \
    unsigned char* aw = wsp + WS_AW; const float* tab = (const float*)(wsp + WS_TAB); \
    (void)HB; (void)RAW; (void)GT; (void)MLARAW; (void)KMLA; (void)ODIFF; (void)LATN; (void)MEMKV; (void)MEMN; (void)W13t; (void)W2t; (void)U; (void)aw; (void)tab

#pragma unroll 1
    for (int l = 0; l < DEPTH; ++l) {
        const float lambda_init = (l == 0) ? 0.2f : (0.8f - 0.6f * 0.74081822068171788f);
        {
            PHASE_PTRS;
            for (int it = gw; it < AI_TOTAL; it += NGW) attn_weight_item(it, l, lds, aw, scr, lane);
            unsigned zz_ = 0u; asm volatile("" : "+v"(zz_)); const v4u zero4 = {zz_, zz_, zz_, zz_};
            for (int c = gt; c < 96 * 128; c += NGT) *(GAS v4u*)(aw + AW_IN + (size_t)1952 * DM * 2 + (size_t)c * 16) = zero4;
            for (int c = gt; c < 1024 * 16; c += NGT) *(GAS v4u*)(aw + AW_KVUP + (size_t)(c >> 4) * 512 + 256 + (c & 15) * 16) = zero4;
            if (l == 0) rms_rows_to_bf16<true>(IN(I_X), IN(I_NORM_ATTN_G), (bf16*)(wsp + WS_HBA), M, gw, NGW, lane, wsp + WS_HB8, S_H8);
            else rms_rows_to_bf16<true, true, true>((const float*)(wsp + WS_XB), IN(I_NORM_ATTN_G) + DM, (bf16*)(wsp + WS_HBA), M, gw, NGW, lane, wsp + WS_HB8, S_H8);
            rms_rows_to_bf16(IN(I_MEM), IN(I_NORM_MEM_G) + l * DM, MEMN, MMEM, gw, NGW, lane);
            if (l == 0) {
                float* tw = (float*)(wsp + WS_TAB);
                for (int e = gt; e < 2048 * 32; e += NGT) rope_entry(e >> 5, e & 31, 64, tw + T_DC / 4 + e, tw + T_DS / 4 + e);
                for (int e = gt; e < 2048 * 16; e += NGT) rope_entry(e >> 4, e & 15, 32, tw + T_MC / 4 + e, tw + T_MS / 4 + e);
                for (int e = gt; e < 2048 * 64; e += NGT) rope_entry(e >> 6, e & 63, 128, tw + T_QC / 4 + e, tw + T_QS / 4 + e);
                for (int e = gt; e < 32 * 16; e += NGT) rope_entry(e >> 4, e & 15, 32, tw + T_RC / 4 + e, tw + T_RS / 4 + e);
                for (int e = gt; e < 64 * 16; e += NGT) rope_entry(e >> 4, e & 15, 32, tw + T_CC / 4 + e, tw + T_CS / 4 + e);
            }
        }
        xcd_barrier(bar, wave0);
        {
            PHASE_PTRS;
            pg8::Gemm g{(const bf16*)(wsp + WS_HBA), (const bf16*)(aw + AW_IN), DM, DM, DM}; pg8::StaticOrder S; S.init(M / 256, RAWW / 256, G, bx);
            pg8::EpiBf16 E{RAW, RAWW};
            pg8::gemm_phase<pg8::EpiBf16, pg8::StaticOrder, true, false>(lds + RING_OFF, g, S, E, wave0);
            pg8::Gemm g2{MEMN, (const bf16*)(aw + AW_MEMKV), DM, DM, DM}; pg8::StaticOrder S2; S2.init(MMEM / 256, DM / 256, G, (bx + G / 2) % G);
            pg8::EpiBf16 E2{MEMKV, DM};
            pg8::gemm_phase<pg8::EpiBf16, pg8::StaticOrder, true, false>(lds + RING_OFF, g2, S2, E2, wave0);
        }
        xcd_barrier(bar, wave0);
        {
            PHASE_PTRS;
            const int j32 = lane & 31, hh = lane >> 3, j8 = lane & 7;
            const f32x4 gdk0 = *(const GAS f32x4*)(IN(I_DK_G) + l * 64 + 4 * j8), gdk1 = *(const GAS f32x4*)(IN(I_DK_G) + l * 64 + 32 + 4 * j8);
            const f32x2 ggk = *((const f32x2*)(IN(I_GQA_K_G) + l * 64) + j32);
            const f32x2 gmk = *((const f32x2*)(IN(I_MEM_K_G) + l * 128) + lane);
            const f32x2 gql0 = *((const f32x2*)(IN(I_MLA_QLAT_G) + l * 256) + lane), gql1 = *((const f32x2*)(IN(I_MLA_QLAT_G) + l * 256 + 128) + lane), gkl = *((const f32x2*)(IN(I_MLA_KVLAT_G) + l * 128) + lane);
            const int fa = (2 * j32) & 15, fm = (2 * lane) & 63; const bool ablk1 = (2 * j32) >= 32;
#define T1_LOAD(K0_, K1_, W_, DC_, DS_, AC_, AS_, mm) do { const int pos_ = (mm) & (SEQ - 1), grow_ = pos_ >> 6, gcol_ = pos_ & 63; const GAS unsigned* rp_ = (const GAS unsigned*)(RAW + (size_t)(mm) * RAWW) + lane; \
                K0_ = *(const GAS v2u*)(RAW + (size_t)(mm) * RAWW + C_DK + 64 * hh + 4 * j8); K1_ = *(const GAS v2u*)(RAW + (size_t)(mm) * RAWW + C_DK + 64 * hh + 32 + 4 * j8); \
                W_[0] = rp_[64 * 12]; W_[1] = rp_[64 * 13]; W_[2] = rp_[64 * 14]; W_[3] = rp_[64 * 20]; \
                DC_ = *(const GAS f32x4*)(tab + T_DC / 4 + pos_ * 32 + 4 * j8); DS_ = *(const GAS f32x4*)(tab + T_DS / 4 + pos_ * 32 + 4 * j8); \
                AC_ = *(const GAS f32x2*)(tab + (ablk1 ? T_CC / 4 + gcol_ * 16 : T_RC / 4 + grow_ * 16) + fa); AS_ = *(const GAS f32x2*)(tab + (ablk1 ? T_CS / 4 + gcol_ * 16 : T_RS / 4 + grow_ * 16) + fa); } while (0)
            v2u k0, k1, k0n, k1n; unsigned w[4], wn[4]; f32x4 dc, ds, dcn, dsn; f32x2 ac, as, acn, asn;
            T1_LOAD(k0, k1, w, dc, ds, ac, as, gw);
            k0n = k0; k1n = k1; dcn = dc; dsn = ds; acn = ac; asn = as;
#pragma unroll
            for (int c = 0; c < 4; ++c) wn[c] = w[c];
            for (int m = gw; m < M; m += NGW) {
                if (m + NGW < M) { T1_LOAD(k0n, k1n, wn, dcn, dsn, acn, asn, m + NGW); }
                v2u o0, o1;
                { float a[4] = {bflo(k0.x), bfhi(k0.x), bflo(k0.y), bfhi(k0.y)}, b[4] = {bflo(k1.x), bfhi(k1.x), bflo(k1.y), bfhi(k1.y)};
                  float ss = 0.f;
#pragma unroll
                  for (int i = 0; i < 4; ++i) ss += a[i] * a[i] + b[i] * b[i];
                  const float rstd = __builtin_amdgcn_rsqf(sum8(ss) * (1.f / 64.f) + NEPS);
                  float y0[4], y1[4];
#pragma unroll
                  for (int i = 0; i < 4; ++i) { const float p = a[i] * rstd * gdk0[i], q = b[i] * rstd * gdk1[i]; y0[i] = p * dc[i] - q * ds[i]; y1[i] = q * dc[i] + p * ds[i]; }
                  o0.x = pk2(y0[0], y0[1]); o0.y = pk2(y0[2], y0[3]); o1.x = pk2(y1[0], y1[1]); o1.y = pk2(y1[2], y1[3]); }
                const unsigned wg = head_apply<64, 2>(w[3], ggk, ac, as, lane);
                unsigned l0, l1, l2;
                { const float a0 = bflo(w[0]), a1 = bfhi(w[0]), a2 = bflo(w[1]), a3 = bfhi(w[1]);
                  const float rstd = __builtin_amdgcn_rsqf(wave_sum(a0 * a0 + a1 * a1 + a2 * a2 + a3 * a3) * (1.f / 256.f) + NEPS);
                  l0 = pk2(a0 * rstd * gql0.x, a1 * rstd * gql0.y); l1 = pk2(a2 * rstd * gql1.x, a3 * rstd * gql1.y); }
                { const float a0 = bflo(w[2]), a1 = bfhi(w[2]);
                  const float rstd = __builtin_amdgcn_rsqf(wave_sum(a0 * a0 + a1 * a1) * (1.f / 128.f) + NEPS); l2 = pk2(a0 * rstd * gkl.x, a1 * rstd * gkl.y); }
                GAS bf16* kp = (GAS bf16*)(RAW + (size_t)m * RAWW + C_DK + 64 * hh + 4 * j8);
                *(GAS v2u*)kp = o0; *(GAS v2u*)(kp + 32) = o1;
                ((GAS unsigned*)(RAW + (size_t)m * RAWW) + lane)[64 * 20] = wg;
                GAS unsigned* lp = (GAS unsigned*)(LATN + (size_t)m * 512) + lane;
                lp[0] = l0; lp[64] = l1; lp[128] = l2; lp[192] = 0u;
                k0 = k0n; k1 = k1n; dc = dcn; ds = dsn; ac = acn; as = asn;
#pragma unroll
                for (int c = 0; c < 4; ++c) w[c] = wn[c];
            }
#undef T1_LOAD
            for (int m = gw; m < MMEM; m += NGW) {
                const int pos = m & (MEML - 1);
                GAS unsigned* kp = (GAS unsigned*)(MEMKV + (size_t)m * DM) + lane;
                unsigned w[4];
#pragma unroll
                for (int h = 0; h < 4; ++h) w[h] = kp[128 * h];
                const f32x2 qc = *(const GAS f32x2*)(tab + T_QC / 4 + pos * 64 + fm), qs = *(const GAS f32x2*)(tab + T_QS / 4 + pos * 64 + fm);
#pragma unroll
                for (int h = 0; h < 4; ++h) w[h] = head_apply<128, 1>(w[h], gmk, qc, qs, lane);
#pragma unroll
                for (int h = 0; h < 4; ++h) kp[128 * h] = w[h];
            }
        }
        xcd_barrier(bar, wave0);
        {
            PHASE_PTRS;
            pg8::Gemm g{LATN, nullptr, 512, 256, 256}; UpOrder S; S.init(M / 256, 7, G, bx); S.wq = (const bf16*)(aw + AW_QUP); S.wkv = (const bf16*)(aw + AW_KVUP);
            pg8::EpiBf16 E{MLARAW, MLAW};
            pg8::gemm_phase<pg8::EpiBf16, UpOrder, true, false>(lds + RING_OFF, g, S, E, wave0);
        }
        xcd_barrier(bar, wave0);
        {
            PHASE_PTRS;
            const int hh = lane >> 3, j = lane & 7;
            const float* gkp = IN(I_MLA_K_G) + l * 96;
            const f32x4 gn0 = *(const GAS f32x4*)(gkp + 8 * j), gn1 = *(const GAS f32x4*)(gkp + 8 * j + 4), gr = *(const GAS f32x4*)(gkp + 64 + 4 * j);
            const bool first = j < 4;
#define T2_LOAD(KN_, KR_, MC_, MS_, mm) do { const int pos_ = (mm) & (SEQ - 1); \
                KN_ = *(const GAS v4u*)(MLARAW + (size_t)(mm) * MLAW + 768 + 128 * hh + 8 * j); KR_ = *(const GAS v2u*)(RAW + (size_t)(mm) * RAWW + C_KROPE + 4 * j); \
                MC_ = *(const GAS f32x4*)(tab + T_MC / 4 + pos_ * 16 + 4 * (j & 3)); MS_ = *(const GAS f32x4*)(tab + T_MS / 4 + pos_ * 16 + 4 * (j & 3)); } while (0)
            v4u kn, knn; v2u kr, krn; f32x4 mc, ms, mcn, msn;
            T2_LOAD(kn, kr, mc, ms, gw);
            knn = kn; krn = kr; mcn = mc; msn = ms;
            for (int m = gw; m < M; m += NGW) {
                if (m + NGW < M) { T2_LOAD(knn, krn, mcn, msn, m + NGW); }
                float a[8] = {bflo(kn.x), bfhi(kn.x), bflo(kn.y), bfhi(kn.y), bflo(kn.z), bfhi(kn.z), bflo(kn.w), bfhi(kn.w)};
                float r[4] = {bflo(kr.x), bfhi(kr.x), bflo(kr.y), bfhi(kr.y)};
                float ss = 0.f;
#pragma unroll
                for (int i = 0; i < 8; ++i) ss += a[i] * a[i];
#pragma unroll
                for (int i = 0; i < 4; ++i) ss += r[i] * r[i];
                ss = sum8(ss);
                const float rstd = __builtin_amdgcn_rsqf(ss * (1.f / 96.f) + NEPS);
                v4u on; on.x = pk2(a[0] * rstd * gn0.x, a[1] * rstd * gn0.y); on.y = pk2(a[2] * rstd * gn0.z, a[3] * rstd * gn0.w);
                on.z = pk2(a[4] * rstd * gn1.x, a[5] * rstd * gn1.y); on.w = pk2(a[6] * rstd * gn1.z, a[7] * rstd * gn1.w);
#pragma unroll
                for (int i = 0; i < 4; ++i) { r[i] = r[i] * rstd * gr[i]; }
                float y[4];
#pragma unroll
                for (int i = 0; i < 4; ++i) { const float pr = xshfl<4>(r[i]); y[i] = first ? (r[i] * mc[i] - pr * ms[i]) : (r[i] * mc[i] + pr * ms[i]); }
                v2u orp; orp.x = pk2(y[0], y[1]); orp.y = pk2(y[2], y[3]);
                GAS bf16* kp = (GAS bf16*)(KMLA + (size_t)m * 768 + 96 * hh);
                *(GAS v4u*)(kp + 8 * j) = on; *(GAS v2u*)(kp + 64 + 4 * j) = orp;
                kn = knn; kr = krn; mc = mcn; ms = msn;
            }
#undef T2_LOAD
        }
        xcd_barrier(bar, wave0);
        {
            PHASE_PTRS;
            LAS char* al = (LAS char*)(lds + RING_OFF);
            constexpr float L2E = 1.4426950408889634f;
#define NBOUND(c, gq, gk, n) __uint_as_float(__builtin_amdgcn_readfirstlane(__float_as_uint(-(c) * L2E * wave_max_abs((gq), (n), lane) * wave_max_abs((gk), (n), lane))))
            const float nb_diff = NBOUND(8.0f, IN(I_DQ_G) + l * 64, IN(I_DK_G) + l * 64, 64);
            const float nb_mla = NBOUND(9.797958971f, IN(I_MLA_Q_G) + l * 96, IN(I_MLA_K_G) + l * 96, 96);
            const float nb_gqa = NBOUND(8.0f, IN(I_GQA_Q_G) + l * 64, IN(I_GQA_K_G) + l * 64, 64);
            const float nb_mem = NBOUND(11.3137085f, IN(I_MEM_Q_G) + l * 128, IN(I_MEM_K_G) + l * 128, 128);
            const float* lp_ = IN(I_DLAMBDA) + l * 256;
            const float lam = __uint_as_float(__builtin_amdgcn_readfirstlane(__float_as_uint(expf(wave_sum(lp_[lane] * lp_[64 + lane])) - expf(wave_sum(lp_[128 + lane] * lp_[192 + lane])) + lambda_init)));
            for (int u = vcu; u < 512; u += G) {
                const int qb = u & 7, h = (u >> 3) & 3, b = u >> 5; const size_t r0 = (size_t)b * SEQ;
                const att::QPrep qp{IN(I_DQ_G) + l * 64, tab + T_DC / 4, tab + T_DS / 4, nullptr, nullptr, qb * 256};
                att::attn_unit<64, 128, 1, 1, 4>(RAW + (r0 + qb * 256) * RAWW + C_DQ + (2 * h) * 64, RAWW, RAW + r0 * RAWW + C_DK + (2 * h) * 64, RAWW, RAW + r0 * RAWW + C_DV + h * 128, RAWW,
                                                 ODIFF + (r0 + qb * 256) * 1024 + h * 128, 1024, SEQ, 0.125f * L2E, nb_diff, qp, al, wave0);
                const att::DiffEpi de{ODIFF + (r0 + qb * 256) * 1024 + h * 128, 1024, lam, IN(I_DSUBLN_G) + l * 128, l};
                att::attn_unit<64, 128, 1, 1, 4, true>(RAW + (r0 + qb * 256) * RAWW + C_DQ + (2 * h + 1) * 64, RAWW, RAW + r0 * RAWW + C_DK + (2 * h + 1) * 64, RAWW, RAW + r0 * RAWW + C_DV + h * 128, RAWW,
                                                       RAW + (r0 + qb * 256) * RAWW + C_OA + h * 128, RAWW, SEQ, 0.125f * L2E, nb_diff, qp, al, wave0, 1.0f, &de);
            }
            for (int u = vcu; u < 512; u += G) {
                const int qb = u & 3, h = (u >> 2) & 7, b = u >> 5; const size_t r0 = (size_t)b * SEQ;
                const att::QPrep qp{IN(I_MLA_Q_G) + l * 96, tab + T_MC / 4, tab + T_MS / 4, nullptr, nullptr, qb * 512};
                att::attn_unit2d<96, 3, true>(MLARAW + (r0 + qb * 512) * MLAW + h * 96, MLAW, KMLA + r0 * 768 + h * 96, 768, MLARAW + r0 * MLAW + 768 + h * 128 + 64, MLAW,
                                                  RAW + (r0 + qb * 512) * RAWW + C_OB + h * 64, RAWW, SEQ, 0.10206207261596575f * L2E, nb_mla, qp, al, wave0);
            }
            for (int u = vcu; u < 512; u += G) {
                const int qb = u & 3, qh = (u >> 2) & 7, b = u >> 5; const size_t r0 = (size_t)b * SEQ;
                const att::QPrep qp{IN(I_GQA_Q_G) + l * 64, tab + T_RC / 4, tab + T_RS / 4, tab + T_CC / 4, tab + T_CS / 4, qb * 512};
                att::attn_unit2d<64, 2>(RAW + (r0 + qb * 512) * RAWW + C_GQ + qh * 64, RAWW, RAW + r0 * RAWW + C_GK + (qh >> 2) * 64, RAWW, RAW + r0 * RAWW + C_GV + (qh >> 2) * 64, RAWW,
                                       RAW + (r0 + qb * 512) * RAWW + C_OC + qh * 64, RAWW, SEQ, 0.125f * L2E, nb_gqa, qp, al, wave0);
            }
            for (int u = vcu; u < 512; u += G) {
                const int qb = u & 7, h = (u >> 3) & 3, b = u >> 5; const size_t r0 = (size_t)b * SEQ;
                const att::QPrep qp{IN(I_MEM_Q_G) + l * 128, tab + T_QC / 4, tab + T_QS / 4, nullptr, nullptr, qb * 256};
                att::attn_unit<128, 128, 1, 1, 4>(RAW + (r0 + qb * 256) * RAWW + C_MEMQ + h * 128, RAWW, MEMKV + (size_t)b * MEML * DM + h * 256, DM, MEMKV + (size_t)b * MEML * DM + h * 256 + 128, DM,
                                               RAW + (r0 + qb * 256) * RAWW + C_OD + h * 128, RAWW, MEML, 0.08838834764831845f * L2E, nb_mem, qp, al, wave0);
            }
        }
        xcd_barrier(bar, wave0);
        {
            PHASE_PTRS;
            pg8::Gemm g{(const bf16*)(wsp + WS_HB8), (const bf16*)(aw + AW_GATE), DM / 2, DM / 2, DM / 2}; pg8::StaticOrder S; S.init(M / 256, 16, G, bx);
            pg8::EpiSigmoidU8 E{(unsigned char*)GT, 4096, IN(I_B_GATE) + l * 4096, 1.0f / (S_H8 * S_WG)};
            pg8::gemm_phase<pg8::EpiSigmoidU8, pg8::StaticOrder, true, false, true>(lds + RING_OFF, g, S, E, wave0);
        }
        xcd_barrier(bar, wave0);
        {
            PHASE_PTRS;
            pg8::Gemm g{RAW, (const bf16*)(aw + AW_BR), RAWW, 512, 512}; MergeOrder S; S.init(M / 256, 4, G, bx);
            EpiMerge E{(const unsigned char*)GT, (bf16*)(wsp + WS_MERGED)};
            pg8::gemm_phase<EpiMerge, MergeOrder, true, false>(lds + RING_OFF, g, S, E, wave0);
        }
        xcd_barrier(bar, wave0);
        {
            PHASE_PTRS;
            pg8::Gemm g{(const bf16*)(wsp + WS_MERGED), (const bf16*)(aw + AW_OUT), DM, DM, DM}; pg8::StaticOrder S; S.init(M / 256, 4, G, bx);
            if (l == 0) { pg8::EpiResidX<false, true> E{IN(I_X), wsp + WS_XB, DM};
                pg8::gemm_phase<pg8::EpiResidX<false, true>, pg8::StaticOrder, true, false>(lds + RING_OFF, g, S, E, wave0); }
            else { pg8::EpiResidX<true, true> E{wsp + WS_XB, wsp + WS_XB, DM};
                pg8::gemm_phase<pg8::EpiResidX<true, true>, pg8::StaticOrder, true, false>(lds + RING_OFF, g, S, E, wave0); }
        }
        xcd_barrier(bar, wave0);
        if (l == 0) {
            {
                PHASE_PTRS;
                for (int it = gw; it < FFN_ITEMS; it += NGW) ffn_weight_item(it, IN(I_DW1), IN(I_DW3), IN(I_DW2), W13t, W2t, scr, lane);
                rms_rows_to_bf16<false, true, true>((const float*)(wsp + WS_XB), IN(I_NORM_FFN_G), (bf16*)(wsp + WS_HBF), M, gw, NGW, lane);
            }
            xcd_barrier(bar, wave0);
            {
                PHASE_PTRS;
                pg8::Gemm g{(const bf16*)(wsp + WS_HBF), W13t, DM, DM, DM}; pg8::StaticOrder S; S.init(M / 256, 2 * FF / 256, G, bx);
                pg8::EpiSwiGLU E{U, FF, 0};
                pg8::gemm_phase<pg8::EpiSwiGLU, pg8::StaticOrder, true, false>(lds + RING_OFF, g, S, E, wave0);
            }
            xcd_barrier(bar, wave0);
            {
                PHASE_PTRS;
                pg8::Gemm g{U, W2t, FF, FF, FF}; pg8::StaticOrder S; S.init(M / 256, DM / 256, G, bx);
                pg8::EpiResidX<true, true> E{wsp + WS_XB, wsp + WS_XB, DM};
                pg8::gemm_phase<pg8::EpiResidX<true, true>, pg8::StaticOrder, true, false>(lds + RING_OFF, g, S, E, wave0);
            }
            xcd_barrier(bar, wave0);
        }

        if (l == 1) {
            {
                PHASE_PTRS;
                volatile LAS int* ml = (volatile LAS int*)(lds + MOE_LDS);
                int* slot_tok = (int*)(wsp + WS_MOE + MO_SLOT_TOK); float* tok_gate = (float*)(wsp + WS_MOE + MO_TOK_GATE); int* wgcnt = (int*)(wsp + WS_MOE + MO_WGCNT);
                for (int it = gw; it < NEXP * FFN_ITEMS; it += NGW) { const int e = it / FFN_ITEMS; unsigned char* w13 = (unsigned char*)W13t + (size_t)e * EXPERT_BYTES;
                    ffn_weight_item8(it % FFN_ITEMS, IN(I_MW1) + (size_t)e * DM * FF, IN(I_MW3) + (size_t)e * DM * FF, IN(I_MW2) + (size_t)e * FF * DM, w13, w13 + W2_OFF, scr, lane); }
                for (int c = gt; c < MOE_SLOTS; c += NGT) slot_tok[c] = 0;
                const float* wr_ = IN(I_ROUTER); const float* gf = IN(I_NORM_FFN_G) + DM;
                f32x4 rw[4][4][2];
#pragma unroll
                for (int j = 0; j < 4; ++j)
#pragma unroll
                    for (int q = 0; q < 4; ++q) { const GAS f32x4* rp = (const GAS f32x4*)(wr_ + (size_t)(4 * (lane + 64 * j) + q) * 8); rw[j][q][0] = rp[0]; rw[j][q][1] = rp[1]; }
                f32x4 v[4], vn[4], ggv[4];
#pragma unroll
                for (int j = 0; j < 4; ++j) ggv[j] = ((const GAS f32x4*)gf + lane)[64 * j];
                { const float* xb_ = (const float*)(wsp + WS_XB);
#pragma unroll
                  for (int j = 0; j < 4; ++j) { v[j] = rr_load<true>(xb_, vcu * 128 + wave * 16, lane, j); vn[j] = v[j]; } }
                for (int i = 0; i < 16; ++i) {
                    const int tl = wave * 16 + i, t = vcu * 128 + tl;
                    if (i + 1 < 16) { const float* xb_ = (const float*)(wsp + WS_XB);
#pragma unroll
                        for (int j = 0; j < 4; ++j) vn[j] = rr_load<true>(xb_, t + 1, lane, j); }
                    float s = 0.f;
#pragma unroll
                    for (int j = 0; j < 4; ++j) { s += (v[j].x * v[j].x + v[j].y * v[j].y) + (v[j].z * v[j].z + v[j].w * v[j].w); }
                    const float rstd = __builtin_amdgcn_rsqf(wave_sum(s) * (1.f / DM) + NEPS);
                    GAS unsigned* o4 = (GAS unsigned*)(wsp + WS_HBM8 + (size_t)t * DM) + lane;
                    float lg[8] = {0.f, 0.f, 0.f, 0.f, 0.f, 0.f, 0.f, 0.f};
#pragma unroll
                    for (int j = 0; j < 4; ++j) { const f32x4 gg = ggv[j]; const float h0 = v[j].x * rstd * gg.x, h1 = v[j].y * rstd * gg.y, h2 = v[j].z * rstd * gg.z, h3 = v[j].w * rstd * gg.w;
                        o4[64 * j] = pg8::cvt4_fp8(h0 * S_H8, h1 * S_H8, h2 * S_H8, h3 * S_H8);
#pragma unroll
                        for (int e = 0; e < 8; ++e) lg[e] += h0 * rw[j][0][e >> 2][e & 3] + h1 * rw[j][1][e >> 2][e & 3] + h2 * rw[j][2][e >> 2][e & 3] + h3 * rw[j][3][e >> 2][e & 3]; }
#pragma unroll
                    for (int e = 0; e < 8; ++e) lg[e] = wave_sum(lg[e]);
                    int e1 = 0; float l1 = lg[0];
#pragma unroll
                    for (int e = 1; e < 8; ++e) if (lg[e] > l1) { l1 = lg[e]; e1 = e; }
                    int e2 = -1; float l2 = -3.0e38f;
#pragma unroll
                    for (int e = 0; e < 8; ++e) if (e != e1 && lg[e] > l2) { l2 = lg[e]; e2 = e; }
                    const float ex = expf(l2 - l1), g1 = 1.0f / (1.0f + ex), g2 = ex / (1.0f + ex);
                    if (lane == 0) { ml[ML_SEL + 2 * tl] = e1; ml[ML_SEL + 2 * tl + 1] = e2; tok_gate[2 * t] = g1; tok_gate[2 * t + 1] = g2; }
#pragma unroll
                    for (int j = 0; j < 4; ++j) v[j] = vn[j];
                }
                LDS_WAIT(); __syncthreads();
                if (wave == 0) {
                    int base[8] = {0, 0, 0, 0, 0, 0, 0, 0}; const unsigned long long lt = (1ull << lane) - 1ull;
#pragma unroll
                    for (int j = 0; j < 4; ++j) { const int a = 64 * j + lane, e = ml[ML_SEL + a]; int r = 0;
#pragma unroll
                        for (int ee = 0; ee < 8; ++ee) { const unsigned long long mk = __ballot(e == ee); if (e == ee) r = base[ee] + __popcll(mk & lt); base[ee] += __popcll(mk); }
                        ml[ML_RNK + a] = r; }
                    int cv = 0;
#pragma unroll
                    for (int ee = 0; ee < 8; ++ee) if (lane == ee) cv = base[ee];
                    if (lane < 8) wgcnt[vcu * 8 + lane] = cv;
                }
            }
            xcd_barrier(bar, wave0);
            {
                PHASE_PTRS;
                volatile LAS int* ml = (volatile LAS int*)(lds + MOE_LDS);
                int* slot_tok = (int*)(wsp + WS_MOE + MO_SLOT_TOK); int* tok_slot = (int*)(wsp + WS_MOE + MO_TOK_SLOT); const int* wgcnt = (const int*)(wsp + WS_MOE + MO_WGCNT);
                { int s = 0, p = 0;
#pragma unroll
                  for (int q = 0; q < 4; ++q) { const int w = 4 * lane + q; const int c = wgcnt[w * 8 + wave]; s += c; if (w < vcu) p += c; }
                  s = wave_sum_i(s); p = wave_sum_i(p);
                  if (lane == 0) { ml[ML_TOT + wave] = s; ml[ML_PRE + wave] = p; } }
                LDS_WAIT(); __syncthreads();
                if (wave == 0 && lane == 0) { int b = 0; for (int e = 0; e < 8; ++e) { ml[ML_SEGB + e] = b; b += (ml[ML_TOT + e] + 255) & ~255; } ml[ML_SEGB + 8] = b; }
                LDS_WAIT(); __syncthreads();
                { const int a = wave * 64 + lane;
                  if (a < 272) { int e = 0;
#pragma unroll
                      for (int q = 1; q < 8; ++q) if (ml[ML_SEGB + q] <= 256 * a) e = q;
                      ml[ML_TE + a] = e; }
                  if (a < 256) { const int e = ml[ML_SEL + a], slot = ml[ML_SEGB + e] + ml[ML_PRE + e] + ml[ML_RNK + a], t = vcu * 128 + (a >> 1);
                      slot_tok[slot] = t; tok_slot[2 * t + (a & 1)] = slot; } }
                LDS_WAIT(); __syncthreads();
                for (int i = 0; i < 32; i += 4) {
                    v4u r[4]; int sl[4];
#pragma unroll
                    for (int q = 0; q < 4; ++q) { const int a = wave * 32 + i + q, e = ml[ML_SEL + a]; sl[q] = ml[ML_SEGB + e] + ml[ML_PRE + e] + ml[ML_RNK + a];
                        r[q] = *((const GAS v4u*)(wsp + WS_HBM8 + (size_t)(vcu * 128 + (a >> 1)) * DM) + lane); }
#pragma unroll
                    for (int q = 0; q < 4; ++q) *((GAS v4u*)(wsp + WS_XS8 + (size_t)sl[q] * DM) + lane) = r[q];
                }
            }
            xcd_barrier(bar, wave0);
            const int n_tiles = __builtin_amdgcn_readfirstlane(((volatile LAS int*)(lds + MOE_LDS))[ML_SEGB + 8]) >> 8;
            const int n_full = n_tiles < 256 ? n_tiles : 256, n_tail = n_tiles - n_full;
#pragma unroll 1
            for (int ch = 0; ch * MOE_CHUNK_TILES < n_full; ++ch) {
                const int tile0 = ch * MOE_CHUNK_TILES, nt_c = (n_full - tile0) < MOE_CHUNK_TILES ? (n_full - tile0) : MOE_CHUNK_TILES;
                {
                    PHASE_PTRS;
                    pg8::Gemm g{(const bf16*)(wsp + WS_XS8 + (size_t)tile0 * 256 * DM), nullptr, DM / 2, DM / 2, DM / 2}; MoeDownOrder S; S.init(nt_c, 2 * FF / 256, G, bx);
                    S.tile0 = tile0; S.te = (const volatile LAS int*)(lds + MOE_LDS) + ML_TE; S.wbase = (const char*)W13t;
                    pg8::EpiSwiGLU8 E{wsp + WS_UM, FF, 1.0f / (S_H8 * S_W13), S_U8};
                    pg8::gemm_phase<pg8::EpiSwiGLU8, MoeDownOrder, true, false, true>(lds + RING_OFF, g, S, E, wave0);
                }
                xcd_barrier(bar, wave0);
                {
                    PHASE_PTRS;
                    pg8::Gemm g{(const bf16*)(wsp + WS_UM), nullptr, FF / 2, FF / 2, FF / 2}; MoeDownOrder S; S.init(nt_c, DM / 256, G, bx);
                    S.tile0 = tile0; S.te = (const volatile LAS int*)(lds + MOE_LDS) + ML_TE; S.wbase = (const char*)W13t + W2_OFF;
                    pg8::EpiBf16 E{(bf16*)(wsp + WS_Y) + (size_t)tile0 * 256 * DM, DM, 1.0f / (S_U8 * S_W2)};
                    pg8::gemm_phase<pg8::EpiBf16, MoeDownOrder, true, false, true>(lds + RING_OFF, g, S, E, wave0);
                }
                xcd_barrier(bar, wave0);
            }
            if (n_tail > 0) {
                {
                    PHASE_PTRS;
                    pg8::Gemm g{(const bf16*)(wsp + WS_XS8 + (size_t)256 * 256 * DM), nullptr, DM / 2, DM / 2, DM / 2}; MoeDownOrder S; S.init(n_tail, 2 * FF / 256, G, bx);
                    S.tile0 = 256; S.te = (const volatile LAS int*)(lds + MOE_LDS) + ML_TE; S.wbase = (const char*)W13t;
                    pg8::EpiSwiGLU8 E{wsp + WS_UM, FF, 1.0f / (S_H8 * S_W13), S_U8};
                    pg8::gemm_phase<pg8::EpiSwiGLU8, MoeDownOrder, true, false, true>(lds + RING_OFF, g, S, E, wave0);
                }
                xcd_barrier(bar, wave0);
                {
                    PHASE_PTRS;
                    pg8::Gemm g{(const bf16*)(wsp + WS_UM), nullptr, FF / 2, FF / 2, 256}; TailDownOrder S; S.init(n_tail, DM / 256, G, bx);
                    S.te = (const volatile LAS int*)(lds + MOE_LDS) + ML_TE; S.wbase = (const char*)W13t + W2_OFF;
                    EpiPartF32 E{(float*)(wsp + WS_TAILP), n_tail * 256};
                    pg8::gemm_phase<EpiPartF32, TailDownOrder, true, false, true>(lds + RING_OFF, g, S, E, wave0);
                }
                xcd_barrier(bar, wave0);
            }
            {
                PHASE_PTRS;
                const int* tok_slot = (const int*)(wsp + WS_MOE + MO_TOK_SLOT); const float* tok_gate = (const float*)(wsp + WS_MOE + MO_TOK_GATE); const bf16* Y = (const bf16*)(wsp + WS_Y);
#define MC_IDX(S1_, S2_, G1_, G2_, tt) do { const int t_ = (tt) < M ? (tt) : gw; S1_ = tok_slot[2 * t_]; S2_ = tok_slot[2 * t_ + 1]; G1_ = tok_gate[2 * t_]; G2_ = tok_gate[2 * t_ + 1]; } while (0)
#define MC_ROWS(X_, A_, B_, S1_, S2_, tt) do { const int t_ = (tt) < M ? (tt) : gw; \
                    const GAS v2u* y1_ = (const GAS v2u*)(Y + (size_t)(S1_) * DM) + lane; const GAS v2u* y2_ = (const GAS v2u*)(Y + (size_t)(S2_) * DM) + lane; \
                    _Pragma("unroll") for (int j = 0; j < 4; ++j) { X_[j] = rr_load<true>(XBp, t_, lane, j); A_[j] = (S1_) >= 65536 ? tail_row(PT, n_tail * 256, (S1_) - 65536, lane + 64 * j, TSC) : y1_[64 * j]; B_[j] = (S2_) >= 65536 ? tail_row(PT, n_tail * 256, (S2_) - 65536, lane + 64 * j, TSC) : y2_[64 * j]; } } while (0)
                const float* PT = (const float*)(wsp + WS_TAILP); const float* XBp = (const float*)(wsp + WS_XB); constexpr float TSC = 1.0f / (S_U8 * S_W2);
                int s1a, s2a, s1b, s2b, s1c, s2c; float g1a, g2a, g1b, g2b, g1c, g2c; f32x4 xc[4], xn[4]; v2u ac[4], bc[4], an[4], bn[4];
                MC_IDX(s1a, s2a, g1a, g2a, gw); MC_IDX(s1b, s2b, g1b, g2b, gw + NGW);
                MC_ROWS(xc, ac, bc, s1a, s2a, gw);
                for (int t = gw; t < M; t += NGW) {
                    MC_IDX(s1c, s2c, g1c, g2c, t + 2 * NGW);
                    MC_ROWS(xn, an, bn, s1b, s2b, t + NGW);
                    GAS f32x4* xr = (GAS f32x4*)(out + (size_t)t * DM) + lane;
#pragma unroll
                    for (int j = 0; j < 4; ++j) { f32x4 x = xc[j]; const v2u a = ac[j], b = bc[j];
                        x.x += g1a * bflo(a.x) + g2a * bflo(b.x); x.y += g1a * bfhi(a.x) + g2a * bfhi(b.x); x.z += g1a * bflo(a.y) + g2a * bflo(b.y); x.w += g1a * bfhi(a.y) + g2a * bfhi(b.y);
                        xr[64 * j] = x; }
#pragma unroll
                    for (int j = 0; j < 4; ++j) { xc[j] = xn[j]; ac[j] = an[j]; bc[j] = bn[j]; }
                    s1a = s1b; s2a = s2b; g1a = g1b; g2a = g2b; s1b = s1c; s2b = s2c; g1b = g1c; g2b = g2c;
                }
#undef MC_IDX
#undef MC_ROWS
            }
        }
    }
}

extern "C" void kernel_launch(void* const* d_in, const int* in_sizes, int n_in, void* d_out, int out_size, void* d_ws, size_t ws_size, hipStream_t stream) {
    static int grid = 0;
    if (grid == 0) {
        if (n_in != N_IN || in_sizes[0] != M * DM || out_size != M * DM || ws_size < WS_END) { fprintf(stderr, "kernel_launch: shape/workspace mismatch (n_in %d, ws %zu)\n", n_in, ws_size); grid = -1; return; }
        int dev = 0, cus = 0;
        if (hipGetDevice(&dev) != hipSuccess || hipDeviceGetAttribute(&cus, hipDeviceAttributeMultiprocessorCount, dev) != hipSuccess) { grid = -1; return; }
        if (hipFuncSetAttribute((const void*)fwd, hipFuncAttributeMaxDynamicSharedMemorySize, LDS_BYTES) != hipSuccess) { grid = -1; return; }
        int per_cu = 0;
        if (hipOccupancyMaxActiveBlocksPerMultiprocessor(&per_cu, (const void*)fwd, NWAVES * 64, LDS_BYTES) != hipSuccess || per_cu < 1) { fprintf(stderr, "kernel_launch: occupancy query says %d\n", per_cu); }
        (void)hipGetLastError();
        if (cus != 256) { fprintf(stderr, "kernel_launch: built for 256 CUs, got %d\n", cus); grid = -1; return; }
        grid = cus;
    }
    if (grid < 0) return;
    if (hipMemsetAsync((char*)d_ws + WS_CTL, 0, CTL_ZERO_BYTES, stream) != hipSuccess) return;
    Args a{};
    for (int i = 0; i < N_IN; ++i) a.in[i] = (const float*)d_in[i];
    a.out = (float*)d_out; a.ws = (unsigned char*)d_ws;
    hipLaunchKernelGGL(fwd, dim3(grid), dim3(NWAVES * 64), LDS_BYTES, stream, a);
}
```
